# Optimizing an MI355X kernel written in HIP

```python
import jax, jax.numpy as jnp
from jax import lax
import numpy as np

D_MODEL = 2048
BATCH = 4
SEQ = 4096
DEPTH = 1

HEAD_DIM = 128
N_ATTN_HEADS = 8
ATTN_WIDTH = N_ATTN_HEADS * HEAD_DIM
CONV_WIDTH = D_MODEL - ATTN_WIDTH
CONV_GROUPS = CONV_WIDTH // HEAD_DIM
CONV_KSIZE = 3
IN_PROJ_WIDTH = 3 * ATTN_WIDTH + 3 * CONV_WIDTH

MOBA_BLOCK = 256
MOBA_TOPK = 3
QUERY_CHUNK = 32
ROPE_THETA = 10000.0

N_MEM = 256
N_XATTN_HEADS = 4
XATTN_HEAD_DIM = 128
XATTN_WIDTH = N_XATTN_HEADS * XATTN_HEAD_DIM

D_FF = -(-(8 * D_MODEL) // (3 * 256)) * 256
EPS = 1e-6

kernel_name = "hymba_moba_shortconv_hybrid_layer"


def rms_norm(x, g):
    xf = x.astype(jnp.float32)
    y = xf * lax.rsqrt(jnp.mean(xf * xf, axis=-1, keepdims=True) + EPS)
    return (y * g.astype(jnp.float32)).astype(x.dtype)


def rope_tables(positions):
    inv_freq = ROPE_THETA ** (-jnp.arange(0, HEAD_DIM, 2, dtype=jnp.float32) / HEAD_DIM)
    ang = positions.astype(jnp.float32)[..., None] * inv_freq
    return jnp.cos(ang), jnp.sin(ang)


def apply_rope(t, cos, sin):
    t1, t2 = jnp.split(t.astype(jnp.float32), 2, axis=-1)
    c = cos[:, :, None, :]
    s = sin[:, :, None, :]
    return jnp.concatenate([t1 * c - t2 * s, t2 * c + t1 * s], axis=-1).astype(t.dtype)


def moba_attention(q, k, v):
    bsz, n_h, s_len, hd = q.shape
    n_blk = -(-s_len // MOBA_BLOCK)
    s_pad = n_blk * MOBA_BLOCK
    top_k = min(MOBA_TOPK, n_blk)
    pad = ((0, 0), (0, 0), (0, s_pad - s_len), (0, 0))
    kp = jnp.pad(k, pad)
    vp = jnp.pad(v, pad)
    kb = kp.reshape(bsz, n_h, n_blk, MOBA_BLOCK, hd)
    vb = vp.reshape(bsz, n_h, n_blk, MOBA_BLOCK, hd)
    k_mean = jnp.mean(kb.astype(jnp.float32), axis=3)
    scale = hd ** -0.5
    b_idx = jnp.arange(bsz)[:, None, None, None]
    h_idx = jnp.arange(n_h)[None, :, None, None]
    blk_ids = jnp.arange(n_blk)
    key_off = jnp.arange(MOBA_BLOCK)

    def one_chunk(c):
        q0 = c * QUERY_CHUNK
        qc = lax.dynamic_slice_in_dim(q, q0, QUERY_CHUNK, axis=2)
        blk = q0 // MOBA_BLOCK
        qpos = q0 + jnp.arange(QUERY_CHUNK)
        gate = jnp.einsum('bhqd,bhnd->bhqn', qc.astype(jnp.float32), k_mean)
        gate = jnp.where(blk_ids < blk, gate, -jnp.inf)
        top_val, top_idx = lax.top_k(gate, top_k)
        sel_valid = jnp.isfinite(top_val)
        k_sel = kb[b_idx, h_idx, top_idx]
        v_sel = vb[b_idx, h_idx, top_idx]
        s_sel = jnp.einsum('bhqd,bhqrkd->bhqrk', qc, k_sel).astype(jnp.float32) * scale
        s_sel = jnp.where(sel_valid[..., None], s_sel, -jnp.inf)
        k_own = lax.dynamic_slice_in_dim(kp, blk * MOBA_BLOCK, MOBA_BLOCK, axis=2)
        v_own = lax.dynamic_slice_in_dim(vp, blk * MOBA_BLOCK, MOBA_BLOCK, axis=2)
        s_own = jnp.einsum('bhqd,bhkd->bhqk', qc, k_own).astype(jnp.float32) * scale
        kpos = blk * MOBA_BLOCK + key_off
        s_own = jnp.where(kpos[None, :] <= qpos[:, None], s_own, -jnp.inf)
        s_all = jnp.concatenate(
            [s_sel.reshape(bsz, n_h, QUERY_CHUNK, top_k * MOBA_BLOCK), s_own], axis=-1)
        p = jax.nn.softmax(s_all, axis=-1)
        p_sel = p[..., :top_k * MOBA_BLOCK].reshape(
            bsz, n_h, QUERY_CHUNK, top_k, MOBA_BLOCK).astype(v.dtype)
        p_own = p[..., top_k * MOBA_BLOCK:].astype(v.dtype)
        return (jnp.einsum('bhqrk,bhqrkd->bhqd', p_sel, v_sel)
                + jnp.einsum('bhqk,bhkd->bhqd', p_own, v_own))

    out = lax.map(one_chunk, jnp.arange(s_len // QUERY_CHUNK))
    return out.transpose(1, 2, 0, 3, 4).reshape(bsz, n_h, s_len, hd)


def short_conv(u, w_conv, b_conv):
    kern = w_conv[:, None, :].astype(u.dtype)
    y = lax.conv_general_dilated(
        u, kern, window_strides=(1,), padding=[(CONV_KSIZE - 1, 0)],
        dimension_numbers=('NWC', 'WIO', 'NWC'), feature_group_count=u.shape[-1])
    return y + b_conv


def hybrid_mixer(h, cos, sin, w_in, w_conv, b_conv, g_attn_out, g_conv_out, w_out):
    bsz, s_len, _ = h.shape
    proj = h @ w_in
    q, k, v, c_gate, b_gate, x_in = jnp.split(
        proj, np.cumsum([ATTN_WIDTH] * 3 + [CONV_WIDTH] * 2).tolist(), axis=-1)
    q = apply_rope(q.reshape(bsz, s_len, N_ATTN_HEADS, HEAD_DIM), cos, sin)
    k = apply_rope(k.reshape(bsz, s_len, N_ATTN_HEADS, HEAD_DIM), cos, sin)
    v = v.reshape(bsz, s_len, N_ATTN_HEADS, HEAD_DIM)
    o_attn = moba_attention(q.transpose(0, 2, 1, 3), k.transpose(0, 2, 1, 3),
                            v.transpose(0, 2, 1, 3)).transpose(0, 2, 1, 3)
    o_attn = rms_norm(o_attn, g_attn_out.reshape(N_ATTN_HEADS, HEAD_DIM))
    y_conv = b_gate * short_conv(c_gate * x_in, w_conv, b_conv)
    y_conv = rms_norm(y_conv.reshape(bsz, s_len, CONV_GROUPS, HEAD_DIM),
                      g_conv_out.reshape(CONV_GROUPS, HEAD_DIM))
    merged = jnp.concatenate([o_attn.reshape(bsz, s_len, ATTN_WIDTH),
                              y_conv.reshape(bsz, s_len, CONV_WIDTH)], axis=-1)
    return merged @ w_out


def memory_cross_attention(h, m, w_xq, w_xkv, w_xo):
    bsz, s_len, _ = h.shape
    q = (h @ w_xq).reshape(bsz, s_len, N_XATTN_HEADS, XATTN_HEAD_DIM)
    kv = (m @ w_xkv).reshape(bsz, m.shape[1], 2, N_XATTN_HEADS, XATTN_HEAD_DIM)
    k, v = kv[:, :, 0], kv[:, :, 1]
    s = jnp.einsum('bqhd,bmhd->bhqm', q, k).astype(jnp.float32) * (XATTN_HEAD_DIM ** -0.5)
    p = jax.nn.softmax(s, axis=-1).astype(v.dtype)
    o = jnp.einsum('bhqm,bmhd->bqhd', p, v).reshape(bsz, s_len, XATTN_WIDTH)
    return o @ w_xo


def swiglu(h, w_gate, w_up, w_down):
    return (jax.nn.silu(h @ w_gate) * (h @ w_up)) @ w_down


def setup_inputs(seed: int = 0) -> dict:
    key = jax.random.key(seed)
    ks = jax.random.split(key, 24)
    f32 = jnp.float32

    def nrm(k, shape, fan_in):
        return jax.random.normal(k, shape, f32) * (fan_in ** -0.5)

    def gain(k, shape):
        return 1.0 + 0.02 * jax.random.normal(k, shape, f32)

    x = jax.random.normal(ks[0], (BATCH, SEQ, D_MODEL), f32)
    mem = jax.random.normal(ks[1], (BATCH, N_MEM, D_MODEL), f32)
    offset = jax.random.randint(ks[2], (BATCH, 1), 0, SEQ, dtype=jnp.int32)
    positions = (offset + jnp.arange(SEQ, dtype=jnp.int32)[None, :]).astype(jnp.int32)
    return {
        "x": x,
        "mem": mem,
        "positions": positions,
        "g_mix": gain(ks[3], (DEPTH, D_MODEL)),
        "w_in": nrm(ks[4], (DEPTH, D_MODEL, IN_PROJ_WIDTH), D_MODEL),
        "w_conv": nrm(ks[5], (DEPTH, CONV_KSIZE, CONV_WIDTH), CONV_KSIZE),
        "b_conv": 0.02 * jax.random.normal(ks[6], (DEPTH, CONV_WIDTH), f32),
        "g_attn_out": gain(ks[7], (DEPTH, ATTN_WIDTH)),
        "g_conv_out": gain(ks[8], (DEPTH, CONV_WIDTH)),
        "w_out": nrm(ks[9], (DEPTH, D_MODEL, D_MODEL), D_MODEL),
        "g_xattn": gain(ks[10], (DEPTH, D_MODEL)),
        "g_mem": gain(ks[11], (DEPTH, D_MODEL)),
        "w_xq": nrm(ks[12], (DEPTH, D_MODEL, XATTN_WIDTH), D_MODEL),
        "w_xkv": nrm(ks[13], (DEPTH, D_MODEL, 2 * XATTN_WIDTH), D_MODEL),
        "w_xo": nrm(ks[14], (DEPTH, XATTN_WIDTH, D_MODEL), XATTN_WIDTH),
        "g_ffn": gain(ks[15], (DEPTH, D_MODEL)),
        "w_gate": nrm(ks[16], (DEPTH, D_MODEL, D_FF), D_MODEL),
        "w_up": nrm(ks[17], (DEPTH, D_MODEL, D_FF), D_MODEL),
        "w_down": nrm(ks[18], (DEPTH, D_FF, D_MODEL), D_FF),
        "g_final": gain(ks[19], (D_MODEL,)),
    }


def reference(x, mem, positions, g_mix, w_in, w_conv, b_conv, g_attn_out, g_conv_out, w_out,
              g_xattn, g_mem, w_xq, w_xkv, w_xo, g_ffn, w_gate, w_up, w_down, g_final):
    cos, sin = rope_tables(positions)
    for l in range(DEPTH):
        h = rms_norm(x, g_mix[l])
        x = x + hybrid_mixer(h, cos, sin, w_in[l], w_conv[l], b_conv[l],
                             g_attn_out[l], g_conv_out[l], w_out[l])
        h = rms_norm(x, g_xattn[l])
        m = rms_norm(mem, g_mem[l])
        x = x + memory_cross_attention(h, m, w_xq[l], w_xkv[l], w_xo[l])
        h = rms_norm(x, g_ffn[l])
        x = x + swiglu(h, w_gate[l], w_up[l], w_down[l])
    return rms_norm(x, g_final)
```

```cpp
#include <hip/hip_runtime.h>
#include <cstdio>
#include <cstdint>
#include <cmath>
namespace pg8 {
#define PG8_LAS __attribute__((address_space(3)))
typedef unsigned short bf16_t;
typedef short bf16x8 __attribute__((ext_vector_type(8)));
typedef float f32x4 __attribute__((ext_vector_type(4)));
typedef unsigned u32x4 __attribute__((ext_vector_type(4)));
constexpr int BM = 256, BK = 64, HALF = 128, HTB = HALF * BK * 2  , STAGE_BYTES = 8 * HTB, NXCD = 8, WGM = 8;

__host__ __device__ __forceinline__ int lds_byte(int r, int c) { const int st = (r >> 4) * 2 + (c >> 5), rr = r & 15, cc = c & 31, ob = rr * 64 + cc * 2; return st * 1024 + (ob ^ (((ob >> 9) & 1) << 5)); }
__host__ __device__ __forceinline__ void stage_rc(int b, int& R, int& C) { const int st = b / 1024, sb = b % 1024, swz = sb ^ (((sb >> 9) & 1) << 5); R = (st >> 1) * 16 + swz / 64; C = (st & 1) * 32 + (swz % 64) / 2; }
__host__ __device__ __forceinline__ int perm32(int rho) { const int n = rho >> 4, i = rho & 15; return 8 * (i >> 2) + 4 * n + (i & 3); }

struct Unit { int pm, pn; };
struct Gemm { const bf16_t* A; const bf16_t* Bt; int M, N, K, pad; };

struct StaticOrder {
    int nM, nN, nwg, G, c;
    __host__ __device__ void init(int M, int N, int G_, int c_) { nM = M / BM; nN = N / BM; nwg = nM * nN; G = G_; c = c_; }
    __host__ __device__ bool next(int i, Unit& u) const {
        const long L = (long)i * G + c; if (L >= nwg) return false;
        int wgid = (int)L; { const int q = nwg / NXCD, r = nwg % NXCD, xcd = wgid % NXCD, off = wgid / NXCD; wgid = (xcd < r ? xcd * (q + 1) : r * (q + 1) + (xcd - r) * q) + off; }
        const int nig = WGM * nN, gid = wgid / nig, fm = gid * WGM, gsz = (nM - fm) < WGM ? (nM - fm) : WGM;
        u.pm = fm + ((wgid % nig) % gsz); u.pn = (wgid % nig) / gsz; return true;
    }
    __device__ __forceinline__ void a_ready(const Unit&) const {}
    __device__ __forceinline__ void done(const Unit&) const {}
};
__device__ __forceinline__ unsigned cvt_pk_bf16(float lo, float hi) { unsigned r; asm volatile("v_cvt_pk_bf16_f32 %0, %1, %2" : "=v"(r) : "v"(lo), "v"(hi)); return r; }
template <class Epi, class Sched, bool ALIGN_EPI = false, bool SP2 = false>
__device__ __forceinline__ void gemm_phase(PG8_LAS unsigned char* lds, const Gemm g, const Sched& S, const Epi& E) {
    const int tid = threadIdx.x, wid = __builtin_amdgcn_readfirstlane(tid >> 6), lane = tid & 63, wr = wid >> 2, wc = wid & 3, fr = lane & 15, fq = lane >> 4;
    const int K = g.K, nt = K / BK;
    unsigned voffA[2], voffB[2];
#pragma unroll
    for (int i = 0; i < 2; ++i) { int R, C; stage_rc(tid * 16 + i * 8192, R, C); const int Rb = Epi::PERM ? ((R & ~31) + perm32(R & 31)) : R;
        voffA[i] = (unsigned)(R * K + C) * 2u; voffB[i] = (unsigned)(Rb * K + C) * 2u; }
    const size_t kstep = (size_t)(BK * 2);
    const size_t hstep = (size_t)HALF * K * 2;
    const size_t tstep = 2 * hstep;
    const unsigned ldsw = (unsigned)wid * 1024u;
    const int aoff = lds_byte(wr * 64 + fr, fq * 8), boff = lds_byte(wc * 32 + fr, fq * 8);
#define PG8_SA(b, h) (((b) * 2 + (h)) * HTB)
#define PG8_SB(b, h) ((4 + (b) * 2 + (h)) * HTB)
#define PG8_STAGE(bufoff, gbase, voff) do { _Pragma("unroll") for (int _i = 0; _i < 2; ++_i) \
        __builtin_amdgcn_global_load_lds((const unsigned*)((const char*)(gbase) + (voff)[_i]), (PG8_LAS unsigned*)(lds + (bufoff) + ldsw + _i * 8192), 16, 0, 0); } while (0)
#define PG8_LDA(dst, b, h) do { _Pragma("unroll") for (int m = 0; m < 4; ++m) _Pragma("unroll") for (int k = 0; k < 2; ++k) dst[m][k] = *(const PG8_LAS bf16x8*)(lds + PG8_SA(b, h) + aoff + m * 2048 + k * 1024); } while (0)
#define PG8_LDB(dst, b, h) do { _Pragma("unroll") for (int n = 0; n < 2; ++n) _Pragma("unroll") for (int k = 0; k < 2; ++k) dst[n][k] = *(const PG8_LAS bf16x8*)(lds + PG8_SB(b, h) + boff + n * 2048 + k * 1024); } while (0)
#define PG8_MMA(ai, bj, At, Bt) do { __builtin_amdgcn_s_setprio(1); _Pragma("unroll") for (int m = 0; m < 4; ++m) _Pragma("unroll") for (int n = 0; n < 2; ++n) _Pragma("unroll") for (int k = 0; k < 2; ++k) \
        acc[ai][bj][m][n] = __builtin_amdgcn_mfma_f32_16x16x32_bf16(Bt[n][k], At[m][k], acc[ai][bj][m][n], 0, 0, 0); __builtin_amdgcn_s_setprio(0); } while (0)
#define PG8_WAIT_V(n) asm volatile("s_waitcnt vmcnt(" #n ")" ::: "memory")
#define PG8_WAIT_L(n) asm volatile("s_waitcnt lgkmcnt(" #n ")" ::: "memory")
#define PG8_BAR __builtin_amdgcn_s_barrier()
#define PG8_SCHED __builtin_amdgcn_sched_barrier(0)
    Unit cur, nxt; int ui = 0;
    if (!S.next(0, cur)) return;
    f32x4 acc[2][2][4][2];
#pragma unroll
    for (int a = 0; a < 2; ++a)
#pragma unroll
        for (int b = 0; b < 2; ++b)
#pragma unroll
            for (int m = 0; m < 4; ++m)
#pragma unroll
                for (int n = 0; n < 2; ++n) acc[a][b][m][n] = (f32x4){0.f, 0.f, 0.f, 0.f};
    bf16x8 At[4][2], B0[2][2], B1[2][2];
    const char* cA = (const char*)g.A + (size_t)cur.pm * tstep; const char* cB = (const char*)g.Bt + (size_t)cur.pn * tstep;
    S.a_ready(cur);
    if constexpr (SP2) {
        PG8_STAGE(PG8_SB(0, 0), cB, voffB); PG8_STAGE(PG8_SB(0, 1), cB + hstep, voffB); PG8_STAGE(PG8_SA(0, 0), cA, voffA); PG8_STAGE(PG8_SA(0, 1), cA + hstep, voffA);
        if (wr == 1) PG8_BAR;
        PG8_WAIT_V(2); PG8_BAR;
        PG8_STAGE(PG8_SB(1, 0), cB + kstep, voffB); PG8_STAGE(PG8_SA(1, 0), cA + kstep, voffA); PG8_STAGE(PG8_SB(1, 1), cB + hstep + kstep, voffB);
        PG8_WAIT_V(6); PG8_BAR;
    } else {
        PG8_STAGE(PG8_SB(0, 0), cB, voffB); PG8_STAGE(PG8_SA(0, 0), cA, voffA); PG8_STAGE(PG8_SB(0, 1), cB + hstep, voffB); PG8_STAGE(PG8_SA(0, 1), cA + hstep, voffA);
        if (wr == 1) PG8_BAR;
        PG8_WAIT_V(4); PG8_BAR;
        PG8_STAGE(PG8_SB(1, 0), cB + kstep, voffB); PG8_STAGE(PG8_SA(1, 0), cA + kstep, voffA); PG8_STAGE(PG8_SB(1, 1), cB + hstep + kstep, voffB);
        PG8_WAIT_V(6); PG8_BAR;
    }
    for (;;) {
        const bool has_next = S.next(ui + 1, nxt);
        const char* nA = has_next ? (const char*)g.A + (size_t)nxt.pm * tstep : cA; const char* nB = has_next ? (const char*)g.Bt + (size_t)nxt.pn * tstep : cB;
        for (int t = 0; t < nt; t += 2) {
            const bool last = (t == nt - 2);
            const char* a1 = cA + (size_t)(t + 1) * kstep;
            const char* a2 = last ? nA : cA + (size_t)(t + 2) * kstep; const char* b2 = last ? nB : cB + (size_t)(t + 2) * kstep;
            const char* a3 = a2 + kstep; const char* b3 = b2 + kstep;
            if (last && has_next) S.a_ready(nxt);
            if constexpr (SP2) {
            PG8_LDB(B0, 0, 0); PG8_LDB(B1, 0, 1); PG8_SCHED; PG8_LDA(At, 0, 0); PG8_STAGE(PG8_SA(1, 1), a1 + hstep, voffA);
            PG8_WAIT_V(8); PG8_WAIT_L(0); PG8_BAR; PG8_MMA(0, 0, At, B0); PG8_MMA(0, 1, At, B1); PG8_BAR; PG8_SCHED;
            PG8_LDA(At, 0, 1); PG8_STAGE(PG8_SB(0, 0), b2, voffB); PG8_STAGE(PG8_SB(0, 1), b2 + hstep, voffB); PG8_STAGE(PG8_SA(0, 0), a2, voffA);
            PG8_WAIT_V(8); PG8_WAIT_L(0); PG8_BAR; PG8_MMA(1, 0, At, B0); PG8_MMA(1, 1, At, B1); PG8_BAR; PG8_SCHED;
            PG8_LDB(B0, 1, 0); PG8_LDB(B1, 1, 1); PG8_SCHED; PG8_LDA(At, 1, 0); PG8_STAGE(PG8_SA(0, 1), a2 + hstep, voffA);
            PG8_WAIT_V(8); PG8_WAIT_L(0); PG8_BAR; PG8_MMA(0, 0, At, B0); PG8_MMA(0, 1, At, B1); PG8_BAR; PG8_SCHED;
            PG8_LDA(At, 1, 1); PG8_STAGE(PG8_SB(1, 0), b3, voffB); PG8_STAGE(PG8_SB(1, 1), b3 + hstep, voffB); PG8_STAGE(PG8_SA(1, 0), a3, voffA);
            PG8_WAIT_V(8); PG8_WAIT_L(0); PG8_BAR; PG8_MMA(1, 0, At, B0); PG8_MMA(1, 1, At, B1); PG8_BAR; PG8_SCHED;
            } else {
            PG8_LDB(B0, 0, 0); PG8_SCHED; PG8_LDA(At, 0, 0); PG8_STAGE(PG8_SA(1, 1), a1 + hstep, voffA);
            PG8_WAIT_L(8); PG8_BAR; PG8_WAIT_L(0); PG8_MMA(0, 0, At, B0); PG8_BAR; PG8_SCHED;
            PG8_LDB(B1, 0, 1); PG8_STAGE(PG8_SB(0, 0), b2, voffB);
            PG8_BAR; PG8_WAIT_L(0); PG8_MMA(0, 1, At, B1); PG8_BAR;
            PG8_LDA(At, 0, 1); PG8_STAGE(PG8_SA(0, 0), a2, voffA);
            PG8_BAR; PG8_WAIT_L(0); PG8_MMA(1, 0, At, B0); PG8_BAR; PG8_SCHED;
            PG8_STAGE(PG8_SB(0, 1), b2 + hstep, voffB);
            PG8_WAIT_V(6); PG8_BAR; PG8_MMA(1, 1, At, B1); PG8_BAR;
            PG8_LDB(B0, 1, 0); PG8_SCHED; PG8_LDA(At, 1, 0); PG8_STAGE(PG8_SA(0, 1), a2 + hstep, voffA);
            PG8_WAIT_L(8); PG8_BAR; PG8_WAIT_L(0); PG8_MMA(0, 0, At, B0); PG8_BAR; PG8_SCHED;
            PG8_LDB(B1, 1, 1); PG8_STAGE(PG8_SB(1, 0), b3, voffB);
            PG8_BAR; PG8_WAIT_L(0); PG8_MMA(0, 1, At, B1); PG8_BAR;
            PG8_LDA(At, 1, 1); PG8_STAGE(PG8_SA(1, 0), a3, voffA);
            PG8_BAR; PG8_WAIT_L(0); PG8_MMA(1, 0, At, B0); PG8_BAR; PG8_SCHED;
            PG8_STAGE(PG8_SB(1, 1), b3 + hstep, voffB);
            PG8_WAIT_V(6); PG8_BAR; PG8_MMA(1, 1, At, B1); PG8_BAR;
            }
        }
        if constexpr (ALIGN_EPI) { if (wr == 0) PG8_BAR; }
        if constexpr (!Epi::AFTER_DRAIN) { E(acc, cur, wr, wc, fr, fq); S.done(cur); }
        if (!has_next) break;
#pragma unroll
        for (int a = 0; a < 2; ++a)
#pragma unroll
            for (int b = 0; b < 2; ++b)
#pragma unroll
                for (int m = 0; m < 4; ++m)
#pragma unroll
                    for (int n = 0; n < 2; ++n) acc[a][b][m][n] = (f32x4){0.f, 0.f, 0.f, 0.f};
        cur = nxt; cA = nA; cB = nB; ++ui;
        if constexpr (ALIGN_EPI) { if (wr == 1) PG8_BAR; }
    }
    PG8_WAIT_V(0);
    if constexpr (!ALIGN_EPI) { if (wr == 0) PG8_BAR; }
    PG8_BAR;
    if constexpr (Epi::AFTER_DRAIN) { E.fused(acc, cur, wr, wc, fr, fq, lds, wid, lane); S.done(cur); }
#undef PG8_SA
#undef PG8_SB
#undef PG8_STAGE
#undef PG8_LDA
#undef PG8_LDB
#undef PG8_MMA
#undef PG8_WAIT_V
#undef PG8_WAIT_L
#undef PG8_BAR
#undef PG8_SCHED
}
}

namespace pg8 {
struct EpiStoreBf16 {
    static constexpr bool PERM = true, AFTER_DRAIN = false;
    bf16_t* O; int ldc, pad;
    __device__ __forceinline__ void operator()(const f32x4 (&acc)[2][2][4][2], const Unit& u, int wr, int wc, int fr, int fq) const {
        const int row0 = u.pm * BM + wr * 64 + fr, col0 = u.pn * BM + wc * 32 + 8 * fq;
#pragma unroll
        for (int ai = 0; ai < 2; ++ai)
#pragma unroll
            for (int m = 0; m < 4; ++m) { bf16_t* rowp = O + (size_t)(row0 + ai * HALF + m * 16) * ldc + col0;
#pragma unroll
                for (int bj = 0; bj < 2; ++bj) { const f32x4 v0 = acc[ai][bj][m][0], v1 = acc[ai][bj][m][1];
                    u32x4 w; w.x = cvt_pk_bf16(v0[0], v0[1]); w.y = cvt_pk_bf16(v0[2], v0[3]); w.z = cvt_pk_bf16(v1[0], v1[1]); w.w = cvt_pk_bf16(v1[2], v1[3]);
                    *(u32x4*)(rowp + bj * HALF) = w; } }
    }
};
struct EpiResF32 {
    static constexpr bool PERM = false, AFTER_DRAIN = false;
    const float* base; float* out; int ldc, pad;
    __device__ __forceinline__ void operator()(const f32x4 (&acc)[2][2][4][2], const Unit& u, int wr, int wc, int fr, int fq) const {
        const int row0 = u.pm * BM + wr * 64 + fr, col0 = u.pn * BM + wc * 32 + 4 * fq;
#pragma unroll
        for (int ai = 0; ai < 2; ++ai)
#pragma unroll
            for (int m = 0; m < 4; ++m) { const size_t off = (size_t)(row0 + ai * HALF + m * 16) * ldc + col0;
#pragma unroll
                for (int bj = 0; bj < 2; ++bj)
#pragma unroll
                    for (int n = 0; n < 2; ++n) { const f32x4 b = *(const f32x4*)(base + off + bj * HALF + n * 16); *(f32x4*)(out + off + bj * HALF + n * 16) = b + acc[ai][bj][m][n]; } }
    }
};
struct EpiSwiGLU {
    static constexpr bool PERM = true, AFTER_DRAIN = false;
    bf16_t* O; int ldc, pad;
    __device__ __forceinline__ void operator()(const f32x4 (&acc)[2][2][4][2], const Unit& u, int wr, int wc, int fr, int fq) const {
        const int row0 = u.pm * BM + wr * 64 + fr, col0 = u.pn * HALF + wc * 32 + 8 * fq;
#pragma unroll
        for (int ai = 0; ai < 2; ++ai)
#pragma unroll
            for (int m = 0; m < 4; ++m) { bf16_t* rowp = O + (size_t)(row0 + ai * HALF + m * 16) * ldc + col0;
                float r[8];
#pragma unroll
                for (int n = 0; n < 2; ++n)
#pragma unroll
                    for (int e = 0; e < 4; ++e) { const float g = acc[ai][0][m][n][e], up = acc[ai][1][m][n][e]; r[n * 4 + e] = g * up / (1.0f + __expf(-g)); }
                u32x4 w; w.x = cvt_pk_bf16(r[0], r[1]); w.y = cvt_pk_bf16(r[2], r[3]); w.z = cvt_pk_bf16(r[4], r[5]); w.w = cvt_pk_bf16(r[6], r[7]);
                *(u32x4*)rowp = w; }
    }
};
}
typedef unsigned short bf16_t;
constexpr int DM = 2048, NB = 4, SEQ = 4096, MT = NB * SEQ;
constexpr int HD = 128, NH = 8, AW = 1024, CW = 1024, NPROJ = 6144;
constexpr int NBLK = 16, MBLK = 256;
constexpr int NMEM = 256, XH = 4, XW = 512, DFF = 5632;
constexpr float EPS = 1e-6f;
constexpr float SM_SCALE = 0.088388347648318440f;
constexpr size_t MiB = 1u << 20;
constexpr size_t WS_WIN = 0;
constexpr size_t WS_WOUT = 24 * MiB;
constexpr size_t WS_WXQ = 32 * MiB;
constexpr size_t WS_WXKV = 34 * MiB;
constexpr size_t WS_WXO = 38 * MiB;
constexpr size_t WS_WGU = 40 * MiB;
constexpr size_t WS_WDN = 84 * MiB;
constexpr size_t WS_H = 112 * MiB;
constexpr size_t WS_MRG = 176 * MiB;
constexpr size_t WS_PROJ = 240 * MiB;
constexpr size_t WS_ACT = 240 * MiB;
constexpr size_t WS_QX = 432 * MiB;
constexpr size_t WS_OX = 448 * MiB;
constexpr size_t WS_KVX = 464 * MiB;
constexpr size_t WS_MEMN = 466 * MiB;
constexpr size_t WS_CS = 470 * MiB;
constexpr size_t WS_KMEAN = 478 * MiB;
constexpr size_t WS_END = 479 * MiB;

__device__ __forceinline__ float bf2f(unsigned v) { return __uint_as_float(v << 16); }
__device__ __forceinline__ unsigned f2bf(float f) { unsigned u = __float_as_uint(f); return (u + 0x7fffu + ((u >> 16) & 1u)) >> 16; }
__device__ __forceinline__ unsigned pk2(float lo, float hi) { return f2bf(lo) | (f2bf(hi) << 16); }
__device__ __forceinline__ float wave_sum(float v) {
#pragma unroll
    for (int o = 1; o < 64; o <<= 1) v += __shfl_xor(v, o);
    return v;
}
__device__ __forceinline__ float wave_max(float v) {
#pragma unroll
    for (int o = 1; o < 64; o <<= 1) v = fmaxf(v, __shfl_xor(v, o));
    return v;
}
typedef float f32x4 __attribute__((ext_vector_type(4)));
typedef unsigned u32x4 __attribute__((ext_vector_type(4)));
typedef unsigned u32x2 __attribute__((ext_vector_type(2)));

struct TJob { const float* src0; const float* src1; const float* gain; bf16_t* dst; int K, Nsrc, nrows, mode; };
struct TJobs { TJob j[8]; int n, pad; };
__device__ __forceinline__ void transpose_item(const TJob& J, float* scr, int item, int lane) {
    const int nblk = J.nrows / 32, kb = item / nblk, nb = item % nblk, k0 = 64 * kb, n0 = 32 * nb;
    const float* src = J.src0; int c0 = n0;
    if (J.mode == 2) { const int tile = n0 >> 8, w = n0 & 255; if (w < 128) { c0 = tile * 128 + w; } else { src = J.src1; c0 = tile * 128 + w - 128; } }
#pragma unroll 8
    for (int i = 0; i < 32; ++i) { const int kk = 2 * i + (lane >> 5); float v = src[(size_t)(k0 + kk) * J.Nsrc + c0 + (lane & 31)]; if (J.gain) v *= J.gain[k0 + kk]; scr[kk * 33 + (lane & 31)] = v; }
    asm volatile("s_waitcnt lgkmcnt(0)" ::: "memory");
    const int c = lane & 7;
#pragma unroll
    for (int j = 0; j < 4; ++j) { const int n = (lane >> 3) + 8 * j; const float* s = scr + (8 * c) * 33 + n;
        u32x4 o; o.x = pk2(s[0 * 33], s[1 * 33]); o.y = pk2(s[2 * 33], s[3 * 33]); o.z = pk2(s[4 * 33], s[5 * 33]); o.w = pk2(s[6 * 33], s[7 * 33]);
        *(u32x4*)(J.dst + (size_t)(n0 + n) * J.K + k0 + 8 * c) = o; }
    asm volatile("s_waitcnt lgkmcnt(0)" ::: "memory");
}
__global__ void __launch_bounds__(256) k_transpose(TJobs T) {
    __shared__ float scr_all[4][64 * 33];
    const int lane = threadIdx.x & 63, w = threadIdx.x >> 6;
    const int gw = blockIdx.x * 4 + w, NGW = gridDim.x * 4;
    int base = 0;
    for (int ji = 0; ji < T.n; ++ji) {
        const TJob J = T.j[ji];
        const int nitems = (J.K / 64) * (J.nrows / 32);
        int first = (gw - base % NGW + NGW) % NGW;
        for (int it = first; it < nitems; it += NGW) transpose_item(J, scr_all[w], it, lane);
        base += nitems;
    }
}

__device__ __forceinline__ void rms_row_bf16(const float* xrow, const float* g, bf16_t* orow, int lane) {
    const f32x4* xr = (const f32x4*)xrow + lane; const f32x4* gr = (const f32x4*)g + lane;
    f32x4 v[8]; float s = 0.f;
#pragma unroll
    for (int j = 0; j < 8; ++j) { v[j] = xr[64 * j]; s += (v[j].x * v[j].x + v[j].y * v[j].y) + (v[j].z * v[j].z + v[j].w * v[j].w); }
    const float rinv = rsqrtf(wave_sum(s) * (1.f / DM) + EPS);
    u32x2* o8 = (u32x2*)orow + lane;
#pragma unroll
    for (int j = 0; j < 8; ++j) { const f32x4 gg = gr[64 * j]; u32x2 w; w.x = pk2(v[j].x * rinv * gg.x, v[j].y * rinv * gg.y); w.y = pk2(v[j].z * rinv * gg.z, v[j].w * rinv * gg.w); o8[64 * j] = w; }
}
__global__ void __launch_bounds__(256) k_rms_bf16(const float* X, const float* g, bf16_t* O, int rows) {
    const int lane = threadIdx.x & 63; const int gw = blockIdx.x * 4 + (threadIdx.x >> 6), NGW = gridDim.x * 4;
    for (int r = gw; r < rows; r += NGW) rms_row_bf16(X + (size_t)r * DM, g, O + (size_t)r * DM, lane);
}
__global__ void __launch_bounds__(256) k_final_norm(float* X, const float* g, int rows) {
    const int lane = threadIdx.x & 63; const int gw = blockIdx.x * 4 + (threadIdx.x >> 6), NGW = gridDim.x * 4;
    for (int r = gw; r < rows; r += NGW) {
        f32x4* xr = (f32x4*)(X + (size_t)r * DM) + lane; const f32x4* gr = (const f32x4*)g + lane;
        f32x4 v[8]; float s = 0.f;
#pragma unroll
        for (int j = 0; j < 8; ++j) { v[j] = xr[64 * j]; s += (v[j].x * v[j].x + v[j].y * v[j].y) + (v[j].z * v[j].z + v[j].w * v[j].w); }
        const float rinv = rsqrtf(wave_sum(s) * (1.f / DM) + EPS);
#pragma unroll
        for (int j = 0; j < 8; ++j) xr[64 * j] = v[j] * rinv * gr[64 * j];
    }
}

__device__ __forceinline__ void sincos_small(double r, double& s, double& c) {
    const double r2 = r * r;
    double a = -1.0 / 10888869450418352160768000000.0;
    a = a * r2 + 1.0 / 15511210043330985984000000.0;
    a = a * r2 - 1.0 / 25852016738884976640000.0;
    a = a * r2 + 1.0 / 51090942171709440000.0;
    a = a * r2 - 1.0 / 121645100408832000.0;
    a = a * r2 + 1.0 / 355687428096000.0;
    a = a * r2 - 1.0 / 1307674368000.0;
    a = a * r2 + 1.0 / 6227020800.0;
    a = a * r2 - 1.0 / 39916800.0;
    a = a * r2 + 1.0 / 362880.0;
    a = a * r2 - 1.0 / 5040.0;
    a = a * r2 + 1.0 / 120.0;
    a = a * r2 - 1.0 / 6.0;
    a = a * r2 + 1.0;
    s = a * r;
    double b = 1.0 / 403291461126605635584000000.0;
    b = b * r2 - 1.0 / 620448401733239439360000.0;
    b = b * r2 + 1.0 / 1124000727777607680000.0;
    b = b * r2 - 1.0 / 2432902008176640000.0;
    b = b * r2 + 1.0 / 6402373705728000.0;
    b = b * r2 - 1.0 / 20922789888000.0;
    b = b * r2 + 1.0 / 87178291200.0;
    b = b * r2 - 1.0 / 479001600.0;
    b = b * r2 + 1.0 / 3628800.0;
    b = b * r2 - 1.0 / 40320.0;
    b = b * r2 + 1.0 / 720.0;
    b = b * r2 - 1.0 / 24.0;
    b = b * r2 + 1.0 / 2.0;
    c = 1.0 - b * r2;
}
__device__ __forceinline__ void cs_entry(const int* pos, float* cs, int idx) {
    const int t = idx >> 6, f = idx & 63;
    double p = 1.0, bs = 0.8659643233600653;
#pragma unroll
    for (int bit = 0; bit < 6; ++bit) { if ((f >> bit) & 1) p *= bs; bs *= bs; }
    const double ang = (double)pos[t] * p;
    const double TWO_PI = 6.283185307179586;
    const double n = rint(ang / TWO_PI);
    const double r = fma(-n, TWO_PI, ang);
    double s, c; sincos_small(r, s, c);
    cs[2 * idx] = (float)c; cs[2 * idx + 1] = (float)s;
}
__global__ void __launch_bounds__(256) k_cs(const int* pos, float* cs) {
    for (int idx = blockIdx.x * 256 + threadIdx.x; idx < MT * 64; idx += gridDim.x * 256) cs_entry(pos, cs, idx);
}
__global__ void __launch_bounds__(256) k_rope_naive(bf16_t* proj, const float* cs) {
    const long total = (long)MT * 2 * NH * 64;
    for (long i = blockIdx.x * 256L + threadIdx.x; i < total; i += gridDim.x * 256L) {
        const int d = (int)(i & 63), h = (int)((i >> 6) & 7), sec = (int)((i >> 9) & 1); const long t = i >> 10;
        bf16_t* p = proj + t * NPROJ + sec * 1024 + h * HD + d;
        const float a = bf2f(p[0]), b = bf2f(p[64]); const float c = cs[(t * 64 + d) * 2], s = cs[(t * 64 + d) * 2 + 1];
        p[0] = (bf16_t)f2bf(a * c - b * s); p[64] = (bf16_t)f2bf(b * c + a * s);
    }
}
__global__ void __launch_bounds__(128) k_kmean_naive(const bf16_t* proj, float* kmean) {
    const int blkid = blockIdx.x, d = threadIdx.x;
    const int blk = blkid & 15, h = (blkid >> 4) & 7, b = blkid >> 7;
    float s = 0.f;
    for (int j = 0; j < MBLK; ++j) s += bf2f(proj[(size_t)(b * SEQ + blk * MBLK + j) * NPROJ + 1024 + h * HD + d]);
    kmean[(size_t)blkid * HD + d] = s * (1.f / MBLK);
}
__device__ __forceinline__ float dot_q_row(const float* sq, const bf16_t* krow) {
    float a = 0.f;
#pragma unroll
    for (int d = 0; d < 128; d += 8) { const u32x4 kk = *(const u32x4*)(krow + d);
        a += sq[d + 0] * bf2f(kk.x & 0xffffu) + sq[d + 1] * bf2f(kk.x >> 16) + sq[d + 2] * bf2f(kk.y & 0xffffu) + sq[d + 3] * bf2f(kk.y >> 16)
           + sq[d + 4] * bf2f(kk.z & 0xffffu) + sq[d + 5] * bf2f(kk.z >> 16) + sq[d + 6] * bf2f(kk.w & 0xffffu) + sq[d + 7] * bf2f(kk.w >> 16); }
    return a;
}
__global__ void __launch_bounds__(256) k_moba_naive(const bf16_t* proj, const float* kmean, const float* g_attn, bf16_t* merged, float qscale_inv) {
    __shared__ float sq_all[4][128];
    __shared__ float sp_all[4][1024];
    const int lane = threadIdx.x & 63, w = threadIdx.x >> 6;
    float* sq = sq_all[w]; float* sp = sp_all[w];
    const int gw = blockIdx.x * 4 + w, NGW = gridDim.x * 4;
    for (int item = gw; item < MT * NH; item += NGW) {
        const int t = item >> 3, h = item & 7, b = t >> 12, ts = t & 4095, qb = ts >> 8, tq = ts & 255;
        const bf16_t* qrow = proj + (size_t)t * NPROJ + h * HD;
        const unsigned qq = *(const unsigned*)(qrow + 2 * lane);
        const float q0 = bf2f(qq & 0xffffu) * qscale_inv, q1 = bf2f(qq >> 16) * qscale_inv;
        asm volatile("s_waitcnt lgkmcnt(0)" ::: "memory");
        sq[2 * lane] = q0; sq[2 * lane + 1] = q1;
        float g[16];
#pragma unroll
        for (int i = 0; i < 16; ++i) { const float* km = kmean + (size_t)((b * 8 + h) * 16 + i) * HD; const float p = wave_sum(q0 * km[2 * lane] + q1 * km[2 * lane + 1]); g[i] = (i < qb) ? p : -INFINITY; }
        int sel[4];
#pragma unroll
        for (int r = 0; r < 3; ++r) { float best = -INFINITY; int bi = -1;
#pragma unroll
            for (int i = 0; i < 16; ++i) if (g[i] > best) { best = g[i]; bi = i; }
            sel[r] = bi;
#pragma unroll
            for (int i = 0; i < 16; ++i) if (i == bi) g[i] = -INFINITY; }
        sel[3] = qb;
        asm volatile("s_waitcnt lgkmcnt(0)" ::: "memory");
#pragma unroll
        for (int s = 0; s < 4; ++s) { const int blk = sel[s];
            for (int jj = 0; jj < 4; ++jj) { const int j = jj * 64 + lane; float sc = -INFINITY;
                if (blk >= 0 && (s < 3 || j <= tq)) sc = dot_q_row(sq, proj + (size_t)(b * SEQ + blk * MBLK + j) * NPROJ + 1024 + h * HD) * SM_SCALE;
                sp[s * 256 + j] = sc; } }
        asm volatile("s_waitcnt lgkmcnt(0)" ::: "memory");
        float m = -INFINITY; for (int i = lane; i < 1024; i += 64) m = fmaxf(m, sp[i]); m = wave_max(m);
        float l = 0.f; for (int i = lane; i < 1024; i += 64) { const float p = __expf(sp[i] - m); sp[i] = p; l += p; } l = wave_sum(l);
        asm volatile("s_waitcnt lgkmcnt(0)" ::: "memory");
        float o0 = 0.f, o1 = 0.f;
#pragma unroll
        for (int s = 0; s < 4; ++s) { const int blk = sel[s]; if (blk < 0) continue;
            const bf16_t* vb = proj + (size_t)(b * SEQ + blk * MBLK) * NPROJ + 2048 + h * HD + 2 * lane;
            for (int j = 0; j < 256; ++j) { const float p = sp[s * 256 + j]; const unsigned vv = *(const unsigned*)(vb + (size_t)j * NPROJ); o0 += p * bf2f(vv & 0xffffu); o1 += p * bf2f(vv >> 16); } }
        const float li = 1.f / l; o0 *= li; o1 *= li;
        const float rinv = rsqrtf(wave_sum(o0 * o0 + o1 * o1) * (1.f / HD) + EPS);
        *(unsigned*)(merged + (size_t)t * DM + h * HD + 2 * lane) = pk2(o0 * rinv * g_attn[h * HD + 2 * lane], o1 * rinv * g_attn[h * HD + 2 * lane + 1]);
    }
}
__global__ void __launch_bounds__(256) k_conv_naive(const bf16_t* proj, const float* w_conv, const float* b_conv, const float* g_conv, bf16_t* merged) {
    const int lane = threadIdx.x & 63; const int gw = blockIdx.x * 4 + (threadIdx.x >> 6), NGW = gridDim.x * 4;
    for (int item = gw; item < MT * 8; item += NGW) {
        const int t = item >> 3, grp = item & 7, ts = t & 4095; const int c = grp * 128 + 2 * lane;
        float y[2];
#pragma unroll
        for (int e = 0; e < 2; ++e) { float acc = b_conv[c + e];
#pragma unroll
            for (int k = 0; k < 3; ++k) { const int back = 2 - k; if (ts - back >= 0) { const bf16_t* r = proj + (size_t)(t - back) * NPROJ; acc += w_conv[k * CW + c + e] * (bf2f(r[3072 + c + e]) * bf2f(r[5120 + c + e])); } }
            y[e] = bf2f(proj[(size_t)t * NPROJ + 4096 + c + e]) * acc; }
        const float rinv = rsqrtf(wave_sum(y[0] * y[0] + y[1] * y[1]) * (1.f / HD) + EPS);
        *(unsigned*)(merged + (size_t)t * DM + AW + c) = pk2(y[0] * rinv * g_conv[c], y[1] * rinv * g_conv[c + 1]);
    }
}
__global__ void __launch_bounds__(256) k_xattn_naive(const bf16_t* qx, const bf16_t* kvx, bf16_t* ox, float qscale_inv) {
    __shared__ float sq_all[4][128];
    __shared__ float sp_all[4][256];
    const int lane = threadIdx.x & 63, w = threadIdx.x >> 6;
    float* sq = sq_all[w]; float* sp = sp_all[w];
    const int gw = blockIdx.x * 4 + w, NGW = gridDim.x * 4;
    for (int item = gw; item < MT * XH; item += NGW) {
        const int t = item >> 2, h = item & 3, b = t >> 12;
        const unsigned qq = *(const unsigned*)(qx + (size_t)t * XW + h * HD + 2 * lane);
        asm volatile("s_waitcnt lgkmcnt(0)" ::: "memory");
        sq[2 * lane] = bf2f(qq & 0xffffu) * qscale_inv; sq[2 * lane + 1] = bf2f(qq >> 16) * qscale_inv;
        asm volatile("s_waitcnt lgkmcnt(0)" ::: "memory");
        float m = -INFINITY;
        for (int jj = 0; jj < 4; ++jj) { const int j = jj * 64 + lane; const float sc = dot_q_row(sq, kvx + (size_t)(b * NMEM + j) * 1024 + h * HD) * SM_SCALE; sp[j] = sc; m = fmaxf(m, sc); }
        m = wave_max(m);
        asm volatile("s_waitcnt lgkmcnt(0)" ::: "memory");
        float l = 0.f; for (int i = lane; i < 256; i += 64) { const float p = __expf(sp[i] - m); sp[i] = p; l += p; } l = wave_sum(l);
        asm volatile("s_waitcnt lgkmcnt(0)" ::: "memory");
        float o0 = 0.f, o1 = 0.f; const bf16_t* vb = kvx + (size_t)(b * NMEM) * 1024 + 512 + h * HD + 2 * lane;
        for (int j = 0; j < 256; ++j) { const float p = sp[j]; const unsigned vv = *(const unsigned*)(vb + (size_t)j * 1024); o0 += p * bf2f(vv & 0xffffu); o1 += p * bf2f(vv >> 16); }
        const float li = 1.f / l;
        *(unsigned*)(ox + (size_t)t * XW + h * HD + 2 * lane) = pk2(o0 * li, o1 * li);
    }
}
template <class Epi> __global__ void __launch_bounds__(512, 2) k_gemm(pg8::Gemm g, Epi E) {
    extern __shared__ __attribute__((aligned(16))) unsigned char lds[];
    pg8::StaticOrder S; S.init(g.M, g.N, (int)gridDim.x, (int)blockIdx.x);
    pg8::gemm_phase<Epi, pg8::StaticOrder, true, true>((PG8_LAS unsigned char*)lds, g, S, E);
}
template <class Epi> static void launch_gemm(const bf16_t* A, const bf16_t* Bt, int M, int N, int K, Epi E, hipStream_t stream) {
    static bool attr = false;
    if (!attr) { (void)hipFuncSetAttribute((const void*)k_gemm<Epi>, hipFuncAttributeMaxDynamicSharedMemorySize, pg8::STAGE_BYTES); attr = true; }
    pg8::Gemm g{A, Bt, M, N, K, 0};
    hipLaunchKernelGGL(k_gemm<Epi>, dim3(256), dim3(512), pg8::STAGE_BYTES, stream, g, E);
}

extern "C" void kernel_launch(void* const* d_in, const int* in_sizes, int n_in, void* d_out, int out_size, void* d_ws, size_t ws_size, hipStream_t stream) {
    if (n_in != 20 || ws_size < WS_END) { fprintf(stderr, "kernel_launch: unexpected n_in %d / ws %zu\n", n_in, ws_size); return; }
    const float* x = (const float*)d_in[0]; const float* mem = (const float*)d_in[1]; const int* pos = (const int*)d_in[2];
    const float* g_mix = (const float*)d_in[3]; const float* w_in = (const float*)d_in[4]; const float* w_conv = (const float*)d_in[5];
    const float* b_conv = (const float*)d_in[6]; const float* g_attn = (const float*)d_in[7]; const float* g_conv = (const float*)d_in[8];
    const float* w_out = (const float*)d_in[9]; const float* g_xattn = (const float*)d_in[10]; const float* g_mem = (const float*)d_in[11];
    const float* w_xq = (const float*)d_in[12]; const float* w_xkv = (const float*)d_in[13]; const float* w_xo = (const float*)d_in[14];
    const float* g_ffn = (const float*)d_in[15]; const float* w_gate = (const float*)d_in[16]; const float* w_up = (const float*)d_in[17];
    const float* w_down = (const float*)d_in[18]; const float* g_final = (const float*)d_in[19];
    float* out = (float*)d_out; unsigned char* ws = (unsigned char*)d_ws;
    bf16_t* Win = (bf16_t*)(ws + WS_WIN); bf16_t* Wout = (bf16_t*)(ws + WS_WOUT); bf16_t* Wxq = (bf16_t*)(ws + WS_WXQ); bf16_t* Wxkv = (bf16_t*)(ws + WS_WXKV);
    bf16_t* Wxo = (bf16_t*)(ws + WS_WXO); bf16_t* Wgu = (bf16_t*)(ws + WS_WGU); bf16_t* Wdn = (bf16_t*)(ws + WS_WDN);
    bf16_t* H = (bf16_t*)(ws + WS_H); bf16_t* MRG = (bf16_t*)(ws + WS_MRG); bf16_t* PROJ = (bf16_t*)(ws + WS_PROJ); bf16_t* ACT = (bf16_t*)(ws + WS_ACT);
    bf16_t* QX = (bf16_t*)(ws + WS_QX); bf16_t* OX = (bf16_t*)(ws + WS_OX); bf16_t* KVX = (bf16_t*)(ws + WS_KVX); bf16_t* MEMN = (bf16_t*)(ws + WS_MEMN);
    float* CS = (float*)(ws + WS_CS); float* KMEAN = (float*)(ws + WS_KMEAN);

    TJobs T{};
    T.j[0] = TJob{w_in, nullptr, nullptr, Win, DM, NPROJ, NPROJ, 0};
    T.j[1] = TJob{w_out, nullptr, nullptr, Wout, DM, DM, DM, 0};
    T.j[2] = TJob{w_xq, nullptr, nullptr, Wxq, DM, XW, XW, 0};
    T.j[3] = TJob{w_xkv, nullptr, nullptr, Wxkv, DM, 2 * XW, 2 * XW, 0};
    T.j[4] = TJob{w_xo, nullptr, nullptr, Wxo, XW, DM, DM, 0};
    T.j[5] = TJob{w_gate, w_up, nullptr, Wgu, DM, DFF, 2 * DFF, 2};
    T.j[6] = TJob{w_down, nullptr, nullptr, Wdn, DFF, DM, DM, 0};
    T.n = 7;
    hipLaunchKernelGGL(k_transpose, dim3(1024), dim3(256), 0, stream, T);
    hipLaunchKernelGGL(k_cs, dim3(1024), dim3(256), 0, stream, pos, CS);
    hipLaunchKernelGGL(k_rms_bf16, dim3(1024), dim3(256), 0, stream, x, g_mix, H, MT);
    hipLaunchKernelGGL(k_rms_bf16, dim3(256), dim3(256), 0, stream, mem, g_mem, MEMN, NB * NMEM);
    launch_gemm(H, Win, MT, NPROJ, DM, pg8::EpiStoreBf16{PROJ, NPROJ, 0}, stream);
    hipLaunchKernelGGL(k_rope_naive, dim3(2048), dim3(256), 0, stream, PROJ, CS);
    hipLaunchKernelGGL(k_kmean_naive, dim3(NB * NH * NBLK), dim3(128), 0, stream, PROJ, KMEAN);
    hipLaunchKernelGGL(k_moba_naive, dim3(2048), dim3(256), 0, stream, PROJ, KMEAN, g_attn, MRG, 1.0f);
    hipLaunchKernelGGL(k_conv_naive, dim3(2048), dim3(256), 0, stream, PROJ, w_conv, b_conv, g_conv, MRG);
    launch_gemm(MRG, Wout, MT, DM, DM, pg8::EpiResF32{x, out, DM, 0}, stream);
    hipLaunchKernelGGL(k_rms_bf16, dim3(1024), dim3(256), 0, stream, out, g_xattn, H, MT);
    launch_gemm(H, Wxq, MT, XW, DM, pg8::EpiStoreBf16{QX, XW, 0}, stream);
    launch_gemm(MEMN, Wxkv, NB * NMEM, 2 * XW, DM, pg8::EpiStoreBf16{KVX, 2 * XW, 0}, stream);
    hipLaunchKernelGGL(k_xattn_naive, dim3(2048), dim3(256), 0, stream, QX, KVX, OX, 1.0f);
    launch_gemm(OX, Wxo, MT, DM, XW, pg8::EpiResF32{out, out, DM, 0}, stream);
    hipLaunchKernelGGL(k_rms_bf16, dim3(1024), dim3(256), 0, stream, out, g_ffn, H, MT);
    launch_gemm(H, Wgu, MT, 2 * DFF, DM, pg8::EpiSwiGLU{ACT, DFF, 0}, stream);
    launch_gemm(ACT, Wdn, MT, DM, DFF, pg8::EpiResF32{out, out, DM, 0}, stream);
    hipLaunchKernelGGL(k_final_norm, dim3(1024), dim3(256), 0, stream, out, g_final, MT);
}
```

```cpp
#include <hip/hip_runtime.h>
#include <hip/hip_cooperative_groups.h>
#include <cstdio>
#include <cstdint>
#include <cmath>
namespace pg8 {
#define PG8_LAS __attribute__((address_space(3)))
typedef unsigned short bf16_t;
typedef short bf16x8 __attribute__((ext_vector_type(8)));
typedef float f32x4 __attribute__((ext_vector_type(4)));
typedef unsigned u32x4 __attribute__((ext_vector_type(4)));
constexpr int BM = 256, BK = 64, HALF = 128, HTB = HALF * BK * 2  , STAGE_BYTES = 8 * HTB, NXCD = 8, WGM = 8;

__host__ __device__ __forceinline__ int lds_byte(int r, int c) { const int st = (r >> 4) * 2 + (c >> 5), rr = r & 15, cc = c & 31, ob = rr * 64 + cc * 2; return st * 1024 + (ob ^ (((ob >> 9) & 1) << 5)); }
__host__ __device__ __forceinline__ void stage_rc(int b, int& R, int& C) { const int st = b / 1024, sb = b % 1024, swz = sb ^ (((sb >> 9) & 1) << 5); R = (st >> 1) * 16 + swz / 64; C = (st & 1) * 32 + (swz % 64) / 2; }
__host__ __device__ __forceinline__ int perm32(int rho) { const int n = rho >> 4, i = rho & 15; return 8 * (i >> 2) + 4 * n + (i & 3); }

struct Unit { int pm, pn; };
struct Gemm { const bf16_t* A; const bf16_t* Bt; int M, N, K, pad; };

struct StaticOrder {
    int nM, nN, nwg, G, c;
    __host__ __device__ void init(int M, int N, int G_, int c_) { nM = M / BM; nN = N / BM; nwg = nM * nN; G = G_; c = c_; }
    __host__ __device__ bool next(int i, Unit& u) const {
        const long L = (long)i * G + c; if (L >= nwg) return false;
        int wgid = (int)L; { const int q = nwg / NXCD, r = nwg % NXCD, xcd = wgid % NXCD, off = wgid / NXCD; wgid = (xcd < r ? xcd * (q + 1) : r * (q + 1) + (xcd - r) * q) + off; }
        const int nig = WGM * nN, gid = wgid / nig, fm = gid * WGM, gsz = (nM - fm) < WGM ? (nM - fm) : WGM;
        u.pm = fm + ((wgid % nig) % gsz); u.pn = (wgid % nig) / gsz; return true;
    }
    __device__ __forceinline__ void a_ready(const Unit&) const {}
    __device__ __forceinline__ void done(const Unit&) const {}
};
__device__ __forceinline__ unsigned cvt_pk_bf16(float lo, float hi) { unsigned r; asm volatile("v_cvt_pk_bf16_f32 %0, %1, %2" : "=v"(r) : "v"(lo), "v"(hi)); return r; }
template <class Epi, class Sched, bool ALIGN_EPI = false, bool SP2 = false>
__device__ __forceinline__ void gemm_phase(PG8_LAS unsigned char* lds, const Gemm g, const Sched& S, const Epi& E) {
    const int tid = threadIdx.x, wid = __builtin_amdgcn_readfirstlane(tid >> 6), lane = tid & 63, wr = wid >> 2, wc = wid & 3, fr = lane & 15, fq = lane >> 4;
    const int K = g.K, nt = K / BK;
    unsigned voffA[2], voffB[2];
#pragma unroll
    for (int i = 0; i < 2; ++i) { int R, C; stage_rc(tid * 16 + i * 8192, R, C); const int Rb = Epi::PERM ? ((R & ~31) + perm32(R & 31)) : R;
        voffA[i] = (unsigned)(R * K + C) * 2u; voffB[i] = (unsigned)(Rb * K + C) * 2u; }
    const size_t kstep = (size_t)(BK * 2);
    const size_t hstep = (size_t)HALF * K * 2;
    const size_t tstep = 2 * hstep;
    const unsigned ldsw = (unsigned)wid * 1024u;
    const int aoff = lds_byte(wr * 64 + fr, fq * 8), boff = lds_byte(wc * 32 + fr, fq * 8);
#define PG8_SA(b, h) (((b) * 2 + (h)) * HTB)
#define PG8_SB(b, h) ((4 + (b) * 2 + (h)) * HTB)
#define PG8_STAGE(bufoff, gbase, voff) do { _Pragma("unroll") for (int _i = 0; _i < 2; ++_i) \
        __builtin_amdgcn_global_load_lds((const unsigned*)((const char*)(gbase) + (voff)[_i]), (PG8_LAS unsigned*)(lds + (bufoff) + ldsw + _i * 8192), 16, 0, 0); } while (0)
#define PG8_LDA(dst, b, h) do { _Pragma("unroll") for (int m = 0; m < 4; ++m) _Pragma("unroll") for (int k = 0; k < 2; ++k) dst[m][k] = *(const PG8_LAS bf16x8*)(lds + PG8_SA(b, h) + aoff + m * 2048 + k * 1024); } while (0)
#define PG8_LDB(dst, b, h) do { _Pragma("unroll") for (int n = 0; n < 2; ++n) _Pragma("unroll") for (int k = 0; k < 2; ++k) dst[n][k] = *(const PG8_LAS bf16x8*)(lds + PG8_SB(b, h) + boff + n * 2048 + k * 1024); } while (0)
#define PG8_MMA(ai, bj, At, Bt) do { __builtin_amdgcn_s_setprio(1); _Pragma("unroll") for (int m = 0; m < 4; ++m) _Pragma("unroll") for (int n = 0; n < 2; ++n) _Pragma("unroll") for (int k = 0; k < 2; ++k) \
        acc[ai][bj][m][n] = __builtin_amdgcn_mfma_f32_16x16x32_bf16(Bt[n][k], At[m][k], acc[ai][bj][m][n], 0, 0, 0); __builtin_amdgcn_s_setprio(0); } while (0)
#define PG8_WAIT_V(n) asm volatile("s_waitcnt vmcnt(" #n ")" ::: "memory")
#define PG8_WAIT_L(n) asm volatile("s_waitcnt lgkmcnt(" #n ")" ::: "memory")
#define PG8_BAR __builtin_amdgcn_s_barrier()
#define PG8_SCHED __builtin_amdgcn_sched_barrier(0)
    Unit cur, nxt; int ui = 0;
    if (!S.next(0, cur)) return;
    f32x4 acc[2][2][4][2];
#pragma unroll
    for (int a = 0; a < 2; ++a)
#pragma unroll
        for (int b = 0; b < 2; ++b)
#pragma unroll
            for (int m = 0; m < 4; ++m)
#pragma unroll
                for (int n = 0; n < 2; ++n) acc[a][b][m][n] = (f32x4){0.f, 0.f, 0.f, 0.f};
    bf16x8 At[4][2], B0[2][2], B1[2][2];
    const char* cA = (const char*)g.A + (size_t)cur.pm * tstep; const char* cB = (const char*)g.Bt + (size_t)cur.pn * tstep;
    S.a_ready(cur);
    if constexpr (SP2) {
        PG8_STAGE(PG8_SB(0, 0), cB, voffB); PG8_STAGE(PG8_SB(0, 1), cB + hstep, voffB); PG8_STAGE(PG8_SA(0, 0), cA, voffA); PG8_STAGE(PG8_SA(0, 1), cA + hstep, voffA);
        if (wr == 1) PG8_BAR;
        PG8_WAIT_V(2); PG8_BAR;
        PG8_STAGE(PG8_SB(1, 0), cB + kstep, voffB); PG8_STAGE(PG8_SA(1, 0), cA + kstep, voffA); PG8_STAGE(PG8_SB(1, 1), cB + hstep + kstep, voffB);
        PG8_WAIT_V(6); PG8_BAR;
    } else {
        PG8_STAGE(PG8_SB(0, 0), cB, voffB); PG8_STAGE(PG8_SA(0, 0), cA, voffA); PG8_STAGE(PG8_SB(0, 1), cB + hstep, voffB); PG8_STAGE(PG8_SA(0, 1), cA + hstep, voffA);
        if (wr == 1) PG8_BAR;
        PG8_WAIT_V(4); PG8_BAR;
        PG8_STAGE(PG8_SB(1, 0), cB + kstep, voffB); PG8_STAGE(PG8_SA(1, 0), cA + kstep, voffA); PG8_STAGE(PG8_SB(1, 1), cB + hstep + kstep, voffB);
        PG8_WAIT_V(6); PG8_BAR;
    }
    for (;;) {
        const bool has_next = S.next(ui + 1, nxt);
        const char* nA = has_next ? (const char*)g.A + (size_t)nxt.pm * tstep : cA; const char* nB = has_next ? (const char*)g.Bt + (size_t)nxt.pn * tstep : cB;
        for (int t = 0; t < nt; t += 2) {
            const bool last = (t == nt - 2);
            const char* a1 = cA + (size_t)(t + 1) * kstep;
            const char* a2 = last ? nA : cA + (size_t)(t + 2) * kstep; const char* b2 = last ? nB : cB + (size_t)(t + 2) * kstep;
            const char* a3 = a2 + kstep; const char* b3 = b2 + kstep;
            if (last && has_next) S.a_ready(nxt);
            if constexpr (SP2) {
            PG8_LDB(B0, 0, 0); PG8_LDB(B1, 0, 1); PG8_SCHED; PG8_LDA(At, 0, 0); PG8_STAGE(PG8_SA(1, 1), a1 + hstep, voffA);
            PG8_WAIT_V(8); PG8_WAIT_L(0); PG8_BAR; PG8_MMA(0, 0, At, B0); PG8_MMA(0, 1, At, B1); PG8_BAR; PG8_SCHED;
            PG8_LDA(At, 0, 1); PG8_STAGE(PG8_SB(0, 0), b2, voffB); PG8_STAGE(PG8_SB(0, 1), b2 + hstep, voffB); PG8_STAGE(PG8_SA(0, 0), a2, voffA);
            PG8_WAIT_V(8); PG8_WAIT_L(0); PG8_BAR; PG8_MMA(1, 0, At, B0); PG8_MMA(1, 1, At, B1); PG8_BAR; PG8_SCHED;
            PG8_LDB(B0, 1, 0); PG8_LDB(B1, 1, 1); PG8_SCHED; PG8_LDA(At, 1, 0); PG8_STAGE(PG8_SA(0, 1), a2 + hstep, voffA);
            PG8_WAIT_V(8); PG8_WAIT_L(0); PG8_BAR; PG8_MMA(0, 0, At, B0); PG8_MMA(0, 1, At, B1); PG8_BAR; PG8_SCHED;
            PG8_LDA(At, 1, 1); PG8_STAGE(PG8_SB(1, 0), b3, voffB); PG8_STAGE(PG8_SB(1, 1), b3 + hstep, voffB); PG8_STAGE(PG8_SA(1, 0), a3, voffA);
            PG8_WAIT_V(8); PG8_WAIT_L(0); PG8_BAR; PG8_MMA(1, 0, At, B0); PG8_MMA(1, 1, At, B1); PG8_BAR; PG8_SCHED;
            } else {
            PG8_LDB(B0, 0, 0); PG8_SCHED; PG8_LDA(At, 0, 0); PG8_STAGE(PG8_SA(1, 1), a1 + hstep, voffA);
            PG8_WAIT_L(8); PG8_BAR; PG8_WAIT_L(0); PG8_MMA(0, 0, At, B0); PG8_BAR; PG8_SCHED;
            PG8_LDB(B1, 0, 1); PG8_STAGE(PG8_SB(0, 0), b2, voffB);
            PG8_BAR; PG8_WAIT_L(0); PG8_MMA(0, 1, At, B1); PG8_BAR;
            PG8_LDA(At, 0, 1); PG8_STAGE(PG8_SA(0, 0), a2, voffA);
            PG8_BAR; PG8_WAIT_L(0); PG8_MMA(1, 0, At, B0); PG8_BAR; PG8_SCHED;
            PG8_STAGE(PG8_SB(0, 1), b2 + hstep, voffB);
            PG8_WAIT_V(6); PG8_BAR; PG8_MMA(1, 1, At, B1); PG8_BAR;
            PG8_LDB(B0, 1, 0); PG8_SCHED; PG8_LDA(At, 1, 0); PG8_STAGE(PG8_SA(0, 1), a2 + hstep, voffA);
            PG8_WAIT_L(8); PG8_BAR; PG8_WAIT_L(0); PG8_MMA(0, 0, At, B0); PG8_BAR; PG8_SCHED;
            PG8_LDB(B1, 1, 1); PG8_STAGE(PG8_SB(1, 0), b3, voffB);
            PG8_BAR; PG8_WAIT_L(0); PG8_MMA(0, 1, At, B1); PG8_BAR;
            PG8_LDA(At, 1, 1); PG8_STAGE(PG8_SA(1, 0), a3, voffA);
            PG8_BAR; PG8_WAIT_L(0); PG8_MMA(1, 0, At, B0); PG8_BAR; PG8_SCHED;
            PG8_STAGE(PG8_SB(1, 1), b3 + hstep, voffB);
            PG8_WAIT_V(6); PG8_BAR; PG8_MMA(1, 1, At, B1); PG8_BAR;
            }
        }
        if constexpr (ALIGN_EPI) { if (wr == 0) PG8_BAR; }
        if constexpr (!Epi::AFTER_DRAIN) { E(acc, cur, wr, wc, fr, fq); S.done(cur); }
        if (!has_next) break;
#pragma unroll
        for (int a = 0; a < 2; ++a)
#pragma unroll
            for (int b = 0; b < 2; ++b)
#pragma unroll
                for (int m = 0; m < 4; ++m)
#pragma unroll
                    for (int n = 0; n < 2; ++n) acc[a][b][m][n] = (f32x4){0.f, 0.f, 0.f, 0.f};
        cur = nxt; cA = nA; cB = nB; ++ui;
        if constexpr (ALIGN_EPI) { if (wr == 1) PG8_BAR; }
    }
    PG8_WAIT_V(0);
    if constexpr (!ALIGN_EPI) { if (wr == 0) PG8_BAR; }
    PG8_BAR;
    if constexpr (Epi::AFTER_DRAIN) { E.fused(acc, cur, wr, wc, fr, fq, lds, wid, lane); S.done(cur); }
#undef PG8_SA
#undef PG8_SB
#undef PG8_STAGE
#undef PG8_LDA
#undef PG8_LDB
#undef PG8_MMA
#undef PG8_WAIT_V
#undef PG8_WAIT_L
#undef PG8_BAR
#undef PG8_SCHED
}
}

namespace pg8 {
struct EpiStoreBf16 {
    static constexpr bool PERM = true, AFTER_DRAIN = false;
    bf16_t* O; int ldc, pad;
    __device__ __forceinline__ void operator()(const f32x4 (&acc)[2][2][4][2], const Unit& u, int wr, int wc, int fr, int fq) const {
        const int row0 = u.pm * BM + wr * 64 + fr, col0 = u.pn * BM + wc * 32 + 8 * fq;
#pragma unroll
        for (int ai = 0; ai < 2; ++ai)
#pragma unroll
            for (int m = 0; m < 4; ++m) { bf16_t* rowp = O + (size_t)(row0 + ai * HALF + m * 16) * ldc + col0;
#pragma unroll
                for (int bj = 0; bj < 2; ++bj) { const f32x4 v0 = acc[ai][bj][m][0], v1 = acc[ai][bj][m][1];
                    u32x4 w; w.x = cvt_pk_bf16(v0[0], v0[1]); w.y = cvt_pk_bf16(v0[2], v0[3]); w.z = cvt_pk_bf16(v1[0], v1[1]); w.w = cvt_pk_bf16(v1[2], v1[3]);
                    *(u32x4*)(rowp + bj * HALF) = w; } }
    }
};
struct EpiResF32 {
    static constexpr bool PERM = false, AFTER_DRAIN = false;
    const float* base; float* out; int ldc, pad;
    __device__ __forceinline__ void operator()(const f32x4 (&acc)[2][2][4][2], const Unit& u, int wr, int wc, int fr, int fq) const {
        const int row0 = u.pm * BM + wr * 64 + fr, col0 = u.pn * BM + wc * 32 + 4 * fq;
#pragma unroll
        for (int ai = 0; ai < 2; ++ai)
#pragma unroll
            for (int m = 0; m < 4; ++m) { const size_t off = (size_t)(row0 + ai * HALF + m * 16) * ldc + col0;
#pragma unroll
                for (int bj = 0; bj < 2; ++bj)
#pragma unroll
                    for (int n = 0; n < 2; ++n) { const f32x4 b = *(const f32x4*)(base + off + bj * HALF + n * 16); *(f32x4*)(out + off + bj * HALF + n * 16) = b + acc[ai][bj][m][n]; } }
    }
};
struct EpiSwiGLU {
    static constexpr bool PERM = true, AFTER_DRAIN = false;
    bf16_t* O; int ldc, pad;
    __device__ __forceinline__ void operator()(const f32x4 (&acc)[2][2][4][2], const Unit& u, int wr, int wc, int fr, int fq) const {
        const int row0 = u.pm * BM + wr * 64 + fr, col0 = u.pn * HALF + wc * 32 + 8 * fq;
#pragma unroll
        for (int ai = 0; ai < 2; ++ai)
#pragma unroll
            for (int m = 0; m < 4; ++m) { bf16_t* rowp = O + (size_t)(row0 + ai * HALF + m * 16) * ldc + col0;
                float r[8];
#pragma unroll
                for (int n = 0; n < 2; ++n)
#pragma unroll
                    for (int e = 0; e < 4; ++e) { const float g = acc[ai][0][m][n][e], up = acc[ai][1][m][n][e]; r[n * 4 + e] = g * up / (1.0f + __expf(-g)); }
                u32x4 w; w.x = cvt_pk_bf16(r[0], r[1]); w.y = cvt_pk_bf16(r[2], r[3]); w.z = cvt_pk_bf16(r[4], r[5]); w.w = cvt_pk_bf16(r[6], r[7]);
                *(u32x4*)rowp = w; }
    }
};
}
typedef unsigned short bf16_t;
constexpr int DM = 2048, NB = 4, SEQ = 4096, MT = NB * SEQ;
constexpr int HD = 128, NH = 8, AW = 1024, CW = 1024, NPROJ = 6144;
constexpr int NBLK = 16, MBLK = 256;
constexpr int NMEM = 256, XH = 4, XW = 512, DFF = 5632;
constexpr float EPS = 1e-6f;
constexpr float SM_SCALE = 0.088388347648318440f;
constexpr size_t MiB = 1u << 20;
constexpr size_t WS_WIN = 0;
constexpr size_t WS_WOUT = 24 * MiB;
constexpr size_t WS_WXQ = 32 * MiB;
constexpr size_t WS_WXKV = 34 * MiB;
constexpr size_t WS_WXO = 38 * MiB;
constexpr size_t WS_WGU = 40 * MiB;
constexpr size_t WS_WDN = 84 * MiB;
constexpr size_t WS_H = 112 * MiB;
constexpr size_t WS_MRG = 176 * MiB;
constexpr size_t WS_PROJ = 240 * MiB;
constexpr size_t WS_ACT = 240 * MiB;
constexpr size_t WS_QX = 432 * MiB;
constexpr size_t WS_OX = 448 * MiB;
constexpr size_t WS_KVX = 464 * MiB;
constexpr size_t WS_MEMN = 466 * MiB;
constexpr size_t WS_CS = 470 * MiB;
constexpr size_t WS_KMEAN = 478 * MiB;
constexpr size_t WS_END = 479 * MiB;

__device__ __forceinline__ float bf2f(unsigned v) { return __uint_as_float(v << 16); }
__device__ __forceinline__ unsigned f2bf(float f) { unsigned u = __float_as_uint(f); return (u + 0x7fffu + ((u >> 16) & 1u)) >> 16; }
__device__ __forceinline__ unsigned pk2(float lo, float hi) { return f2bf(lo) | (f2bf(hi) << 16); }
__device__ __forceinline__ float wave_sum(float v) {
#pragma unroll
    for (int o = 1; o < 64; o <<= 1) v += __shfl_xor(v, o);
    return v;
}
__device__ __forceinline__ float wave_max(float v) {
#pragma unroll
    for (int o = 1; o < 64; o <<= 1) v = fmaxf(v, __shfl_xor(v, o));
    return v;
}
typedef float f32x4 __attribute__((ext_vector_type(4)));
typedef unsigned u32x4 __attribute__((ext_vector_type(4)));
typedef unsigned u32x2 __attribute__((ext_vector_type(2)));

struct TJob { const float* src0; const float* src1; const float* gain; bf16_t* dst; int K, Nsrc, nrows, mode; };
__device__ __forceinline__ void transpose_item(const TJob& J, float* scr, int item, int lane) {
    const int nblk = J.nrows / 32, kb = item / nblk, nb = item % nblk, k0 = 64 * kb, n0 = 32 * nb;
    const float* src = J.src0; int c0 = n0;
    if (J.mode == 2) { const int tile = n0 >> 8, w = n0 & 255; if (w < 128) { c0 = tile * 128 + w; } else { src = J.src1; c0 = tile * 128 + w - 128; } }
#pragma unroll 8
    for (int i = 0; i < 32; ++i) { const int kk = 2 * i + (lane >> 5); float v = src[(size_t)(k0 + kk) * J.Nsrc + c0 + (lane & 31)]; if (J.gain) v *= J.gain[k0 + kk]; scr[kk * 33 + (lane & 31)] = v; }
    asm volatile("s_waitcnt lgkmcnt(0)" ::: "memory");
    const int c = lane & 7;
#pragma unroll
    for (int j = 0; j < 4; ++j) { const int n = (lane >> 3) + 8 * j; const float* s = scr + (8 * c) * 33 + n;
        u32x4 o; o.x = pk2(s[0 * 33], s[1 * 33]); o.y = pk2(s[2 * 33], s[3 * 33]); o.z = pk2(s[4 * 33], s[5 * 33]); o.w = pk2(s[6 * 33], s[7 * 33]);
        *(u32x4*)(J.dst + (size_t)(n0 + n) * J.K + k0 + 8 * c) = o; }
    asm volatile("s_waitcnt lgkmcnt(0)" ::: "memory");
}
__device__ __forceinline__ int ph_transpose_job(const TJob J, int base, float* scr, int gw, int NGW, int lane) {
    const int nitems = (J.K / 64) * (J.nrows / 32);
    const int first = (gw - base % NGW + NGW) % NGW;
    for (int it = first; it < nitems; it += NGW) transpose_item(J, scr, it, lane);
    return base + nitems;
}

__device__ __forceinline__ void rms_row_bf16(const float* xrow, const float* g, bf16_t* orow, int lane) {
    const f32x4* xr = (const f32x4*)xrow + lane; const f32x4* gr = (const f32x4*)g + lane;
    f32x4 v[8]; float s = 0.f;
#pragma unroll
    for (int j = 0; j < 8; ++j) { v[j] = xr[64 * j]; s += (v[j].x * v[j].x + v[j].y * v[j].y) + (v[j].z * v[j].z + v[j].w * v[j].w); }
    const float rinv = rsqrtf(wave_sum(s) * (1.f / DM) + EPS);
    u32x2* o8 = (u32x2*)orow + lane;
#pragma unroll
    for (int j = 0; j < 8; ++j) { const f32x4 gg = gr[64 * j]; u32x2 w; w.x = pk2(v[j].x * rinv * gg.x, v[j].y * rinv * gg.y); w.y = pk2(v[j].z * rinv * gg.z, v[j].w * rinv * gg.w); o8[64 * j] = w; }
}
__device__ __forceinline__ void ph_rms_bf16(const float* X, const float* g, bf16_t* O, int rows, int gw, int NGW, int lane) {
    for (int r = gw; r < rows; r += NGW) rms_row_bf16(X + (size_t)r * DM, g, O + (size_t)r * DM, lane);
}
__device__ __forceinline__ void ph_final_norm(float* X, const float* g, int rows, int gw, int NGW, int lane) {
    for (int r = gw; r < rows; r += NGW) {
        f32x4* xr = (f32x4*)(X + (size_t)r * DM) + lane; const f32x4* gr = (const f32x4*)g + lane;
        f32x4 v[8]; float s = 0.f;
#pragma unroll
        for (int j = 0; j < 8; ++j) { v[j] = xr[64 * j]; s += (v[j].x * v[j].x + v[j].y * v[j].y) + (v[j].z * v[j].z + v[j].w * v[j].w); }
        const float rinv = rsqrtf(wave_sum(s) * (1.f / DM) + EPS);
#pragma unroll
        for (int j = 0; j < 8; ++j) xr[64 * j] = v[j] * rinv * gr[64 * j];
    }
}

__device__ __forceinline__ void sincos_small(double r, double& s, double& c) {
    const double r2 = r * r;
    double a = -1.0 / 10888869450418352160768000000.0;
    a = a * r2 + 1.0 / 15511210043330985984000000.0;
    a = a * r2 - 1.0 / 25852016738884976640000.0;
    a = a * r2 + 1.0 / 51090942171709440000.0;
    a = a * r2 - 1.0 / 121645100408832000.0;
    a = a * r2 + 1.0 / 355687428096000.0;
    a = a * r2 - 1.0 / 1307674368000.0;
    a = a * r2 + 1.0 / 6227020800.0;
    a = a * r2 - 1.0 / 39916800.0;
    a = a * r2 + 1.0 / 362880.0;
    a = a * r2 - 1.0 / 5040.0;
    a = a * r2 + 1.0 / 120.0;
    a = a * r2 - 1.0 / 6.0;
    a = a * r2 + 1.0;
    s = a * r;
    double b = 1.0 / 403291461126605635584000000.0;
    b = b * r2 - 1.0 / 620448401733239439360000.0;
    b = b * r2 + 1.0 / 1124000727777607680000.0;
    b = b * r2 - 1.0 / 2432902008176640000.0;
    b = b * r2 + 1.0 / 6402373705728000.0;
    b = b * r2 - 1.0 / 20922789888000.0;
    b = b * r2 + 1.0 / 87178291200.0;
    b = b * r2 - 1.0 / 479001600.0;
    b = b * r2 + 1.0 / 3628800.0;
    b = b * r2 - 1.0 / 40320.0;
    b = b * r2 + 1.0 / 720.0;
    b = b * r2 - 1.0 / 24.0;
    b = b * r2 + 1.0 / 2.0;
    c = 1.0 - b * r2;
}
__device__ __forceinline__ void cs_entry(const int* pos, float* cs, int idx) {
    const int t = idx >> 6, f = idx & 63;
    double p = 1.0, bs = 0.8659643233600653;
#pragma unroll
    for (int bit = 0; bit < 6; ++bit) { if ((f >> bit) & 1) p *= bs; bs *= bs; }
    const double ang = (double)pos[t] * p;
    const double TWO_PI = 6.283185307179586;
    const double n = rint(ang / TWO_PI);
    const double r = fma(-n, TWO_PI, ang);
    double s, c; sincos_small(r, s, c);
    cs[2 * idx] = (float)c; cs[2 * idx + 1] = (float)s;
}
__device__ __forceinline__ void ph_cs(const int* pos, float* cs, int gtid, int NT) {
    for (int idx = gtid; idx < MT * 64; idx += NT) cs_entry(pos, cs, idx);
}
__device__ __forceinline__ void ph_rope_naive(bf16_t* proj, const float* cs, int gtid, int NT) {
    const long total = (long)MT * 2 * NH * 64;
    for (long i = gtid; i < total; i += NT) {
        const int d = (int)(i & 63), h = (int)((i >> 6) & 7), sec = (int)((i >> 9) & 1); const long t = i >> 10;
        bf16_t* p = proj + t * NPROJ + sec * 1024 + h * HD + d;
        const float a = bf2f(p[0]), b = bf2f(p[64]); const float c = cs[(t * 64 + d) * 2], s = cs[(t * 64 + d) * 2 + 1];
        p[0] = (bf16_t)f2bf(a * c - b * s); p[64] = (bf16_t)f2bf(b * c + a * s);
    }
}
__device__ __forceinline__ void ph_kmean_naive(const bf16_t* proj, float* kmean, int gtid, int NT) {
    for (int i = gtid; i < NB * NH * NBLK * HD; i += NT) {
        const int d = i & 127, blkid = i >> 7;
        const int blk = blkid & 15, h = (blkid >> 4) & 7, b = blkid >> 7;
        float s = 0.f;
        for (int j = 0; j < MBLK; ++j) s += bf2f(proj[(size_t)(b * SEQ + blk * MBLK + j) * NPROJ + 1024 + h * HD + d]);
        kmean[(size_t)blkid * HD + d] = s * (1.f / MBLK);
    }
}
__device__ __forceinline__ float dot_q_row(const float* sq, const bf16_t* krow) {
    float a = 0.f;
#pragma unroll
    for (int d = 0; d < 128; d += 8) { const u32x4 kk = *(const u32x4*)(krow + d);
        a += sq[d + 0] * bf2f(kk.x & 0xffffu) + sq[d + 1] * bf2f(kk.x >> 16) + sq[d + 2] * bf2f(kk.y & 0xffffu) + sq[d + 3] * bf2f(kk.y >> 16)
           + sq[d + 4] * bf2f(kk.z & 0xffffu) + sq[d + 5] * bf2f(kk.z >> 16) + sq[d + 6] * bf2f(kk.w & 0xffffu) + sq[d + 7] * bf2f(kk.w >> 16); }
    return a;
}
__device__ __forceinline__ void ph_moba_naive(const bf16_t* proj, const float* kmean, const float* g_attn, bf16_t* merged, float qscale_inv, float* scr, int gw, int NGW, int lane) {
    float* sq = scr; float* sp = scr + 128;
    for (int item = gw; item < MT * NH; item += NGW) {
        const int t = item >> 3, h = item & 7, b = t >> 12, ts = t & 4095, qb = ts >> 8, tq = ts & 255;
        const bf16_t* qrow = proj + (size_t)t * NPROJ + h * HD;
        const unsigned qq = *(const unsigned*)(qrow + 2 * lane);
        const float q0 = bf2f(qq & 0xffffu) * qscale_inv, q1 = bf2f(qq >> 16) * qscale_inv;
        asm volatile("s_waitcnt lgkmcnt(0)" ::: "memory");
        sq[2 * lane] = q0; sq[2 * lane + 1] = q1;
        float g[16];
#pragma unroll
        for (int i = 0; i < 16; ++i) { const float* km = kmean + (size_t)((b * 8 + h) * 16 + i) * HD; const float p = wave_sum(q0 * km[2 * lane] + q1 * km[2 * lane + 1]); g[i] = (i < qb) ? p : -INFINITY; }
        int sel[4];
#pragma unroll
        for (int r = 0; r < 3; ++r) { float best = -INFINITY; int bi = -1;
#pragma unroll
            for (int i = 0; i < 16; ++i) if (g[i] > best) { best = g[i]; bi = i; }
            sel[r] = bi;
#pragma unroll
            for (int i = 0; i < 16; ++i) if (i == bi) g[i] = -INFINITY; }
        sel[3] = qb;
        asm volatile("s_waitcnt lgkmcnt(0)" ::: "memory");
#pragma unroll
        for (int s = 0; s < 4; ++s) { const int blk = sel[s];
            for (int jj = 0; jj < 4; ++jj) { const int j = jj * 64 + lane; float sc = -INFINITY;
                if (blk >= 0 && (s < 3 || j <= tq)) sc = dot_q_row(sq, proj + (size_t)(b * SEQ + blk * MBLK + j) * NPROJ + 1024 + h * HD) * SM_SCALE;
                sp[s * 256 + j] = sc; } }
        asm volatile("s_waitcnt lgkmcnt(0)" ::: "memory");
        float m = -INFINITY; for (int i = lane; i < 1024; i += 64) m = fmaxf(m, sp[i]); m = wave_max(m);
        float l = 0.f; for (int i = lane; i < 1024; i += 64) { const float p = __expf(sp[i] - m); sp[i] = p; l += p; } l = wave_sum(l);
        asm volatile("s_waitcnt lgkmcnt(0)" ::: "memory");
        float o0 = 0.f, o1 = 0.f;
#pragma unroll
        for (int s = 0; s < 4; ++s) { const int blk = sel[s]; if (blk < 0) continue;
            const bf16_t* vb = proj + (size_t)(b * SEQ + blk * MBLK) * NPROJ + 2048 + h * HD + 2 * lane;
            for (int j = 0; j < 256; ++j) { const float p = sp[s * 256 + j]; const unsigned vv = *(const unsigned*)(vb + (size_t)j * NPROJ); o0 += p * bf2f(vv & 0xffffu); o1 += p * bf2f(vv >> 16); } }
        const float li = 1.f / l; o0 *= li; o1 *= li;
        const float rinv = rsqrtf(wave_sum(o0 * o0 + o1 * o1) * (1.f / HD) + EPS);
        *(unsigned*)(merged + (size_t)t * DM + h * HD + 2 * lane) = pk2(o0 * rinv * g_attn[h * HD + 2 * lane], o1 * rinv * g_attn[h * HD + 2 * lane + 1]);
    }
}
__device__ __forceinline__ void ph_conv_naive(const bf16_t* proj, const float* w_conv, const float* b_conv, const float* g_conv, bf16_t* merged, int gw, int NGW, int lane) {
    for (int item = gw; item < MT * 8; item += NGW) {
        const int t = item >> 3, grp = item & 7, ts = t & 4095; const int c = grp * 128 + 2 * lane;
        float y[2];
#pragma unroll
        for (int e = 0; e < 2; ++e) { float acc = b_conv[c + e];
#pragma unroll
            for (int k = 0; k < 3; ++k) { const int back = 2 - k; if (ts - back >= 0) { const bf16_t* r = proj + (size_t)(t - back) * NPROJ; acc += w_conv[k * CW + c + e] * (bf2f(r[3072 + c + e]) * bf2f(r[5120 + c + e])); } }
            y[e] = bf2f(proj[(size_t)t * NPROJ + 4096 + c + e]) * acc; }
        const float rinv = rsqrtf(wave_sum(y[0] * y[0] + y[1] * y[1]) * (1.f / HD) + EPS);
        *(unsigned*)(merged + (size_t)t * DM + AW + c) = pk2(y[0] * rinv * g_conv[c], y[1] * rinv * g_conv[c + 1]);
    }
}
__device__ __forceinline__ void ph_xattn_naive(const bf16_t* qx, const bf16_t* kvx, bf16_t* ox, float qscale_inv, float* scr, int gw, int NGW, int lane) {
    float* sq = scr; float* sp = scr + 128;
    for (int item = gw; item < MT * XH; item += NGW) {
        const int t = item >> 2, h = item & 3, b = t >> 12;
        const unsigned qq = *(const unsigned*)(qx + (size_t)t * XW + h * HD + 2 * lane);
        asm volatile("s_waitcnt lgkmcnt(0)" ::: "memory");
        sq[2 * lane] = bf2f(qq & 0xffffu) * qscale_inv; sq[2 * lane + 1] = bf2f(qq >> 16) * qscale_inv;
        asm volatile("s_waitcnt lgkmcnt(0)" ::: "memory");
        float m = -INFINITY;
        for (int jj = 0; jj < 4; ++jj) { const int j = jj * 64 + lane; const float sc = dot_q_row(sq, kvx + (size_t)(b * NMEM + j) * 1024 + h * HD) * SM_SCALE; sp[j] = sc; m = fmaxf(m, sc); }
        m = wave_max(m);
        asm volatile("s_waitcnt lgkmcnt(0)" ::: "memory");
        float l = 0.f; for (int i = lane; i < 256; i += 64) { const float p = __expf(sp[i] - m); sp[i] = p; l += p; } l = wave_sum(l);
        asm volatile("s_waitcnt lgkmcnt(0)" ::: "memory");
        float o0 = 0.f, o1 = 0.f; const bf16_t* vb = kvx + (size_t)(b * NMEM) * 1024 + 512 + h * HD + 2 * lane;
        for (int j = 0; j < 256; ++j) { const float p = sp[j]; const unsigned vv = *(const unsigned*)(vb + (size_t)j * 1024); o0 += p * bf2f(vv & 0xffffu); o1 += p * bf2f(vv >> 16); }
        const float li = 1.f / l;
        *(unsigned*)(ox + (size_t)t * XW + h * HD + 2 * lane) = pk2(o0 * li, o1 * li);
    }
}

namespace cg = cooperative_groups;
constexpr int LDS_BYTES = 147456;
struct Args { const void* in[20]; float* out; unsigned char* ws; };
__global__ void __launch_bounds__(512, 2) mk_fwd(Args a) {
    extern __shared__ __attribute__((aligned(16))) unsigned char lds[];
    cg::grid_group grid = cg::this_grid();
    const int tid = threadIdx.x, lane = tid & 63, wave = __builtin_amdgcn_readfirstlane(tid >> 6);
    const int G = (int)gridDim.x, bx = (int)blockIdx.x;
    const int gw = bx * 8 + wave, NGW = G * 8, gtid = bx * 512 + tid, NT = G * 512;
    const float* x = (const float*)a.in[0]; const float* mem = (const float*)a.in[1]; const int* pos = (const int*)a.in[2];
    const float* g_mix = (const float*)a.in[3]; const float* w_in = (const float*)a.in[4]; const float* w_conv = (const float*)a.in[5];
    const float* b_conv = (const float*)a.in[6]; const float* g_attn = (const float*)a.in[7]; const float* g_conv = (const float*)a.in[8];
    const float* w_out = (const float*)a.in[9]; const float* g_xattn = (const float*)a.in[10]; const float* g_mem = (const float*)a.in[11];
    const float* w_xq = (const float*)a.in[12]; const float* w_xkv = (const float*)a.in[13]; const float* w_xo = (const float*)a.in[14];
    const float* g_ffn = (const float*)a.in[15]; const float* w_gate = (const float*)a.in[16]; const float* w_up = (const float*)a.in[17];
    const float* w_down = (const float*)a.in[18]; const float* g_final = (const float*)a.in[19];
    float* out = a.out; unsigned char* ws = a.ws;
    bf16_t* Win = (bf16_t*)(ws + WS_WIN); bf16_t* Wout = (bf16_t*)(ws + WS_WOUT); bf16_t* Wxq = (bf16_t*)(ws + WS_WXQ); bf16_t* Wxkv = (bf16_t*)(ws + WS_WXKV);
    bf16_t* Wxo = (bf16_t*)(ws + WS_WXO); bf16_t* Wgu = (bf16_t*)(ws + WS_WGU); bf16_t* Wdn = (bf16_t*)(ws + WS_WDN);
    bf16_t* H = (bf16_t*)(ws + WS_H); bf16_t* MRG = (bf16_t*)(ws + WS_MRG); bf16_t* PROJ = (bf16_t*)(ws + WS_PROJ); bf16_t* ACT = (bf16_t*)(ws + WS_ACT);
    bf16_t* QX = (bf16_t*)(ws + WS_QX); bf16_t* OX = (bf16_t*)(ws + WS_OX); bf16_t* KVX = (bf16_t*)(ws + WS_KVX); bf16_t* MEMN = (bf16_t*)(ws + WS_MEMN);
    float* CS = (float*)(ws + WS_CS); float* KMEAN = (float*)(ws + WS_KMEAN);
    PG8_LAS unsigned char* ldsg = (PG8_LAS unsigned char*)lds;
    float* wscr = (float*)(lds + wave * 16384);

#define GEMM(EpiT, Aop, Bop, Mr, Nc, Kd, ...) do { pg8::Gemm g_{Aop, Bop, Mr, Nc, Kd, 0}; pg8::StaticOrder S_; S_.init(Mr, Nc, G, bx); EpiT E_{__VA_ARGS__}; \
        pg8::gemm_phase<EpiT, pg8::StaticOrder, true, true>(ldsg, g_, S_, E_); } while (0)

    {
        int base = 0;
        base = ph_transpose_job(TJob{w_in, nullptr, nullptr, Win, DM, NPROJ, NPROJ, 0}, base, wscr, gw, NGW, lane);
        base = ph_transpose_job(TJob{w_out, nullptr, nullptr, Wout, DM, DM, DM, 0}, base, wscr, gw, NGW, lane);
        base = ph_transpose_job(TJob{w_xq, nullptr, nullptr, Wxq, DM, XW, XW, 0}, base, wscr, gw, NGW, lane);
        base = ph_transpose_job(TJob{w_xkv, nullptr, nullptr, Wxkv, DM, 2 * XW, 2 * XW, 0}, base, wscr, gw, NGW, lane);
        base = ph_transpose_job(TJob{w_xo, nullptr, nullptr, Wxo, XW, DM, DM, 0}, base, wscr, gw, NGW, lane);
        base = ph_transpose_job(TJob{w_gate, w_up, nullptr, Wgu, DM, DFF, 2 * DFF, 2}, base, wscr, gw, NGW, lane);
        base = ph_transpose_job(TJob{w_down, nullptr, nullptr, Wdn, DFF, DM, DM, 0}, base, wscr, gw, NGW, lane);
    }
    ph_cs(pos, CS, gtid, NT);
    ph_rms_bf16(x, g_mix, H, MT, gw, NGW, lane);
    ph_rms_bf16(mem, g_mem, MEMN, NB * NMEM, gw, NGW, lane);
    grid.sync();
    GEMM(pg8::EpiStoreBf16, H, Win, MT, NPROJ, DM, PROJ, NPROJ, 0);
    GEMM(pg8::EpiStoreBf16, MEMN, Wxkv, NB * NMEM, 2 * XW, DM, KVX, 2 * XW, 0);
    grid.sync();
    ph_rope_naive(PROJ, CS, gtid, NT);
    grid.sync();
    ph_kmean_naive(PROJ, KMEAN, gtid, NT);
    grid.sync();
    ph_moba_naive(PROJ, KMEAN, g_attn, MRG, 1.0f, wscr, gw, NGW, lane);
    ph_conv_naive(PROJ, w_conv, b_conv, g_conv, MRG, gw, NGW, lane);
    grid.sync();
    GEMM(pg8::EpiResF32, MRG, Wout, MT, DM, DM, x, out, DM, 0);
    grid.sync();
    ph_rms_bf16(out, g_xattn, H, MT, gw, NGW, lane);
    grid.sync();
    GEMM(pg8::EpiStoreBf16, H, Wxq, MT, XW, DM, QX, XW, 0);
    grid.sync();
    ph_xattn_naive(QX, KVX, OX, 1.0f, wscr, gw, NGW, lane);
    grid.sync();
    GEMM(pg8::EpiResF32, OX, Wxo, MT, DM, XW, out, out, DM, 0);
    grid.sync();
    ph_rms_bf16(out, g_ffn, H, MT, gw, NGW, lane);
    grid.sync();
    GEMM(pg8::EpiSwiGLU, H, Wgu, MT, 2 * DFF, DM, ACT, DFF, 0);
    grid.sync();
    GEMM(pg8::EpiResF32, ACT, Wdn, MT, DM, DFF, out, out, DM, 0);
    grid.sync();
    ph_final_norm(out, g_final, MT, gw, NGW, lane);
#undef GEMM
}

extern "C" void kernel_launch(void* const* d_in, const int* in_sizes, int n_in, void* d_out, int out_size, void* d_ws, size_t ws_size, hipStream_t stream) {
    static int grid_blocks = 0;
    if (grid_blocks == 0) {
        if (n_in != 20 || ws_size < WS_END) { fprintf(stderr, "kernel_launch: unexpected n_in %d / ws %zu\n", n_in, ws_size); grid_blocks = -1; return; }
        int dev = 0, cus = 0, per_cu = 0;
        (void)hipGetDevice(&dev); (void)hipDeviceGetAttribute(&cus, hipDeviceAttributeMultiprocessorCount, dev);
        (void)hipFuncSetAttribute((const void*)mk_fwd, hipFuncAttributeMaxDynamicSharedMemorySize, LDS_BYTES);
        (void)hipOccupancyMaxActiveBlocksPerMultiprocessor(&per_cu, (const void*)mk_fwd, 512, LDS_BYTES);
        if (per_cu < 1) { fprintf(stderr, "kernel_launch: occupancy query says %d blocks per CU\n", per_cu); per_cu = 1; }
        grid_blocks = cus;
        (void)hipGetLastError();
    }
    if (grid_blocks < 0) return;
    Args a{};
    for (int i = 0; i < 20; ++i) a.in[i] = d_in[i];
    a.out = (float*)d_out; a.ws = (unsigned char*)d_ws;
    void* args[] = {&a};
    hipError_t e = hipLaunchCooperativeKernel((const void*)mk_fwd, dim3(grid_blocks), dim3(512), args, LDS_BYTES, stream);
    if (e != hipSuccess) fprintf(stderr, "cooperative launch failed: %s (grid %d)\n", hipGetErrorString(e), grid_blocks);
}
```

```cpp
#include <hip/hip_runtime.h>
#include <hip/hip_cooperative_groups.h>
#include <cstdio>
#include <cstdint>
#include <cmath>
__device__ __forceinline__ int otid() { int t = (int)threadIdx.x; asm volatile("" : "+v"(t)); return t; }
namespace pg8 {
#define PG8_LAS __attribute__((address_space(3)))
typedef unsigned short bf16_t;
typedef short bf16x8 __attribute__((ext_vector_type(8)));
typedef float f32x4 __attribute__((ext_vector_type(4)));
typedef unsigned u32x4 __attribute__((ext_vector_type(4)));
constexpr int BM = 256, BK = 64, HALF = 128, HTB = HALF * BK * 2  , STAGE_BYTES = 8 * HTB, NXCD = 8, WGM = 8;

__host__ __device__ __forceinline__ int lds_byte(int r, int c) { const int st = (r >> 4) * 2 + (c >> 5), rr = r & 15, cc = c & 31, ob = rr * 64 + cc * 2; return st * 1024 + (ob ^ (((ob >> 9) & 1) << 5)); }
__host__ __device__ __forceinline__ void stage_rc(int b, int& R, int& C) { const int st = b / 1024, sb = b % 1024, swz = sb ^ (((sb >> 9) & 1) << 5); R = (st >> 1) * 16 + swz / 64; C = (st & 1) * 32 + (swz % 64) / 2; }
__host__ __device__ __forceinline__ int perm32(int rho) { const int n = rho >> 4, i = rho & 15; return 8 * (i >> 2) + 4 * n + (i & 3); }

struct Unit { int pm, pn; };
struct Gemm { const bf16_t* A; const bf16_t* Bt; int M, N, K, pad; };

struct StaticOrder {
    int nM, nN, nwg, G, c;
    __host__ __device__ void init(int M, int N, int G_, int c_) { nM = M / BM; nN = N / BM; nwg = nM * nN; G = G_; c = c_; }
    __host__ __device__ bool next(int i, Unit& u) const {
        const long L = (long)i * G + c; if (L >= nwg) return false;
        int wgid = (int)L; { const int q = nwg / NXCD, r = nwg % NXCD, xcd = wgid % NXCD, off = wgid / NXCD; wgid = (xcd < r ? xcd * (q + 1) : r * (q + 1) + (xcd - r) * q) + off; }
        const int nig = WGM * nN, gid = wgid / nig, fm = gid * WGM, gsz = (nM - fm) < WGM ? (nM - fm) : WGM;
        u.pm = fm + ((wgid % nig) % gsz); u.pn = (wgid % nig) / gsz; return true;
    }
    __device__ __forceinline__ void a_ready(const Unit&) const {}
    __device__ __forceinline__ void done(const Unit&) const {}
};
__device__ __forceinline__ unsigned cvt_pk_bf16(float lo, float hi) { unsigned r; asm volatile("v_cvt_pk_bf16_f32 %0, %1, %2" : "=v"(r) : "v"(lo), "v"(hi)); return r; }
template <class Epi, class Sched, bool ALIGN_EPI = false, bool SP2 = false>
__device__ __forceinline__ void gemm_phase(PG8_LAS unsigned char* lds, const Gemm g, const Sched& S, const Epi& E) {
    const int tid = otid(), wid = __builtin_amdgcn_readfirstlane(tid >> 6), lane = tid & 63, wr = wid >> 2, wc = wid & 3, fr = lane & 15, fq = lane >> 4;
    const int K = g.K, nt = K / BK;
    unsigned voffA[2], voffB[2];
#pragma unroll
    for (int i = 0; i < 2; ++i) { int R, C; stage_rc(tid * 16 + i * 8192, R, C); const int Rb = Epi::PERM ? ((R & ~31) + perm32(R & 31)) : R;
        voffA[i] = (unsigned)(R * K + C) * 2u; voffB[i] = (unsigned)(Rb * K + C) * 2u; }
    const size_t kstep = (size_t)(BK * 2);
    const size_t hstep = (size_t)HALF * K * 2;
    const size_t tstep = 2 * hstep;
    const unsigned ldsw = (unsigned)wid * 1024u;
    const int aoff = lds_byte(wr * 64 + fr, fq * 8), boff = lds_byte(wc * 32 + fr, fq * 8);
#define PG8_SA(b, h) (((b) * 2 + (h)) * HTB)
#define PG8_SB(b, h) ((4 + (b) * 2 + (h)) * HTB)
#define PG8_STAGE(bufoff, gbase, voff) do { _Pragma("unroll") for (int _i = 0; _i < 2; ++_i) \
        __builtin_amdgcn_global_load_lds((const unsigned*)((const char*)(gbase) + (voff)[_i]), (PG8_LAS unsigned*)(lds + (bufoff) + ldsw + _i * 8192), 16, 0, 0); } while (0)
#define PG8_LDA(dst, b, h) do { _Pragma("unroll") for (int m = 0; m < 4; ++m) _Pragma("unroll") for (int k = 0; k < 2; ++k) dst[m][k] = *(const PG8_LAS bf16x8*)(lds + PG8_SA(b, h) + aoff + m * 2048 + k * 1024); } while (0)
#define PG8_LDB(dst, b, h) do { _Pragma("unroll") for (int n = 0; n < 2; ++n) _Pragma("unroll") for (int k = 0; k < 2; ++k) dst[n][k] = *(const PG8_LAS bf16x8*)(lds + PG8_SB(b, h) + boff + n * 2048 + k * 1024); } while (0)
#define PG8_MMA(ai, bj, At, Bt) do { __builtin_amdgcn_s_setprio(1); _Pragma("unroll") for (int m = 0; m < 4; ++m) _Pragma("unroll") for (int n = 0; n < 2; ++n) _Pragma("unroll") for (int k = 0; k < 2; ++k) \
        acc[ai][bj][m][n] = __builtin_amdgcn_mfma_f32_16x16x32_bf16(Bt[n][k], At[m][k], acc[ai][bj][m][n], 0, 0, 0); __builtin_amdgcn_s_setprio(0); } while (0)
#define PG8_WAIT_V(n) asm volatile("s_waitcnt vmcnt(" #n ")" ::: "memory")
#define PG8_WAIT_L(n) asm volatile("s_waitcnt lgkmcnt(" #n ")" ::: "memory")
#define PG8_BAR __builtin_amdgcn_s_barrier()
#define PG8_SCHED __builtin_amdgcn_sched_barrier(0)
    Unit cur, nxt; int ui = 0;
    if (!S.next(0, cur)) return;
    f32x4 acc[2][2][4][2];
#pragma unroll
    for (int a = 0; a < 2; ++a)
#pragma unroll
        for (int b = 0; b < 2; ++b)
#pragma unroll
            for (int m = 0; m < 4; ++m)
#pragma unroll
                for (int n = 0; n < 2; ++n) acc[a][b][m][n] = (f32x4){0.f, 0.f, 0.f, 0.f};
    bf16x8 At[4][2], B0[2][2], B1[2][2];
    const char* cA = (const char*)g.A + (size_t)cur.pm * tstep; const char* cB = (const char*)g.Bt + (size_t)cur.pn * tstep;
    S.a_ready(cur);
    if constexpr (SP2) {
        PG8_STAGE(PG8_SB(0, 0), cB, voffB); PG8_STAGE(PG8_SB(0, 1), cB + hstep, voffB); PG8_STAGE(PG8_SA(0, 0), cA, voffA); PG8_STAGE(PG8_SA(0, 1), cA + hstep, voffA);
        if (wr == 1) PG8_BAR;
        PG8_WAIT_V(2); PG8_BAR;
        PG8_STAGE(PG8_SB(1, 0), cB + kstep, voffB); PG8_STAGE(PG8_SA(1, 0), cA + kstep, voffA); PG8_STAGE(PG8_SB(1, 1), cB + hstep + kstep, voffB);
        PG8_WAIT_V(6); PG8_BAR;
    } else {
        PG8_STAGE(PG8_SB(0, 0), cB, voffB); PG8_STAGE(PG8_SA(0, 0), cA, voffA); PG8_STAGE(PG8_SB(0, 1), cB + hstep, voffB); PG8_STAGE(PG8_SA(0, 1), cA + hstep, voffA);
        if (wr == 1) PG8_BAR;
        PG8_WAIT_V(4); PG8_BAR;
        PG8_STAGE(PG8_SB(1, 0), cB + kstep, voffB); PG8_STAGE(PG8_SA(1, 0), cA + kstep, voffA); PG8_STAGE(PG8_SB(1, 1), cB + hstep + kstep, voffB);
        PG8_WAIT_V(6); PG8_BAR;
    }
    for (;;) {
        const bool has_next = S.next(ui + 1, nxt);
        const char* nA = has_next ? (const char*)g.A + (size_t)nxt.pm * tstep : cA; const char* nB = has_next ? (const char*)g.Bt + (size_t)nxt.pn * tstep : cB;
        for (int t = 0; t < nt; t += 2) {
            const bool last = (t == nt - 2);
            const char* a1 = cA + (size_t)(t + 1) * kstep;
            const char* a2 = last ? nA : cA + (size_t)(t + 2) * kstep; const char* b2 = last ? nB : cB + (size_t)(t + 2) * kstep;
            const char* a3 = a2 + kstep; const char* b3 = b2 + kstep;
            if (last && has_next) S.a_ready(nxt);
            if constexpr (SP2) {
            PG8_LDB(B0, 0, 0); PG8_LDB(B1, 0, 1); PG8_SCHED; PG8_LDA(At, 0, 0); PG8_STAGE(PG8_SA(1, 1), a1 + hstep, voffA);
            PG8_WAIT_V(8); PG8_WAIT_L(0); PG8_BAR; PG8_MMA(0, 0, At, B0); PG8_MMA(0, 1, At, B1); PG8_BAR; PG8_SCHED;
            PG8_LDA(At, 0, 1); PG8_STAGE(PG8_SB(0, 0), b2, voffB); PG8_STAGE(PG8_SB(0, 1), b2 + hstep, voffB); PG8_STAGE(PG8_SA(0, 0), a2, voffA);
            PG8_WAIT_V(8); PG8_WAIT_L(0); PG8_BAR; PG8_MMA(1, 0, At, B0); PG8_MMA(1, 1, At, B1); PG8_BAR; PG8_SCHED;
            PG8_LDB(B0, 1, 0); PG8_LDB(B1, 1, 1); PG8_SCHED; PG8_LDA(At, 1, 0); PG8_STAGE(PG8_SA(0, 1), a2 + hstep, voffA);
            PG8_WAIT_V(8); PG8_WAIT_L(0); PG8_BAR; PG8_MMA(0, 0, At, B0); PG8_MMA(0, 1, At, B1); PG8_BAR; PG8_SCHED;
            PG8_LDA(At, 1, 1); PG8_STAGE(PG8_SB(1, 0), b3, voffB); PG8_STAGE(PG8_SB(1, 1), b3 + hstep, voffB); PG8_STAGE(PG8_SA(1, 0), a3, voffA);
            PG8_WAIT_V(8); PG8_WAIT_L(0); PG8_BAR; PG8_MMA(1, 0, At, B0); PG8_MMA(1, 1, At, B1); PG8_BAR; PG8_SCHED;
            } else {
            PG8_LDB(B0, 0, 0); PG8_SCHED; PG8_LDA(At, 0, 0); PG8_STAGE(PG8_SA(1, 1), a1 + hstep, voffA);
            PG8_WAIT_L(8); PG8_BAR; PG8_WAIT_L(0); PG8_MMA(0, 0, At, B0); PG8_BAR; PG8_SCHED;
            PG8_LDB(B1, 0, 1); PG8_STAGE(PG8_SB(0, 0), b2, voffB);
            PG8_BAR; PG8_WAIT_L(0); PG8_MMA(0, 1, At, B1); PG8_BAR;
            PG8_LDA(At, 0, 1); PG8_STAGE(PG8_SA(0, 0), a2, voffA);
            PG8_BAR; PG8_WAIT_L(0); PG8_MMA(1, 0, At, B0); PG8_BAR; PG8_SCHED;
            PG8_STAGE(PG8_SB(0, 1), b2 + hstep, voffB);
            PG8_WAIT_V(6); PG8_BAR; PG8_MMA(1, 1, At, B1); PG8_BAR;
            PG8_LDB(B0, 1, 0); PG8_SCHED; PG8_LDA(At, 1, 0); PG8_STAGE(PG8_SA(0, 1), a2 + hstep, voffA);
            PG8_WAIT_L(8); PG8_BAR; PG8_WAIT_L(0); PG8_MMA(0, 0, At, B0); PG8_BAR; PG8_SCHED;
            PG8_LDB(B1, 1, 1); PG8_STAGE(PG8_SB(1, 0), b3, voffB);
            PG8_BAR; PG8_WAIT_L(0); PG8_MMA(0, 1, At, B1); PG8_BAR;
            PG8_LDA(At, 1, 1); PG8_STAGE(PG8_SA(1, 0), a3, voffA);
            PG8_BAR; PG8_WAIT_L(0); PG8_MMA(1, 0, At, B0); PG8_BAR; PG8_SCHED;
            PG8_STAGE(PG8_SB(1, 1), b3 + hstep, voffB);
            PG8_WAIT_V(6); PG8_BAR; PG8_MMA(1, 1, At, B1); PG8_BAR;
            }
        }
        if constexpr (ALIGN_EPI) { if (wr == 0) PG8_BAR; }
        if constexpr (!Epi::AFTER_DRAIN) { E(acc, cur, wr, wc, fr, fq); S.done(cur); }
        if (!has_next) break;
#pragma unroll
        for (int a = 0; a < 2; ++a)
#pragma unroll
            for (int b = 0; b < 2; ++b)
#pragma unroll
                for (int m = 0; m < 4; ++m)
#pragma unroll
                    for (int n = 0; n < 2; ++n) acc[a][b][m][n] = (f32x4){0.f, 0.f, 0.f, 0.f};
        cur = nxt; cA = nA; cB = nB; ++ui;
        if constexpr (ALIGN_EPI) { if (wr == 1) PG8_BAR; }
    }
    PG8_WAIT_V(0);
    if constexpr (!ALIGN_EPI) { if (wr == 0) PG8_BAR; }
    PG8_BAR;
    if constexpr (Epi::AFTER_DRAIN) { E.fused(acc, cur, wr, wc, fr, fq, lds, wid, lane); S.done(cur); }
#undef PG8_SA
#undef PG8_SB
#undef PG8_STAGE
#undef PG8_LDA
#undef PG8_LDB
#undef PG8_MMA
#undef PG8_WAIT_V
#undef PG8_WAIT_L
#undef PG8_BAR
#undef PG8_SCHED
}
}

namespace pg8 {
struct EpiStoreBf16 {
    static constexpr bool PERM = true, AFTER_DRAIN = false;
    bf16_t* O; int ldc, pad;
    __device__ __forceinline__ void operator()(const f32x4 (&acc)[2][2][4][2], const Unit& u, int wr, int wc, int fr, int fq) const {
        const int row0 = u.pm * BM + wr * 64 + fr, col0 = u.pn * BM + wc * 32 + 8 * fq;
#pragma unroll
        for (int ai = 0; ai < 2; ++ai)
#pragma unroll
            for (int m = 0; m < 4; ++m) { bf16_t* rowp = O + (size_t)(row0 + ai * HALF + m * 16) * ldc + col0;
#pragma unroll
                for (int bj = 0; bj < 2; ++bj) { const f32x4 v0 = acc[ai][bj][m][0], v1 = acc[ai][bj][m][1];
                    u32x4 w; w.x = cvt_pk_bf16(v0[0], v0[1]); w.y = cvt_pk_bf16(v0[2], v0[3]); w.z = cvt_pk_bf16(v1[0], v1[1]); w.w = cvt_pk_bf16(v1[2], v1[3]);
                    *(u32x4*)(rowp + bj * HALF) = w; } }
    }
};
struct EpiResF32 {
    static constexpr bool PERM = false, AFTER_DRAIN = false;
    const float* base; float* out; int ldc, pad;
    __device__ __forceinline__ void operator()(const f32x4 (&acc)[2][2][4][2], const Unit& u, int wr, int wc, int fr, int fq) const {
        const int row0 = u.pm * BM + wr * 64 + fr, col0 = u.pn * BM + wc * 32 + 4 * fq;
#pragma unroll
        for (int ai = 0; ai < 2; ++ai)
#pragma unroll
            for (int m = 0; m < 4; ++m) { const size_t off = (size_t)(row0 + ai * HALF + m * 16) * ldc + col0;
#pragma unroll
                for (int bj = 0; bj < 2; ++bj)
#pragma unroll
                    for (int n = 0; n < 2; ++n) { const f32x4 b = *(const f32x4*)(base + off + bj * HALF + n * 16); *(f32x4*)(out + off + bj * HALF + n * 16) = b + acc[ai][bj][m][n]; } }
    }
};
struct EpiSwiGLU {
    static constexpr bool PERM = true, AFTER_DRAIN = false;
    bf16_t* O; int ldc, pad;
    __device__ __forceinline__ void operator()(const f32x4 (&acc)[2][2][4][2], const Unit& u, int wr, int wc, int fr, int fq) const {
        const int row0 = u.pm * BM + wr * 64 + fr, col0 = u.pn * HALF + wc * 32 + 8 * fq;
#pragma unroll
        for (int ai = 0; ai < 2; ++ai)
#pragma unroll
            for (int m = 0; m < 4; ++m) { bf16_t* rowp = O + (size_t)(row0 + ai * HALF + m * 16) * ldc + col0;
                float r[8];
#pragma unroll
                for (int n = 0; n < 2; ++n)
#pragma unroll
                    for (int e = 0; e < 4; ++e) { const float g = acc[ai][0][m][n][e], up = acc[ai][1][m][n][e]; r[n * 4 + e] = g * up / (1.0f + __expf(-g)); }
                u32x4 w; w.x = cvt_pk_bf16(r[0], r[1]); w.y = cvt_pk_bf16(r[2], r[3]); w.z = cvt_pk_bf16(r[4], r[5]); w.w = cvt_pk_bf16(r[6], r[7]);
                *(u32x4*)rowp = w; }
    }
};
}
typedef unsigned short bf16_t;
constexpr int DM = 2048, NB = 4, SEQ = 4096, MT = NB * SEQ;
constexpr int HD = 128, NH = 8, AW = 1024, CW = 1024, NPROJ = 6144;
constexpr int NBLK = 16, MBLK = 256;
constexpr int NMEM = 256, XH = 4, XW = 512, DFF = 5632;
constexpr float EPS = 1e-6f;
constexpr float SM_SCALE = 0.088388347648318440f;
constexpr size_t MiB = 1u << 20;
constexpr size_t WS_WIN = 0;
constexpr size_t WS_WOUT = 24 * MiB;
constexpr size_t WS_WXQ = 32 * MiB;
constexpr size_t WS_WXKV = 34 * MiB;
constexpr size_t WS_WXO = 38 * MiB;
constexpr size_t WS_WGU = 40 * MiB;
constexpr size_t WS_WDN = 84 * MiB;
constexpr size_t WS_H = 112 * MiB;
constexpr size_t WS_MRG = 176 * MiB;
constexpr size_t WS_PROJ = 240 * MiB;
constexpr size_t WS_ACT = 240 * MiB;
constexpr size_t WS_QX = 432 * MiB;
constexpr size_t WS_OX = 448 * MiB;
constexpr size_t WS_KVX = 464 * MiB;
constexpr size_t WS_MEMN = 466 * MiB;
constexpr size_t WS_CS = 470 * MiB;
constexpr size_t WS_KMEAN = 478 * MiB;
constexpr size_t WS_END = 479 * MiB;

__device__ __forceinline__ float bf2f(unsigned v) { return __uint_as_float(v << 16); }
__device__ __forceinline__ unsigned f2bf(float f) { unsigned u = __float_as_uint(f); return (u + 0x7fffu + ((u >> 16) & 1u)) >> 16; }
__device__ __forceinline__ unsigned pk2(float lo, float hi) { return f2bf(lo) | (f2bf(hi) << 16); }
__device__ __forceinline__ float wave_sum(float v) {
#pragma unroll
    for (int o = 1; o < 64; o <<= 1) v += __shfl_xor(v, o);
    return v;
}
__device__ __forceinline__ float wave_max(float v) {
#pragma unroll
    for (int o = 1; o < 64; o <<= 1) v = fmaxf(v, __shfl_xor(v, o));
    return v;
}
typedef float f32x4 __attribute__((ext_vector_type(4)));
typedef unsigned u32x4 __attribute__((ext_vector_type(4)));
typedef unsigned u32x2 __attribute__((ext_vector_type(2)));

struct TJob { const float* src0; const float* src1; const float* gain; bf16_t* dst; int K, Nsrc, nrows, mode; };
__device__ __forceinline__ void transpose_item(const TJob& J, float* scr, int item, int lane) {
    const int nblk = J.nrows / 32, kb = item / nblk, nb = item % nblk, k0 = 64 * kb, n0 = 32 * nb;
    const float* src = J.src0; int c0 = n0;
    if (J.mode == 2) { const int tile = n0 >> 8, w = n0 & 255; if (w < 128) { c0 = tile * 128 + w; } else { src = J.src1; c0 = tile * 128 + w - 128; } }
#pragma unroll 8
    for (int i = 0; i < 32; ++i) { const int kk = 2 * i + (lane >> 5); float v = src[(size_t)(k0 + kk) * J.Nsrc + c0 + (lane & 31)]; if (J.gain) v *= J.gain[k0 + kk]; scr[kk * 33 + (lane & 31)] = v; }
    asm volatile("s_waitcnt lgkmcnt(0)" ::: "memory");
    const int c = lane & 7;
#pragma unroll
    for (int j = 0; j < 4; ++j) { const int n = (lane >> 3) + 8 * j; const float* s = scr + (8 * c) * 33 + n;
        u32x4 o; o.x = pk2(s[0 * 33], s[1 * 33]); o.y = pk2(s[2 * 33], s[3 * 33]); o.z = pk2(s[4 * 33], s[5 * 33]); o.w = pk2(s[6 * 33], s[7 * 33]);
        *(u32x4*)(J.dst + (size_t)(n0 + n) * J.K + k0 + 8 * c) = o; }
    asm volatile("s_waitcnt lgkmcnt(0)" ::: "memory");
}
__device__ __forceinline__ int ph_transpose_job(const TJob J, int base, float* scr, int gw, int NGW, int lane) {
    const int nitems = (J.K / 64) * (J.nrows / 32);
    const int first = (gw - base % NGW + NGW) % NGW;
    for (int it = first; it < nitems; it += NGW) transpose_item(J, scr, it, lane);
    return base + nitems;
}

__device__ __forceinline__ void rms_row_bf16(const float* xrow, const float* g, bf16_t* orow, int lane) {
    const f32x4* xr = (const f32x4*)xrow + lane; const f32x4* gr = (const f32x4*)g + lane;
    f32x4 v[8]; float s = 0.f;
#pragma unroll
    for (int j = 0; j < 8; ++j) { v[j] = xr[64 * j]; s += (v[j].x * v[j].x + v[j].y * v[j].y) + (v[j].z * v[j].z + v[j].w * v[j].w); }
    const float rinv = rsqrtf(wave_sum(s) * (1.f / DM) + EPS);
    u32x2* o8 = (u32x2*)orow + lane;
#pragma unroll
    for (int j = 0; j < 8; ++j) { const f32x4 gg = gr[64 * j]; u32x2 w; w.x = pk2(v[j].x * rinv * gg.x, v[j].y * rinv * gg.y); w.y = pk2(v[j].z * rinv * gg.z, v[j].w * rinv * gg.w); o8[64 * j] = w; }
}
__device__ __forceinline__ void ph_rms_bf16(const float* X, const float* g, bf16_t* O, int rows, int gw, int NGW, int lane) {
    for (int r = gw; r < rows; r += NGW) rms_row_bf16(X + (size_t)r * DM, g, O + (size_t)r * DM, lane);
}
__device__ __forceinline__ void ph_final_norm(float* X, const float* g, int rows, int gw, int NGW, int lane) {
    for (int r = gw; r < rows; r += NGW) {
        f32x4* xr = (f32x4*)(X + (size_t)r * DM) + lane; const f32x4* gr = (const f32x4*)g + lane;
        f32x4 v[8]; float s = 0.f;
#pragma unroll
        for (int j = 0; j < 8; ++j) { v[j] = xr[64 * j]; s += (v[j].x * v[j].x + v[j].y * v[j].y) + (v[j].z * v[j].z + v[j].w * v[j].w); }
        const float rinv = rsqrtf(wave_sum(s) * (1.f / DM) + EPS);
#pragma unroll
        for (int j = 0; j < 8; ++j) xr[64 * j] = v[j] * rinv * gr[64 * j];
    }
}

__device__ __forceinline__ void sincos_small(double r, double& s, double& c) {
    const double r2 = r * r;
    double a = -1.0 / 10888869450418352160768000000.0;
    a = a * r2 + 1.0 / 15511210043330985984000000.0;
    a = a * r2 - 1.0 / 25852016738884976640000.0;
    a = a * r2 + 1.0 / 51090942171709440000.0;
    a = a * r2 - 1.0 / 121645100408832000.0;
    a = a * r2 + 1.0 / 355687428096000.0;
    a = a * r2 - 1.0 / 1307674368000.0;
    a = a * r2 + 1.0 / 6227020800.0;
    a = a * r2 - 1.0 / 39916800.0;
    a = a * r2 + 1.0 / 362880.0;
    a = a * r2 - 1.0 / 5040.0;
    a = a * r2 + 1.0 / 120.0;
    a = a * r2 - 1.0 / 6.0;
    a = a * r2 + 1.0;
    s = a * r;
    double b = 1.0 / 403291461126605635584000000.0;
    b = b * r2 - 1.0 / 620448401733239439360000.0;
    b = b * r2 + 1.0 / 1124000727777607680000.0;
    b = b * r2 - 1.0 / 2432902008176640000.0;
    b = b * r2 + 1.0 / 6402373705728000.0;
    b = b * r2 - 1.0 / 20922789888000.0;
    b = b * r2 + 1.0 / 87178291200.0;
    b = b * r2 - 1.0 / 479001600.0;
    b = b * r2 + 1.0 / 3628800.0;
    b = b * r2 - 1.0 / 40320.0;
    b = b * r2 + 1.0 / 720.0;
    b = b * r2 - 1.0 / 24.0;
    b = b * r2 + 1.0 / 2.0;
    c = 1.0 - b * r2;
}
__device__ __forceinline__ void cs_entry(const int* pos, float* cs, int idx) {
    const int t = idx >> 6, f = idx & 63;
    double p = 1.0, bs = 0.8659643233600653;
#pragma unroll
    for (int bit = 0; bit < 6; ++bit) { if ((f >> bit) & 1) p *= bs; bs *= bs; }
    const double ang = (double)pos[t] * p;
    const double TWO_PI = 6.283185307179586;
    const double n = rint(ang / TWO_PI);
    const double r = fma(-n, TWO_PI, ang);
    double s, c; sincos_small(r, s, c);
    cs[2 * idx] = (float)c; cs[2 * idx + 1] = (float)s;
}
__device__ __forceinline__ void ph_cs(const int* pos, float* cs, int gtid, int NT) {
    for (int idx = gtid; idx < MT * 64; idx += NT) cs_entry(pos, cs, idx);
}
__device__ __forceinline__ void ph_rope_naive(bf16_t* proj, const float* cs, int gtid, int NT) {
    const long total = (long)MT * 2 * NH * 64;
    for (long i = gtid; i < total; i += NT) {
        const int d = (int)(i & 63), h = (int)((i >> 6) & 7), sec = (int)((i >> 9) & 1); const long t = i >> 10;
        bf16_t* p = proj + t * NPROJ + sec * 1024 + h * HD + d;
        const float a = bf2f(p[0]), b = bf2f(p[64]); const float c = cs[(t * 64 + d) * 2], s = cs[(t * 64 + d) * 2 + 1];
        p[0] = (bf16_t)f2bf(a * c - b * s); p[64] = (bf16_t)f2bf(b * c + a * s);
    }
}
__device__ __forceinline__ void ph_kmean_naive(const bf16_t* proj, float* kmean, int gtid, int NT) {
    for (int i = gtid; i < NB * NH * NBLK * HD; i += NT) {
        const int d = i & 127, blkid = i >> 7;
        const int blk = blkid & 15, h = (blkid >> 4) & 7, b = blkid >> 7;
        float s = 0.f;
        for (int j = 0; j < MBLK; ++j) s += bf2f(proj[(size_t)(b * SEQ + blk * MBLK + j) * NPROJ + 1024 + h * HD + d]);
        kmean[(size_t)blkid * HD + d] = s * (1.f / MBLK);
    }
}
__device__ __forceinline__ float dot_q_row(const float* sq, const bf16_t* krow) {
    float a = 0.f;
#pragma unroll
    for (int d = 0; d < 128; d += 8) { const u32x4 kk = *(const u32x4*)(krow + d);
        a += sq[d + 0] * bf2f(kk.x & 0xffffu) + sq[d + 1] * bf2f(kk.x >> 16) + sq[d + 2] * bf2f(kk.y & 0xffffu) + sq[d + 3] * bf2f(kk.y >> 16)
           + sq[d + 4] * bf2f(kk.z & 0xffffu) + sq[d + 5] * bf2f(kk.z >> 16) + sq[d + 6] * bf2f(kk.w & 0xffffu) + sq[d + 7] * bf2f(kk.w >> 16); }
    return a;
}
__device__ __forceinline__ void ph_moba_naive(const bf16_t* proj, const float* kmean, const float* g_attn, bf16_t* merged, float qscale_inv, float* scr, int gw, int NGW, int lane) {
    float* sq = scr; float* sp = scr + 128;
    for (int item = gw; item < MT * NH; item += NGW) {
        const int t = item >> 3, h = item & 7, b = t >> 12, ts = t & 4095, qb = ts >> 8, tq = ts & 255;
        const bf16_t* qrow = proj + (size_t)t * NPROJ + h * HD;
        const unsigned qq = *(const unsigned*)(qrow + 2 * lane);
        const float q0 = bf2f(qq & 0xffffu) * qscale_inv, q1 = bf2f(qq >> 16) * qscale_inv;
        asm volatile("s_waitcnt lgkmcnt(0)" ::: "memory");
        sq[2 * lane] = q0; sq[2 * lane + 1] = q1;
        float g[16];
#pragma unroll
        for (int i = 0; i < 16; ++i) { const float* km = kmean + (size_t)((b * 8 + h) * 16 + i) * HD; const float p = wave_sum(q0 * km[2 * lane] + q1 * km[2 * lane + 1]); g[i] = (i < qb) ? p : -INFINITY; }
        int sel[4];
#pragma unroll
        for (int r = 0; r < 3; ++r) { float best = -INFINITY; int bi = -1;
#pragma unroll
            for (int i = 0; i < 16; ++i) if (g[i] > best) { best = g[i]; bi = i; }
            sel[r] = bi;
#pragma unroll
            for (int i = 0; i < 16; ++i) if (i == bi) g[i] = -INFINITY; }
        sel[3] = qb;
        asm volatile("s_waitcnt lgkmcnt(0)" ::: "memory");
#pragma unroll
        for (int s = 0; s < 4; ++s) { const int blk = sel[s];
            for (int jj = 0; jj < 4; ++jj) { const int j = jj * 64 + lane; float sc = -INFINITY;
                if (blk >= 0 && (s < 3 || j <= tq)) sc = dot_q_row(sq, proj + (size_t)(b * SEQ + blk * MBLK + j) * NPROJ + 1024 + h * HD) * SM_SCALE;
                sp[s * 256 + j] = sc; } }
        asm volatile("s_waitcnt lgkmcnt(0)" ::: "memory");
        float m = -INFINITY; for (int i = lane; i < 1024; i += 64) m = fmaxf(m, sp[i]); m = wave_max(m);
        float l = 0.f; for (int i = lane; i < 1024; i += 64) { const float p = __expf(sp[i] - m); sp[i] = p; l += p; } l = wave_sum(l);
        asm volatile("s_waitcnt lgkmcnt(0)" ::: "memory");
        float o0 = 0.f, o1 = 0.f;
#pragma unroll
        for (int s = 0; s < 4; ++s) { const int blk = sel[s]; if (blk < 0) continue;
            const bf16_t* vb = proj + (size_t)(b * SEQ + blk * MBLK) * NPROJ + 2048 + h * HD + 2 * lane;
            for (int j = 0; j < 256; ++j) { const float p = sp[s * 256 + j]; const unsigned vv = *(const unsigned*)(vb + (size_t)j * NPROJ); o0 += p * bf2f(vv & 0xffffu); o1 += p * bf2f(vv >> 16); } }
        const float li = 1.f / l; o0 *= li; o1 *= li;
        const float rinv = rsqrtf(wave_sum(o0 * o0 + o1 * o1) * (1.f / HD) + EPS);
        *(unsigned*)(merged + (size_t)t * DM + h * HD + 2 * lane) = pk2(o0 * rinv * g_attn[h * HD + 2 * lane], o1 * rinv * g_attn[h * HD + 2 * lane + 1]);
    }
}
__device__ __forceinline__ void ph_conv_naive(const bf16_t* proj, const float* w_conv, const float* b_conv, const float* g_conv, bf16_t* merged, int gw, int NGW, int lane) {
    for (int item = gw; item < MT * 8; item += NGW) {
        const int t = item >> 3, grp = item & 7, ts = t & 4095; const int c = grp * 128 + 2 * lane;
        float y[2];
#pragma unroll
        for (int e = 0; e < 2; ++e) { float acc = b_conv[c + e];
#pragma unroll
            for (int k = 0; k < 3; ++k) { const int back = 2 - k; if (ts - back >= 0) { const bf16_t* r = proj + (size_t)(t - back) * NPROJ; acc += w_conv[k * CW + c + e] * (bf2f(r[3072 + c + e]) * bf2f(r[5120 + c + e])); } }
            y[e] = bf2f(proj[(size_t)t * NPROJ + 4096 + c + e]) * acc; }
        const float rinv = rsqrtf(wave_sum(y[0] * y[0] + y[1] * y[1]) * (1.f / HD) + EPS);
        *(unsigned*)(merged + (size_t)t * DM + AW + c) = pk2(y[0] * rinv * g_conv[c], y[1] * rinv * g_conv[c + 1]);
    }
}
__device__ __forceinline__ void ph_xattn_naive(const bf16_t* qx, const bf16_t* kvx, bf16_t* ox, float qscale_inv, float* scr, int gw, int NGW, int lane) {
    float* sq = scr; float* sp = scr + 128;
    for (int item = gw; item < MT * XH; item += NGW) {
        const int t = item >> 2, h = item & 3, b = t >> 12;
        const unsigned qq = *(const unsigned*)(qx + (size_t)t * XW + h * HD + 2 * lane);
        asm volatile("s_waitcnt lgkmcnt(0)" ::: "memory");
        sq[2 * lane] = bf2f(qq & 0xffffu) * qscale_inv; sq[2 * lane + 1] = bf2f(qq >> 16) * qscale_inv;
        asm volatile("s_waitcnt lgkmcnt(0)" ::: "memory");
        float m = -INFINITY;
        for (int jj = 0; jj < 4; ++jj) { const int j = jj * 64 + lane; const float sc = dot_q_row(sq, kvx + (size_t)(b * NMEM + j) * 1024 + h * HD) * SM_SCALE; sp[j] = sc; m = fmaxf(m, sc); }
        m = wave_max(m);
        asm volatile("s_waitcnt lgkmcnt(0)" ::: "memory");
        float l = 0.f; for (int i = lane; i < 256; i += 64) { const float p = __expf(sp[i] - m); sp[i] = p; l += p; } l = wave_sum(l);
        asm volatile("s_waitcnt lgkmcnt(0)" ::: "memory");
        float o0 = 0.f, o1 = 0.f; const bf16_t* vb = kvx + (size_t)(b * NMEM) * 1024 + 512 + h * HD + 2 * lane;
        for (int j = 0; j < 256; ++j) { const float p = sp[j]; const unsigned vv = *(const unsigned*)(vb + (size_t)j * 1024); o0 += p * bf2f(vv & 0xffffu); o1 += p * bf2f(vv >> 16); }
        const float li = 1.f / l;
        *(unsigned*)(ox + (size_t)t * XW + h * HD + 2 * lane) = pk2(o0 * li, o1 * li);
    }
}

namespace moba {
using bf16x8 = __attribute__((ext_vector_type(8))) short;
using s16x4  = __attribute__((ext_vector_type(4))) short;
using f32x16 = __attribute__((ext_vector_type(16))) float;
using u32x4v = __attribute__((ext_vector_type(4))) unsigned;
using f32x4v = __attribute__((ext_vector_type(4))) float;
constexpr int D = 128, NW = 8, QBLK = 32, KVBLK = 64, LDP = NPROJ;
constexpr float SCALE = 0.088388347648318440f, THR = 8.f;
constexpr int SHM_V = KVBLK * D * 2, SHM_K = KVBLK * D * 2;
constexpr int OFF_V = 0, OFF_K = 2 * SHM_V, OFF_WS = OFF_K + 2 * SHM_K, OFF_KM = OFF_WS + NW * 256, OFF_RS = OFF_KM + 16 * 128 * 4, RS_BYTES = (32 * 33 + 32) * 4, LDS_END = OFF_RS + NW * RS_BYTES;
static_assert(LDS_END <= 131072, "moba LDS");
#define KSWZ(row, colB) ((row) * 256 + ((colB) ^ (((row) & 7) << 4)))
#define SBAR() __builtin_amdgcn_sched_barrier(0)
__device__ __forceinline__ int crow(int r, int hi) { return (r & 3) + 8 * (r >> 2) + 4 * hi; }
__device__ __forceinline__ unsigned cvtpk(float lo, float hi) { unsigned r; asm volatile("v_cvt_pk_bf16_f32 %0, %1, %2" : "=v"(r) : "v"(lo), "v"(hi)); return r; }
__device__ __forceinline__ void partialSM(f32x16& p0, f32x16& p1, float& m_reg, float& mn, float& alpha) {
  constexpr float C = SCALE * 1.4426950408889634f;
  float pmax = p0[0];
#pragma unroll
  for (int r = 1; r < 16; ++r) pmax = fmaxf(pmax, p0[r]);
#pragma unroll
  for (int r = 0; r < 16; ++r) pmax = fmaxf(pmax, p1[r]);
  { auto rr = __builtin_amdgcn_permlane32_swap(__float_as_uint(pmax), __float_as_uint(pmax), false, false);
    pmax = fmaxf(__uint_as_float(rr[0]), __uint_as_float(rr[1])); }
  if (__builtin_expect(__all(pmax - m_reg <= THR / SCALE), 1)) { mn = m_reg; alpha = 1.f; }
  else { mn = fmaxf(m_reg, pmax); alpha = __builtin_amdgcn_exp2f((m_reg - mn) * C); m_reg = mn; }
  float mnC = -mn * C;
#pragma unroll
  for (int r = 0; r < 16; ++r) p0[r] = fmaf(p0[r], C, mnC);
#pragma unroll
  for (int r = 0; r < 16; ++r) p1[r] = fmaf(p1[r], C, mnC);
#pragma unroll
  for (int r = 0; r < 16; ++r) p0[r] = __builtin_amdgcn_exp2f(p0[r]);
}
__device__ __forceinline__ void finishSM(f32x16& p0, f32x16& p1, float alpha, float& l_reg, bf16x8& pa0, bf16x8& pa1, bf16x8& pa2, bf16x8& pa3) {
#pragma unroll
  for (int r = 0; r < 16; ++r) p1[r] = __builtin_amdgcn_exp2f(p1[r]);
  float ps = 0;
#pragma unroll
  for (int r = 0; r < 16; ++r) ps += p0[r];
#pragma unroll
  for (int r = 0; r < 16; ++r) ps += p1[r];
  { auto rr = __builtin_amdgcn_permlane32_swap(__float_as_uint(ps), __float_as_uint(ps), false, false);
    ps = __uint_as_float(rr[0]) + __uint_as_float(rr[1]); }
  l_reg = l_reg * alpha + ps;
#define PK4(P, BASE, OUT) do { unsigned a0 = cvtpk(P[BASE + 0], P[BASE + 1]), a1 = cvtpk(P[BASE + 2], P[BASE + 3]);   \
    unsigned b0 = cvtpk(P[BASE + 4], P[BASE + 5]), b1 = cvtpk(P[BASE + 6], P[BASE + 7]);                              \
    auto r0 = __builtin_amdgcn_permlane32_swap(a0, b0, false, false); auto r1 = __builtin_amdgcn_permlane32_swap(a1, b1, false, false); \
    u32x4v w = {r0[0], r1[0], r0[1], r1[1]}; OUT = *reinterpret_cast<bf16x8*>(&w); } while (0)
  PK4(p0, 0, pa0); PK4(p0, 8, pa1); PK4(p1, 0, pa2); PK4(p1, 8, pa3);
#undef PK4
}
__device__ __forceinline__ void qkt(f32x16& p0, f32x16& p1, const char* Ks, const bf16x8* qr, int r32, int hi) {
  p0 = f32x16{}; p1 = f32x16{};
#pragma unroll
  for (int d0 = 0; d0 < 8; ++d0) { int cb = (d0 * 16 + hi * 8) * 2;
    bf16x8 b0 = *reinterpret_cast<const bf16x8*>(Ks + KSWZ(r32, cb));
    bf16x8 b1 = *reinterpret_cast<const bf16x8*>(Ks + KSWZ(32 + r32, cb));
    p0 = __builtin_amdgcn_mfma_f32_32x32x16_bf16(b0, qr[d0], p0, 0, 0, 0);
    p1 = __builtin_amdgcn_mfma_f32_32x32x16_bf16(b1, qr[d0], p1, 0, 0, 0); }
}
__device__ __forceinline__ int v_st(int k, int c) { const int kk = (k & ~0xC) | ((k & 4) << 1) | ((k & 8) >> 1); return ((kk >> 3) * 4 + (c >> 5)) * 512 + ((kk & 7) * 32 + (c & 31)) * 2; }
__device__ __forceinline__ int v_rd_base(int lane) { return ((lane & 3) << 3) | (((lane >> 2) & 3) << 6) | (((lane >> 4) & 1) << 5) | (((lane >> 5) & 1) << 8); }
constexpr int v_rd_off(int d0, int ks, int half) { return d0 * 512 + ks * 4096 + half * 2048; }
template <int OFF> __device__ __forceinline__ s16x4 tr_read(int vb) {
  s16x4 r; asm volatile("ds_read_b64_tr_b16 %0, %1 offset:%2" : "=&v"(r) : "v"(vb), "i"(OFF) : "memory"); return r;
}
template <int D0> __device__ __forceinline__ void pv_one(f32x16& od, int vb, bf16x8 pa0, bf16x8 pa1, bf16x8 pa2, bf16x8 pa3) {
  const s16x4 l0 = tr_read<v_rd_off(D0, 0, 0)>(vb), h0 = tr_read<v_rd_off(D0, 0, 1)>(vb), l1 = tr_read<v_rd_off(D0, 1, 0)>(vb), h1 = tr_read<v_rd_off(D0, 1, 1)>(vb);
  const s16x4 l2 = tr_read<v_rd_off(D0, 2, 0)>(vb), h2 = tr_read<v_rd_off(D0, 2, 1)>(vb), l3 = tr_read<v_rd_off(D0, 3, 0)>(vb), h3 = tr_read<v_rd_off(D0, 3, 1)>(vb);
  asm volatile("s_waitcnt lgkmcnt(0)" ::: "memory"); SBAR();
#define PK(L, H) (bf16x8){L[0], L[1], L[2], L[3], H[0], H[1], H[2], H[3]}
  od = __builtin_amdgcn_mfma_f32_32x32x16_bf16(pa0, PK(l0, h0), od, 0, 0, 0);
  od = __builtin_amdgcn_mfma_f32_32x32x16_bf16(pa1, PK(l1, h1), od, 0, 0, 0);
  od = __builtin_amdgcn_mfma_f32_32x32x16_bf16(pa2, PK(l2, h2), od, 0, 0, 0);
  od = __builtin_amdgcn_mfma_f32_32x32x16_bf16(pa3, PK(l3, h3), od, 0, 0, 0);
#undef PK
}
__device__ __forceinline__ void pv_d0(f32x16* o, int vb, bf16x8 pa0, bf16x8 pa1, bf16x8 pa2, bf16x8 pa3) {
  pv_one<0>(o[0], vb, pa0, pa1, pa2, pa3); pv_one<1>(o[1], vb, pa0, pa1, pa2, pa3); pv_one<2>(o[2], vb, pa0, pa1, pa2, pa3); pv_one<3>(o[3], vb, pa0, pa1, pa2, pa3);
}
__device__ __forceinline__ void tile_mask(f32x16& p0, f32x16& p1, int j, int qb, unsigned selmask, int qrow, int hi) {
  const int kb = j >> 2;
  if (kb < qb) {
    if (!((selmask >> kb) & 1u)) {
#pragma unroll
      for (int r = 0; r < 16; ++r) { p0[r] = -INFINITY; p1[r] = -INFINITY; } }
  } else {
    const int kbase = (j & 3) * 64;
#pragma unroll
    for (int r = 0; r < 16; ++r) { const int key = kbase + crow(r, hi); if (key > qrow) p0[r] = -INFINITY; if (key + 32 > qrow) p1[r] = -INFINITY; }
  }
}
__device__ __forceinline__ void unit(int b, int h, int qb, const bf16_t* __restrict__ proj, const float* __restrict__ kmean, const float* __restrict__ gain, bf16_t* __restrict__ merged, char* lds) {
  const int tid = otid(), wid = tid >> 6, lane = tid & 63, r32 = lane & 31, hi = lane >> 5;
  char* V_lds = lds + OFF_V; char* K_lds = lds + OFF_K;
  float* ws = (float*)(lds + OFF_WS) + wid * 64; float* li_l = ws; float* al_l = ws + 32;
  char* KM = lds + OFF_KM; float* RS = (float*)(lds + OFF_RS + wid * RS_BYTES); float* RV = RS + 32 * 33;
  const long rowbase = (long)b * SEQ;
  const bf16_t* Qw = proj + (rowbase + qb * 256 + wid * QBLK + r32) * LDP + h * D + hi * 8;
  const bf16_t* Kh = proj + rowbase * LDP + 1024 + h * D;
  const bf16_t* Vh = proj + rowbase * LDP + 2048 + h * D;
  __syncthreads();
  { const int blk = tid >> 5, c4 = (tid & 31) * 4;
    const f32x4v kv = *(const f32x4v*)(kmean + (size_t)((b * 8 + h) * 16 + blk) * D + c4);
    unsigned hb[4], lb[4];
#pragma unroll
    for (int e = 0; e < 4; ++e) { hb[e] = f2bf(kv[e]); lb[e] = f2bf(kv[e] - __uint_as_float(hb[e] << 16)); }
    typedef unsigned u32x2v __attribute__((ext_vector_type(2)));
    *(u32x2v*)(KM + KSWZ(blk, c4 * 2)) = (u32x2v){hb[0] | (hb[1] << 16), hb[2] | (hb[3] << 16)};
    *(u32x2v*)(KM + KSWZ(16 + blk, c4 * 2)) = (u32x2v){lb[0] | (lb[1] << 16), lb[2] | (lb[3] << 16)}; }
  float m_reg = -1e30f, l_reg = 0; f32x16 o[4] = {}; bf16x8 qr[8];
#pragma unroll
  for (int d0 = 0; d0 < 8; ++d0) qr[d0] = *reinterpret_cast<const bf16x8*>(Qw + d0 * 16);
  const int sr = tid >> 4, sc = (tid & 15) * 8, vst0 = v_st(sr, sc), vst1 = v_st(32 + sr, sc);
  const int vb0 = (int)(uintptr_t)V_lds + v_rd_base(lane);
  struct { bf16x8 vs0, vs1, ks0, ks1; } sr_[1];
#define SLOAD(i, k0) do { sr_[i].vs0 = *reinterpret_cast<const bf16x8*>(&Vh[(long)((k0) + sr) * LDP + sc]); sr_[i].vs1 = *reinterpret_cast<const bf16x8*>(&Vh[(long)((k0) + 32 + sr) * LDP + sc]); \
    sr_[i].ks0 = *reinterpret_cast<const bf16x8*>(&Kh[(long)((k0) + sr) * LDP + sc]); sr_[i].ks1 = *reinterpret_cast<const bf16x8*>(&Kh[(long)((k0) + 32 + sr) * LDP + sc]); } while (0)
#define SWRITE(bb, i) do { *(bf16x8*)(V_lds + (bb) * SHM_V + vst0) = sr_[i].vs0;          \
    *(bf16x8*)(V_lds + (bb) * SHM_V + vst1) = sr_[i].vs1; int kc = sc * 2;               \
    *(bf16x8*)(K_lds + (bb) * SHM_K + KSWZ(sr, kc)) = sr_[i].ks0;                       \
    *(bf16x8*)(K_lds + (bb) * SHM_K + KSWZ(32 + sr, kc)) = sr_[i].ks1; } while (0)
#define SWAIT() asm volatile("s_waitcnt vmcnt(0)" ::: "memory")
#define RESC(a) do { if (__any((a) < 1.f)) { if (hi == 0) al_l[r32] = (a); asm volatile("s_waitcnt lgkmcnt(0)" ::: "memory"); \
    _Pragma("unroll") for (int d = 0; d < 4; ++d) _Pragma("unroll") for (int r = 0; r < 16; ++r) o[d][r] *= al_l[crow(r, hi)]; } } while (0)
  const int NT = 4 * (qb + 1);
  constexpr int SE = 0, SO = 0;
  SLOAD(SE, 0);
  __syncthreads();
  unsigned selmask = 0u;
  {
    f32x16 gp = f32x16{};
#pragma unroll
    for (int d0 = 0; d0 < 8; ++d0) { const int cb = (d0 * 16 + hi * 8) * 2;
      const bf16x8 b0 = *reinterpret_cast<const bf16x8*>(KM + KSWZ(r32, cb));
      gp = __builtin_amdgcn_mfma_f32_32x32x16_bf16(b0, qr[d0], gp, 0, 0, 0); }
    float g[16];
#pragma unroll
    for (int r = 0; r < 8; ++r) { const float v = gp[r] + gp[r + 8];
      auto rr = __builtin_amdgcn_permlane32_swap(__float_as_uint(v), __float_as_uint(v), false, false);
      const int blo = (r < 4) ? r : 8 + (r - 4);
      g[blo] = __uint_as_float(rr[0]); g[blo + 4] = __uint_as_float(rr[1]); }
#pragma unroll
    for (int i = 0; i < 16; ++i) g[i] = (i < qb) ? g[i] : -INFINITY;
#pragma unroll
    for (int rnd = 0; rnd < 3; ++rnd) { float best = -INFINITY; int bi = -1;
#pragma unroll
      for (int i = 0; i < 16; ++i) if (g[i] > best) { best = g[i]; bi = i; }
      if (bi >= 0) selmask |= 1u << bi;
#pragma unroll
      for (int i = 0; i < 16; ++i) if (i == bi) g[i] = -INFINITY; }
  }
  const int qrow = wid * QBLK + r32;
  f32x16 pA0, pA1, pB0, pB1; float mnA, mnB, alA, alB; bf16x8 pa0, pa1, pa2, pa3;
  asm volatile("s_waitcnt vmcnt(0)" ::: "memory"); SWRITE(0, SE); __syncthreads();
  qkt(pA0, pA1, K_lds, qr, r32, hi); tile_mask(pA0, pA1, 0, qb, selmask, qrow, hi); partialSM(pA0, pA1, m_reg, mnA, alA);
  SLOAD(SO, KVBLK);
  SWAIT(); SWRITE(1, SO); __syncthreads();
  for (int j = 1; j + 1 < NT; j += 2) {
    SBAR(); qkt(pB0, pB1, K_lds + SHM_K, qr, r32, hi); tile_mask(pB0, pB1, j, qb, selmask, qrow, hi);
    finishSM(pA0, pA1, alA, l_reg, pa0, pa1, pa2, pa3); SBAR();
    SLOAD(SE, (j + 1) * KVBLK); SBAR();
    pv_d0(o, vb0, pa0, pa1, pa2, pa3); partialSM(pB0, pB1, m_reg, mnB, alB);
    __syncthreads(); SWAIT(); SWRITE(0, SE);
    RESC(alB); __syncthreads();
    SBAR(); qkt(pA0, pA1, K_lds, qr, r32, hi); tile_mask(pA0, pA1, j + 1, qb, selmask, qrow, hi);
    finishSM(pB0, pB1, alB, l_reg, pa0, pa1, pa2, pa3); SBAR();
    SLOAD(SO, (j + 2) * KVBLK); SBAR();
    pv_d0(o, vb0 + SHM_V, pa0, pa1, pa2, pa3); partialSM(pA0, pA1, m_reg, mnA, alA);
    __syncthreads(); SWAIT(); SWRITE(1, SO);
    RESC(alA); __syncthreads();
  }
  SBAR(); qkt(pB0, pB1, K_lds + SHM_K, qr, r32, hi); tile_mask(pB0, pB1, NT - 1, qb, selmask, qrow, hi);
  finishSM(pA0, pA1, alA, l_reg, pa0, pa1, pa2, pa3); SBAR();
  pv_d0(o, vb0, pa0, pa1, pa2, pa3); partialSM(pB0, pB1, m_reg, mnB, alB);
  __syncthreads(); RESC(alB);
  finishSM(pB0, pB1, alB, l_reg, pa0, pa1, pa2, pa3); SBAR();
  pv_d0(o, vb0 + SHM_V, pa0, pa1, pa2, pa3);
  if (hi == 0) li_l[r32] = l_reg; asm volatile("s_waitcnt lgkmcnt(0)" ::: "memory");
  float rli[16];
#pragma unroll
  for (int r = 0; r < 16; ++r) rli[r] = __builtin_amdgcn_rcpf(li_l[crow(r, hi)]);
#pragma unroll
  for (int r = 0; r < 16; ++r) { float s = 0.f;
#pragma unroll
    for (int d0 = 0; d0 < 4; ++d0) { o[d0][r] *= rli[r]; s += o[d0][r] * o[d0][r]; }
    RS[crow(r, hi) * 33 + r32] = s; }
  asm volatile("s_waitcnt lgkmcnt(0)" ::: "memory");
  { float s = 0.f;
#pragma unroll
    for (int c = 0; c < 32; ++c) s += RS[r32 * 33 + c];
    if (hi == 0) RV[r32] = rsqrtf(s * (1.f / D) + EPS); }
  asm volatile("s_waitcnt lgkmcnt(0)" ::: "memory");
  float gn[4];
#pragma unroll
  for (int d0 = 0; d0 < 4; ++d0) gn[d0] = gain[h * D + d0 * 32 + r32];
  bf16_t* Ow = merged + (rowbase + qb * 256 + wid * QBLK) * DM + h * D;
#pragma unroll
  for (int r = 0; r < 16; ++r) { const int orow = crow(r, hi); const float rv = RV[orow];
#pragma unroll
    for (int d0 = 0; d0 < 4; ++d0) Ow[(long)orow * DM + d0 * 32 + r32] = (bf16_t)f2bf(o[d0][r] * rv * gn[d0]); }
#undef SLOAD
#undef SWRITE
#undef SWAIT
#undef RESC
}
#undef KSWZ
#undef SBAR
}

namespace cg = cooperative_groups;
constexpr int LDS_BYTES = 147456;
struct Args { const void* in[20]; float* out; unsigned char* ws; };
__global__ void __launch_bounds__(512, 2) mk_fwd(Args a) {
    extern __shared__ __attribute__((aligned(16))) unsigned char lds[];
    cg::grid_group grid = cg::this_grid();
    const int G = (int)gridDim.x, bx = (int)blockIdx.x;
    const int NGW = G * 8, NT = G * 512;
#define IDS() const int tid = otid(), lane = tid & 63, wave = __builtin_amdgcn_readfirstlane(tid >> 6); const int gw = bx * 8 + wave, gtid = bx * 512 + tid; float* wscr = (float*)(lds + wave * 16384); (void)lane; (void)gw; (void)gtid; (void)wscr
#define IN_F(k) ((const float*)a.in[k])
#define WSP(T, off) ((T)(a.ws + (off)))
#define x IN_F(0)
#define mem IN_F(1)
#define pos ((const int*)a.in[2])
#define g_mix IN_F(3)
#define w_in IN_F(4)
#define w_conv IN_F(5)
#define b_conv IN_F(6)
#define g_attn IN_F(7)
#define g_conv IN_F(8)
#define w_out IN_F(9)
#define g_xattn IN_F(10)
#define g_mem IN_F(11)
#define w_xq IN_F(12)
#define w_xkv IN_F(13)
#define w_xo IN_F(14)
#define g_ffn IN_F(15)
#define w_gate IN_F(16)
#define w_up IN_F(17)
#define w_down IN_F(18)
#define g_final IN_F(19)
#define out (a.out)
#define Win WSP(bf16_t*, WS_WIN)
#define Wout WSP(bf16_t*, WS_WOUT)
#define Wxq WSP(bf16_t*, WS_WXQ)
#define Wxkv WSP(bf16_t*, WS_WXKV)
#define Wxo WSP(bf16_t*, WS_WXO)
#define Wgu WSP(bf16_t*, WS_WGU)
#define Wdn WSP(bf16_t*, WS_WDN)
#define H WSP(bf16_t*, WS_H)
#define MRG WSP(bf16_t*, WS_MRG)
#define PROJ WSP(bf16_t*, WS_PROJ)
#define ACT WSP(bf16_t*, WS_ACT)
#define QX WSP(bf16_t*, WS_QX)
#define OX WSP(bf16_t*, WS_OX)
#define KVX WSP(bf16_t*, WS_KVX)
#define MEMN WSP(bf16_t*, WS_MEMN)
#define CS WSP(float*, WS_CS)
#define KMEAN WSP(float*, WS_KMEAN)
    PG8_LAS unsigned char* ldsg = (PG8_LAS unsigned char*)lds;

#define GEMM(EpiT, Aop, Bop, Mr, Nc, Kd, ...) do { pg8::Gemm g_{Aop, Bop, Mr, Nc, Kd, 0}; pg8::StaticOrder S_; S_.init(Mr, Nc, G, bx); EpiT E_{__VA_ARGS__}; \
        pg8::gemm_phase<EpiT, pg8::StaticOrder, true, true>(ldsg, g_, S_, E_); } while (0)

    {
        IDS();
        int base = 0;
        base = ph_transpose_job(TJob{w_in, nullptr, nullptr, Win, DM, NPROJ, NPROJ, 0}, base, wscr, gw, NGW, lane);
        base = ph_transpose_job(TJob{w_out, nullptr, nullptr, Wout, DM, DM, DM, 0}, base, wscr, gw, NGW, lane);
        base = ph_transpose_job(TJob{w_xq, nullptr, nullptr, Wxq, DM, XW, XW, 0}, base, wscr, gw, NGW, lane);
        base = ph_transpose_job(TJob{w_xkv, nullptr, nullptr, Wxkv, DM, 2 * XW, 2 * XW, 0}, base, wscr, gw, NGW, lane);
        base = ph_transpose_job(TJob{w_xo, nullptr, nullptr, Wxo, XW, DM, DM, 0}, base, wscr, gw, NGW, lane);
        base = ph_transpose_job(TJob{w_gate, w_up, nullptr, Wgu, DM, DFF, 2 * DFF, 2}, base, wscr, gw, NGW, lane);
        base = ph_transpose_job(TJob{w_down, nullptr, nullptr, Wdn, DFF, DM, DM, 0}, base, wscr, gw, NGW, lane);
    }
    { IDS(); ph_cs(pos, CS, gtid, NT); }
    { IDS(); ph_rms_bf16(x, g_mix, H, MT, gw, NGW, lane); ph_rms_bf16(mem, g_mem, MEMN, NB * NMEM, gw, NGW, lane); }
    grid.sync();
    GEMM(pg8::EpiStoreBf16, H, Win, MT, NPROJ, DM, PROJ, NPROJ, 0);
    GEMM(pg8::EpiStoreBf16, MEMN, Wxkv, NB * NMEM, 2 * XW, DM, KVX, 2 * XW, 0);
    grid.sync();
    { IDS(); ph_rope_naive(PROJ, CS, gtid, NT); }
    grid.sync();
    { IDS(); ph_kmean_naive(PROJ, KMEAN, gtid, NT); }
    grid.sync();
    {
        const int vcu = (G % 8 == 0) ? (bx % 8) * (G / 8) + bx / 8 : bx;
        for (int p = vcu; p < NB * NH * 8; p += G) {
            const int bh = p >> 3, s = p & 7;
            moba::unit(bh >> 3, bh & 7, s, PROJ, KMEAN, g_attn, MRG, (char*)lds);
            moba::unit(bh >> 3, bh & 7, 15 - s, PROJ, KMEAN, g_attn, MRG, (char*)lds);
        }
        __syncthreads();
    }
    { IDS(); ph_conv_naive(PROJ, w_conv, b_conv, g_conv, MRG, gw, NGW, lane); }
    grid.sync();
    GEMM(pg8::EpiResF32, MRG, Wout, MT, DM, DM, x, out, DM, 0);
    grid.sync();
    { IDS(); ph_rms_bf16(out, g_xattn, H, MT, gw, NGW, lane); }
    grid.sync();
    GEMM(pg8::EpiStoreBf16, H, Wxq, MT, XW, DM, QX, XW, 0);
    grid.sync();
    { IDS(); ph_xattn_naive(QX, KVX, OX, 1.0f, wscr, gw, NGW, lane); }
    grid.sync();
    GEMM(pg8::EpiResF32, OX, Wxo, MT, DM, XW, out, out, DM, 0);
    grid.sync();
    { IDS(); ph_rms_bf16(out, g_ffn, H, MT, gw, NGW, lane); }
    grid.sync();
    GEMM(pg8::EpiSwiGLU, H, Wgu, MT, 2 * DFF, DM, ACT, DFF, 0);
    grid.sync();
    GEMM(pg8::EpiResF32, ACT, Wdn, MT, DM, DFF, out, out, DM, 0);
    grid.sync();
    { IDS(); ph_final_norm(out, g_final, MT, gw, NGW, lane); }
#undef GEMM
#undef IDS
#undef x
#undef mem
#undef pos
#undef g_mix
#undef w_in
#undef w_conv
#undef b_conv
#undef g_attn
#undef g_conv
#undef w_out
#undef g_xattn
#undef g_mem
#undef w_xq
#undef w_xkv
#undef w_xo
#undef g_ffn
#undef w_gate
#undef w_up
#undef w_down
#undef g_final
#undef out
#undef Win
#undef Wout
#undef Wxq
#undef Wxkv
#undef Wxo
#undef Wgu
#undef Wdn
#undef H
#undef MRG
#undef PROJ
#undef ACT
#undef QX
#undef OX
#undef KVX
#undef MEMN
#undef CS
#undef KMEAN
#undef IN_F
#undef WSP
}

extern "C" void kernel_launch(void* const* d_in, const int* in_sizes, int n_in, void* d_out, int out_size, void* d_ws, size_t ws_size, hipStream_t stream) {
    static int grid_blocks = 0;
    if (grid_blocks == 0) {
        if (n_in != 20 || ws_size < WS_END) { fprintf(stderr, "kernel_launch: unexpected n_in %d / ws %zu\n", n_in, ws_size); grid_blocks = -1; return; }
        int dev = 0, cus = 0, per_cu = 0;
        (void)hipGetDevice(&dev); (void)hipDeviceGetAttribute(&cus, hipDeviceAttributeMultiprocessorCount, dev);
        (void)hipFuncSetAttribute((const void*)mk_fwd, hipFuncAttributeMaxDynamicSharedMemorySize, LDS_BYTES);
        (void)hipOccupancyMaxActiveBlocksPerMultiprocessor(&per_cu, (const void*)mk_fwd, 512, LDS_BYTES);
        if (per_cu < 1) { fprintf(stderr, "kernel_launch: occupancy query says %d blocks per CU\n", per_cu); per_cu = 1; }
        grid_blocks = cus;
        (void)hipGetLastError();
    }
    if (grid_blocks < 0) return;
    Args a{};
    for (int i = 0; i < 20; ++i) a.in[i] = d_in[i];
    a.out = (float*)d_out; a.ws = (unsigned char*)d_ws;
    void* args[] = {&a};
    hipError_t e = hipLaunchCooperativeKernel((const void*)mk_fwd, dim3(grid_blocks), dim3(512), args, LDS_BYTES, stream);
    if (e != hipSuccess) fprintf(stderr, "cooperative launch failed: %s (grid %d)\n", hipGetErrorString(e), grid_blocks);
}
```

```cpp
#include <hip/hip_runtime.h>
#include <hip/hip_cooperative_groups.h>
#include <cstdio>
#include <cstdint>
#include <cmath>
__device__ __forceinline__ int otid() { int t = (int)threadIdx.x; asm volatile("" : "+v"(t)); return t; }
namespace pg8 {
#define PG8_LAS __attribute__((address_space(3)))
typedef unsigned short bf16_t;
typedef short bf16x8 __attribute__((ext_vector_type(8)));
typedef float f32x4 __attribute__((ext_vector_type(4)));
typedef unsigned u32x4 __attribute__((ext_vector_type(4)));
constexpr int BM = 256, BK = 64, HALF = 128, HTB = HALF * BK * 2  , STAGE_BYTES = 8 * HTB, NXCD = 8, WGM = 8;

__host__ __device__ __forceinline__ int lds_byte(int r, int c) { const int st = (r >> 4) * 2 + (c >> 5), rr = r & 15, cc = c & 31, ob = rr * 64 + cc * 2; return st * 1024 + (ob ^ (((ob >> 9) & 1) << 5)); }
__host__ __device__ __forceinline__ void stage_rc(int b, int& R, int& C) { const int st = b / 1024, sb = b % 1024, swz = sb ^ (((sb >> 9) & 1) << 5); R = (st >> 1) * 16 + swz / 64; C = (st & 1) * 32 + (swz % 64) / 2; }
__host__ __device__ __forceinline__ int perm32(int rho) { const int n = rho >> 4, i = rho & 15; return 8 * (i >> 2) + 4 * n + (i & 3); }

struct Unit { int pm, pn; };
struct Gemm { const bf16_t* A; const bf16_t* Bt; int M, N, K, pad; };

struct StaticOrder {
    int nM, nN, nwg, G, c;
    __host__ __device__ void init(int M, int N, int G_, int c_) { nM = M / BM; nN = N / BM; nwg = nM * nN; G = G_; c = c_; }
    __host__ __device__ bool next(int i, Unit& u) const {
        const long L = (long)i * G + c; if (L >= nwg) return false;
        int wgid = (int)L; { const int q = nwg / NXCD, r = nwg % NXCD, xcd = wgid % NXCD, off = wgid / NXCD; wgid = (xcd < r ? xcd * (q + 1) : r * (q + 1) + (xcd - r) * q) + off; }
        const int nig = WGM * nN, gid = wgid / nig, fm = gid * WGM, gsz = (nM - fm) < WGM ? (nM - fm) : WGM;
        u.pm = fm + ((wgid % nig) % gsz); u.pn = (wgid % nig) / gsz; return true;
    }
    __device__ __forceinline__ void a_ready(const Unit&) const {}
    __device__ __forceinline__ void done(const Unit&) const {}
};
__device__ __forceinline__ unsigned cvt_pk_bf16(float lo, float hi) { unsigned r; asm volatile("v_cvt_pk_bf16_f32 %0, %1, %2" : "=v"(r) : "v"(lo), "v"(hi)); return r; }
template <class Epi, class Sched, bool ALIGN_EPI = false, bool SP2 = false>
__device__ __forceinline__ void gemm_phase(PG8_LAS unsigned char* lds, const Gemm g, const Sched& S, const Epi& E) {
    const int tid = otid(), wid = __builtin_amdgcn_readfirstlane(tid >> 6), lane = tid & 63, wr = wid >> 2, wc = wid & 3, fr = lane & 15, fq = lane >> 4;
    const int K = g.K, nt = K / BK;
    unsigned voffA[2], voffB[2];
#pragma unroll
    for (int i = 0; i < 2; ++i) { int R, C; stage_rc(tid * 16 + i * 8192, R, C); const int Rb = Epi::PERM ? ((R & ~31) + perm32(R & 31)) : R;
        voffA[i] = (unsigned)(R * K + C) * 2u; voffB[i] = (unsigned)(Rb * K + C) * 2u; }
    const size_t kstep = (size_t)(BK * 2);
    const size_t hstep = (size_t)HALF * K * 2;
    const size_t tstep = 2 * hstep;
    const unsigned ldsw = (unsigned)wid * 1024u;
    const int aoff = lds_byte(wr * 64 + fr, fq * 8), boff = lds_byte(wc * 32 + fr, fq * 8);
#define PG8_SA(b, h) (((b) * 2 + (h)) * HTB)
#define PG8_SB(b, h) ((4 + (b) * 2 + (h)) * HTB)
#define PG8_STAGE(bufoff, gbase, voff) do { _Pragma("unroll") for (int _i = 0; _i < 2; ++_i) \
        __builtin_amdgcn_global_load_lds((const unsigned*)((const char*)(gbase) + (voff)[_i]), (PG8_LAS unsigned*)(lds + (bufoff) + ldsw + _i * 8192), 16, 0, 0); } while (0)
#define PG8_LDA(dst, b, h) do { _Pragma("unroll") for (int m = 0; m < 4; ++m) _Pragma("unroll") for (int k = 0; k < 2; ++k) dst[m][k] = *(const PG8_LAS bf16x8*)(lds + PG8_SA(b, h) + aoff + m * 2048 + k * 1024); } while (0)
#define PG8_LDB(dst, b, h) do { _Pragma("unroll") for (int n = 0; n < 2; ++n) _Pragma("unroll") for (int k = 0; k < 2; ++k) dst[n][k] = *(const PG8_LAS bf16x8*)(lds + PG8_SB(b, h) + boff + n * 2048 + k * 1024); } while (0)
#define PG8_MMA(ai, bj, At, Bt) do { __builtin_amdgcn_s_setprio(1); _Pragma("unroll") for (int m = 0; m < 4; ++m) _Pragma("unroll") for (int n = 0; n < 2; ++n) _Pragma("unroll") for (int k = 0; k < 2; ++k) \
        acc[ai][bj][m][n] = __builtin_amdgcn_mfma_f32_16x16x32_bf16(Bt[n][k], At[m][k], acc[ai][bj][m][n], 0, 0, 0); __builtin_amdgcn_s_setprio(0); } while (0)
#define PG8_WAIT_V(n) asm volatile("s_waitcnt vmcnt(" #n ")" ::: "memory")
#define PG8_WAIT_L(n) asm volatile("s_waitcnt lgkmcnt(" #n ")" ::: "memory")
#define PG8_BAR __builtin_amdgcn_s_barrier()
#define PG8_SCHED __builtin_amdgcn_sched_barrier(0)
    Unit cur, nxt; int ui = 0;
    if (!S.next(0, cur)) return;
    f32x4 acc[2][2][4][2];
#pragma unroll
    for (int a = 0; a < 2; ++a)
#pragma unroll
        for (int b = 0; b < 2; ++b)
#pragma unroll
            for (int m = 0; m < 4; ++m)
#pragma unroll
                for (int n = 0; n < 2; ++n) acc[a][b][m][n] = (f32x4){0.f, 0.f, 0.f, 0.f};
    bf16x8 At[4][2], B0[2][2], B1[2][2];
    const char* cA = (const char*)g.A + (size_t)cur.pm * tstep; const char* cB = (const char*)g.Bt + (size_t)cur.pn * tstep;
    S.a_ready(cur);
    if constexpr (SP2) {
        PG8_STAGE(PG8_SB(0, 0), cB, voffB); PG8_STAGE(PG8_SB(0, 1), cB + hstep, voffB); PG8_STAGE(PG8_SA(0, 0), cA, voffA); PG8_STAGE(PG8_SA(0, 1), cA + hstep, voffA);
        if (wr == 1) PG8_BAR;
        PG8_WAIT_V(2); PG8_BAR;
        PG8_STAGE(PG8_SB(1, 0), cB + kstep, voffB); PG8_STAGE(PG8_SA(1, 0), cA + kstep, voffA); PG8_STAGE(PG8_SB(1, 1), cB + hstep + kstep, voffB);
        PG8_WAIT_V(6); PG8_BAR;
    } else {
        PG8_STAGE(PG8_SB(0, 0), cB, voffB); PG8_STAGE(PG8_SA(0, 0), cA, voffA); PG8_STAGE(PG8_SB(0, 1), cB + hstep, voffB); PG8_STAGE(PG8_SA(0, 1), cA + hstep, voffA);
        if (wr == 1) PG8_BAR;
        PG8_WAIT_V(4); PG8_BAR;
        PG8_STAGE(PG8_SB(1, 0), cB + kstep, voffB); PG8_STAGE(PG8_SA(1, 0), cA + kstep, voffA); PG8_STAGE(PG8_SB(1, 1), cB + hstep + kstep, voffB);
        PG8_WAIT_V(6); PG8_BAR;
    }
    for (;;) {
        const bool has_next = S.next(ui + 1, nxt);
        const char* nA = has_next ? (const char*)g.A + (size_t)nxt.pm * tstep : cA; const char* nB = has_next ? (const char*)g.Bt + (size_t)nxt.pn * tstep : cB;
        for (int t = 0; t < nt; t += 2) {
            const bool last = (t == nt - 2);
            const char* a1 = cA + (size_t)(t + 1) * kstep;
            const char* a2 = last ? nA : cA + (size_t)(t + 2) * kstep; const char* b2 = last ? nB : cB + (size_t)(t + 2) * kstep;
            const char* a3 = a2 + kstep; const char* b3 = b2 + kstep;
            if (last && has_next) S.a_ready(nxt);
            if constexpr (SP2) {
            PG8_LDB(B0, 0, 0); PG8_LDB(B1, 0, 1); PG8_SCHED; PG8_LDA(At, 0, 0); PG8_STAGE(PG8_SA(1, 1), a1 + hstep, voffA);
            PG8_WAIT_V(8); PG8_WAIT_L(0); PG8_BAR; PG8_MMA(0, 0, At, B0); PG8_MMA(0, 1, At, B1); PG8_BAR; PG8_SCHED;
            PG8_LDA(At, 0, 1); PG8_STAGE(PG8_SB(0, 0), b2, voffB); PG8_STAGE(PG8_SB(0, 1), b2 + hstep, voffB); PG8_STAGE(PG8_SA(0, 0), a2, voffA);
            PG8_WAIT_V(8); PG8_WAIT_L(0); PG8_BAR; PG8_MMA(1, 0, At, B0); PG8_MMA(1, 1, At, B1); PG8_BAR; PG8_SCHED;
            PG8_LDB(B0, 1, 0); PG8_LDB(B1, 1, 1); PG8_SCHED; PG8_LDA(At, 1, 0); PG8_STAGE(PG8_SA(0, 1), a2 + hstep, voffA);
            PG8_WAIT_V(8); PG8_WAIT_L(0); PG8_BAR; PG8_MMA(0, 0, At, B0); PG8_MMA(0, 1, At, B1); PG8_BAR; PG8_SCHED;
            PG8_LDA(At, 1, 1); PG8_STAGE(PG8_SB(1, 0), b3, voffB); PG8_STAGE(PG8_SB(1, 1), b3 + hstep, voffB); PG8_STAGE(PG8_SA(1, 0), a3, voffA);
            PG8_WAIT_V(8); PG8_WAIT_L(0); PG8_BAR; PG8_MMA(1, 0, At, B0); PG8_MMA(1, 1, At, B1); PG8_BAR; PG8_SCHED;
            } else {
            PG8_LDB(B0, 0, 0); PG8_SCHED; PG8_LDA(At, 0, 0); PG8_STAGE(PG8_SA(1, 1), a1 + hstep, voffA);
            PG8_WAIT_L(8); PG8_BAR; PG8_WAIT_L(0); PG8_MMA(0, 0, At, B0); PG8_BAR; PG8_SCHED;
            PG8_LDB(B1, 0, 1); PG8_STAGE(PG8_SB(0, 0), b2, voffB);
            PG8_BAR; PG8_WAIT_L(0); PG8_MMA(0, 1, At, B1); PG8_BAR;
            PG8_LDA(At, 0, 1); PG8_STAGE(PG8_SA(0, 0), a2, voffA);
            PG8_BAR; PG8_WAIT_L(0); PG8_MMA(1, 0, At, B0); PG8_BAR; PG8_SCHED;
            PG8_STAGE(PG8_SB(0, 1), b2 + hstep, voffB);
            PG8_WAIT_V(6); PG8_BAR; PG8_MMA(1, 1, At, B1); PG8_BAR;
            PG8_LDB(B0, 1, 0); PG8_SCHED; PG8_LDA(At, 1, 0); PG8_STAGE(PG8_SA(0, 1), a2 + hstep, voffA);
            PG8_WAIT_L(8); PG8_BAR; PG8_WAIT_L(0); PG8_MMA(0, 0, At, B0); PG8_BAR; PG8_SCHED;
            PG8_LDB(B1, 1, 1); PG8_STAGE(PG8_SB(1, 0), b3, voffB);
            PG8_BAR; PG8_WAIT_L(0); PG8_MMA(0, 1, At, B1); PG8_BAR;
            PG8_LDA(At, 1, 1); PG8_STAGE(PG8_SA(1, 0), a3, voffA);
            PG8_BAR; PG8_WAIT_L(0); PG8_MMA(1, 0, At, B0); PG8_BAR; PG8_SCHED;
            PG8_STAGE(PG8_SB(1, 1), b3 + hstep, voffB);
            PG8_WAIT_V(6); PG8_BAR; PG8_MMA(1, 1, At, B1); PG8_BAR;
            }
        }
        if constexpr (ALIGN_EPI) { if (wr == 0) PG8_BAR; }
        if constexpr (!Epi::AFTER_DRAIN) { E(acc, cur, wr, wc, fr, fq); S.done(cur); }
        if (!has_next) break;
#pragma unroll
        for (int a = 0; a < 2; ++a)
#pragma unroll
            for (int b = 0; b < 2; ++b)
#pragma unroll
                for (int m = 0; m < 4; ++m)
#pragma unroll
                    for (int n = 0; n < 2; ++n) acc[a][b][m][n] = (f32x4){0.f, 0.f, 0.f, 0.f};
        cur = nxt; cA = nA; cB = nB; ++ui;
        if constexpr (ALIGN_EPI) { if (wr == 1) PG8_BAR; }
    }
    PG8_WAIT_V(0);
    if constexpr (!ALIGN_EPI) { if (wr == 0) PG8_BAR; }
    PG8_BAR;
    if constexpr (Epi::AFTER_DRAIN) { E.fused(acc, cur, wr, wc, fr, fq, lds, wid, lane); S.done(cur); }
#undef PG8_SA
#undef PG8_SB
#undef PG8_STAGE
#undef PG8_LDA
#undef PG8_LDB
#undef PG8_MMA
#undef PG8_WAIT_V
#undef PG8_WAIT_L
#undef PG8_BAR
#undef PG8_SCHED
}
}

namespace pg8 {
struct EpiStoreBf16 {
    static constexpr bool PERM = true, AFTER_DRAIN = false;
    bf16_t* O; int ldc, pad;
    __device__ __forceinline__ void operator()(const f32x4 (&acc)[2][2][4][2], const Unit& u, int wr, int wc, int fr, int fq) const {
        const int row0 = u.pm * BM + wr * 64 + fr, col0 = u.pn * BM + wc * 32 + 8 * fq;
#pragma unroll
        for (int ai = 0; ai < 2; ++ai)
#pragma unroll
            for (int m = 0; m < 4; ++m) { bf16_t* rowp = O + (size_t)(row0 + ai * HALF + m * 16) * ldc + col0;
#pragma unroll
                for (int bj = 0; bj < 2; ++bj) { const f32x4 v0 = acc[ai][bj][m][0], v1 = acc[ai][bj][m][1];
                    u32x4 w; w.x = cvt_pk_bf16(v0[0], v0[1]); w.y = cvt_pk_bf16(v0[2], v0[3]); w.z = cvt_pk_bf16(v1[0], v1[1]); w.w = cvt_pk_bf16(v1[2], v1[3]);
                    *(u32x4*)(rowp + bj * HALF) = w; } }
    }
};
struct EpiResF32 {
    static constexpr bool PERM = false, AFTER_DRAIN = false;
    const float* base; float* out; int ldc, pad;
    __device__ __forceinline__ void operator()(const f32x4 (&acc)[2][2][4][2], const Unit& u, int wr, int wc, int fr, int fq) const {
        const int row0 = u.pm * BM + wr * 64 + fr, col0 = u.pn * BM + wc * 32 + 4 * fq;
#pragma unroll
        for (int ai = 0; ai < 2; ++ai)
#pragma unroll
            for (int m = 0; m < 4; ++m) { const size_t off = (size_t)(row0 + ai * HALF + m * 16) * ldc + col0;
#pragma unroll
                for (int bj = 0; bj < 2; ++bj)
#pragma unroll
                    for (int n = 0; n < 2; ++n) { const f32x4 b = *(const f32x4*)(base + off + bj * HALF + n * 16); *(f32x4*)(out + off + bj * HALF + n * 16) = b + acc[ai][bj][m][n]; } }
    }
};
struct EpiSwiGLU {
    static constexpr bool PERM = true, AFTER_DRAIN = false;
    bf16_t* O; int ldc, pad;
    __device__ __forceinline__ void operator()(const f32x4 (&acc)[2][2][4][2], const Unit& u, int wr, int wc, int fr, int fq) const {
        const int row0 = u.pm * BM + wr * 64 + fr, col0 = u.pn * HALF + wc * 32 + 8 * fq;
#pragma unroll
        for (int ai = 0; ai < 2; ++ai)
#pragma unroll
            for (int m = 0; m < 4; ++m) { bf16_t* rowp = O + (size_t)(row0 + ai * HALF + m * 16) * ldc + col0;
                float r[8];
#pragma unroll
                for (int n = 0; n < 2; ++n)
#pragma unroll
                    for (int e = 0; e < 4; ++e) { const float g = acc[ai][0][m][n][e], up = acc[ai][1][m][n][e]; r[n * 4 + e] = g * up / (1.0f + __expf(-g)); }
                u32x4 w; w.x = cvt_pk_bf16(r[0], r[1]); w.y = cvt_pk_bf16(r[2], r[3]); w.z = cvt_pk_bf16(r[4], r[5]); w.w = cvt_pk_bf16(r[6], r[7]);
                *(u32x4*)rowp = w; }
    }
};
}

namespace pg8 {
struct EpiInProj {
    static constexpr bool PERM = true, AFTER_DRAIN = false;
    bf16_t* O; const float* cs; float* kmean;
    __device__ __forceinline__ void operator()(const f32x4 (&acc)[2][2][4][2], const Unit& u, int wr, int wc, int fr, int fq) const {
        const int row0 = u.pm * BM + wr * 64 + fr;
        if (u.pn >= 8) {
            const int col0 = u.pn * BM + wc * 32 + 8 * fq;
#pragma unroll
            for (int ai = 0; ai < 2; ++ai)
#pragma unroll
                for (int m = 0; m < 4; ++m) { bf16_t* rowp = O + (size_t)(row0 + ai * HALF + m * 16) * 6144 + col0;
#pragma unroll
                    for (int bj = 0; bj < 2; ++bj) { const f32x4 v0 = acc[ai][bj][m][0], v1 = acc[ai][bj][m][1];
                        u32x4 w; w.x = cvt_pk_bf16(v0[0], v0[1]); w.y = cvt_pk_bf16(v0[2], v0[3]); w.z = cvt_pk_bf16(v1[0], v1[1]); w.w = cvt_pk_bf16(v1[2], v1[3]);
                        *(u32x4*)(rowp + bj * HALF) = w; } }
        } else {
            const int sec = u.pn >> 2, head = 2 * (u.pn & 3) + (wc >> 1), d0 = (wc & 1) * 32 + 8 * fq;
            bf16_t* obase = O + sec * 1024 + head * 128 + d0;
            float csum[16];
#pragma unroll
            for (int i = 0; i < 16; ++i) csum[i] = 0.f;
#pragma unroll
            for (int ai = 0; ai < 2; ++ai)
#pragma unroll
                for (int m = 0; m < 4; ++m) { const int row = row0 + ai * HALF + m * 16;
                    const f32x4* cp = (const f32x4*)(cs + ((size_t)row * 64 + d0) * 2);
                    float ol[8], oh[8];
#pragma unroll
                    for (int n = 0; n < 2; ++n) { const f32x4 t0 = cp[2 * n], t1 = cp[2 * n + 1]; const f32x4 lo = acc[ai][0][m][n], hi = acc[ai][1][m][n];
                        ol[4 * n + 0] = lo[0] * t0[0] - hi[0] * t0[1]; oh[4 * n + 0] = hi[0] * t0[0] + lo[0] * t0[1];
                        ol[4 * n + 1] = lo[1] * t0[2] - hi[1] * t0[3]; oh[4 * n + 1] = hi[1] * t0[2] + lo[1] * t0[3];
                        ol[4 * n + 2] = lo[2] * t1[0] - hi[2] * t1[1]; oh[4 * n + 2] = hi[2] * t1[0] + lo[2] * t1[1];
                        ol[4 * n + 3] = lo[3] * t1[2] - hi[3] * t1[3]; oh[4 * n + 3] = hi[3] * t1[2] + lo[3] * t1[3]; }
                    u32x4 w; w.x = cvt_pk_bf16(ol[0], ol[1]); w.y = cvt_pk_bf16(ol[2], ol[3]); w.z = cvt_pk_bf16(ol[4], ol[5]); w.w = cvt_pk_bf16(ol[6], ol[7]);
                    *(u32x4*)(obase + (size_t)row * 6144) = w;
                    w.x = cvt_pk_bf16(oh[0], oh[1]); w.y = cvt_pk_bf16(oh[2], oh[3]); w.z = cvt_pk_bf16(oh[4], oh[5]); w.w = cvt_pk_bf16(oh[6], oh[7]);
                    *(u32x4*)(obase + (size_t)row * 6144 + 64) = w;
                    if (sec == 1) {
#pragma unroll
                        for (int i = 0; i < 8; ++i) { csum[i] += ol[i]; csum[8 + i] += oh[i]; } } }
            if (sec == 1) {
                float* km = kmean + (size_t)(((u.pm >> 4) * 8 + head) * 16 + (u.pm & 15)) * 128 + d0;
#pragma unroll
                for (int i = 0; i < 16; ++i) { float v = csum[i]; v += __shfl_xor(v, 1); v += __shfl_xor(v, 2); v += __shfl_xor(v, 4); v += __shfl_xor(v, 8);
                    if (fr == 0) atomicAdd(km + (i & 7) + (i >> 3) * 64, v * (1.f / 256.f)); }
            }
        }
    }
};
__device__ __forceinline__ float row_rinv(const float* ss, int row, int fq) {
    const f32x4* p = (const f32x4*)(ss + (size_t)row * 32 + fq * 8); const f32x4 a = p[0], b = p[1];
    float s = ((a[0] + a[1]) + (a[2] + a[3])) + ((b[0] + b[1]) + (b[2] + b[3]));
    s += __shfl_xor(s, 16); s += __shfl_xor(s, 32);
    return rsqrtf(s * (1.f / 2048.f) + 1e-6f);
}
template <bool WRITE_BF> struct EpiResNorm {
    static constexpr bool PERM = true, AFTER_DRAIN = false;
    const float* base; float* out; bf16_t* xb; float* ss;
    __device__ __forceinline__ void operator()(const f32x4 (&acc)[2][2][4][2], const Unit& u, int wr, int wc, int fr, int fq) const {
        const int row0 = u.pm * BM + wr * 64 + fr, col0 = u.pn * BM + wc * 32 + 8 * fq;
#pragma unroll
        for (int ai = 0; ai < 2; ++ai)
#pragma unroll
            for (int m = 0; m < 4; ++m) { const int row = row0 + ai * HALF + m * 16; const size_t off = (size_t)row * 2048 + col0; float s = 0.f;
#pragma unroll
                for (int bj = 0; bj < 2; ++bj) { const f32x4 v0 = *(const f32x4*)(base + off + bj * HALF) + acc[ai][bj][m][0], v1 = *(const f32x4*)(base + off + bj * HALF + 4) + acc[ai][bj][m][1];
                    *(f32x4*)(out + off + bj * HALF) = v0; *(f32x4*)(out + off + bj * HALF + 4) = v1;
                    s += ((v0[0] * v0[0] + v0[1] * v0[1]) + (v0[2] * v0[2] + v0[3] * v0[3])) + ((v1[0] * v1[0] + v1[1] * v1[1]) + (v1[2] * v1[2] + v1[3] * v1[3]));
                    if (WRITE_BF) { u32x4 w; w.x = cvt_pk_bf16(v0[0], v0[1]); w.y = cvt_pk_bf16(v0[2], v0[3]); w.z = cvt_pk_bf16(v1[0], v1[1]); w.w = cvt_pk_bf16(v1[2], v1[3]);
                        *(u32x4*)(xb + off + bj * HALF) = w; } }
                s += __shfl_xor(s, 16); s += __shfl_xor(s, 32);
                if (fq == 0) ss[(size_t)row * 32 + u.pn * 4 + wc] = s; }
    }
};
struct EpiRowScaleBf16 {
    static constexpr bool PERM = true, AFTER_DRAIN = false;
    bf16_t* O; const float* ss; int ldc, pad;
    __device__ __forceinline__ void operator()(const f32x4 (&acc)[2][2][4][2], const Unit& u, int wr, int wc, int fr, int fq) const {
        const int row0 = u.pm * BM + wr * 64 + fr, col0 = u.pn * BM + wc * 32 + 8 * fq;
#pragma unroll
        for (int ai = 0; ai < 2; ++ai)
#pragma unroll
            for (int m = 0; m < 4; ++m) { const int row = row0 + ai * HALF + m * 16; const float ri = row_rinv(ss, row, fq); bf16_t* rowp = O + (size_t)row * ldc + col0;
#pragma unroll
                for (int bj = 0; bj < 2; ++bj) { const f32x4 v0 = acc[ai][bj][m][0] * ri, v1 = acc[ai][bj][m][1] * ri;
                    u32x4 w; w.x = cvt_pk_bf16(v0[0], v0[1]); w.y = cvt_pk_bf16(v0[2], v0[3]); w.z = cvt_pk_bf16(v1[0], v1[1]); w.w = cvt_pk_bf16(v1[2], v1[3]);
                    *(u32x4*)(rowp + bj * HALF) = w; } }
    }
};
struct EpiSwiGLUNorm {
    static constexpr bool PERM = true, AFTER_DRAIN = false;
    bf16_t* O; const float* ss; int ldc, pad;
    __device__ __forceinline__ void operator()(const f32x4 (&acc)[2][2][4][2], const Unit& u, int wr, int wc, int fr, int fq) const {
        const int row0 = u.pm * BM + wr * 64 + fr, col0 = u.pn * HALF + wc * 32 + 8 * fq;
#pragma unroll
        for (int ai = 0; ai < 2; ++ai)
#pragma unroll
            for (int m = 0; m < 4; ++m) { const int row = row0 + ai * HALF + m * 16; const float ri = row_rinv(ss, row, fq); bf16_t* rowp = O + (size_t)row * ldc + col0;
                float r[8];
#pragma unroll
                for (int n = 0; n < 2; ++n)
#pragma unroll
                    for (int e = 0; e < 4; ++e) { const float g = acc[ai][0][m][n][e] * ri, up = acc[ai][1][m][n][e] * ri; r[n * 4 + e] = g * up / (1.0f + __expf(-g)); }
                u32x4 w; w.x = cvt_pk_bf16(r[0], r[1]); w.y = cvt_pk_bf16(r[2], r[3]); w.z = cvt_pk_bf16(r[4], r[5]); w.w = cvt_pk_bf16(r[6], r[7]);
                *(u32x4*)rowp = w; }
    }
};
}
typedef unsigned short bf16_t;
constexpr int DM = 2048, NB = 4, SEQ = 4096, MT = NB * SEQ;
constexpr int HD = 128, NH = 8, AW = 1024, CW = 1024, NPROJ = 6144;
constexpr int NBLK = 16, MBLK = 256;
constexpr int NMEM = 256, XH = 4, XW = 512, DFF = 5632;
constexpr float EPS = 1e-6f;
constexpr float SM_SCALE = 0.088388347648318440f;
constexpr size_t MiB = 1u << 20;
constexpr size_t WS_WIN = 0;
constexpr size_t WS_WOUT = 24 * MiB;
constexpr size_t WS_WXQ = 32 * MiB;
constexpr size_t WS_WXKV = 34 * MiB;
constexpr size_t WS_WXO = 38 * MiB;
constexpr size_t WS_WGU = 40 * MiB;
constexpr size_t WS_WDN = 84 * MiB;
constexpr size_t WS_H = 112 * MiB;
constexpr size_t WS_MRG = 176 * MiB;
constexpr size_t WS_PROJ = 240 * MiB;
constexpr size_t WS_ACT = 240 * MiB;
constexpr size_t WS_QX = 432 * MiB;
constexpr size_t WS_OX = 448 * MiB;
constexpr size_t WS_KVX = 464 * MiB;
constexpr size_t WS_MEMN = 466 * MiB;
constexpr size_t WS_CS = 470 * MiB;
constexpr size_t WS_KMEAN = 478 * MiB;
constexpr size_t WS_SS = 479 * MiB;
constexpr size_t WS_END = 485 * MiB;

__device__ __forceinline__ float bf2f(unsigned v) { return __uint_as_float(v << 16); }
__device__ __forceinline__ unsigned f2bf(float f) { unsigned u = __float_as_uint(f); return (u + 0x7fffu + ((u >> 16) & 1u)) >> 16; }
__device__ __forceinline__ unsigned pk2(float lo, float hi) { return f2bf(lo) | (f2bf(hi) << 16); }
__device__ __forceinline__ float wave_sum(float v) {
#pragma unroll
    for (int o = 1; o < 64; o <<= 1) v += __shfl_xor(v, o);
    return v;
}
__device__ __forceinline__ float wave_max(float v) {
#pragma unroll
    for (int o = 1; o < 64; o <<= 1) v = fmaxf(v, __shfl_xor(v, o));
    return v;
}
typedef float f32x4 __attribute__((ext_vector_type(4)));
typedef unsigned u32x4 __attribute__((ext_vector_type(4)));
typedef unsigned u32x2 __attribute__((ext_vector_type(2)));

struct TJob { const float* src0; const float* src1; const float* gain; bf16_t* dst; int K, Nsrc, nrows, mode; };
__device__ __forceinline__ void transpose_item(const TJob& J, float* scr, int item, int lane) {
    const int nblk = J.nrows / 32, kb = item / nblk, nb = item % nblk, k0 = 64 * kb, n0 = 32 * nb;
    const float* src = J.src0; int c0 = n0;
    if (J.mode == 1 && n0 < 2048) { const int tile = n0 >> 8, c = n0 & 255, cc = c & 127; c0 = (tile >> 2) * 1024 + (2 * (tile & 3) + (cc >> 6)) * 128 + (cc & 63) + ((c >> 7) ? 64 : 0); }
    if (J.mode == 2) { const int tile = n0 >> 8, w = n0 & 255; if (w < 128) { c0 = tile * 128 + w; } else { src = J.src1; c0 = tile * 128 + w - 128; } }
#pragma unroll 8
    for (int i = 0; i < 32; ++i) { const int kk = 2 * i + (lane >> 5); float v = src[(size_t)(k0 + kk) * J.Nsrc + c0 + (lane & 31)]; if (J.gain) v *= J.gain[k0 + kk]; scr[kk * 33 + (lane & 31)] = v; }
    asm volatile("s_waitcnt lgkmcnt(0)" ::: "memory");
    const int c = lane & 7;
#pragma unroll
    for (int j = 0; j < 4; ++j) { const int n = (lane >> 3) + 8 * j; const float* s = scr + (8 * c) * 33 + n;
        u32x4 o; o.x = pk2(s[0 * 33], s[1 * 33]); o.y = pk2(s[2 * 33], s[3 * 33]); o.z = pk2(s[4 * 33], s[5 * 33]); o.w = pk2(s[6 * 33], s[7 * 33]);
        *(u32x4*)(J.dst + (size_t)(n0 + n) * J.K + k0 + 8 * c) = o; }
    asm volatile("s_waitcnt lgkmcnt(0)" ::: "memory");
}
__device__ __forceinline__ int ph_transpose_job(const TJob J, int base, float* scr, int gw, int NGW, int lane) {
    const int nitems = (J.K / 64) * (J.nrows / 32);
    const int first = (gw - base % NGW + NGW) % NGW;
    for (int it = first; it < nitems; it += NGW) transpose_item(J, scr, it, lane);
    return base + nitems;
}

__device__ __forceinline__ void rms_row_bf16(const float* xrow, const float* g, bf16_t* orow, int lane) {
    const f32x4* xr = (const f32x4*)xrow + lane; const f32x4* gr = (const f32x4*)g + lane;
    f32x4 v[8]; float s = 0.f;
#pragma unroll
    for (int j = 0; j < 8; ++j) { v[j] = xr[64 * j]; s += (v[j].x * v[j].x + v[j].y * v[j].y) + (v[j].z * v[j].z + v[j].w * v[j].w); }
    const float rinv = rsqrtf(wave_sum(s) * (1.f / DM) + EPS);
    u32x2* o8 = (u32x2*)orow + lane;
#pragma unroll
    for (int j = 0; j < 8; ++j) { const f32x4 gg = gr[64 * j]; u32x2 w; w.x = pk2(v[j].x * rinv * gg.x, v[j].y * rinv * gg.y); w.y = pk2(v[j].z * rinv * gg.z, v[j].w * rinv * gg.w); o8[64 * j] = w; }
}
__device__ __forceinline__ void ph_rms_bf16(const float* X, const float* g, bf16_t* O, int rows, int gw, int NGW, int lane) {
    for (int r = gw; r < rows; r += NGW) rms_row_bf16(X + (size_t)r * DM, g, O + (size_t)r * DM, lane);
}
__device__ __forceinline__ void ph_final_norm(float* X, const float* g, const float* ss, int rows, int gw, int NGW, int lane) {
    for (int r = gw; r < rows; r += NGW) {
        f32x4* xr = (f32x4*)(X + (size_t)r * DM) + lane; const f32x4* gr = (const f32x4*)g + lane;
        const float part = (lane < 32) ? ss[(size_t)r * 32 + lane] : 0.f;
        const float rinv = rsqrtf(wave_sum(part) * (1.f / DM) + EPS);
#pragma unroll
        for (int j = 0; j < 8; ++j) xr[64 * j] = xr[64 * j] * rinv * gr[64 * j];
    }
}

__device__ __forceinline__ void sincos_small(double r, double& s, double& c) {
    const double r2 = r * r;
    double a = -1.0 / 10888869450418352160768000000.0;
    a = a * r2 + 1.0 / 15511210043330985984000000.0;
    a = a * r2 - 1.0 / 25852016738884976640000.0;
    a = a * r2 + 1.0 / 51090942171709440000.0;
    a = a * r2 - 1.0 / 121645100408832000.0;
    a = a * r2 + 1.0 / 355687428096000.0;
    a = a * r2 - 1.0 / 1307674368000.0;
    a = a * r2 + 1.0 / 6227020800.0;
    a = a * r2 - 1.0 / 39916800.0;
    a = a * r2 + 1.0 / 362880.0;
    a = a * r2 - 1.0 / 5040.0;
    a = a * r2 + 1.0 / 120.0;
    a = a * r2 - 1.0 / 6.0;
    a = a * r2 + 1.0;
    s = a * r;
    double b = 1.0 / 403291461126605635584000000.0;
    b = b * r2 - 1.0 / 620448401733239439360000.0;
    b = b * r2 + 1.0 / 1124000727777607680000.0;
    b = b * r2 - 1.0 / 2432902008176640000.0;
    b = b * r2 + 1.0 / 6402373705728000.0;
    b = b * r2 - 1.0 / 20922789888000.0;
    b = b * r2 + 1.0 / 87178291200.0;
    b = b * r2 - 1.0 / 479001600.0;
    b = b * r2 + 1.0 / 3628800.0;
    b = b * r2 - 1.0 / 40320.0;
    b = b * r2 + 1.0 / 720.0;
    b = b * r2 - 1.0 / 24.0;
    b = b * r2 + 1.0 / 2.0;
    c = 1.0 - b * r2;
}
__device__ __forceinline__ void cs_entry(const int* pos, float* cs, int idx) {
    const int t = idx >> 6, f = idx & 63;
    double p = 1.0, bs = 0.8659643233600653;
#pragma unroll
    for (int bit = 0; bit < 6; ++bit) { if ((f >> bit) & 1) p *= bs; bs *= bs; }
    const double ang = (double)pos[t] * p;
    const double TWO_PI = 6.283185307179586;
    const double n = rint(ang / TWO_PI);
    const double r = fma(-n, TWO_PI, ang);
    double s, c; sincos_small(r, s, c);
    cs[2 * idx] = (float)c; cs[2 * idx + 1] = (float)s;
}
__device__ __forceinline__ void ph_cs(const int* pos, float* cs, int gtid, int NT) {
    for (int idx = gtid; idx < MT * 64; idx += NT) cs_entry(pos, cs, idx);
}
__device__ __forceinline__ void ph_rope_naive(bf16_t* proj, const float* cs, int gtid, int NT) {
    const long total = (long)MT * 2 * NH * 64;
    for (long i = gtid; i < total; i += NT) {
        const int d = (int)(i & 63), h = (int)((i >> 6) & 7), sec = (int)((i >> 9) & 1); const long t = i >> 10;
        bf16_t* p = proj + t * NPROJ + sec * 1024 + h * HD + d;
        const float a = bf2f(p[0]), b = bf2f(p[64]); const float c = cs[(t * 64 + d) * 2], s = cs[(t * 64 + d) * 2 + 1];
        p[0] = (bf16_t)f2bf(a * c - b * s); p[64] = (bf16_t)f2bf(b * c + a * s);
    }
}
__device__ __forceinline__ void ph_kmean_naive(const bf16_t* proj, float* kmean, int gtid, int NT) {
    for (int i = gtid; i < NB * NH * NBLK * HD; i += NT) {
        const int d = i & 127, blkid = i >> 7;
        const int blk = blkid & 15, h = (blkid >> 4) & 7, b = blkid >> 7;
        float s = 0.f;
        for (int j = 0; j < MBLK; ++j) s += bf2f(proj[(size_t)(b * SEQ + blk * MBLK + j) * NPROJ + 1024 + h * HD + d]);
        kmean[(size_t)blkid * HD + d] = s * (1.f / MBLK);
    }
}
__device__ __forceinline__ float dot_q_row(const float* sq, const bf16_t* krow) {
    float a = 0.f;
#pragma unroll
    for (int d = 0; d < 128; d += 8) { const u32x4 kk = *(const u32x4*)(krow + d);
        a += sq[d + 0] * bf2f(kk.x & 0xffffu) + sq[d + 1] * bf2f(kk.x >> 16) + sq[d + 2] * bf2f(kk.y & 0xffffu) + sq[d + 3] * bf2f(kk.y >> 16)
           + sq[d + 4] * bf2f(kk.z & 0xffffu) + sq[d + 5] * bf2f(kk.z >> 16) + sq[d + 6] * bf2f(kk.w & 0xffffu) + sq[d + 7] * bf2f(kk.w >> 16); }
    return a;
}
__device__ __forceinline__ void ph_moba_naive(const bf16_t* proj, const float* kmean, const float* g_attn, bf16_t* merged, float qscale_inv, float* scr, int gw, int NGW, int lane) {
    float* sq = scr; float* sp = scr + 128;
    for (int item = gw; item < MT * NH; item += NGW) {
        const int t = item >> 3, h = item & 7, b = t >> 12, ts = t & 4095, qb = ts >> 8, tq = ts & 255;
        const bf16_t* qrow = proj + (size_t)t * NPROJ + h * HD;
        const unsigned qq = *(const unsigned*)(qrow + 2 * lane);
        const float q0 = bf2f(qq & 0xffffu) * qscale_inv, q1 = bf2f(qq >> 16) * qscale_inv;
        asm volatile("s_waitcnt lgkmcnt(0)" ::: "memory");
        sq[2 * lane] = q0; sq[2 * lane + 1] = q1;
        float g[16];
#pragma unroll
        for (int i = 0; i < 16; ++i) { const float* km = kmean + (size_t)((b * 8 + h) * 16 + i) * HD; const float p = wave_sum(q0 * km[2 * lane] + q1 * km[2 * lane + 1]); g[i] = (i < qb) ? p : -INFINITY; }
        int sel[4];
#pragma unroll
        for (int r = 0; r < 3; ++r) { float best = -INFINITY; int bi = -1;
#pragma unroll
            for (int i = 0; i < 16; ++i) if (g[i] > best) { best = g[i]; bi = i; }
            sel[r] = bi;
#pragma unroll
            for (int i = 0; i < 16; ++i) if (i == bi) g[i] = -INFINITY; }
        sel[3] = qb;
        asm volatile("s_waitcnt lgkmcnt(0)" ::: "memory");
#pragma unroll
        for (int s = 0; s < 4; ++s) { const int blk = sel[s];
            for (int jj = 0; jj < 4; ++jj) { const int j = jj * 64 + lane; float sc = -INFINITY;
                if (blk >= 0 && (s < 3 || j <= tq)) sc = dot_q_row(sq, proj + (size_t)(b * SEQ + blk * MBLK + j) * NPROJ + 1024 + h * HD) * SM_SCALE;
                sp[s * 256 + j] = sc; } }
        asm volatile("s_waitcnt lgkmcnt(0)" ::: "memory");
        float m = -INFINITY; for (int i = lane; i < 1024; i += 64) m = fmaxf(m, sp[i]); m = wave_max(m);
        float l = 0.f; for (int i = lane; i < 1024; i += 64) { const float p = __expf(sp[i] - m); sp[i] = p; l += p; } l = wave_sum(l);
        asm volatile("s_waitcnt lgkmcnt(0)" ::: "memory");
        float o0 = 0.f, o1 = 0.f;
#pragma unroll
        for (int s = 0; s < 4; ++s) { const int blk = sel[s]; if (blk < 0) continue;
            const bf16_t* vb = proj + (size_t)(b * SEQ + blk * MBLK) * NPROJ + 2048 + h * HD + 2 * lane;
            for (int j = 0; j < 256; ++j) { const float p = sp[s * 256 + j]; const unsigned vv = *(const unsigned*)(vb + (size_t)j * NPROJ); o0 += p * bf2f(vv & 0xffffu); o1 += p * bf2f(vv >> 16); } }
        const float li = 1.f / l; o0 *= li; o1 *= li;
        const float rinv = rsqrtf(wave_sum(o0 * o0 + o1 * o1) * (1.f / HD) + EPS);
        *(unsigned*)(merged + (size_t)t * DM + h * HD + 2 * lane) = pk2(o0 * rinv * g_attn[h * HD + 2 * lane], o1 * rinv * g_attn[h * HD + 2 * lane + 1]);
    }
}
__device__ __forceinline__ void ph_conv_naive(const bf16_t* proj, const float* w_conv, const float* b_conv, const float* g_conv, bf16_t* merged, int gw, int NGW, int lane) {
    for (int item = gw; item < MT * 8; item += NGW) {
        const int t = item >> 3, grp = item & 7, ts = t & 4095; const int c = grp * 128 + 2 * lane;
        float y[2];
#pragma unroll
        for (int e = 0; e < 2; ++e) { float acc = b_conv[c + e];
#pragma unroll
            for (int k = 0; k < 3; ++k) { const int back = 2 - k; if (ts - back >= 0) { const bf16_t* r = proj + (size_t)(t - back) * NPROJ; acc += w_conv[k * CW + c + e] * (bf2f(r[3072 + c + e]) * bf2f(r[5120 + c + e])); } }
            y[e] = bf2f(proj[(size_t)t * NPROJ + 4096 + c + e]) * acc; }
        const float rinv = rsqrtf(wave_sum(y[0] * y[0] + y[1] * y[1]) * (1.f / HD) + EPS);
        *(unsigned*)(merged + (size_t)t * DM + AW + c) = pk2(y[0] * rinv * g_conv[c], y[1] * rinv * g_conv[c + 1]);
    }
}
__device__ __forceinline__ void ph_xattn_naive(const bf16_t* qx, const bf16_t* kvx, bf16_t* ox, float qscale_inv, float* scr, int gw, int NGW, int lane) {
    float* sq = scr; float* sp = scr + 128;
    for (int item = gw; item < MT * XH; item += NGW) {
        const int t = item >> 2, h = item & 3, b = t >> 12;
        const unsigned qq = *(const unsigned*)(qx + (size_t)t * XW + h * HD + 2 * lane);
        asm volatile("s_waitcnt lgkmcnt(0)" ::: "memory");
        sq[2 * lane] = bf2f(qq & 0xffffu) * qscale_inv; sq[2 * lane + 1] = bf2f(qq >> 16) * qscale_inv;
        asm volatile("s_waitcnt lgkmcnt(0)" ::: "memory");
        float m = -INFINITY;
        for (int jj = 0; jj < 4; ++jj) { const int j = jj * 64 + lane; const float sc = dot_q_row(sq, kvx + (size_t)(b * NMEM + j) * 1024 + h * HD) * SM_SCALE; sp[j] = sc; m = fmaxf(m, sc); }
        m = wave_max(m);
        asm volatile("s_waitcnt lgkmcnt(0)" ::: "memory");
        float l = 0.f; for (int i = lane; i < 256; i += 64) { const float p = __expf(sp[i] - m); sp[i] = p; l += p; } l = wave_sum(l);
        asm volatile("s_waitcnt lgkmcnt(0)" ::: "memory");
        float o0 = 0.f, o1 = 0.f; const bf16_t* vb = kvx + (size_t)(b * NMEM) * 1024 + 512 + h * HD + 2 * lane;
        for (int j = 0; j < 256; ++j) { const float p = sp[j]; const unsigned vv = *(const unsigned*)(vb + (size_t)j * 1024); o0 += p * bf2f(vv & 0xffffu); o1 += p * bf2f(vv >> 16); }
        const float li = 1.f / l;
        *(unsigned*)(ox + (size_t)t * XW + h * HD + 2 * lane) = pk2(o0 * li, o1 * li);
    }
}

namespace moba {
using bf16x8 = __attribute__((ext_vector_type(8))) short;
using s16x4  = __attribute__((ext_vector_type(4))) short;
using f32x16 = __attribute__((ext_vector_type(16))) float;
using u32x4v = __attribute__((ext_vector_type(4))) unsigned;
using f32x4v = __attribute__((ext_vector_type(4))) float;
constexpr int D = 128, NW = 8, QBLK = 32, KVBLK = 64;
constexpr float SCALE = 0.088388347648318440f, THR = 8.f;
constexpr int SHM_V = KVBLK * D * 2, SHM_K = KVBLK * D * 2;
constexpr int OFF_V = 0, OFF_K = 2 * SHM_V, OFF_WS = OFF_K + 2 * SHM_K, OFF_KM = OFF_WS + NW * 256, OFF_RS = OFF_KM + 16 * 128 * 4, RS_BYTES = (32 * 33 + 32) * 4, LDS_END = OFF_RS + NW * RS_BYTES;
static_assert(LDS_END <= 131072, "moba LDS");
#define KSWZ(row, colB) ((row) * 256 + ((colB) ^ (((row) & 7) << 4)))
#define SBAR() __builtin_amdgcn_sched_barrier(0)
__device__ __forceinline__ int crow(int r, int hi) { return (r & 3) + 8 * (r >> 2) + 4 * hi; }
__device__ __forceinline__ unsigned cvtpk(float lo, float hi) { unsigned r; asm volatile("v_cvt_pk_bf16_f32 %0, %1, %2" : "=v"(r) : "v"(lo), "v"(hi)); return r; }
__device__ __forceinline__ void partialSM(f32x16& p0, f32x16& p1, float& m_reg, float& mn, float& alpha) {
  constexpr float C = SCALE * 1.4426950408889634f;
  float pmax = p0[0];
#pragma unroll
  for (int r = 1; r < 16; ++r) pmax = fmaxf(pmax, p0[r]);
#pragma unroll
  for (int r = 0; r < 16; ++r) pmax = fmaxf(pmax, p1[r]);
  { auto rr = __builtin_amdgcn_permlane32_swap(__float_as_uint(pmax), __float_as_uint(pmax), false, false);
    pmax = fmaxf(__uint_as_float(rr[0]), __uint_as_float(rr[1])); }
  if (__builtin_expect(__all(pmax - m_reg <= THR / SCALE), 1)) { mn = m_reg; alpha = 1.f; }
  else { mn = fmaxf(m_reg, pmax); alpha = __builtin_amdgcn_exp2f((m_reg - mn) * C); m_reg = mn; }
  float mnC = -mn * C;
#pragma unroll
  for (int r = 0; r < 16; ++r) p0[r] = fmaf(p0[r], C, mnC);
#pragma unroll
  for (int r = 0; r < 16; ++r) p1[r] = fmaf(p1[r], C, mnC);
#pragma unroll
  for (int r = 0; r < 16; ++r) p0[r] = __builtin_amdgcn_exp2f(p0[r]);
}
__device__ __forceinline__ void finishSM(f32x16& p0, f32x16& p1, float alpha, float& l_reg, bf16x8& pa0, bf16x8& pa1, bf16x8& pa2, bf16x8& pa3) {
#pragma unroll
  for (int r = 0; r < 16; ++r) p1[r] = __builtin_amdgcn_exp2f(p1[r]);
  float ps = 0;
#pragma unroll
  for (int r = 0; r < 16; ++r) ps += p0[r];
#pragma unroll
  for (int r = 0; r < 16; ++r) ps += p1[r];
  { auto rr = __builtin_amdgcn_permlane32_swap(__float_as_uint(ps), __float_as_uint(ps), false, false);
    ps = __uint_as_float(rr[0]) + __uint_as_float(rr[1]); }
  l_reg = l_reg * alpha + ps;
#define PK4(P, BASE, OUT) do { unsigned a0 = cvtpk(P[BASE + 0], P[BASE + 1]), a1 = cvtpk(P[BASE + 2], P[BASE + 3]);   \
    unsigned b0 = cvtpk(P[BASE + 4], P[BASE + 5]), b1 = cvtpk(P[BASE + 6], P[BASE + 7]);                              \
    auto r0 = __builtin_amdgcn_permlane32_swap(a0, b0, false, false); auto r1 = __builtin_amdgcn_permlane32_swap(a1, b1, false, false); \
    u32x4v w = {r0[0], r1[0], r0[1], r1[1]}; OUT = *reinterpret_cast<bf16x8*>(&w); } while (0)
  PK4(p0, 0, pa0); PK4(p0, 8, pa1); PK4(p1, 0, pa2); PK4(p1, 8, pa3);
#undef PK4
}
__device__ __forceinline__ void qkt(f32x16& p0, f32x16& p1, const char* Ks, const bf16x8* qr, int r32, int hi) {
  p0 = f32x16{}; p1 = f32x16{};
#pragma unroll
  for (int d0 = 0; d0 < 8; ++d0) { int cb = (d0 * 16 + hi * 8) * 2;
    bf16x8 b0 = *reinterpret_cast<const bf16x8*>(Ks + KSWZ(r32, cb));
    bf16x8 b1 = *reinterpret_cast<const bf16x8*>(Ks + KSWZ(32 + r32, cb));
    p0 = __builtin_amdgcn_mfma_f32_32x32x16_bf16(b0, qr[d0], p0, 0, 0, 0);
    p1 = __builtin_amdgcn_mfma_f32_32x32x16_bf16(b1, qr[d0], p1, 0, 0, 0); }
}
__device__ __forceinline__ int v_st(int k, int c) { const int kk = (k & ~0xC) | ((k & 4) << 1) | ((k & 8) >> 1); return ((kk >> 3) * 4 + (c >> 5)) * 512 + ((kk & 7) * 32 + (c & 31)) * 2; }
__device__ __forceinline__ int v_rd_base(int lane) { return ((lane & 3) << 3) | (((lane >> 2) & 3) << 6) | (((lane >> 4) & 1) << 5) | (((lane >> 5) & 1) << 8); }
constexpr int v_rd_off(int d0, int ks, int half) { return d0 * 512 + ks * 4096 + half * 2048; }
template <int OFF> __device__ __forceinline__ s16x4 tr_read(int vb) {
  s16x4 r; asm volatile("ds_read_b64_tr_b16 %0, %1 offset:%2" : "=&v"(r) : "v"(vb), "i"(OFF) : "memory"); return r;
}
template <int D0> __device__ __forceinline__ void pv_one(f32x16& od, int vb, bf16x8 pa0, bf16x8 pa1, bf16x8 pa2, bf16x8 pa3) {
  const s16x4 l0 = tr_read<v_rd_off(D0, 0, 0)>(vb), h0 = tr_read<v_rd_off(D0, 0, 1)>(vb), l1 = tr_read<v_rd_off(D0, 1, 0)>(vb), h1 = tr_read<v_rd_off(D0, 1, 1)>(vb);
  const s16x4 l2 = tr_read<v_rd_off(D0, 2, 0)>(vb), h2 = tr_read<v_rd_off(D0, 2, 1)>(vb), l3 = tr_read<v_rd_off(D0, 3, 0)>(vb), h3 = tr_read<v_rd_off(D0, 3, 1)>(vb);
  asm volatile("s_waitcnt lgkmcnt(0)" ::: "memory"); SBAR();
#define PK(L, H) (bf16x8){L[0], L[1], L[2], L[3], H[0], H[1], H[2], H[3]}
  od = __builtin_amdgcn_mfma_f32_32x32x16_bf16(pa0, PK(l0, h0), od, 0, 0, 0);
  od = __builtin_amdgcn_mfma_f32_32x32x16_bf16(pa1, PK(l1, h1), od, 0, 0, 0);
  od = __builtin_amdgcn_mfma_f32_32x32x16_bf16(pa2, PK(l2, h2), od, 0, 0, 0);
  od = __builtin_amdgcn_mfma_f32_32x32x16_bf16(pa3, PK(l3, h3), od, 0, 0, 0);
#undef PK
}
__device__ __forceinline__ void pv_d0(f32x16* o, int vb, bf16x8 pa0, bf16x8 pa1, bf16x8 pa2, bf16x8 pa3) {
  pv_one<0>(o[0], vb, pa0, pa1, pa2, pa3); pv_one<1>(o[1], vb, pa0, pa1, pa2, pa3); pv_one<2>(o[2], vb, pa0, pa1, pa2, pa3); pv_one<3>(o[3], vb, pa0, pa1, pa2, pa3);
}
template <int MODE> __device__ __forceinline__ void tile_mask(f32x16& p0, f32x16& p1, int j, int qb, unsigned selmask, int qrow, int hi) {
  if constexpr (MODE != 0) return;
  const int kb = j >> 2;
  if (kb < qb) {
    if (!((selmask >> kb) & 1u)) {
#pragma unroll
      for (int r = 0; r < 16; ++r) { p0[r] = -INFINITY; p1[r] = -INFINITY; } }
  } else {
    const int kbase = (j & 3) * 64;
#pragma unroll
    for (int r = 0; r < 16; ++r) { const int key = kbase + crow(r, hi); if (key > qrow) p0[r] = -INFINITY; if (key + 32 > qrow) p1[r] = -INFINITY; }
  }
}
template <int MODE> __device__ __forceinline__ void unit(int b, int h, int qb, const bf16_t* __restrict__ proj, const bf16_t* __restrict__ kvp, const float* __restrict__ kmean, const float* __restrict__ gain, bf16_t* __restrict__ merged, char* lds) {
  constexpr int LDQ = MODE == 0 ? NPROJ : XW, LDK = MODE == 0 ? NPROJ : 2 * XW, LDO = MODE == 0 ? DM : XW;
  const int tid = otid(), wid = tid >> 6, lane = tid & 63, r32 = lane & 31, hi = lane >> 5;
  char* V_lds = lds + OFF_V; char* K_lds = lds + OFF_K;
  float* ws = (float*)(lds + OFF_WS) + wid * 64; float* li_l = ws; float* al_l = ws + 32;
  char* KM = lds + OFF_KM; float* RS = (float*)(lds + OFF_RS + wid * RS_BYTES); float* RV = RS + 32 * 33;
  const long rowbase = (long)b * SEQ;
  const bf16_t* Qw = proj + (rowbase + qb * 256 + wid * QBLK + r32) * LDQ + h * D + hi * 8;
  const bf16_t* Kh = MODE == 0 ? proj + rowbase * LDK + 1024 + h * D : kvp + (long)b * NMEM * LDK + h * D;
  const bf16_t* Vh = MODE == 0 ? proj + rowbase * LDK + 2048 + h * D : kvp + (long)b * NMEM * LDK + XW + h * D;
  __syncthreads();
  if constexpr (MODE == 0)
  { const int blk = tid >> 5, c4 = (tid & 31) * 4;
    const f32x4v kv = *(const f32x4v*)(kmean + (size_t)((b * 8 + h) * 16 + blk) * D + c4);
    unsigned hb[4], lb[4];
#pragma unroll
    for (int e = 0; e < 4; ++e) { hb[e] = f2bf(kv[e]); lb[e] = f2bf(kv[e] - __uint_as_float(hb[e] << 16)); }
    typedef unsigned u32x2v __attribute__((ext_vector_type(2)));
    *(u32x2v*)(KM + KSWZ(blk, c4 * 2)) = (u32x2v){hb[0] | (hb[1] << 16), hb[2] | (hb[3] << 16)};
    *(u32x2v*)(KM + KSWZ(16 + blk, c4 * 2)) = (u32x2v){lb[0] | (lb[1] << 16), lb[2] | (lb[3] << 16)}; }
  float m_reg = -1e30f, l_reg = 0; f32x16 o[4] = {}; bf16x8 qr[8];
#pragma unroll
  for (int d0 = 0; d0 < 8; ++d0) qr[d0] = *reinterpret_cast<const bf16x8*>(Qw + d0 * 16);
  const int sr = tid >> 4, sc = (tid & 15) * 8, vst0 = v_st(sr, sc), vst1 = v_st(32 + sr, sc);
  const int vb0 = (int)(uintptr_t)V_lds + v_rd_base(lane);
  struct { bf16x8 vs0, vs1, ks0, ks1; } sr_[1];
#define SLOAD(i, k0) do { sr_[i].vs0 = *reinterpret_cast<const bf16x8*>(&Vh[(long)((k0) + sr) * LDK + sc]); sr_[i].vs1 = *reinterpret_cast<const bf16x8*>(&Vh[(long)((k0) + 32 + sr) * LDK + sc]); \
    sr_[i].ks0 = *reinterpret_cast<const bf16x8*>(&Kh[(long)((k0) + sr) * LDK + sc]); sr_[i].ks1 = *reinterpret_cast<const bf16x8*>(&Kh[(long)((k0) + 32 + sr) * LDK + sc]); } while (0)
#define SWRITE(bb, i) do { *(bf16x8*)(V_lds + (bb) * SHM_V + vst0) = sr_[i].vs0;          \
    *(bf16x8*)(V_lds + (bb) * SHM_V + vst1) = sr_[i].vs1; int kc = sc * 2;               \
    *(bf16x8*)(K_lds + (bb) * SHM_K + KSWZ(sr, kc)) = sr_[i].ks0;                       \
    *(bf16x8*)(K_lds + (bb) * SHM_K + KSWZ(32 + sr, kc)) = sr_[i].ks1; } while (0)
#define SWAIT() asm volatile("s_waitcnt vmcnt(0)" ::: "memory")
#define RESC(a) do { if (__any((a) < 1.f)) { if (hi == 0) al_l[r32] = (a); asm volatile("s_waitcnt lgkmcnt(0)" ::: "memory"); \
    _Pragma("unroll") for (int d = 0; d < 4; ++d) _Pragma("unroll") for (int r = 0; r < 16; ++r) o[d][r] *= al_l[crow(r, hi)]; } } while (0)
  const int NT = MODE == 0 ? 4 * (qb + 1) : 4;
  constexpr int SE = 0, SO = 0;
  SLOAD(SE, 0);
  __syncthreads();
  unsigned selmask = 0u;
  if constexpr (MODE == 0) {
    f32x16 gp = f32x16{};
#pragma unroll
    for (int d0 = 0; d0 < 8; ++d0) { const int cb = (d0 * 16 + hi * 8) * 2;
      const bf16x8 b0 = *reinterpret_cast<const bf16x8*>(KM + KSWZ(r32, cb));
      gp = __builtin_amdgcn_mfma_f32_32x32x16_bf16(b0, qr[d0], gp, 0, 0, 0); }
    float g[16];
#pragma unroll
    for (int r = 0; r < 8; ++r) { const float v = gp[r] + gp[r + 8];
      auto rr = __builtin_amdgcn_permlane32_swap(__float_as_uint(v), __float_as_uint(v), false, false);
      const int blo = (r < 4) ? r : 8 + (r - 4);
      g[blo] = __uint_as_float(rr[0]); g[blo + 4] = __uint_as_float(rr[1]); }
#pragma unroll
    for (int i = 0; i < 16; ++i) g[i] = (i < qb) ? g[i] : -INFINITY;
#pragma unroll
    for (int rnd = 0; rnd < 3; ++rnd) { float best = -INFINITY; int bi = -1;
#pragma unroll
      for (int i = 0; i < 16; ++i) if (g[i] > best) { best = g[i]; bi = i; }
      if (bi >= 0) selmask |= 1u << bi;
#pragma unroll
      for (int i = 0; i < 16; ++i) if (i == bi) g[i] = -INFINITY; }
  }
  const int qrow = wid * QBLK + r32;
  f32x16 pA0, pA1, pB0, pB1; float mnA, mnB, alA, alB; bf16x8 pa0, pa1, pa2, pa3;
  asm volatile("s_waitcnt vmcnt(0)" ::: "memory"); SWRITE(0, SE); __syncthreads();
  qkt(pA0, pA1, K_lds, qr, r32, hi); tile_mask<MODE>(pA0, pA1, 0, qb, selmask, qrow, hi); partialSM(pA0, pA1, m_reg, mnA, alA);
  SLOAD(SO, KVBLK);
  SWAIT(); SWRITE(1, SO); __syncthreads();
  for (int j = 1; j + 1 < NT; j += 2) {
    SBAR(); qkt(pB0, pB1, K_lds + SHM_K, qr, r32, hi); tile_mask<MODE>(pB0, pB1, j, qb, selmask, qrow, hi);
    finishSM(pA0, pA1, alA, l_reg, pa0, pa1, pa2, pa3); SBAR();
    SLOAD(SE, (j + 1) * KVBLK); SBAR();
    pv_d0(o, vb0, pa0, pa1, pa2, pa3); partialSM(pB0, pB1, m_reg, mnB, alB);
    __syncthreads(); SWAIT(); SWRITE(0, SE);
    RESC(alB); __syncthreads();
    SBAR(); qkt(pA0, pA1, K_lds, qr, r32, hi); tile_mask<MODE>(pA0, pA1, j + 1, qb, selmask, qrow, hi);
    finishSM(pB0, pB1, alB, l_reg, pa0, pa1, pa2, pa3); SBAR();
    SLOAD(SO, (j + 2) * KVBLK); SBAR();
    pv_d0(o, vb0 + SHM_V, pa0, pa1, pa2, pa3); partialSM(pA0, pA1, m_reg, mnA, alA);
    __syncthreads(); SWAIT(); SWRITE(1, SO);
    RESC(alA); __syncthreads();
  }
  SBAR(); qkt(pB0, pB1, K_lds + SHM_K, qr, r32, hi); tile_mask<MODE>(pB0, pB1, NT - 1, qb, selmask, qrow, hi);
  finishSM(pA0, pA1, alA, l_reg, pa0, pa1, pa2, pa3); SBAR();
  pv_d0(o, vb0, pa0, pa1, pa2, pa3); partialSM(pB0, pB1, m_reg, mnB, alB);
  __syncthreads(); RESC(alB);
  finishSM(pB0, pB1, alB, l_reg, pa0, pa1, pa2, pa3); SBAR();
  pv_d0(o, vb0 + SHM_V, pa0, pa1, pa2, pa3);
  if (hi == 0) li_l[r32] = l_reg; asm volatile("s_waitcnt lgkmcnt(0)" ::: "memory");
  float rli[16];
#pragma unroll
  for (int r = 0; r < 16; ++r) rli[r] = __builtin_amdgcn_rcpf(li_l[crow(r, hi)]);
  if constexpr (MODE == 0) {
#pragma unroll
  for (int r = 0; r < 16; ++r) { float s = 0.f;
#pragma unroll
    for (int d0 = 0; d0 < 4; ++d0) { o[d0][r] *= rli[r]; s += o[d0][r] * o[d0][r]; }
    RS[crow(r, hi) * 33 + r32] = s; }
  asm volatile("s_waitcnt lgkmcnt(0)" ::: "memory");
  { float s = 0.f;
#pragma unroll
    for (int c = 0; c < 32; ++c) s += RS[r32 * 33 + c];
    if (hi == 0) RV[r32] = rsqrtf(s * (1.f / D) + EPS); }
  asm volatile("s_waitcnt lgkmcnt(0)" ::: "memory");
  float gn[4];
#pragma unroll
  for (int d0 = 0; d0 < 4; ++d0) gn[d0] = gain[h * D + d0 * 32 + r32];
  bf16_t* Ow = merged + (rowbase + qb * 256 + wid * QBLK) * LDO + h * D;
#pragma unroll
  for (int r = 0; r < 16; ++r) { const int orow = crow(r, hi); const float rv = RV[orow];
#pragma unroll
    for (int d0 = 0; d0 < 4; ++d0) Ow[(long)orow * LDO + d0 * 32 + r32] = (bf16_t)f2bf(o[d0][r] * rv * gn[d0]); }
  } else {
    bf16_t* Ow = merged + (rowbase + qb * 256 + wid * QBLK) * LDO + h * D;
#pragma unroll
    for (int r = 0; r < 16; ++r) { const int orow = crow(r, hi);
#pragma unroll
      for (int d0 = 0; d0 < 4; ++d0) Ow[(long)orow * LDO + d0 * 32 + r32] = (bf16_t)f2bf(o[d0][r] * rli[r]); }
  }
#undef SLOAD
#undef SWRITE
#undef SWAIT
#undef RESC
}
#undef KSWZ
#undef SBAR
}

namespace cg = cooperative_groups;
constexpr int LDS_BYTES = 147456;
struct Args { const void* in[20]; float* out; unsigned char* ws; };
__global__ void __launch_bounds__(512, 2) mk_fwd(Args a) {
    extern __shared__ __attribute__((aligned(16))) unsigned char lds[];
    cg::grid_group grid = cg::this_grid();
    const int G = (int)gridDim.x, bx = (int)blockIdx.x;
    const int NGW = G * 8, NT = G * 512;
#define IDS() const int tid = otid(), lane = tid & 63, wave = __builtin_amdgcn_readfirstlane(tid >> 6); const int gw = bx * 8 + wave, gtid = bx * 512 + tid; float* wscr = (float*)(lds + wave * 16384); (void)lane; (void)gw; (void)gtid; (void)wscr
#define IN_F(k) ((const float*)a.in[k])
#define WSP(T, off) ((T)(a.ws + (off)))
#define x IN_F(0)
#define mem IN_F(1)
#define pos ((const int*)a.in[2])
#define g_mix IN_F(3)
#define w_in IN_F(4)
#define w_conv IN_F(5)
#define b_conv IN_F(6)
#define g_attn IN_F(7)
#define g_conv IN_F(8)
#define w_out IN_F(9)
#define g_xattn IN_F(10)
#define g_mem IN_F(11)
#define w_xq IN_F(12)
#define w_xkv IN_F(13)
#define w_xo IN_F(14)
#define g_ffn IN_F(15)
#define w_gate IN_F(16)
#define w_up IN_F(17)
#define w_down IN_F(18)
#define g_final IN_F(19)
#define out (a.out)
#define Win WSP(bf16_t*, WS_WIN)
#define Wout WSP(bf16_t*, WS_WOUT)
#define Wxq WSP(bf16_t*, WS_WXQ)
#define Wxkv WSP(bf16_t*, WS_WXKV)
#define Wxo WSP(bf16_t*, WS_WXO)
#define Wgu WSP(bf16_t*, WS_WGU)
#define Wdn WSP(bf16_t*, WS_WDN)
#define H WSP(bf16_t*, WS_H)
#define MRG WSP(bf16_t*, WS_MRG)
#define PROJ WSP(bf16_t*, WS_PROJ)
#define ACT WSP(bf16_t*, WS_ACT)
#define QX WSP(bf16_t*, WS_QX)
#define OX WSP(bf16_t*, WS_OX)
#define KVX WSP(bf16_t*, WS_KVX)
#define MEMN WSP(bf16_t*, WS_MEMN)
#define CS WSP(float*, WS_CS)
#define KMEAN WSP(float*, WS_KMEAN)
#define SS1 WSP(float*, WS_SS)
#define SS2 WSP(float*, WS_SS + 2 * MiB)
#define SS3 WSP(float*, WS_SS + 4 * MiB)
    PG8_LAS unsigned char* ldsg = (PG8_LAS unsigned char*)lds;

#define GEMM(EpiT, Aop, Bop, Mr, Nc, Kd, ...) do { pg8::Gemm g_{Aop, Bop, Mr, Nc, Kd, 0}; pg8::StaticOrder S_; S_.init(Mr, Nc, G, bx); EpiT E_{__VA_ARGS__}; \
        pg8::gemm_phase<EpiT, pg8::StaticOrder, true, true>(ldsg, g_, S_, E_); } while (0)

    {
        IDS();
        int base = 0;
        base = ph_transpose_job(TJob{w_in, nullptr, nullptr, Win, DM, NPROJ, NPROJ, 1}, base, wscr, gw, NGW, lane);
        base = ph_transpose_job(TJob{w_out, nullptr, nullptr, Wout, DM, DM, DM, 0}, base, wscr, gw, NGW, lane);
        base = ph_transpose_job(TJob{w_xq, nullptr, g_xattn, Wxq, DM, XW, XW, 0}, base, wscr, gw, NGW, lane);
        base = ph_transpose_job(TJob{w_xkv, nullptr, nullptr, Wxkv, DM, 2 * XW, 2 * XW, 0}, base, wscr, gw, NGW, lane);
        base = ph_transpose_job(TJob{w_xo, nullptr, nullptr, Wxo, XW, DM, DM, 0}, base, wscr, gw, NGW, lane);
        base = ph_transpose_job(TJob{w_gate, w_up, g_ffn, Wgu, DM, DFF, 2 * DFF, 2}, base, wscr, gw, NGW, lane);
        base = ph_transpose_job(TJob{w_down, nullptr, nullptr, Wdn, DFF, DM, DM, 0}, base, wscr, gw, NGW, lane);
    }
    { IDS(); ph_cs(pos, CS, gtid, NT); for (int i = gtid; i < NB * NH * NBLK * HD; i += NT) KMEAN[i] = 0.f; }
    { IDS(); ph_rms_bf16(x, g_mix, H, MT, gw, NGW, lane); ph_rms_bf16(mem, g_mem, MEMN, NB * NMEM, gw, NGW, lane); }
    grid.sync();
    GEMM(pg8::EpiInProj, H, Win, MT, NPROJ, DM, PROJ, CS, KMEAN);
    GEMM(pg8::EpiStoreBf16, MEMN, Wxkv, NB * NMEM, 2 * XW, DM, KVX, 2 * XW, 0);
    grid.sync();
    {
        const int vcu = (G % 8 == 0) ? (bx % 8) * (G / 8) + bx / 8 : bx;
        for (int p = vcu; p < NB * NH * 8; p += G) {
            const int bh = p >> 3, s = p & 7;
            moba::unit<0>(bh >> 3, bh & 7, s, PROJ, nullptr, KMEAN, g_attn, MRG, (char*)lds);
            moba::unit<0>(bh >> 3, bh & 7, 15 - s, PROJ, nullptr, KMEAN, g_attn, MRG, (char*)lds);
        }
        __syncthreads();
    }
    { IDS(); ph_conv_naive(PROJ, w_conv, b_conv, g_conv, MRG, gw, NGW, lane); }
    grid.sync();
    GEMM(pg8::EpiResNorm<true>, MRG, Wout, MT, DM, DM, x, out, H, SS1);
    grid.sync();
    GEMM(pg8::EpiRowScaleBf16, H, Wxq, MT, XW, DM, QX, SS1, XW, 0);
    grid.sync();
    {
        const int vcu = (G % 8 == 0) ? (bx % 8) * (G / 8) + bx / 8 : bx;
        for (int p = vcu; p < NB * XH * (SEQ / 256); p += G) { const int bh = p >> 4, qt = p & 15; moba::unit<1>(bh >> 2, bh & 3, qt, QX, KVX, nullptr, nullptr, OX, (char*)lds); }
        __syncthreads();
    }
    grid.sync();
    GEMM(pg8::EpiResNorm<true>, OX, Wxo, MT, DM, XW, out, out, H, SS2);
    grid.sync();
    GEMM(pg8::EpiSwiGLUNorm, H, Wgu, MT, 2 * DFF, DM, ACT, SS2, DFF, 0);
    grid.sync();
    GEMM(pg8::EpiResNorm<false>, ACT, Wdn, MT, DM, DFF, out, out, nullptr, SS3);
    grid.sync();
    { IDS(); ph_final_norm(out, g_final, SS3, MT, gw, NGW, lane); }
#undef GEMM
#undef IDS
#undef x
#undef mem
#undef pos
#undef g_mix
#undef w_in
#undef w_conv
#undef b_conv
#undef g_attn
#undef g_conv
#undef w_out
#undef g_xattn
#undef g_mem
#undef w_xq
#undef w_xkv
#undef w_xo
#undef g_ffn
#undef w_gate
#undef w_up
#undef w_down
#undef g_final
#undef out
#undef Win
#undef Wout
#undef Wxq
#undef Wxkv
#undef Wxo
#undef Wgu
#undef Wdn
#undef H
#undef MRG
#undef PROJ
#undef ACT
#undef QX
#undef OX
#undef KVX
#undef MEMN
#undef CS
#undef KMEAN
#undef SS1
#undef SS2
#undef SS3
#undef IN_F
#undef WSP
}

extern "C" void kernel_launch(void* const* d_in, const int* in_sizes, int n_in, void* d_out, int out_size, void* d_ws, size_t ws_size, hipStream_t stream) {
    static int grid_blocks = 0;
    if (grid_blocks == 0) {
        if (n_in != 20 || ws_size < WS_END) { fprintf(stderr, "kernel_launch: unexpected n_in %d / ws %zu\n", n_in, ws_size); grid_blocks = -1; return; }
        int dev = 0, cus = 0, per_cu = 0;
        (void)hipGetDevice(&dev); (void)hipDeviceGetAttribute(&cus, hipDeviceAttributeMultiprocessorCount, dev);
        (void)hipFuncSetAttribute((const void*)mk_fwd, hipFuncAttributeMaxDynamicSharedMemorySize, LDS_BYTES);
        (void)hipOccupancyMaxActiveBlocksPerMultiprocessor(&per_cu, (const void*)mk_fwd, 512, LDS_BYTES);
        if (per_cu < 1) { fprintf(stderr, "kernel_launch: occupancy query says %d blocks per CU\n", per_cu); per_cu = 1; }
        grid_blocks = cus;
        (void)hipGetLastError();
    }
    if (grid_blocks < 0) return;
    Args a{};
    for (int i = 0; i < 20; ++i) a.in[i] = d_in[i];
    a.out = (float*)d_out; a.ws = (unsigned char*)d_ws;
    void* args[] = {&a};
    hipError_t e = hipLaunchCooperativeKernel((const void*)mk_fwd, dim3(grid_blocks), dim3(512), args, LDS_BYTES, stream);
    if (e != hipSuccess) fprintf(stderr, "cooperative launch failed: %s (grid %d)\n", hipGetErrorString(e), grid_blocks);
}
```

```cpp
#include <hip/hip_runtime.h>
#include <hip/hip_cooperative_groups.h>
#include <cstdio>
#include <cstdint>
#include <cmath>
__device__ __forceinline__ int otid() { int t = (int)threadIdx.x; asm volatile("" : "+v"(t)); return t; }
namespace pg8 {
#define PG8_LAS __attribute__((address_space(3)))
typedef unsigned short bf16_t;
typedef short bf16x8 __attribute__((ext_vector_type(8)));
typedef float f32x4 __attribute__((ext_vector_type(4)));
typedef unsigned u32x4 __attribute__((ext_vector_type(4)));
constexpr int BM = 256, BK = 64, HALF = 128, HTB = HALF * BK * 2  , STAGE_BYTES = 8 * HTB, NXCD = 8, WGM = 8;

__host__ __device__ __forceinline__ int lds_byte(int r, int c) { const int st = (r >> 4) * 2 + (c >> 5), rr = r & 15, cc = c & 31, ob = rr * 64 + cc * 2; return st * 1024 + (ob ^ (((ob >> 9) & 1) << 5)); }
__host__ __device__ __forceinline__ void stage_rc(int b, int& R, int& C) { const int st = b / 1024, sb = b % 1024, swz = sb ^ (((sb >> 9) & 1) << 5); R = (st >> 1) * 16 + swz / 64; C = (st & 1) * 32 + (swz % 64) / 2; }
__host__ __device__ __forceinline__ int perm32(int rho) { const int n = rho >> 4, i = rho & 15; return 8 * (i >> 2) + 4 * n + (i & 3); }

struct Unit { int pm, pn; };
struct Gemm { const bf16_t* A; const bf16_t* Bt; int M, N, K, pad; };

struct StaticOrder {
    int nM, nN, nwg, G, c;
    __host__ __device__ void init(int M, int N, int G_, int c_) { nM = M / BM; nN = N / BM; nwg = nM * nN; G = G_; c = c_; }
    __host__ __device__ bool next(int i, Unit& u) const {
        const long L = (long)i * G + c; if (L >= nwg) return false;
        int wgid = (int)L; { const int q = nwg / NXCD, r = nwg % NXCD, xcd = wgid % NXCD, off = wgid / NXCD; wgid = (xcd < r ? xcd * (q + 1) : r * (q + 1) + (xcd - r) * q) + off; }
        const int nig = WGM * nN, gid = wgid / nig, fm = gid * WGM, gsz = (nM - fm) < WGM ? (nM - fm) : WGM;
        u.pm = fm + ((wgid % nig) % gsz); u.pn = (wgid % nig) / gsz; return true;
    }
    __device__ __forceinline__ void a_ready(const Unit&) const {}
    __device__ __forceinline__ void done(const Unit&) const {}
};
__device__ __forceinline__ unsigned cvt_pk_bf16(float lo, float hi) { unsigned r; asm volatile("v_cvt_pk_bf16_f32 %0, %1, %2" : "=v"(r) : "v"(lo), "v"(hi)); return r; }
__device__ __forceinline__ unsigned pk4_fp8(float a, float b, float c, float d) {
    a = __builtin_amdgcn_fmed3f(a, -448.f, 448.f); b = __builtin_amdgcn_fmed3f(b, -448.f, 448.f); c = __builtin_amdgcn_fmed3f(c, -448.f, 448.f); d = __builtin_amdgcn_fmed3f(d, -448.f, 448.f);
    int r = 0; r = __builtin_amdgcn_cvt_pk_fp8_f32(a, b, r, false); r = __builtin_amdgcn_cvt_pk_fp8_f32(c, d, r, true); return (unsigned)r;
}
__device__ __forceinline__ void mfma_f8(f32x4& acc, const bf16x8& w0, const bf16x8& w1, const bf16x8& a0, const bf16x8& a1, int scale_w, int scale_a) {
    typedef int i32x8_ __attribute__((ext_vector_type(8))); typedef int i32x4_ __attribute__((ext_vector_type(4)));
    const i32x4_ p0 = __builtin_bit_cast(i32x4_, w0), p1 = __builtin_bit_cast(i32x4_, w1), q0 = __builtin_bit_cast(i32x4_, a0), q1 = __builtin_bit_cast(i32x4_, a1);
    const i32x8_ W = {p0[0], p0[1], p0[2], p0[3], p1[0], p1[1], p1[2], p1[3]}, A = {q0[0], q0[1], q0[2], q0[3], q1[0], q1[1], q1[2], q1[3]};
    asm volatile("v_mfma_scale_f32_16x16x128_f8f6f4 %0, %1, %2, %0, %3, %4 op_sel_hi:[0,0,0]" : "+v"(acc) : "v"(W), "v"(A), "v"(scale_w), "v"(scale_a));
}
template <class Epi, class Sched, bool ALIGN_EPI = false, bool SP2 = false, bool F8 = false, int SCALE_W = 0x7f7f7f7f>
__device__ __forceinline__ void gemm_phase(PG8_LAS unsigned char* lds, const Gemm g, const Sched& S, const Epi& E) {
    const int tid = otid(), wid = __builtin_amdgcn_readfirstlane(tid >> 6), lane = tid & 63, wr = wid >> 2, wc = wid & 3, fr = lane & 15, fq = lane >> 4;
    const int K = F8 ? g.K / 2 : g.K, nt = K / BK;
    unsigned voffA[2], voffB[2];
#pragma unroll
    for (int i = 0; i < 2; ++i) { int R, C; stage_rc(tid * 16 + i * 8192, R, C); const int Rb = Epi::PERM ? ((R & ~31) + perm32(R & 31)) : R;
        voffA[i] = (unsigned)(R * K + C) * 2u; voffB[i] = (unsigned)(Rb * K + C) * 2u; }
    const size_t kstep = (size_t)(BK * 2);
    const size_t hstep = (size_t)HALF * K * 2;
    const size_t tstep = 2 * hstep;
    const unsigned ldsw = (unsigned)wid * 1024u;
    const int aoff = lds_byte(wr * 64 + fr, F8 ? fq * 16 : fq * 8), boff = lds_byte(wc * 32 + fr, F8 ? fq * 16 : fq * 8);
    constexpr int KOFF = F8 ? 16 : 1024;
#define PG8_SA(b, h) (((b) * 2 + (h)) * HTB)
#define PG8_SB(b, h) ((4 + (b) * 2 + (h)) * HTB)
#define PG8_STAGE(bufoff, gbase, voff) do { _Pragma("unroll") for (int _i = 0; _i < 2; ++_i) \
        __builtin_amdgcn_global_load_lds((const unsigned*)((const char*)(gbase) + (voff)[_i]), (PG8_LAS unsigned*)(lds + (bufoff) + ldsw + _i * 8192), 16, 0, 0); } while (0)
#define PG8_LDA(dst, b, h) do { _Pragma("unroll") for (int m = 0; m < 4; ++m) _Pragma("unroll") for (int k = 0; k < 2; ++k) dst[m][k] = *(const PG8_LAS bf16x8*)(lds + PG8_SA(b, h) + aoff + m * 2048 + k * KOFF); } while (0)
#define PG8_LDB(dst, b, h) do { _Pragma("unroll") for (int n = 0; n < 2; ++n) _Pragma("unroll") for (int k = 0; k < 2; ++k) dst[n][k] = *(const PG8_LAS bf16x8*)(lds + PG8_SB(b, h) + boff + n * 2048 + k * KOFF); } while (0)
#define PG8_MMA(ai, bj, At, Bt) do { __builtin_amdgcn_s_setprio(1); _Pragma("unroll") for (int m = 0; m < 4; ++m) _Pragma("unroll") for (int n = 0; n < 2; ++n) { \
        if constexpr (F8) { mfma_f8(acc[ai][bj][m][n], Bt[n][0], Bt[n][1], At[m][0], At[m][1], SCALE_W, 0x7f7f7f7f); } \
        else { _Pragma("unroll") for (int k = 0; k < 2; ++k) acc[ai][bj][m][n] = __builtin_amdgcn_mfma_f32_16x16x32_bf16(Bt[n][k], At[m][k], acc[ai][bj][m][n], 0, 0, 0); } } \
        __builtin_amdgcn_s_setprio(0); } while (0)
#define PG8_WAIT_V(n) asm volatile("s_waitcnt vmcnt(" #n ")" ::: "memory")
#define PG8_WAIT_L(n) asm volatile("s_waitcnt lgkmcnt(" #n ")" ::: "memory")
#define PG8_BAR __builtin_amdgcn_s_barrier()
#define PG8_SCHED __builtin_amdgcn_sched_barrier(0)
    Unit cur, nxt; int ui = 0;
    if (!S.next(0, cur)) return;
    f32x4 acc[2][2][4][2];
#pragma unroll
    for (int a = 0; a < 2; ++a)
#pragma unroll
        for (int b = 0; b < 2; ++b)
#pragma unroll
            for (int m = 0; m < 4; ++m)
#pragma unroll
                for (int n = 0; n < 2; ++n) acc[a][b][m][n] = (f32x4){0.f, 0.f, 0.f, 0.f};
    bf16x8 At[4][2], B0[2][2], B1[2][2];
    const char* cA = (const char*)g.A + (size_t)cur.pm * tstep; const char* cB = (const char*)g.Bt + (size_t)cur.pn * tstep;
    S.a_ready(cur);
    if constexpr (SP2) {
        PG8_STAGE(PG8_SB(0, 0), cB, voffB); PG8_STAGE(PG8_SB(0, 1), cB + hstep, voffB); PG8_STAGE(PG8_SA(0, 0), cA, voffA); PG8_STAGE(PG8_SA(0, 1), cA + hstep, voffA);
        if (wr == 1) PG8_BAR;
        PG8_WAIT_V(2); PG8_BAR;
        PG8_STAGE(PG8_SB(1, 0), cB + kstep, voffB); PG8_STAGE(PG8_SA(1, 0), cA + kstep, voffA); PG8_STAGE(PG8_SB(1, 1), cB + hstep + kstep, voffB);
        PG8_WAIT_V(6); PG8_BAR;
    } else {
        PG8_STAGE(PG8_SB(0, 0), cB, voffB); PG8_STAGE(PG8_SA(0, 0), cA, voffA); PG8_STAGE(PG8_SB(0, 1), cB + hstep, voffB); PG8_STAGE(PG8_SA(0, 1), cA + hstep, voffA);
        if (wr == 1) PG8_BAR;
        PG8_WAIT_V(4); PG8_BAR;
        PG8_STAGE(PG8_SB(1, 0), cB + kstep, voffB); PG8_STAGE(PG8_SA(1, 0), cA + kstep, voffA); PG8_STAGE(PG8_SB(1, 1), cB + hstep + kstep, voffB);
        PG8_WAIT_V(6); PG8_BAR;
    }
    for (;;) {
        const bool has_next = S.next(ui + 1, nxt);
        const char* nA = has_next ? (const char*)g.A + (size_t)nxt.pm * tstep : cA; const char* nB = has_next ? (const char*)g.Bt + (size_t)nxt.pn * tstep : cB;
        for (int t = 0; t < nt; t += 2) {
            const bool last = (t == nt - 2);
            const char* a1 = cA + (size_t)(t + 1) * kstep;
            const char* a2 = last ? nA : cA + (size_t)(t + 2) * kstep; const char* b2 = last ? nB : cB + (size_t)(t + 2) * kstep;
            const char* a3 = a2 + kstep; const char* b3 = b2 + kstep;
            if (last && has_next) S.a_ready(nxt);
            if constexpr (SP2) {
            PG8_LDB(B0, 0, 0); PG8_LDB(B1, 0, 1); PG8_SCHED; PG8_LDA(At, 0, 0); PG8_STAGE(PG8_SA(1, 1), a1 + hstep, voffA);
            PG8_WAIT_V(8); PG8_WAIT_L(0); PG8_BAR; PG8_MMA(0, 0, At, B0); PG8_MMA(0, 1, At, B1); PG8_BAR; PG8_SCHED;
            PG8_LDA(At, 0, 1); PG8_STAGE(PG8_SB(0, 0), b2, voffB); PG8_STAGE(PG8_SB(0, 1), b2 + hstep, voffB); PG8_STAGE(PG8_SA(0, 0), a2, voffA);
            PG8_WAIT_V(8); PG8_WAIT_L(0); PG8_BAR; PG8_MMA(1, 0, At, B0); PG8_MMA(1, 1, At, B1); PG8_BAR; PG8_SCHED;
            PG8_LDB(B0, 1, 0); PG8_LDB(B1, 1, 1); PG8_SCHED; PG8_LDA(At, 1, 0); PG8_STAGE(PG8_SA(0, 1), a2 + hstep, voffA);
            PG8_WAIT_V(8); PG8_WAIT_L(0); PG8_BAR; PG8_MMA(0, 0, At, B0); PG8_MMA(0, 1, At, B1); PG8_BAR; PG8_SCHED;
            PG8_LDA(At, 1, 1); PG8_STAGE(PG8_SB(1, 0), b3, voffB); PG8_STAGE(PG8_SB(1, 1), b3 + hstep, voffB); PG8_STAGE(PG8_SA(1, 0), a3, voffA);
            PG8_WAIT_V(8); PG8_WAIT_L(0); PG8_BAR; PG8_MMA(1, 0, At, B0); PG8_MMA(1, 1, At, B1); PG8_BAR; PG8_SCHED;
            } else {
            PG8_LDB(B0, 0, 0); PG8_SCHED; PG8_LDA(At, 0, 0); PG8_STAGE(PG8_SA(1, 1), a1 + hstep, voffA);
            PG8_WAIT_L(8); PG8_BAR; PG8_WAIT_L(0); PG8_MMA(0, 0, At, B0); PG8_BAR; PG8_SCHED;
            PG8_LDB(B1, 0, 1); PG8_STAGE(PG8_SB(0, 0), b2, voffB);
            PG8_BAR; PG8_WAIT_L(0); PG8_MMA(0, 1, At, B1); PG8_BAR;
            PG8_LDA(At, 0, 1); PG8_STAGE(PG8_SA(0, 0), a2, voffA);
            PG8_BAR; PG8_WAIT_L(0); PG8_MMA(1, 0, At, B0); PG8_BAR; PG8_SCHED;
            PG8_STAGE(PG8_SB(0, 1), b2 + hstep, voffB);
            PG8_WAIT_V(6); PG8_BAR; PG8_MMA(1, 1, At, B1); PG8_BAR;
            PG8_LDB(B0, 1, 0); PG8_SCHED; PG8_LDA(At, 1, 0); PG8_STAGE(PG8_SA(0, 1), a2 + hstep, voffA);
            PG8_WAIT_L(8); PG8_BAR; PG8_WAIT_L(0); PG8_MMA(0, 0, At, B0); PG8_BAR; PG8_SCHED;
            PG8_LDB(B1, 1, 1); PG8_STAGE(PG8_SB(1, 0), b3, voffB);
            PG8_BAR; PG8_WAIT_L(0); PG8_MMA(0, 1, At, B1); PG8_BAR;
            PG8_LDA(At, 1, 1); PG8_STAGE(PG8_SA(1, 0), a3, voffA);
            PG8_BAR; PG8_WAIT_L(0); PG8_MMA(1, 0, At, B0); PG8_BAR; PG8_SCHED;
            PG8_STAGE(PG8_SB(1, 1), b3 + hstep, voffB);
            PG8_WAIT_V(6); PG8_BAR; PG8_MMA(1, 1, At, B1); PG8_BAR;
            }
        }
        if constexpr (ALIGN_EPI) { if (wr == 0) PG8_BAR; }
        if constexpr (F8) asm volatile("s_nop 15\n\ts_nop 15" ::: "memory");
        if constexpr (!Epi::AFTER_DRAIN) { E(acc, cur, wr, wc, fr, fq); S.done(cur); }
        if (!has_next) break;
#pragma unroll
        for (int a = 0; a < 2; ++a)
#pragma unroll
            for (int b = 0; b < 2; ++b)
#pragma unroll
                for (int m = 0; m < 4; ++m)
#pragma unroll
                    for (int n = 0; n < 2; ++n) acc[a][b][m][n] = (f32x4){0.f, 0.f, 0.f, 0.f};
        cur = nxt; cA = nA; cB = nB; ++ui;
        if constexpr (ALIGN_EPI) { if (wr == 1) PG8_BAR; }
    }
    PG8_WAIT_V(0);
    if constexpr (!ALIGN_EPI) { if (wr == 0) PG8_BAR; }
    PG8_BAR;
    if constexpr (Epi::AFTER_DRAIN) { E.fused(acc, cur, wr, wc, fr, fq, lds, wid, lane); S.done(cur); }
#undef PG8_SA
#undef PG8_SB
#undef PG8_STAGE
#undef PG8_LDA
#undef PG8_LDB
#undef PG8_MMA
#undef PG8_WAIT_V
#undef PG8_WAIT_L
#undef PG8_BAR
#undef PG8_SCHED
}
}

namespace pg8 {
struct EpiStoreBf16 {
    static constexpr bool PERM = true, AFTER_DRAIN = false;
    bf16_t* O; int ldc, pad;
    __device__ __forceinline__ void operator()(const f32x4 (&acc)[2][2][4][2], const Unit& u, int wr, int wc, int fr, int fq) const {
        const int row0 = u.pm * BM + wr * 64 + fr, col0 = u.pn * BM + wc * 32 + 8 * fq;
#pragma unroll
        for (int ai = 0; ai < 2; ++ai)
#pragma unroll
            for (int m = 0; m < 4; ++m) { bf16_t* rowp = O + (size_t)(row0 + ai * HALF + m * 16) * ldc + col0;
#pragma unroll
                for (int bj = 0; bj < 2; ++bj) { const f32x4 v0 = acc[ai][bj][m][0], v1 = acc[ai][bj][m][1];
                    u32x4 w; w.x = cvt_pk_bf16(v0[0], v0[1]); w.y = cvt_pk_bf16(v0[2], v0[3]); w.z = cvt_pk_bf16(v1[0], v1[1]); w.w = cvt_pk_bf16(v1[2], v1[3]);
                    *(u32x4*)(rowp + bj * HALF) = w; } }
    }
};
struct EpiResF32 {
    static constexpr bool PERM = false, AFTER_DRAIN = false;
    const float* base; float* out; int ldc, pad;
    __device__ __forceinline__ void operator()(const f32x4 (&acc)[2][2][4][2], const Unit& u, int wr, int wc, int fr, int fq) const {
        const int row0 = u.pm * BM + wr * 64 + fr, col0 = u.pn * BM + wc * 32 + 4 * fq;
#pragma unroll
        for (int ai = 0; ai < 2; ++ai)
#pragma unroll
            for (int m = 0; m < 4; ++m) { const size_t off = (size_t)(row0 + ai * HALF + m * 16) * ldc + col0;
#pragma unroll
                for (int bj = 0; bj < 2; ++bj)
#pragma unroll
                    for (int n = 0; n < 2; ++n) { const f32x4 b = *(const f32x4*)(base + off + bj * HALF + n * 16); *(f32x4*)(out + off + bj * HALF + n * 16) = b + acc[ai][bj][m][n]; } }
    }
};
struct EpiSwiGLU {
    static constexpr bool PERM = true, AFTER_DRAIN = false;
    bf16_t* O; int ldc, pad;
    __device__ __forceinline__ void operator()(const f32x4 (&acc)[2][2][4][2], const Unit& u, int wr, int wc, int fr, int fq) const {
        const int row0 = u.pm * BM + wr * 64 + fr, col0 = u.pn * HALF + wc * 32 + 8 * fq;
#pragma unroll
        for (int ai = 0; ai < 2; ++ai)
#pragma unroll
            for (int m = 0; m < 4; ++m) { bf16_t* rowp = O + (size_t)(row0 + ai * HALF + m * 16) * ldc + col0;
                float r[8];
#pragma unroll
                for (int n = 0; n < 2; ++n)
#pragma unroll
                    for (int e = 0; e < 4; ++e) { const float g = acc[ai][0][m][n][e], up = acc[ai][1][m][n][e]; r[n * 4 + e] = g * up / (1.0f + __expf(-g)); }
                u32x4 w; w.x = cvt_pk_bf16(r[0], r[1]); w.y = cvt_pk_bf16(r[2], r[3]); w.z = cvt_pk_bf16(r[4], r[5]); w.w = cvt_pk_bf16(r[6], r[7]);
                *(u32x4*)rowp = w; }
    }
};
}

namespace pg8 {
struct EpiInProj {
    static constexpr bool PERM = true, AFTER_DRAIN = false;
    bf16_t* O; const float* cs; float* kmean;
    __device__ __forceinline__ void operator()(const f32x4 (&acc)[2][2][4][2], const Unit& u, int wr, int wc, int fr, int fq) const {
        const int row0 = u.pm * BM + wr * 64 + fr;
        if (u.pn >= 8) {
            const int col0 = u.pn * BM + wc * 32 + 8 * fq;
#pragma unroll
            for (int ai = 0; ai < 2; ++ai)
#pragma unroll
                for (int m = 0; m < 4; ++m) { bf16_t* rowp = O + (size_t)(row0 + ai * HALF + m * 16) * 6144 + col0;
#pragma unroll
                    for (int bj = 0; bj < 2; ++bj) { const f32x4 v0 = acc[ai][bj][m][0], v1 = acc[ai][bj][m][1];
                        u32x4 w; w.x = cvt_pk_bf16(v0[0], v0[1]); w.y = cvt_pk_bf16(v0[2], v0[3]); w.z = cvt_pk_bf16(v1[0], v1[1]); w.w = cvt_pk_bf16(v1[2], v1[3]);
                        *(u32x4*)(rowp + bj * HALF) = w; } }
        } else {
            const int sec = u.pn >> 2, head = 2 * (u.pn & 3) + (wc >> 1), d0 = (wc & 1) * 32 + 8 * fq;
            bf16_t* obase = O + sec * 1024 + head * 128 + d0;
            float csum[16];
#pragma unroll
            for (int i = 0; i < 16; ++i) csum[i] = 0.f;
#pragma unroll
            for (int ai = 0; ai < 2; ++ai)
#pragma unroll
                for (int m = 0; m < 4; ++m) { const int row = row0 + ai * HALF + m * 16;
                    const f32x4* cp = (const f32x4*)(cs + ((size_t)row * 64 + d0) * 2);
                    float ol[8], oh[8];
#pragma unroll
                    for (int n = 0; n < 2; ++n) { const f32x4 t0 = cp[2 * n], t1 = cp[2 * n + 1]; const f32x4 lo = acc[ai][0][m][n], hi = acc[ai][1][m][n];
                        ol[4 * n + 0] = lo[0] * t0[0] - hi[0] * t0[1]; oh[4 * n + 0] = hi[0] * t0[0] + lo[0] * t0[1];
                        ol[4 * n + 1] = lo[1] * t0[2] - hi[1] * t0[3]; oh[4 * n + 1] = hi[1] * t0[2] + lo[1] * t0[3];
                        ol[4 * n + 2] = lo[2] * t1[0] - hi[2] * t1[1]; oh[4 * n + 2] = hi[2] * t1[0] + lo[2] * t1[1];
                        ol[4 * n + 3] = lo[3] * t1[2] - hi[3] * t1[3]; oh[4 * n + 3] = hi[3] * t1[2] + lo[3] * t1[3]; }
                    u32x4 w; w.x = cvt_pk_bf16(ol[0], ol[1]); w.y = cvt_pk_bf16(ol[2], ol[3]); w.z = cvt_pk_bf16(ol[4], ol[5]); w.w = cvt_pk_bf16(ol[6], ol[7]);
                    *(u32x4*)(obase + (size_t)row * 6144) = w;
                    w.x = cvt_pk_bf16(oh[0], oh[1]); w.y = cvt_pk_bf16(oh[2], oh[3]); w.z = cvt_pk_bf16(oh[4], oh[5]); w.w = cvt_pk_bf16(oh[6], oh[7]);
                    *(u32x4*)(obase + (size_t)row * 6144 + 64) = w;
                    if (sec == 1) {
#pragma unroll
                        for (int i = 0; i < 8; ++i) { csum[i] += ol[i]; csum[8 + i] += oh[i]; } } }
            if (sec == 1) {
                float* km = kmean + (size_t)(((u.pm >> 4) * 8 + head) * 16 + (u.pm & 15)) * 128 + d0;
#pragma unroll
                for (int i = 0; i < 16; ++i) { float v = csum[i]; v += __shfl_xor(v, 1); v += __shfl_xor(v, 2); v += __shfl_xor(v, 4); v += __shfl_xor(v, 8);
                    if (fr == 0) atomicAdd(km + (i & 7) + (i >> 3) * 64, v * (1.f / 256.f)); }
            }
        }
    }
};
__device__ __forceinline__ float row_rinv(const float* ss, int row, int fq) {
    const f32x4* p = (const f32x4*)(ss + (size_t)row * 32 + fq * 8); const f32x4 a = p[0], b = p[1];
    float s = ((a[0] + a[1]) + (a[2] + a[3])) + ((b[0] + b[1]) + (b[2] + b[3]));
    s += __shfl_xor(s, 16); s += __shfl_xor(s, 32);
    return rsqrtf(s * (1.f / 2048.f) + 1e-6f);
}
template <int COPY> struct EpiResNorm {
    static constexpr bool PERM = true, AFTER_DRAIN = false;
    const float* base; float* out; bf16_t* xb; float* ss;
    __device__ __forceinline__ void operator()(const f32x4 (&acc)[2][2][4][2], const Unit& u, int wr, int wc, int fr, int fq) const {
        const int row0 = u.pm * BM + wr * 64 + fr, col0 = u.pn * BM + wc * 32 + 8 * fq;
#pragma unroll
        for (int ai = 0; ai < 2; ++ai)
#pragma unroll
            for (int m = 0; m < 4; ++m) { const int row = row0 + ai * HALF + m * 16; const size_t off = (size_t)row * 2048 + col0; float s = 0.f;
#pragma unroll
                for (int bj = 0; bj < 2; ++bj) { const f32x4 v0 = *(const f32x4*)(base + off + bj * HALF) + acc[ai][bj][m][0], v1 = *(const f32x4*)(base + off + bj * HALF + 4) + acc[ai][bj][m][1];
                    *(f32x4*)(out + off + bj * HALF) = v0; *(f32x4*)(out + off + bj * HALF + 4) = v1;
                    s += ((v0[0] * v0[0] + v0[1] * v0[1]) + (v0[2] * v0[2] + v0[3] * v0[3])) + ((v1[0] * v1[0] + v1[1] * v1[1]) + (v1[2] * v1[2] + v1[3] * v1[3]));
                    if (COPY == 1) { u32x4 w; w.x = cvt_pk_bf16(v0[0], v0[1]); w.y = cvt_pk_bf16(v0[2], v0[3]); w.z = cvt_pk_bf16(v1[0], v1[1]); w.w = cvt_pk_bf16(v1[2], v1[3]);
                        *(u32x4*)(xb + off + bj * HALF) = w; }
                    if (COPY == 2) { typedef unsigned u32x2_ __attribute__((ext_vector_type(2))); u32x2_ w; w.x = pk4_fp8(v0[0], v0[1], v0[2], v0[3]); w.y = pk4_fp8(v1[0], v1[1], v1[2], v1[3]);
                        *(u32x2_*)((unsigned char*)xb + off + bj * HALF) = w; } }
                s += __shfl_xor(s, 16); s += __shfl_xor(s, 32);
                if (fq == 0) ss[(size_t)row * 32 + u.pn * 4 + wc] = s; }
    }
};
struct EpiRowScaleBf16 {
    static constexpr bool PERM = true, AFTER_DRAIN = false;
    bf16_t* O; const float* ss; int ldc, pad;
    __device__ __forceinline__ void operator()(const f32x4 (&acc)[2][2][4][2], const Unit& u, int wr, int wc, int fr, int fq) const {
        const int row0 = u.pm * BM + wr * 64 + fr, col0 = u.pn * BM + wc * 32 + 8 * fq;
#pragma unroll
        for (int ai = 0; ai < 2; ++ai)
#pragma unroll
            for (int m = 0; m < 4; ++m) { const int row = row0 + ai * HALF + m * 16; const float ri = row_rinv(ss, row, fq); bf16_t* rowp = O + (size_t)row * ldc + col0;
#pragma unroll
                for (int bj = 0; bj < 2; ++bj) { const f32x4 v0 = acc[ai][bj][m][0] * ri, v1 = acc[ai][bj][m][1] * ri;
                    u32x4 w; w.x = cvt_pk_bf16(v0[0], v0[1]); w.y = cvt_pk_bf16(v0[2], v0[3]); w.z = cvt_pk_bf16(v1[0], v1[1]); w.w = cvt_pk_bf16(v1[2], v1[3]);
                    *(u32x4*)(rowp + bj * HALF) = w; } }
    }
};
template <bool F8OUT> struct EpiSwiGLUNorm {
    static constexpr bool PERM = true, AFTER_DRAIN = false;
    bf16_t* O; const float* ss; int ldc, pad;
    __device__ __forceinline__ void operator()(const f32x4 (&acc)[2][2][4][2], const Unit& u, int wr, int wc, int fr, int fq) const {
        const int row0 = u.pm * BM + wr * 64 + fr, col0 = u.pn * HALF + wc * 32 + 8 * fq;
#pragma unroll
        for (int ai = 0; ai < 2; ++ai)
#pragma unroll
            for (int m = 0; m < 4; ++m) { const int row = row0 + ai * HALF + m * 16; const float ri = row_rinv(ss, row, fq); bf16_t* rowp = O + (size_t)row * ldc + col0;
                float r[8];
#pragma unroll
                for (int n = 0; n < 2; ++n)
#pragma unroll
                    for (int e = 0; e < 4; ++e) { const float g = acc[ai][0][m][n][e] * ri, up = acc[ai][1][m][n][e] * ri; r[n * 4 + e] = g * up / (1.0f + __expf(-g)); }
                if (F8OUT) { typedef unsigned u32x2_ __attribute__((ext_vector_type(2))); u32x2_ w; w.x = pk4_fp8(r[0], r[1], r[2], r[3]); w.y = pk4_fp8(r[4], r[5], r[6], r[7]);
                    *(u32x2_*)((unsigned char*)O + (size_t)row * ldc + col0) = w; }
                else { u32x4 w; w.x = cvt_pk_bf16(r[0], r[1]); w.y = cvt_pk_bf16(r[2], r[3]); w.z = cvt_pk_bf16(r[4], r[5]); w.w = cvt_pk_bf16(r[6], r[7]);
                    *(u32x4*)rowp = w; } }
    }
};
}
typedef unsigned short bf16_t;
constexpr int DM = 2048, NB = 4, SEQ = 4096, MT = NB * SEQ;
constexpr int HD = 128, NH = 8, AW = 1024, CW = 1024, NPROJ = 6144;
constexpr int NBLK = 16, MBLK = 256;
constexpr int NMEM = 256, XH = 4, XW = 512, DFF = 5632;
constexpr float EPS = 1e-6f;
constexpr float SM_SCALE = 0.088388347648318440f;
constexpr size_t MiB = 1u << 20;
constexpr size_t WS_WIN = 0;
constexpr size_t WS_WOUT = 24 * MiB;
constexpr size_t WS_WXQ = 32 * MiB;
constexpr size_t WS_WXKV = 34 * MiB;
constexpr size_t WS_WXO = 38 * MiB;
constexpr size_t WS_WGU = 40 * MiB;
constexpr size_t WS_WDN = 84 * MiB;
constexpr size_t WS_H = 112 * MiB;
constexpr size_t WS_MRG = 176 * MiB;
constexpr size_t WS_PROJ = 240 * MiB;
constexpr size_t WS_ACT = 240 * MiB;
constexpr size_t WS_QX = 432 * MiB;
constexpr size_t WS_OX = 448 * MiB;
constexpr size_t WS_KVX = 464 * MiB;
constexpr size_t WS_MEMN = 466 * MiB;
constexpr size_t WS_CS = 470 * MiB;
constexpr size_t WS_KMEAN = 478 * MiB;
constexpr size_t WS_SS = 479 * MiB;
constexpr size_t WS_END = 485 * MiB;

__device__ __forceinline__ float bf2f(unsigned v) { return __uint_as_float(v << 16); }
__device__ __forceinline__ unsigned f2bf(float f) { unsigned u = __float_as_uint(f); return (u + 0x7fffu + ((u >> 16) & 1u)) >> 16; }
__device__ __forceinline__ unsigned pk2(float lo, float hi) { return f2bf(lo) | (f2bf(hi) << 16); }
__device__ __forceinline__ float wave_sum(float v) {
#pragma unroll
    for (int o = 1; o < 64; o <<= 1) v += __shfl_xor(v, o);
    return v;
}
__device__ __forceinline__ float wave_max(float v) {
#pragma unroll
    for (int o = 1; o < 64; o <<= 1) v = fmaxf(v, __shfl_xor(v, o));
    return v;
}
typedef float f32x4 __attribute__((ext_vector_type(4)));
typedef unsigned u32x4 __attribute__((ext_vector_type(4)));
typedef unsigned u32x2 __attribute__((ext_vector_type(2)));

struct TJob { const float* src0; const float* src1; const float* gain; bf16_t* dst; int K, Nsrc, nrows, mode; float wscale; int f8; };
__device__ __forceinline__ void transpose_item(const TJob& J, float* scr, int item, int lane) {
    const int nblk = J.nrows / 32, kb = item / nblk, nb = item % nblk, k0 = 64 * kb, n0 = 32 * nb;
    const float* src = J.src0; int c0 = n0;
    if (J.mode == 1 && n0 < 2048) { const int tile = n0 >> 8, c = n0 & 255, cc = c & 127; c0 = (tile >> 2) * 1024 + (2 * (tile & 3) + (cc >> 6)) * 128 + (cc & 63) + ((c >> 7) ? 64 : 0); }
    if (J.mode == 2) { const int tile = n0 >> 8, w = n0 & 255; if (w < 128) { c0 = tile * 128 + w; } else { src = J.src1; c0 = tile * 128 + w - 128; } }
#pragma unroll 8
    for (int i = 0; i < 32; ++i) { const int kk = 2 * i + (lane >> 5); float v = src[(size_t)(k0 + kk) * J.Nsrc + c0 + (lane & 31)]; if (J.gain) v *= J.gain[k0 + kk]; scr[kk * 33 + (lane & 31)] = v * J.wscale; }
    asm volatile("s_waitcnt lgkmcnt(0)" ::: "memory");
    const int c = lane & 7;
#pragma unroll
    for (int j = 0; j < 4; ++j) { const int n = (lane >> 3) + 8 * j; const float* s = scr + (8 * c) * 33 + n;
        if (J.f8) { u32x2 o; o.x = pg8::pk4_fp8(s[0 * 33], s[1 * 33], s[2 * 33], s[3 * 33]); o.y = pg8::pk4_fp8(s[4 * 33], s[5 * 33], s[6 * 33], s[7 * 33]);
            *(u32x2*)((unsigned char*)J.dst + (size_t)(n0 + n) * J.K + k0 + 8 * c) = o; }
        else { u32x4 o; o.x = pk2(s[0 * 33], s[1 * 33]); o.y = pk2(s[2 * 33], s[3 * 33]); o.z = pk2(s[4 * 33], s[5 * 33]); o.w = pk2(s[6 * 33], s[7 * 33]);
            *(u32x4*)(J.dst + (size_t)(n0 + n) * J.K + k0 + 8 * c) = o; } }
    asm volatile("s_waitcnt lgkmcnt(0)" ::: "memory");
}
__device__ __forceinline__ int ph_transpose_job(const TJob J, int base, float* scr, int gw, int NGW, int lane) {
    const int nitems = (J.K / 64) * (J.nrows / 32);
    const int first = (gw - base % NGW + NGW) % NGW;
    for (int it = first; it < nitems; it += NGW) transpose_item(J, scr, it, lane);
    return base + nitems;
}

__device__ __forceinline__ void rms_row_bf16(const float* xrow, const float* g, bf16_t* orow, int lane) {
    const f32x4* xr = (const f32x4*)xrow + lane; const f32x4* gr = (const f32x4*)g + lane;
    f32x4 v[8]; float s = 0.f;
#pragma unroll
    for (int j = 0; j < 8; ++j) { v[j] = xr[64 * j]; s += (v[j].x * v[j].x + v[j].y * v[j].y) + (v[j].z * v[j].z + v[j].w * v[j].w); }
    const float rinv = rsqrtf(wave_sum(s) * (1.f / DM) + EPS);
    u32x2* o8 = (u32x2*)orow + lane;
#pragma unroll
    for (int j = 0; j < 8; ++j) { const f32x4 gg = gr[64 * j]; u32x2 w; w.x = pk2(v[j].x * rinv * gg.x, v[j].y * rinv * gg.y); w.y = pk2(v[j].z * rinv * gg.z, v[j].w * rinv * gg.w); o8[64 * j] = w; }
}
__device__ __forceinline__ void ph_rms_bf16(const float* X, const float* g, bf16_t* O, int rows, int gw, int NGW, int lane) {
    for (int r = gw; r < rows; r += NGW) rms_row_bf16(X + (size_t)r * DM, g, O + (size_t)r * DM, lane);
}
__device__ __forceinline__ void ph_final_norm(float* X, const float* g, const float* ss, int rows, int gw, int NGW, int lane) {
    for (int r = gw; r < rows; r += NGW) {
        f32x4* xr = (f32x4*)(X + (size_t)r * DM) + lane; const f32x4* gr = (const f32x4*)g + lane;
        const float part = (lane < 32) ? ss[(size_t)r * 32 + lane] : 0.f;
        const float rinv = rsqrtf(wave_sum(part) * (1.f / DM) + EPS);
#pragma unroll
        for (int j = 0; j < 8; ++j) xr[64 * j] = xr[64 * j] * rinv * gr[64 * j];
    }
}

__device__ __forceinline__ void sincos_small(double r, double& s, double& c) {
    const double r2 = r * r;
    double a = -1.0 / 10888869450418352160768000000.0;
    a = a * r2 + 1.0 / 15511210043330985984000000.0;
    a = a * r2 - 1.0 / 25852016738884976640000.0;
    a = a * r2 + 1.0 / 51090942171709440000.0;
    a = a * r2 - 1.0 / 121645100408832000.0;
    a = a * r2 + 1.0 / 355687428096000.0;
    a = a * r2 - 1.0 / 1307674368000.0;
    a = a * r2 + 1.0 / 6227020800.0;
    a = a * r2 - 1.0 / 39916800.0;
    a = a * r2 + 1.0 / 362880.0;
    a = a * r2 - 1.0 / 5040.0;
    a = a * r2 + 1.0 / 120.0;
    a = a * r2 - 1.0 / 6.0;
    a = a * r2 + 1.0;
    s = a * r;
    double b = 1.0 / 403291461126605635584000000.0;
    b = b * r2 - 1.0 / 620448401733239439360000.0;
    b = b * r2 + 1.0 / 1124000727777607680000.0;
    b = b * r2 - 1.0 / 2432902008176640000.0;
    b = b * r2 + 1.0 / 6402373705728000.0;
    b = b * r2 - 1.0 / 20922789888000.0;
    b = b * r2 + 1.0 / 87178291200.0;
    b = b * r2 - 1.0 / 479001600.0;
    b = b * r2 + 1.0 / 3628800.0;
    b = b * r2 - 1.0 / 40320.0;
    b = b * r2 + 1.0 / 720.0;
    b = b * r2 - 1.0 / 24.0;
    b = b * r2 + 1.0 / 2.0;
    c = 1.0 - b * r2;
}
__device__ __forceinline__ void cs_entry(const int* pos, float* cs, int idx) {
    const int t = idx >> 6, f = idx & 63;
    double p = 1.0, bs = 0.8659643233600653;
#pragma unroll
    for (int bit = 0; bit < 6; ++bit) { if ((f >> bit) & 1) p *= bs; bs *= bs; }
    const double ang = (double)pos[t] * p;
    const double TWO_PI = 6.283185307179586;
    const double n = rint(ang / TWO_PI);
    const double r = fma(-n, TWO_PI, ang);
    double s, c; sincos_small(r, s, c);
    cs[2 * idx] = (float)c; cs[2 * idx + 1] = (float)s;
}
__device__ __forceinline__ void ph_cs(const int* pos, float* cs, int gtid, int NT) {
    for (int idx = gtid; idx < MT * 64; idx += NT) cs_entry(pos, cs, idx);
}
__device__ __forceinline__ void ph_rope_naive(bf16_t* proj, const float* cs, int gtid, int NT) {
    const long total = (long)MT * 2 * NH * 64;
    for (long i = gtid; i < total; i += NT) {
        const int d = (int)(i & 63), h = (int)((i >> 6) & 7), sec = (int)((i >> 9) & 1); const long t = i >> 10;
        bf16_t* p = proj + t * NPROJ + sec * 1024 + h * HD + d;
        const float a = bf2f(p[0]), b = bf2f(p[64]); const float c = cs[(t * 64 + d) * 2], s = cs[(t * 64 + d) * 2 + 1];
        p[0] = (bf16_t)f2bf(a * c - b * s); p[64] = (bf16_t)f2bf(b * c + a * s);
    }
}
__device__ __forceinline__ void ph_kmean_naive(const bf16_t* proj, float* kmean, int gtid, int NT) {
    for (int i = gtid; i < NB * NH * NBLK * HD; i += NT) {
        const int d = i & 127, blkid = i >> 7;
        const int blk = blkid & 15, h = (blkid >> 4) & 7, b = blkid >> 7;
        float s = 0.f;
        for (int j = 0; j < MBLK; ++j) s += bf2f(proj[(size_t)(b * SEQ + blk * MBLK + j) * NPROJ + 1024 + h * HD + d]);
        kmean[(size_t)blkid * HD + d] = s * (1.f / MBLK);
    }
}
__device__ __forceinline__ float dot_q_row(const float* sq, const bf16_t* krow) {
    float a = 0.f;
#pragma unroll
    for (int d = 0; d < 128; d += 8) { const u32x4 kk = *(const u32x4*)(krow + d);
        a += sq[d + 0] * bf2f(kk.x & 0xffffu) + sq[d + 1] * bf2f(kk.x >> 16) + sq[d + 2] * bf2f(kk.y & 0xffffu) + sq[d + 3] * bf2f(kk.y >> 16)
           + sq[d + 4] * bf2f(kk.z & 0xffffu) + sq[d + 5] * bf2f(kk.z >> 16) + sq[d + 6] * bf2f(kk.w & 0xffffu) + sq[d + 7] * bf2f(kk.w >> 16); }
    return a;
}
__device__ __forceinline__ void ph_moba_naive(const bf16_t* proj, const float* kmean, const float* g_attn, bf16_t* merged, float qscale_inv, float* scr, int gw, int NGW, int lane) {
    float* sq = scr; float* sp = scr + 128;
    for (int item = gw; item < MT * NH; item += NGW) {
        const int t = item >> 3, h = item & 7, b = t >> 12, ts = t & 4095, qb = ts >> 8, tq = ts & 255;
        const bf16_t* qrow = proj + (size_t)t * NPROJ + h * HD;
        const unsigned qq = *(const unsigned*)(qrow + 2 * lane);
        const float q0 = bf2f(qq & 0xffffu) * qscale_inv, q1 = bf2f(qq >> 16) * qscale_inv;
        asm volatile("s_waitcnt lgkmcnt(0)" ::: "memory");
        sq[2 * lane] = q0; sq[2 * lane + 1] = q1;
        float g[16];
#pragma unroll
        for (int i = 0; i < 16; ++i) { const float* km = kmean + (size_t)((b * 8 + h) * 16 + i) * HD; const float p = wave_sum(q0 * km[2 * lane] + q1 * km[2 * lane + 1]); g[i] = (i < qb) ? p : -INFINITY; }
        int sel[4];
#pragma unroll
        for (int r = 0; r < 3; ++r) { float best = -INFINITY; int bi = -1;
#pragma unroll
            for (int i = 0; i < 16; ++i) if (g[i] > best) { best = g[i]; bi = i; }
            sel[r] = bi;
#pragma unroll
            for (int i = 0; i < 16; ++i) if (i == bi) g[i] = -INFINITY; }
        sel[3] = qb;
        asm volatile("s_waitcnt lgkmcnt(0)" ::: "memory");
#pragma unroll
        for (int s = 0; s < 4; ++s) { const int blk = sel[s];
            for (int jj = 0; jj < 4; ++jj) { const int j = jj * 64 + lane; float sc = -INFINITY;
                if (blk >= 0 && (s < 3 || j <= tq)) sc = dot_q_row(sq, proj + (size_t)(b * SEQ + blk * MBLK + j) * NPROJ + 1024 + h * HD) * SM_SCALE;
                sp[s * 256 + j] = sc; } }
        asm volatile("s_waitcnt lgkmcnt(0)" ::: "memory");
        float m = -INFINITY; for (int i = lane; i < 1024; i += 64) m = fmaxf(m, sp[i]); m = wave_max(m);
        float l = 0.f; for (int i = lane; i < 1024; i += 64) { const float p = __expf(sp[i] - m); sp[i] = p; l += p; } l = wave_sum(l);
        asm volatile("s_waitcnt lgkmcnt(0)" ::: "memory");
        float o0 = 0.f, o1 = 0.f;
#pragma unroll
        for (int s = 0; s < 4; ++s) { const int blk = sel[s]; if (blk < 0) continue;
            const bf16_t* vb = proj + (size_t)(b * SEQ + blk * MBLK) * NPROJ + 2048 + h * HD + 2 * lane;
            for (int j = 0; j < 256; ++j) { const float p = sp[s * 256 + j]; const unsigned vv = *(const unsigned*)(vb + (size_t)j * NPROJ); o0 += p * bf2f(vv & 0xffffu); o1 += p * bf2f(vv >> 16); } }
        const float li = 1.f / l; o0 *= li; o1 *= li;
        const float rinv = rsqrtf(wave_sum(o0 * o0 + o1 * o1) * (1.f / HD) + EPS);
        *(unsigned*)(merged + (size_t)t * DM + h * HD + 2 * lane) = pk2(o0 * rinv * g_attn[h * HD + 2 * lane], o1 * rinv * g_attn[h * HD + 2 * lane + 1]);
    }
}
__device__ __forceinline__ void ph_conv_naive(const bf16_t* proj, const float* w_conv, const float* b_conv, const float* g_conv, bf16_t* merged, int gw, int NGW, int lane) {
    for (int item = gw; item < MT * 8; item += NGW) {
        const int t = item >> 3, grp = item & 7, ts = t & 4095; const int c = grp * 128 + 2 * lane;
        float y[2];
#pragma unroll
        for (int e = 0; e < 2; ++e) { float acc = b_conv[c + e];
#pragma unroll
            for (int k = 0; k < 3; ++k) { const int back = 2 - k; if (ts - back >= 0) { const bf16_t* r = proj + (size_t)(t - back) * NPROJ; acc += w_conv[k * CW + c + e] * (bf2f(r[3072 + c + e]) * bf2f(r[5120 + c + e])); } }
            y[e] = bf2f(proj[(size_t)t * NPROJ + 4096 + c + e]) * acc; }
        const float rinv = rsqrtf(wave_sum(y[0] * y[0] + y[1] * y[1]) * (1.f / HD) + EPS);
        *(unsigned*)(merged + (size_t)t * DM + AW + c) = pk2(y[0] * rinv * g_conv[c], y[1] * rinv * g_conv[c + 1]);
    }
}
__device__ __forceinline__ void ph_xattn_naive(const bf16_t* qx, const bf16_t* kvx, bf16_t* ox, float qscale_inv, float* scr, int gw, int NGW, int lane) {
    float* sq = scr; float* sp = scr + 128;
    for (int item = gw; item < MT * XH; item += NGW) {
        const int t = item >> 2, h = item & 3, b = t >> 12;
        const unsigned qq = *(const unsigned*)(qx + (size_t)t * XW + h * HD + 2 * lane);
        asm volatile("s_waitcnt lgkmcnt(0)" ::: "memory");
        sq[2 * lane] = bf2f(qq & 0xffffu) * qscale_inv; sq[2 * lane + 1] = bf2f(qq >> 16) * qscale_inv;
        asm volatile("s_waitcnt lgkmcnt(0)" ::: "memory");
        float m = -INFINITY;
        for (int jj = 0; jj < 4; ++jj) { const int j = jj * 64 + lane; const float sc = dot_q_row(sq, kvx + (size_t)(b * NMEM + j) * 1024 + h * HD) * SM_SCALE; sp[j] = sc; m = fmaxf(m, sc); }
        m = wave_max(m);
        asm volatile("s_waitcnt lgkmcnt(0)" ::: "memory");
        float l = 0.f; for (int i = lane; i < 256; i += 64) { const float p = __expf(sp[i] - m); sp[i] = p; l += p; } l = wave_sum(l);
        asm volatile("s_waitcnt lgkmcnt(0)" ::: "memory");
        float o0 = 0.f, o1 = 0.f; const bf16_t* vb = kvx + (size_t)(b * NMEM) * 1024 + 512 + h * HD + 2 * lane;
        for (int j = 0; j < 256; ++j) { const float p = sp[j]; const unsigned vv = *(const unsigned*)(vb + (size_t)j * 1024); o0 += p * bf2f(vv & 0xffffu); o1 += p * bf2f(vv >> 16); }
        const float li = 1.f / l;
        *(unsigned*)(ox + (size_t)t * XW + h * HD + 2 * lane) = pk2(o0 * li, o1 * li);
    }
}

namespace moba {
using bf16x8 = __attribute__((ext_vector_type(8))) short;
using s16x4  = __attribute__((ext_vector_type(4))) short;
using f32x16 = __attribute__((ext_vector_type(16))) float;
using u32x4v = __attribute__((ext_vector_type(4))) unsigned;
using f32x4v = __attribute__((ext_vector_type(4))) float;
constexpr int D = 128, NW = 8, QBLK = 32, KVBLK = 64;
constexpr float SCALE = 0.088388347648318440f, THR = 8.f;
constexpr int SHM_V = KVBLK * D * 2, SHM_K = KVBLK * D * 2;
constexpr int OFF_V = 0, OFF_K = 2 * SHM_V, OFF_WS = OFF_K + 2 * SHM_K, OFF_KM = OFF_WS + NW * 256, OFF_RS = OFF_KM + 16 * 128 * 4, RS_BYTES = (32 * 33 + 32) * 4, LDS_END = OFF_RS + NW * RS_BYTES;
static_assert(LDS_END <= 131072, "moba LDS");
#define KSWZ(row, colB) ((row) * 256 + ((colB) ^ (((row) & 7) << 4)))
#define SBAR() __builtin_amdgcn_sched_barrier(0)
__device__ __forceinline__ int crow(int r, int hi) { return (r & 3) + 8 * (r >> 2) + 4 * hi; }
__device__ __forceinline__ unsigned cvtpk(float lo, float hi) { unsigned r; asm volatile("v_cvt_pk_bf16_f32 %0, %1, %2" : "=v"(r) : "v"(lo), "v"(hi)); return r; }
__device__ __forceinline__ void partialSM(f32x16& p0, f32x16& p1, float& m_reg, float& mn, float& alpha) {
  constexpr float C = SCALE * 1.4426950408889634f;
  float pmax = p0[0];
#pragma unroll
  for (int r = 1; r < 16; ++r) pmax = fmaxf(pmax, p0[r]);
#pragma unroll
  for (int r = 0; r < 16; ++r) pmax = fmaxf(pmax, p1[r]);
  { auto rr = __builtin_amdgcn_permlane32_swap(__float_as_uint(pmax), __float_as_uint(pmax), false, false);
    pmax = fmaxf(__uint_as_float(rr[0]), __uint_as_float(rr[1])); }
  if (__builtin_expect(__all(pmax - m_reg <= THR / SCALE), 1)) { mn = m_reg; alpha = 1.f; }
  else { mn = fmaxf(m_reg, pmax); alpha = __builtin_amdgcn_exp2f((m_reg - mn) * C); m_reg = mn; }
  float mnC = -mn * C;
#pragma unroll
  for (int r = 0; r < 16; ++r) p0[r] = fmaf(p0[r], C, mnC);
#pragma unroll
  for (int r = 0; r < 16; ++r) p1[r] = fmaf(p1[r], C, mnC);
#pragma unroll
  for (int r = 0; r < 16; ++r) p0[r] = __builtin_amdgcn_exp2f(p0[r]);
}
__device__ __forceinline__ void finishSM(f32x16& p0, f32x16& p1, float alpha, float& l_reg, bf16x8& pa0, bf16x8& pa1, bf16x8& pa2, bf16x8& pa3) {
#pragma unroll
  for (int r = 0; r < 16; ++r) p1[r] = __builtin_amdgcn_exp2f(p1[r]);
  float ps = 0;
#pragma unroll
  for (int r = 0; r < 16; ++r) ps += p0[r];
#pragma unroll
  for (int r = 0; r < 16; ++r) ps += p1[r];
  { auto rr = __builtin_amdgcn_permlane32_swap(__float_as_uint(ps), __float_as_uint(ps), false, false);
    ps = __uint_as_float(rr[0]) + __uint_as_float(rr[1]); }
  l_reg = l_reg * alpha + ps;
#define PK4(P, BASE, OUT) do { unsigned a0 = cvtpk(P[BASE + 0], P[BASE + 1]), a1 = cvtpk(P[BASE + 2], P[BASE + 3]);   \
    unsigned b0 = cvtpk(P[BASE + 4], P[BASE + 5]), b1 = cvtpk(P[BASE + 6], P[BASE + 7]);                              \
    auto r0 = __builtin_amdgcn_permlane32_swap(a0, b0, false, false); auto r1 = __builtin_amdgcn_permlane32_swap(a1, b1, false, false); \
    u32x4v w = {r0[0], r1[0], r0[1], r1[1]}; OUT = *reinterpret_cast<bf16x8*>(&w); } while (0)
  PK4(p0, 0, pa0); PK4(p0, 8, pa1); PK4(p1, 0, pa2); PK4(p1, 8, pa3);
#undef PK4
}
__device__ __forceinline__ void qkt(f32x16& p0, f32x16& p1, const char* Ks, const bf16x8* qr, int r32, int hi) {
  p0 = f32x16{}; p1 = f32x16{};
#pragma unroll
  for (int d0 = 0; d0 < 8; ++d0) { int cb = (d0 * 16 + hi * 8) * 2;
    bf16x8 b0 = *reinterpret_cast<const bf16x8*>(Ks + KSWZ(r32, cb));
    bf16x8 b1 = *reinterpret_cast<const bf16x8*>(Ks + KSWZ(32 + r32, cb));
    p0 = __builtin_amdgcn_mfma_f32_32x32x16_bf16(b0, qr[d0], p0, 0, 0, 0);
    p1 = __builtin_amdgcn_mfma_f32_32x32x16_bf16(b1, qr[d0], p1, 0, 0, 0); }
}
__device__ __forceinline__ int v_st(int k, int c) { const int kk = (k & ~0xC) | ((k & 4) << 1) | ((k & 8) >> 1); return ((kk >> 3) * 4 + (c >> 5)) * 512 + ((kk & 7) * 32 + (c & 31)) * 2; }
__device__ __forceinline__ int v_rd_base(int lane) { return ((lane & 3) << 3) | (((lane >> 2) & 3) << 6) | (((lane >> 4) & 1) << 5) | (((lane >> 5) & 1) << 8); }
constexpr int v_rd_off(int d0, int ks, int half) { return d0 * 512 + ks * 4096 + half * 2048; }
template <int OFF> __device__ __forceinline__ s16x4 tr_read(int vb) {
  s16x4 r; asm volatile("ds_read_b64_tr_b16 %0, %1 offset:%2" : "=&v"(r) : "v"(vb), "i"(OFF) : "memory"); return r;
}
template <int D0> __device__ __forceinline__ void pv_one(f32x16& od, int vb, bf16x8 pa0, bf16x8 pa1, bf16x8 pa2, bf16x8 pa3) {
  const s16x4 l0 = tr_read<v_rd_off(D0, 0, 0)>(vb), h0 = tr_read<v_rd_off(D0, 0, 1)>(vb), l1 = tr_read<v_rd_off(D0, 1, 0)>(vb), h1 = tr_read<v_rd_off(D0, 1, 1)>(vb);
  const s16x4 l2 = tr_read<v_rd_off(D0, 2, 0)>(vb), h2 = tr_read<v_rd_off(D0, 2, 1)>(vb), l3 = tr_read<v_rd_off(D0, 3, 0)>(vb), h3 = tr_read<v_rd_off(D0, 3, 1)>(vb);
  asm volatile("s_waitcnt lgkmcnt(0)" ::: "memory"); SBAR();
#define PK(L, H) (bf16x8){L[0], L[1], L[2], L[3], H[0], H[1], H[2], H[3]}
  od = __builtin_amdgcn_mfma_f32_32x32x16_bf16(pa0, PK(l0, h0), od, 0, 0, 0);
  od = __builtin_amdgcn_mfma_f32_32x32x16_bf16(pa1, PK(l1, h1), od, 0, 0, 0);
  od = __builtin_amdgcn_mfma_f32_32x32x16_bf16(pa2, PK(l2, h2), od, 0, 0, 0);
  od = __builtin_amdgcn_mfma_f32_32x32x16_bf16(pa3, PK(l3, h3), od, 0, 0, 0);
#undef PK
}
__device__ __forceinline__ void pv_d0(f32x16* o, int vb, bf16x8 pa0, bf16x8 pa1, bf16x8 pa2, bf16x8 pa3) {
  pv_one<0>(o[0], vb, pa0, pa1, pa2, pa3); pv_one<1>(o[1], vb, pa0, pa1, pa2, pa3); pv_one<2>(o[2], vb, pa0, pa1, pa2, pa3); pv_one<3>(o[3], vb, pa0, pa1, pa2, pa3);
}
template <int MODE> __device__ __forceinline__ void tile_mask(f32x16& p0, f32x16& p1, int j, int qb, unsigned selmask, int qrow, int hi) {
  if constexpr (MODE != 0) return;
  const int kb = j >> 2;
  if (kb < qb) {
    if (!((selmask >> kb) & 1u)) {
#pragma unroll
      for (int r = 0; r < 16; ++r) { p0[r] = -INFINITY; p1[r] = -INFINITY; } }
  } else {
    const int kbase = (j & 3) * 64;
#pragma unroll
    for (int r = 0; r < 16; ++r) { const int key = kbase + crow(r, hi); if (key > qrow) p0[r] = -INFINITY; if (key + 32 > qrow) p1[r] = -INFINITY; }
  }
}
template <int MODE> __device__ __forceinline__ void unit(int b, int h, int qb, const bf16_t* __restrict__ proj, const bf16_t* __restrict__ kvp, const float* __restrict__ kmean, const float* __restrict__ gain, bf16_t* __restrict__ merged, char* lds) {
  constexpr int LDQ = MODE == 0 ? NPROJ : XW, LDK = MODE == 0 ? NPROJ : 2 * XW, LDO = MODE == 0 ? DM : XW;
  const int tid = otid(), wid = tid >> 6, lane = tid & 63, r32 = lane & 31, hi = lane >> 5;
  char* V_lds = lds + OFF_V; char* K_lds = lds + OFF_K;
  float* ws = (float*)(lds + OFF_WS) + wid * 64; float* li_l = ws; float* al_l = ws + 32;
  char* KM = lds + OFF_KM; float* RS = (float*)(lds + OFF_RS + wid * RS_BYTES); float* RV = RS + 32 * 33;
  const long rowbase = (long)b * SEQ;
  const bf16_t* Qw = proj + (rowbase + qb * 256 + wid * QBLK + r32) * LDQ + h * D + hi * 8;
  const bf16_t* Kh = MODE == 0 ? proj + rowbase * LDK + 1024 + h * D : kvp + (long)b * NMEM * LDK + h * D;
  const bf16_t* Vh = MODE == 0 ? proj + rowbase * LDK + 2048 + h * D : kvp + (long)b * NMEM * LDK + XW + h * D;
  __syncthreads();
  if constexpr (MODE == 0)
  { const int blk = tid >> 5, c4 = (tid & 31) * 4;
    const f32x4v kv = *(const f32x4v*)(kmean + (size_t)((b * 8 + h) * 16 + blk) * D + c4);
    unsigned hb[4], lb[4];
#pragma unroll
    for (int e = 0; e < 4; ++e) { hb[e] = f2bf(kv[e]); lb[e] = f2bf(kv[e] - __uint_as_float(hb[e] << 16)); }
    typedef unsigned u32x2v __attribute__((ext_vector_type(2)));
    *(u32x2v*)(KM + KSWZ(blk, c4 * 2)) = (u32x2v){hb[0] | (hb[1] << 16), hb[2] | (hb[3] << 16)};
    *(u32x2v*)(KM + KSWZ(16 + blk, c4 * 2)) = (u32x2v){lb[0] | (lb[1] << 16), lb[2] | (lb[3] << 16)}; }
  float m_reg = -1e30f, l_reg = 0; f32x16 o[4] = {}; bf16x8 qr[8];
#pragma unroll
  for (int d0 = 0; d0 < 8; ++d0) qr[d0] = *reinterpret_cast<const bf16x8*>(Qw + d0 * 16);
  const int sr = tid >> 4, sc = (tid & 15) * 8, vst0 = v_st(sr, sc), vst1 = v_st(32 + sr, sc);
  const int vb0 = (int)(uintptr_t)V_lds + v_rd_base(lane);
  struct { bf16x8 vs0, vs1, ks0, ks1; } sr_[1];
#define SLOAD(i, k0) do { sr_[i].vs0 = *reinterpret_cast<const bf16x8*>(&Vh[(long)((k0) + sr) * LDK + sc]); sr_[i].vs1 = *reinterpret_cast<const bf16x8*>(&Vh[(long)((k0) + 32 + sr) * LDK + sc]); \
    sr_[i].ks0 = *reinterpret_cast<const bf16x8*>(&Kh[(long)((k0) + sr) * LDK + sc]); sr_[i].ks1 = *reinterpret_cast<const bf16x8*>(&Kh[(long)((k0) + 32 + sr) * LDK + sc]); } while (0)
#define SWRITE(bb, i) do { *(bf16x8*)(V_lds + (bb) * SHM_V + vst0) = sr_[i].vs0;          \
    *(bf16x8*)(V_lds + (bb) * SHM_V + vst1) = sr_[i].vs1; int kc = sc * 2;               \
    *(bf16x8*)(K_lds + (bb) * SHM_K + KSWZ(sr, kc)) = sr_[i].ks0;                       \
    *(bf16x8*)(K_lds + (bb) * SHM_K + KSWZ(32 + sr, kc)) = sr_[i].ks1; } while (0)
#define SWAIT() asm volatile("s_waitcnt vmcnt(0)" ::: "memory")
#define RESC(a) do { if (__any((a) < 1.f)) { if (hi == 0) al_l[r32] = (a); asm volatile("s_waitcnt lgkmcnt(0)" ::: "memory"); \
    _Pragma("unroll") for (int d = 0; d < 4; ++d) _Pragma("unroll") for (int r = 0; r < 16; ++r) o[d][r] *= al_l[crow(r, hi)]; } } while (0)
  const int NT = MODE == 0 ? 4 * (qb + 1) : 4;
  constexpr int SE = 0, SO = 0;
  SLOAD(SE, 0);
  __syncthreads();
  unsigned selmask = 0u;
  if constexpr (MODE == 0) {
    f32x16 gp = f32x16{};
#pragma unroll
    for (int d0 = 0; d0 < 8; ++d0) { const int cb = (d0 * 16 + hi * 8) * 2;
      const bf16x8 b0 = *reinterpret_cast<const bf16x8*>(KM + KSWZ(r32, cb));
      gp = __builtin_amdgcn_mfma_f32_32x32x16_bf16(b0, qr[d0], gp, 0, 0, 0); }
    float g[16];
#pragma unroll
    for (int r = 0; r < 8; ++r) { const float v = gp[r] + gp[r + 8];
      auto rr = __builtin_amdgcn_permlane32_swap(__float_as_uint(v), __float_as_uint(v), false, false);
      const int blo = (r < 4) ? r : 8 + (r - 4);
      g[blo] = __uint_as_float(rr[0]); g[blo + 4] = __uint_as_float(rr[1]); }
#pragma unroll
    for (int i = 0; i < 16; ++i) g[i] = (i < qb) ? g[i] : -INFINITY;
#pragma unroll
    for (int rnd = 0; rnd < 3; ++rnd) { float best = -INFINITY; int bi = -1;
#pragma unroll
      for (int i = 0; i < 16; ++i) if (g[i] > best) { best = g[i]; bi = i; }
      if (bi >= 0) selmask |= 1u << bi;
#pragma unroll
      for (int i = 0; i < 16; ++i) if (i == bi) g[i] = -INFINITY; }
  }
  const int qrow = wid * QBLK + r32;
  f32x16 pA0, pA1, pB0, pB1; float mnA, mnB, alA, alB; bf16x8 pa0, pa1, pa2, pa3;
  asm volatile("s_waitcnt vmcnt(0)" ::: "memory"); SWRITE(0, SE); __syncthreads();
  qkt(pA0, pA1, K_lds, qr, r32, hi); tile_mask<MODE>(pA0, pA1, 0, qb, selmask, qrow, hi); partialSM(pA0, pA1, m_reg, mnA, alA);
  SLOAD(SO, KVBLK);
  SWAIT(); SWRITE(1, SO); __syncthreads();
  for (int j = 1; j + 1 < NT; j += 2) {
    SBAR(); qkt(pB0, pB1, K_lds + SHM_K, qr, r32, hi); tile_mask<MODE>(pB0, pB1, j, qb, selmask, qrow, hi);
    finishSM(pA0, pA1, alA, l_reg, pa0, pa1, pa2, pa3); SBAR();
    SLOAD(SE, (j + 1) * KVBLK); SBAR();
    pv_d0(o, vb0, pa0, pa1, pa2, pa3); partialSM(pB0, pB1, m_reg, mnB, alB);
    __syncthreads(); SWAIT(); SWRITE(0, SE);
    RESC(alB); __syncthreads();
    SBAR(); qkt(pA0, pA1, K_lds, qr, r32, hi); tile_mask<MODE>(pA0, pA1, j + 1, qb, selmask, qrow, hi);
    finishSM(pB0, pB1, alB, l_reg, pa0, pa1, pa2, pa3); SBAR();
    SLOAD(SO, (j + 2) * KVBLK); SBAR();
    pv_d0(o, vb0 + SHM_V, pa0, pa1, pa2, pa3); partialSM(pA0, pA1, m_reg, mnA, alA);
    __syncthreads(); SWAIT(); SWRITE(1, SO);
    RESC(alA); __syncthreads();
  }
  SBAR(); qkt(pB0, pB1, K_lds + SHM_K, qr, r32, hi); tile_mask<MODE>(pB0, pB1, NT - 1, qb, selmask, qrow, hi);
  finishSM(pA0, pA1, alA, l_reg, pa0, pa1, pa2, pa3); SBAR();
  pv_d0(o, vb0, pa0, pa1, pa2, pa3); partialSM(pB0, pB1, m_reg, mnB, alB);
  __syncthreads(); RESC(alB);
  finishSM(pB0, pB1, alB, l_reg, pa0, pa1, pa2, pa3); SBAR();
  pv_d0(o, vb0 + SHM_V, pa0, pa1, pa2, pa3);
  if (hi == 0) li_l[r32] = l_reg; asm volatile("s_waitcnt lgkmcnt(0)" ::: "memory");
  float rli[16];
#pragma unroll
  for (int r = 0; r < 16; ++r) rli[r] = __builtin_amdgcn_rcpf(li_l[crow(r, hi)]);
  if constexpr (MODE == 0) {
#pragma unroll
  for (int r = 0; r < 16; ++r) { float s = 0.f;
#pragma unroll
    for (int d0 = 0; d0 < 4; ++d0) { o[d0][r] *= rli[r]; s += o[d0][r] * o[d0][r]; }
    RS[crow(r, hi) * 33 + r32] = s; }
  asm volatile("s_waitcnt lgkmcnt(0)" ::: "memory");
  { float s = 0.f;
#pragma unroll
    for (int c = 0; c < 32; ++c) s += RS[r32 * 33 + c];
    if (hi == 0) RV[r32] = rsqrtf(s * (1.f / D) + EPS); }
  asm volatile("s_waitcnt lgkmcnt(0)" ::: "memory");
  float gn[4];
#pragma unroll
  for (int d0 = 0; d0 < 4; ++d0) gn[d0] = gain[h * D + d0 * 32 + r32];
  bf16_t* Ow = merged + (rowbase + qb * 256 + wid * QBLK) * LDO + h * D;
#pragma unroll
  for (int r = 0; r < 16; ++r) { const int orow = crow(r, hi); const float rv = RV[orow];
#pragma unroll
    for (int d0 = 0; d0 < 4; ++d0) Ow[(long)orow * LDO + d0 * 32 + r32] = (bf16_t)f2bf(o[d0][r] * rv * gn[d0]); }
  } else {
    bf16_t* Ow = merged + (rowbase + qb * 256 + wid * QBLK) * LDO + h * D;
#pragma unroll
    for (int r = 0; r < 16; ++r) { const int orow = crow(r, hi);
#pragma unroll
      for (int d0 = 0; d0 < 4; ++d0) Ow[(long)orow * LDO + d0 * 32 + r32] = (bf16_t)f2bf(o[d0][r] * rli[r]); }
  }
#undef SLOAD
#undef SWRITE
#undef SWAIT
#undef RESC
}
#undef KSWZ
#undef SBAR
}

namespace cg = cooperative_groups;
constexpr int LDS_BYTES = 147456;
struct Args { const void* in[20]; float* out; unsigned char* ws; };
__global__ void __launch_bounds__(512, 2) mk_fwd(Args a) {
    extern __shared__ __attribute__((aligned(16))) unsigned char lds[];
    cg::grid_group grid = cg::this_grid();
    const int G = (int)gridDim.x, bx = (int)blockIdx.x;
    const int NGW = G * 8, NT = G * 512;
#define IDS() const int tid = otid(), lane = tid & 63, wave = __builtin_amdgcn_readfirstlane(tid >> 6); const int gw = bx * 8 + wave, gtid = bx * 512 + tid; float* wscr = (float*)(lds + wave * 16384); (void)lane; (void)gw; (void)gtid; (void)wscr
#define IN_F(k) ((const float*)a.in[k])
#define WSP(T, off) ((T)(a.ws + (off)))
#define x IN_F(0)
#define mem IN_F(1)
#define pos ((const int*)a.in[2])
#define g_mix IN_F(3)
#define w_in IN_F(4)
#define w_conv IN_F(5)
#define b_conv IN_F(6)
#define g_attn IN_F(7)
#define g_conv IN_F(8)
#define w_out IN_F(9)
#define g_xattn IN_F(10)
#define g_mem IN_F(11)
#define w_xq IN_F(12)
#define w_xkv IN_F(13)
#define w_xo IN_F(14)
#define g_ffn IN_F(15)
#define w_gate IN_F(16)
#define w_up IN_F(17)
#define w_down IN_F(18)
#define g_final IN_F(19)
#define out (a.out)
#define Win WSP(bf16_t*, WS_WIN)
#define Wout WSP(bf16_t*, WS_WOUT)
#define Wxq WSP(bf16_t*, WS_WXQ)
#define Wxkv WSP(bf16_t*, WS_WXKV)
#define Wxo WSP(bf16_t*, WS_WXO)
#define Wgu WSP(bf16_t*, WS_WGU)
#define Wdn WSP(bf16_t*, WS_WDN)
#define H WSP(bf16_t*, WS_H)
#define MRG WSP(bf16_t*, WS_MRG)
#define PROJ WSP(bf16_t*, WS_PROJ)
#define ACT WSP(bf16_t*, WS_ACT)
#define QX WSP(bf16_t*, WS_QX)
#define OX WSP(bf16_t*, WS_OX)
#define KVX WSP(bf16_t*, WS_KVX)
#define MEMN WSP(bf16_t*, WS_MEMN)
#define CS WSP(float*, WS_CS)
#define KMEAN WSP(float*, WS_KMEAN)
#define SS1 WSP(float*, WS_SS)
#define SS2 WSP(float*, WS_SS + 2 * MiB)
#define SS3 WSP(float*, WS_SS + 4 * MiB)
    PG8_LAS unsigned char* ldsg = (PG8_LAS unsigned char*)lds;

#define GEMM(EpiT, Aop, Bop, Mr, Nc, Kd, ...) do { pg8::Gemm g_{Aop, Bop, Mr, Nc, Kd, 0}; pg8::StaticOrder S_; S_.init(Mr, Nc, G, bx); EpiT E_{__VA_ARGS__}; \
        pg8::gemm_phase<EpiT, pg8::StaticOrder, true, true>(ldsg, g_, S_, E_); } while (0)
#define GEMM8(EpiT, Aop, Bop, Mr, Nc, Kd, ...) do { pg8::Gemm g_{Aop, Bop, Mr, Nc, Kd, 0}; pg8::StaticOrder S_; S_.init(Mr, Nc, G, bx); EpiT E_{__VA_ARGS__}; \
        pg8::gemm_phase<EpiT, pg8::StaticOrder, true, true, true, 0x77777777>(ldsg, g_, S_, E_); } while (0)

    {
        IDS();
        int base = 0;
        base = ph_transpose_job(TJob{w_in, nullptr, nullptr, Win, DM, NPROJ, NPROJ, 1, 1.f, 0}, base, wscr, gw, NGW, lane);
        base = ph_transpose_job(TJob{w_out, nullptr, nullptr, Wout, DM, DM, DM, 0, 1.f, 0}, base, wscr, gw, NGW, lane);
        base = ph_transpose_job(TJob{w_xq, nullptr, g_xattn, Wxq, DM, XW, XW, 0, 1.f, 0}, base, wscr, gw, NGW, lane);
        base = ph_transpose_job(TJob{w_xkv, nullptr, nullptr, Wxkv, DM, 2 * XW, 2 * XW, 0, 1.f, 0}, base, wscr, gw, NGW, lane);
        base = ph_transpose_job(TJob{w_xo, nullptr, nullptr, Wxo, XW, DM, DM, 0, 1.f, 0}, base, wscr, gw, NGW, lane);
        base = ph_transpose_job(TJob{w_gate, w_up, g_ffn, Wgu, DM, DFF, 2 * DFF, 2, 256.f, 1}, base, wscr, gw, NGW, lane);
        base = ph_transpose_job(TJob{w_down, nullptr, nullptr, Wdn, DFF, DM, DM, 0, 256.f, 1}, base, wscr, gw, NGW, lane);
    }
    { IDS(); ph_cs(pos, CS, gtid, NT); for (int i = gtid; i < NB * NH * NBLK * HD; i += NT) KMEAN[i] = 0.f; }
    { IDS(); ph_rms_bf16(x, g_mix, H, MT, gw, NGW, lane); ph_rms_bf16(mem, g_mem, MEMN, NB * NMEM, gw, NGW, lane); }
    grid.sync();
    GEMM(pg8::EpiInProj, H, Win, MT, NPROJ, DM, PROJ, CS, KMEAN);
    GEMM(pg8::EpiStoreBf16, MEMN, Wxkv, NB * NMEM, 2 * XW, DM, KVX, 2 * XW, 0);
    grid.sync();
    {
        const int vcu = (G % 8 == 0) ? (bx % 8) * (G / 8) + bx / 8 : bx;
        for (int p = vcu; p < NB * NH * 8; p += G) {
            const int bh = p >> 3, s = p & 7;
            moba::unit<0>(bh >> 3, bh & 7, s, PROJ, nullptr, KMEAN, g_attn, MRG, (char*)lds);
            moba::unit<0>(bh >> 3, bh & 7, 15 - s, PROJ, nullptr, KMEAN, g_attn, MRG, (char*)lds);
        }
        __syncthreads();
    }
    { IDS(); ph_conv_naive(PROJ, w_conv, b_conv, g_conv, MRG, gw, NGW, lane); }
    grid.sync();
    GEMM(pg8::EpiResNorm<1>, MRG, Wout, MT, DM, DM, x, out, H, SS1);
    grid.sync();
    GEMM(pg8::EpiRowScaleBf16, H, Wxq, MT, XW, DM, QX, SS1, XW, 0);
    grid.sync();
    {
        const int vcu = (G % 8 == 0) ? (bx % 8) * (G / 8) + bx / 8 : bx;
        for (int p = vcu; p < NB * XH * (SEQ / 256); p += G) { const int bh = p >> 4, qt = p & 15; moba::unit<1>(bh >> 2, bh & 3, qt, QX, KVX, nullptr, nullptr, OX, (char*)lds); }
        __syncthreads();
    }
    grid.sync();
    GEMM(pg8::EpiResNorm<2>, OX, Wxo, MT, DM, XW, out, out, H, SS2);
    grid.sync();
    GEMM8(pg8::EpiSwiGLUNorm<true>, H, Wgu, MT, 2 * DFF, DM, ACT, SS2, DFF, 0);
    grid.sync();
    GEMM8(pg8::EpiResNorm<0>, ACT, Wdn, MT, DM, DFF, out, out, nullptr, SS3);
    grid.sync();
    { IDS(); ph_final_norm(out, g_final, SS3, MT, gw, NGW, lane); }
#undef GEMM
#undef GEMM8
#undef IDS
#undef x
#undef mem
#undef pos
#undef g_mix
#undef w_in
#undef w_conv
#undef b_conv
#undef g_attn
#undef g_conv
#undef w_out
#undef g_xattn
#undef g_mem
#undef w_xq
#undef w_xkv
#undef w_xo
#undef g_ffn
#undef w_gate
#undef w_up
#undef w_down
#undef g_final
#undef out
#undef Win
#undef Wout
#undef Wxq
#undef Wxkv
#undef Wxo
#undef Wgu
#undef Wdn
#undef H
#undef MRG
#undef PROJ
#undef ACT
#undef QX
#undef OX
#undef KVX
#undef MEMN
#undef CS
#undef KMEAN
#undef SS1
#undef SS2
#undef SS3
#undef IN_F
#undef WSP
}

extern "C" void kernel_launch(void* const* d_in, const int* in_sizes, int n_in, void* d_out, int out_size, void* d_ws, size_t ws_size, hipStream_t stream) {
    static int grid_blocks = 0;
    if (grid_blocks == 0) {
        if (n_in != 20 || ws_size < WS_END) { fprintf(stderr, "kernel_launch: unexpected n_in %d / ws %zu\n", n_in, ws_size); grid_blocks = -1; return; }
        int dev = 0, cus = 0, per_cu = 0;
        (void)hipGetDevice(&dev); (void)hipDeviceGetAttribute(&cus, hipDeviceAttributeMultiprocessorCount, dev);
        (void)hipFuncSetAttribute((const void*)mk_fwd, hipFuncAttributeMaxDynamicSharedMemorySize, LDS_BYTES);
        (void)hipOccupancyMaxActiveBlocksPerMultiprocessor(&per_cu, (const void*)mk_fwd, 512, LDS_BYTES);
        if (per_cu < 1) { fprintf(stderr, "kernel_launch: occupancy query says %d blocks per CU\n", per_cu); per_cu = 1; }
        grid_blocks = cus;
        (void)hipGetLastError();
    }
    if (grid_blocks < 0) return;
    Args a{};
    for (int i = 0; i < 20; ++i) a.in[i] = d_in[i];
    a.out = (float*)d_out; a.ws = (unsigned char*)d_ws;
    void* args[] = {&a};
    hipError_t e = hipLaunchCooperativeKernel((const void*)mk_fwd, dim3(grid_blocks), dim3(512), args, LDS_BYTES, stream);
    if (e != hipSuccess) fprintf(stderr, "cooperative launch failed: %s (grid %d)\n", hipGetErrorString(e), grid_blocks);
}
```

```cpp
#include <hip/hip_runtime.h>
#include <hip/hip_cooperative_groups.h>
#include <cstdio>
#include <cstdint>
#include <cmath>
__device__ __forceinline__ int otid() { int t = (int)threadIdx.x; asm volatile("" : "+v"(t)); return t; }
namespace pg8 {
#define PG8_LAS __attribute__((address_space(3)))
typedef unsigned short bf16_t;
typedef short bf16x8 __attribute__((ext_vector_type(8)));
typedef float f32x4 __attribute__((ext_vector_type(4)));
typedef unsigned u32x4 __attribute__((ext_vector_type(4)));
constexpr int BM = 256, BK = 64, HALF = 128, HTB = HALF * BK * 2  , STAGE_BYTES = 8 * HTB, NXCD = 8, WGM = 8;

__host__ __device__ __forceinline__ int lds_byte(int r, int c) { const int st = (r >> 4) * 2 + (c >> 5), rr = r & 15, cc = c & 31, ob = rr * 64 + cc * 2; return st * 1024 + (ob ^ (((ob >> 9) & 1) << 5)); }
__host__ __device__ __forceinline__ void stage_rc(int b, int& R, int& C) { const int st = b / 1024, sb = b % 1024, swz = sb ^ (((sb >> 9) & 1) << 5); R = (st >> 1) * 16 + swz / 64; C = (st & 1) * 32 + (swz % 64) / 2; }
__host__ __device__ __forceinline__ int perm32(int rho) { const int n = rho >> 4, i = rho & 15; return 8 * (i >> 2) + 4 * n + (i & 3); }

struct Unit { int pm, pn; };
struct Gemm { const bf16_t* A; const bf16_t* Bt; int M, N, K, pad; };

struct StaticOrder {
    int nM, nN, nwg, G, c;
    __host__ __device__ void init(int M, int N, int G_, int c_) { nM = M / BM; nN = N / BM; nwg = nM * nN; G = G_; c = c_; }
    __host__ __device__ bool next(int i, Unit& u) const {
        const long L = (long)i * G + c; if (L >= nwg) return false;
        int wgid = (int)L; { const int q = nwg / NXCD, r = nwg % NXCD, xcd = wgid % NXCD, off = wgid / NXCD; wgid = (xcd < r ? xcd * (q + 1) : r * (q + 1) + (xcd - r) * q) + off; }
        const int nig = WGM * nN, gid = wgid / nig, fm = gid * WGM, gsz = (nM - fm) < WGM ? (nM - fm) : WGM;
        u.pm = fm + ((wgid % nig) % gsz); u.pn = (wgid % nig) / gsz; return true;
    }
    __device__ __forceinline__ void a_ready(const Unit&) const {}
    __device__ __forceinline__ void done(const Unit&) const {}
};
__device__ __forceinline__ unsigned cvt_pk_bf16(float lo, float hi) { unsigned r; asm volatile("v_cvt_pk_bf16_f32 %0, %1, %2" : "=v"(r) : "v"(lo), "v"(hi)); return r; }
__device__ __forceinline__ unsigned pk4_fp8(float a, float b, float c, float d) {
    a = __builtin_amdgcn_fmed3f(a, -448.f, 448.f); b = __builtin_amdgcn_fmed3f(b, -448.f, 448.f); c = __builtin_amdgcn_fmed3f(c, -448.f, 448.f); d = __builtin_amdgcn_fmed3f(d, -448.f, 448.f);
    int r = 0; r = __builtin_amdgcn_cvt_pk_fp8_f32(a, b, r, false); r = __builtin_amdgcn_cvt_pk_fp8_f32(c, d, r, true); return (unsigned)r;
}
__device__ __forceinline__ void mfma_f8(f32x4& acc, const bf16x8& w0, const bf16x8& w1, const bf16x8& a0, const bf16x8& a1, int scale_w, int scale_a) {
    typedef int i32x8_ __attribute__((ext_vector_type(8))); typedef int i32x4_ __attribute__((ext_vector_type(4)));
    const i32x4_ p0 = __builtin_bit_cast(i32x4_, w0), p1 = __builtin_bit_cast(i32x4_, w1), q0 = __builtin_bit_cast(i32x4_, a0), q1 = __builtin_bit_cast(i32x4_, a1);
    const i32x8_ W = {p0[0], p0[1], p0[2], p0[3], p1[0], p1[1], p1[2], p1[3]}, A = {q0[0], q0[1], q0[2], q0[3], q1[0], q1[1], q1[2], q1[3]};
    asm volatile("v_mfma_scale_f32_16x16x128_f8f6f4 %0, %1, %2, %0, %3, %4 op_sel_hi:[0,0,0]" : "+v"(acc) : "v"(W), "v"(A), "v"(scale_w), "v"(scale_a));
}
template <class Epi, class Sched, bool ALIGN_EPI = false, bool SP2 = false, bool F8 = false, int SCALE_W = 0x7f7f7f7f>
__device__ __forceinline__ void gemm_phase(PG8_LAS unsigned char* lds, const Gemm g, const Sched& S, const Epi& E) {
    const int tid = otid(), wid = __builtin_amdgcn_readfirstlane(tid >> 6), lane = tid & 63, wr = wid >> 2, wc = wid & 3, fr = lane & 15, fq = lane >> 4;
    const int K = F8 ? g.K / 2 : g.K, nt = K / BK;
    unsigned voffA[2], voffB[2];
#pragma unroll
    for (int i = 0; i < 2; ++i) { int R, C; stage_rc(tid * 16 + i * 8192, R, C); const int Rb = Epi::PERM ? ((R & ~31) + perm32(R & 31)) : R;
        voffA[i] = (unsigned)(R * K + C) * 2u; voffB[i] = (unsigned)(Rb * K + C) * 2u; }
    const size_t kstep = (size_t)(BK * 2);
    const size_t hstep = (size_t)HALF * K * 2;
    const size_t tstep = 2 * hstep;
    const unsigned ldsw = (unsigned)wid * 1024u;
    const int aoff = lds_byte(wr * 64 + fr, F8 ? fq * 16 : fq * 8), boff = lds_byte(wc * 32 + fr, F8 ? fq * 16 : fq * 8);
    constexpr int KOFF = F8 ? 16 : 1024;
#define PG8_SA(b, h) (((b) * 2 + (h)) * HTB)
#define PG8_SB(b, h) ((4 + (b) * 2 + (h)) * HTB)
#define PG8_STAGE(bufoff, gbase, voff) do { _Pragma("unroll") for (int _i = 0; _i < 2; ++_i) \
        __builtin_amdgcn_global_load_lds((const unsigned*)((const char*)(gbase) + (voff)[_i]), (PG8_LAS unsigned*)(lds + (bufoff) + ldsw + _i * 8192), 16, 0, 0); } while (0)
#define PG8_LDA(dst, b, h) do { _Pragma("unroll") for (int m = 0; m < 4; ++m) _Pragma("unroll") for (int k = 0; k < 2; ++k) dst[m][k] = *(const PG8_LAS bf16x8*)(lds + PG8_SA(b, h) + aoff + m * 2048 + k * KOFF); } while (0)
#define PG8_LDB(dst, b, h) do { _Pragma("unroll") for (int n = 0; n < 2; ++n) _Pragma("unroll") for (int k = 0; k < 2; ++k) dst[n][k] = *(const PG8_LAS bf16x8*)(lds + PG8_SB(b, h) + boff + n * 2048 + k * KOFF); } while (0)
#define PG8_MMA(ai, bj, At, Bt) do { __builtin_amdgcn_s_setprio(1); _Pragma("unroll") for (int m = 0; m < 4; ++m) _Pragma("unroll") for (int n = 0; n < 2; ++n) { \
        if constexpr (F8) { mfma_f8(acc[ai][bj][m][n], Bt[n][0], Bt[n][1], At[m][0], At[m][1], SCALE_W, 0x7f7f7f7f); } \
        else { _Pragma("unroll") for (int k = 0; k < 2; ++k) acc[ai][bj][m][n] = __builtin_amdgcn_mfma_f32_16x16x32_bf16(Bt[n][k], At[m][k], acc[ai][bj][m][n], 0, 0, 0); } } \
        __builtin_amdgcn_s_setprio(0); } while (0)
#define PG8_WAIT_V(n) asm volatile("s_waitcnt vmcnt(" #n ")" ::: "memory")
#define PG8_WAIT_L(n) asm volatile("s_waitcnt lgkmcnt(" #n ")" ::: "memory")
#define PG8_BAR __builtin_amdgcn_s_barrier()
#define PG8_SCHED __builtin_amdgcn_sched_barrier(0)
    Unit cur, nxt; int ui = 0;
    if (!S.next(0, cur)) return;
    f32x4 acc[2][2][4][2];
#pragma unroll
    for (int a = 0; a < 2; ++a)
#pragma unroll
        for (int b = 0; b < 2; ++b)
#pragma unroll
            for (int m = 0; m < 4; ++m)
#pragma unroll
                for (int n = 0; n < 2; ++n) acc[a][b][m][n] = (f32x4){0.f, 0.f, 0.f, 0.f};
    bf16x8 At[4][2], B0[2][2], B1[2][2];
    const char* cA = (const char*)g.A + (size_t)cur.pm * tstep; const char* cB = (const char*)g.Bt + (size_t)cur.pn * tstep;
    S.a_ready(cur);
    if constexpr (SP2) {
        PG8_STAGE(PG8_SB(0, 0), cB, voffB); PG8_STAGE(PG8_SB(0, 1), cB + hstep, voffB); PG8_STAGE(PG8_SA(0, 0), cA, voffA); PG8_STAGE(PG8_SA(0, 1), cA + hstep, voffA);
        if (wr == 1) PG8_BAR;
        PG8_WAIT_V(2); PG8_BAR;
        PG8_STAGE(PG8_SB(1, 0), cB + kstep, voffB); PG8_STAGE(PG8_SA(1, 0), cA + kstep, voffA); PG8_STAGE(PG8_SB(1, 1), cB + hstep + kstep, voffB);
        PG8_WAIT_V(6); PG8_BAR;
    } else {
        PG8_STAGE(PG8_SB(0, 0), cB, voffB); PG8_STAGE(PG8_SA(0, 0), cA, voffA); PG8_STAGE(PG8_SB(0, 1), cB + hstep, voffB); PG8_STAGE(PG8_SA(0, 1), cA + hstep, voffA);
        if (wr == 1) PG8_BAR;
        PG8_WAIT_V(4); PG8_BAR;
        PG8_STAGE(PG8_SB(1, 0), cB + kstep, voffB); PG8_STAGE(PG8_SA(1, 0), cA + kstep, voffA); PG8_STAGE(PG8_SB(1, 1), cB + hstep + kstep, voffB);
        PG8_WAIT_V(6); PG8_BAR;
    }
    for (;;) {
        const bool has_next = S.next(ui + 1, nxt);
        const char* nA = has_next ? (const char*)g.A + (size_t)nxt.pm * tstep : cA; const char* nB = has_next ? (const char*)g.Bt + (size_t)nxt.pn * tstep : cB;
        for (int t = 0; t < nt; t += 2) {
            const bool last = (t == nt - 2);
            const char* a1 = cA + (size_t)(t + 1) * kstep;
            const char* a2 = last ? nA : cA + (size_t)(t + 2) * kstep; const char* b2 = last ? nB : cB + (size_t)(t + 2) * kstep;
            const char* a3 = a2 + kstep; const char* b3 = b2 + kstep;
            if (last && has_next) S.a_ready(nxt);
            if constexpr (SP2) {
            PG8_LDB(B0, 0, 0); PG8_LDB(B1, 0, 1); PG8_SCHED; PG8_LDA(At, 0, 0); PG8_STAGE(PG8_SA(1, 1), a1 + hstep, voffA);
            PG8_WAIT_V(8); PG8_WAIT_L(0); PG8_BAR; PG8_MMA(0, 0, At, B0); PG8_MMA(0, 1, At, B1); PG8_BAR; PG8_SCHED;
            PG8_LDA(At, 0, 1); PG8_STAGE(PG8_SB(0, 0), b2, voffB); PG8_STAGE(PG8_SB(0, 1), b2 + hstep, voffB); PG8_STAGE(PG8_SA(0, 0), a2, voffA);
            PG8_WAIT_V(8); PG8_WAIT_L(0); PG8_BAR; PG8_MMA(1, 0, At, B0); PG8_MMA(1, 1, At, B1); PG8_BAR; PG8_SCHED;
            PG8_LDB(B0, 1, 0); PG8_LDB(B1, 1, 1); PG8_SCHED; PG8_LDA(At, 1, 0); PG8_STAGE(PG8_SA(0, 1), a2 + hstep, voffA);
            PG8_WAIT_V(8); PG8_WAIT_L(0); PG8_BAR; PG8_MMA(0, 0, At, B0); PG8_MMA(0, 1, At, B1); PG8_BAR; PG8_SCHED;
            PG8_LDA(At, 1, 1); PG8_STAGE(PG8_SB(1, 0), b3, voffB); PG8_STAGE(PG8_SB(1, 1), b3 + hstep, voffB); PG8_STAGE(PG8_SA(1, 0), a3, voffA);
            PG8_WAIT_V(8); PG8_WAIT_L(0); PG8_BAR; PG8_MMA(1, 0, At, B0); PG8_MMA(1, 1, At, B1); PG8_BAR; PG8_SCHED;
            } else {
            PG8_LDB(B0, 0, 0); PG8_SCHED; PG8_LDA(At, 0, 0); PG8_STAGE(PG8_SA(1, 1), a1 + hstep, voffA);
            PG8_WAIT_L(8); PG8_BAR; PG8_WAIT_L(0); PG8_MMA(0, 0, At, B0); PG8_BAR; PG8_SCHED;
            PG8_LDB(B1, 0, 1); PG8_STAGE(PG8_SB(0, 0), b2, voffB);
            PG8_BAR; PG8_WAIT_L(0); PG8_MMA(0, 1, At, B1); PG8_BAR;
            PG8_LDA(At, 0, 1); PG8_STAGE(PG8_SA(0, 0), a2, voffA);
            PG8_BAR; PG8_WAIT_L(0); PG8_MMA(1, 0, At, B0); PG8_BAR; PG8_SCHED;
            PG8_STAGE(PG8_SB(0, 1), b2 + hstep, voffB);
            PG8_WAIT_V(6); PG8_BAR; PG8_MMA(1, 1, At, B1); PG8_BAR;
            PG8_LDB(B0, 1, 0); PG8_SCHED; PG8_LDA(At, 1, 0); PG8_STAGE(PG8_SA(0, 1), a2 + hstep, voffA);
            PG8_WAIT_L(8); PG8_BAR; PG8_WAIT_L(0); PG8_MMA(0, 0, At, B0); PG8_BAR; PG8_SCHED;
            PG8_LDB(B1, 1, 1); PG8_STAGE(PG8_SB(1, 0), b3, voffB);
            PG8_BAR; PG8_WAIT_L(0); PG8_MMA(0, 1, At, B1); PG8_BAR;
            PG8_LDA(At, 1, 1); PG8_STAGE(PG8_SA(1, 0), a3, voffA);
            PG8_BAR; PG8_WAIT_L(0); PG8_MMA(1, 0, At, B0); PG8_BAR; PG8_SCHED;
            PG8_STAGE(PG8_SB(1, 1), b3 + hstep, voffB);
            PG8_WAIT_V(6); PG8_BAR; PG8_MMA(1, 1, At, B1); PG8_BAR;
            }
        }
        if constexpr (ALIGN_EPI) { if (wr == 0) PG8_BAR; }
        if constexpr (F8) asm volatile("s_nop 15\n\ts_nop 15" ::: "memory");
        if constexpr (!Epi::AFTER_DRAIN) { E(acc, cur, wr, wc, fr, fq); S.done(cur); }
        if (!has_next) break;
#pragma unroll
        for (int a = 0; a < 2; ++a)
#pragma unroll
            for (int b = 0; b < 2; ++b)
#pragma unroll
                for (int m = 0; m < 4; ++m)
#pragma unroll
                    for (int n = 0; n < 2; ++n) acc[a][b][m][n] = (f32x4){0.f, 0.f, 0.f, 0.f};
        cur = nxt; cA = nA; cB = nB; ++ui;
        if constexpr (ALIGN_EPI) { if (wr == 1) PG8_BAR; }
    }
    PG8_WAIT_V(0);
    if constexpr (!ALIGN_EPI) { if (wr == 0) PG8_BAR; }
    PG8_BAR;
    if constexpr (Epi::AFTER_DRAIN) { E.fused(acc, cur, wr, wc, fr, fq, lds, wid, lane); S.done(cur); }
#undef PG8_SA
#undef PG8_SB
#undef PG8_STAGE
#undef PG8_LDA
#undef PG8_LDB
#undef PG8_MMA
#undef PG8_WAIT_V
#undef PG8_WAIT_L
#undef PG8_BAR
#undef PG8_SCHED
}
}

namespace pg8 {
struct EpiStoreBf16 {
    static constexpr bool PERM = true, AFTER_DRAIN = false;
    bf16_t* O; int ldc, pad;
    __device__ __forceinline__ void operator()(const f32x4 (&acc)[2][2][4][2], const Unit& u, int wr, int wc, int fr, int fq) const {
        const int row0 = u.pm * BM + wr * 64 + fr, col0 = u.pn * BM + wc * 32 + 8 * fq;
#pragma unroll
        for (int ai = 0; ai < 2; ++ai)
#pragma unroll
            for (int m = 0; m < 4; ++m) { bf16_t* rowp = O + (size_t)(row0 + ai * HALF + m * 16) * ldc + col0;
#pragma unroll
                for (int bj = 0; bj < 2; ++bj) { const f32x4 v0 = acc[ai][bj][m][0], v1 = acc[ai][bj][m][1];
                    u32x4 w; w.x = cvt_pk_bf16(v0[0], v0[1]); w.y = cvt_pk_bf16(v0[2], v0[3]); w.z = cvt_pk_bf16(v1[0], v1[1]); w.w = cvt_pk_bf16(v1[2], v1[3]);
                    *(u32x4*)(rowp + bj * HALF) = w; } }
    }
};
struct EpiResF32 {
    static constexpr bool PERM = false, AFTER_DRAIN = false;
    const float* base; float* out; int ldc, pad;
    __device__ __forceinline__ void operator()(const f32x4 (&acc)[2][2][4][2], const Unit& u, int wr, int wc, int fr, int fq) const {
        const int row0 = u.pm * BM + wr * 64 + fr, col0 = u.pn * BM + wc * 32 + 4 * fq;
#pragma unroll
        for (int ai = 0; ai < 2; ++ai)
#pragma unroll
            for (int m = 0; m < 4; ++m) { const size_t off = (size_t)(row0 + ai * HALF + m * 16) * ldc + col0;
#pragma unroll
                for (int bj = 0; bj < 2; ++bj)
#pragma unroll
                    for (int n = 0; n < 2; ++n) { const f32x4 b = *(const f32x4*)(base + off + bj * HALF + n * 16); *(f32x4*)(out + off + bj * HALF + n * 16) = b + acc[ai][bj][m][n]; } }
    }
};
struct EpiSwiGLU {
    static constexpr bool PERM = true, AFTER_DRAIN = false;
    bf16_t* O; int ldc, pad;
    __device__ __forceinline__ void operator()(const f32x4 (&acc)[2][2][4][2], const Unit& u, int wr, int wc, int fr, int fq) const {
        const int row0 = u.pm * BM + wr * 64 + fr, col0 = u.pn * HALF + wc * 32 + 8 * fq;
#pragma unroll
        for (int ai = 0; ai < 2; ++ai)
#pragma unroll
            for (int m = 0; m < 4; ++m) { bf16_t* rowp = O + (size_t)(row0 + ai * HALF + m * 16) * ldc + col0;
                float r[8];
#pragma unroll
                for (int n = 0; n < 2; ++n)
#pragma unroll
                    for (int e = 0; e < 4; ++e) { const float g = acc[ai][0][m][n][e], up = acc[ai][1][m][n][e]; r[n * 4 + e] = g * up / (1.0f + __expf(-g)); }
                u32x4 w; w.x = cvt_pk_bf16(r[0], r[1]); w.y = cvt_pk_bf16(r[2], r[3]); w.z = cvt_pk_bf16(r[4], r[5]); w.w = cvt_pk_bf16(r[6], r[7]);
                *(u32x4*)rowp = w; }
    }
};
}

namespace pg8 {
struct EpiInProj {
    static constexpr bool PERM = true, AFTER_DRAIN = false;
    bf16_t* O; const float* cs; float* kmean;
    __device__ __forceinline__ void operator()(const f32x4 (&acc)[2][2][4][2], const Unit& u, int wr, int wc, int fr, int fq) const {
        const int row0 = u.pm * BM + wr * 64 + fr;
        if (u.pn >= 8) {
            const int col0 = u.pn * BM + wc * 32 + 8 * fq;
#pragma unroll
            for (int ai = 0; ai < 2; ++ai)
#pragma unroll
                for (int m = 0; m < 4; ++m) { bf16_t* rowp = O + (size_t)(row0 + ai * HALF + m * 16) * 6144 + col0;
#pragma unroll
                    for (int bj = 0; bj < 2; ++bj) { const f32x4 v0 = acc[ai][bj][m][0], v1 = acc[ai][bj][m][1];
                        u32x4 w; w.x = cvt_pk_bf16(v0[0], v0[1]); w.y = cvt_pk_bf16(v0[2], v0[3]); w.z = cvt_pk_bf16(v1[0], v1[1]); w.w = cvt_pk_bf16(v1[2], v1[3]);
                        *(u32x4*)(rowp + bj * HALF) = w; } }
        } else {
            const int sec = u.pn >> 2, head = 2 * (u.pn & 3) + (wc >> 1), d0 = (wc & 1) * 32 + 8 * fq;
            bf16_t* obase = O + sec * 1024 + head * 128 + d0;
            float csum[16];
#pragma unroll
            for (int i = 0; i < 16; ++i) csum[i] = 0.f;
#pragma unroll
            for (int ai = 0; ai < 2; ++ai)
#pragma unroll
                for (int m = 0; m < 4; ++m) { const int row = row0 + ai * HALF + m * 16;
                    const f32x4* cp = (const f32x4*)(cs + ((size_t)row * 64 + d0) * 2);
                    float ol[8], oh[8];
#pragma unroll
                    for (int n = 0; n < 2; ++n) { const f32x4 t0 = cp[2 * n], t1 = cp[2 * n + 1]; const f32x4 lo = acc[ai][0][m][n], hi = acc[ai][1][m][n];
                        ol[4 * n + 0] = lo[0] * t0[0] - hi[0] * t0[1]; oh[4 * n + 0] = hi[0] * t0[0] + lo[0] * t0[1];
                        ol[4 * n + 1] = lo[1] * t0[2] - hi[1] * t0[3]; oh[4 * n + 1] = hi[1] * t0[2] + lo[1] * t0[3];
                        ol[4 * n + 2] = lo[2] * t1[0] - hi[2] * t1[1]; oh[4 * n + 2] = hi[2] * t1[0] + lo[2] * t1[1];
                        ol[4 * n + 3] = lo[3] * t1[2] - hi[3] * t1[3]; oh[4 * n + 3] = hi[3] * t1[2] + lo[3] * t1[3]; }
                    u32x4 w; w.x = cvt_pk_bf16(ol[0], ol[1]); w.y = cvt_pk_bf16(ol[2], ol[3]); w.z = cvt_pk_bf16(ol[4], ol[5]); w.w = cvt_pk_bf16(ol[6], ol[7]);
                    *(u32x4*)(obase + (size_t)row * 6144) = w;
                    w.x = cvt_pk_bf16(oh[0], oh[1]); w.y = cvt_pk_bf16(oh[2], oh[3]); w.z = cvt_pk_bf16(oh[4], oh[5]); w.w = cvt_pk_bf16(oh[6], oh[7]);
                    *(u32x4*)(obase + (size_t)row * 6144 + 64) = w;
                    if (sec == 1) {
#pragma unroll
                        for (int i = 0; i < 8; ++i) { csum[i] += ol[i]; csum[8 + i] += oh[i]; } } }
            if (sec == 1) {
                float* km = kmean + (size_t)(((u.pm >> 4) * 8 + head) * 16 + (u.pm & 15)) * 128 + d0;
#pragma unroll
                for (int i = 0; i < 16; ++i) { float v = csum[i]; v += __shfl_xor(v, 1); v += __shfl_xor(v, 2); v += __shfl_xor(v, 4); v += __shfl_xor(v, 8);
                    if (fr == 0) atomicAdd(km + (i & 7) + (i >> 3) * 64, v * (1.f / 256.f)); }
            }
        }
    }
};
__device__ __forceinline__ float row_rinv(const float* ss, int row, int fq) {
    const f32x4* p = (const f32x4*)(ss + (size_t)row * 32 + fq * 8); const f32x4 a = p[0], b = p[1];
    float s = ((a[0] + a[1]) + (a[2] + a[3])) + ((b[0] + b[1]) + (b[2] + b[3]));
    s += __shfl_xor(s, 16); s += __shfl_xor(s, 32);
    return rsqrtf(s * (1.f / 2048.f) + 1e-6f);
}
template <int COPY> struct EpiResNorm {
    static constexpr bool PERM = true, AFTER_DRAIN = false;
    const float* base; float* out; bf16_t* xb; float* ss;
    __device__ __forceinline__ void operator()(const f32x4 (&acc)[2][2][4][2], const Unit& u, int wr, int wc, int fr, int fq) const {
        const int row0 = u.pm * BM + wr * 64 + fr, col0 = u.pn * BM + wc * 32 + 8 * fq;
#pragma unroll
        for (int ai = 0; ai < 2; ++ai)
#pragma unroll
            for (int m = 0; m < 4; ++m) { const int row = row0 + ai * HALF + m * 16; const size_t off = (size_t)row * 2048 + col0; float s = 0.f;
#pragma unroll
                for (int bj = 0; bj < 2; ++bj) { const f32x4 v0 = *(const f32x4*)(base + off + bj * HALF) + acc[ai][bj][m][0], v1 = *(const f32x4*)(base + off + bj * HALF + 4) + acc[ai][bj][m][1];
                    *(f32x4*)(out + off + bj * HALF) = v0; *(f32x4*)(out + off + bj * HALF + 4) = v1;
                    s += ((v0[0] * v0[0] + v0[1] * v0[1]) + (v0[2] * v0[2] + v0[3] * v0[3])) + ((v1[0] * v1[0] + v1[1] * v1[1]) + (v1[2] * v1[2] + v1[3] * v1[3]));
                    if (COPY == 1) { u32x4 w; w.x = cvt_pk_bf16(v0[0], v0[1]); w.y = cvt_pk_bf16(v0[2], v0[3]); w.z = cvt_pk_bf16(v1[0], v1[1]); w.w = cvt_pk_bf16(v1[2], v1[3]);
                        *(u32x4*)(xb + off + bj * HALF) = w; }
                    if (COPY == 2) { typedef unsigned u32x2_ __attribute__((ext_vector_type(2))); u32x2_ w; w.x = pk4_fp8(v0[0], v0[1], v0[2], v0[3]); w.y = pk4_fp8(v1[0], v1[1], v1[2], v1[3]);
                        *(u32x2_*)((unsigned char*)xb + off + bj * HALF) = w; } }
                s += __shfl_xor(s, 16); s += __shfl_xor(s, 32);
                if (fq == 0) ss[(size_t)row * 32 + u.pn * 4 + wc] = s; }
    }
};
struct EpiRowScaleBf16 {
    static constexpr bool PERM = true, AFTER_DRAIN = false;
    bf16_t* O; const float* ss; int ldc, pad;
    __device__ __forceinline__ void operator()(const f32x4 (&acc)[2][2][4][2], const Unit& u, int wr, int wc, int fr, int fq) const {
        const int row0 = u.pm * BM + wr * 64 + fr, col0 = u.pn * BM + wc * 32 + 8 * fq;
#pragma unroll
        for (int ai = 0; ai < 2; ++ai)
#pragma unroll
            for (int m = 0; m < 4; ++m) { const int row = row0 + ai * HALF + m * 16; const float ri = row_rinv(ss, row, fq); bf16_t* rowp = O + (size_t)row * ldc + col0;
#pragma unroll
                for (int bj = 0; bj < 2; ++bj) { const f32x4 v0 = acc[ai][bj][m][0] * ri, v1 = acc[ai][bj][m][1] * ri;
                    u32x4 w; w.x = cvt_pk_bf16(v0[0], v0[1]); w.y = cvt_pk_bf16(v0[2], v0[3]); w.z = cvt_pk_bf16(v1[0], v1[1]); w.w = cvt_pk_bf16(v1[2], v1[3]);
                    *(u32x4*)(rowp + bj * HALF) = w; } }
    }
};
template <bool F8OUT> struct EpiSwiGLUNorm {
    static constexpr bool PERM = true, AFTER_DRAIN = false;
    bf16_t* O; const float* ss; int ldc, pad;
    __device__ __forceinline__ void operator()(const f32x4 (&acc)[2][2][4][2], const Unit& u, int wr, int wc, int fr, int fq) const {
        const int row0 = u.pm * BM + wr * 64 + fr, col0 = u.pn * HALF + wc * 32 + 8 * fq;
#pragma unroll
        for (int ai = 0; ai < 2; ++ai)
#pragma unroll
            for (int m = 0; m < 4; ++m) { const int row = row0 + ai * HALF + m * 16; const float ri = row_rinv(ss, row, fq); bf16_t* rowp = O + (size_t)row * ldc + col0;
                float r[8];
#pragma unroll
                for (int n = 0; n < 2; ++n)
#pragma unroll
                    for (int e = 0; e < 4; ++e) { const float g = acc[ai][0][m][n][e] * ri, up = acc[ai][1][m][n][e] * ri; r[n * 4 + e] = g * up / (1.0f + __expf(-g)); }
                if (F8OUT) { typedef unsigned u32x2_ __attribute__((ext_vector_type(2))); u32x2_ w; w.x = pk4_fp8(r[0], r[1], r[2], r[3]); w.y = pk4_fp8(r[4], r[5], r[6], r[7]);
                    *(u32x2_*)((unsigned char*)O + (size_t)row * ldc + col0) = w; }
                else { u32x4 w; w.x = cvt_pk_bf16(r[0], r[1]); w.y = cvt_pk_bf16(r[2], r[3]); w.z = cvt_pk_bf16(r[4], r[5]); w.w = cvt_pk_bf16(r[6], r[7]);
                    *(u32x4*)rowp = w; } }
    }
};
}
typedef unsigned short bf16_t;
constexpr int DM = 2048, NB = 4, SEQ = 4096, MT = NB * SEQ;
constexpr int HD = 128, NH = 8, AW = 1024, CW = 1024, NPROJ = 6144;
constexpr int NBLK = 16, MBLK = 256;
constexpr int NMEM = 256, XH = 4, XW = 512, DFF = 5632;
constexpr float EPS = 1e-6f;
constexpr float SM_SCALE = 0.088388347648318440f;
constexpr size_t MiB = 1u << 20;
constexpr size_t WS_WIN = 0;
constexpr size_t WS_WOUT = 24 * MiB;
constexpr size_t WS_WXQ = 32 * MiB;
constexpr size_t WS_WXKV = 34 * MiB;
constexpr size_t WS_WXO = 38 * MiB;
constexpr size_t WS_WGU = 40 * MiB;
constexpr size_t WS_WDN = 84 * MiB;
constexpr size_t WS_H = 112 * MiB;
constexpr size_t WS_MRG = 176 * MiB;
constexpr size_t WS_PROJ = 240 * MiB;
constexpr size_t WS_ACT = 240 * MiB;
constexpr size_t WS_QX = 432 * MiB;
constexpr size_t WS_OX = 448 * MiB;
constexpr size_t WS_KVX = 464 * MiB;
constexpr size_t WS_MEMN = 466 * MiB;
constexpr size_t WS_CS = 470 * MiB;
constexpr size_t WS_KMEAN = 478 * MiB;
constexpr size_t WS_SS = 479 * MiB;
constexpr size_t WS_BAR = 485 * MiB;
constexpr size_t WS_END = 486 * MiB;

__device__ __forceinline__ float bf2f(unsigned v) { return __uint_as_float(v << 16); }
__device__ __forceinline__ unsigned f2bf(float f) { unsigned u = __float_as_uint(f); return (u + 0x7fffu + ((u >> 16) & 1u)) >> 16; }
__device__ __forceinline__ unsigned pk2(float lo, float hi) { return f2bf(lo) | (f2bf(hi) << 16); }
__device__ __forceinline__ float wave_sum(float v) {
#pragma unroll
    for (int o = 1; o < 64; o <<= 1) v += __shfl_xor(v, o);
    return v;
}
__device__ __forceinline__ float wave_max(float v) {
#pragma unroll
    for (int o = 1; o < 64; o <<= 1) v = fmaxf(v, __shfl_xor(v, o));
    return v;
}
typedef float f32x4 __attribute__((ext_vector_type(4)));
typedef unsigned u32x4 __attribute__((ext_vector_type(4)));
typedef unsigned u32x2 __attribute__((ext_vector_type(2)));

struct TJob { const float* src0; const float* src1; const float* gain; bf16_t* dst; int K, Nsrc, nrows, mode; float wscale; int f8; };
__device__ __forceinline__ void transpose_item(const TJob& J, float* scr, int item, int lane) {
    const int nblk = J.nrows / 32, kb = item / nblk, nb = item % nblk, k0 = 64 * kb, n0 = 32 * nb;
    const float* src = J.src0; int c0 = n0;
    if (J.mode == 1 && n0 < 2048) { const int tile = n0 >> 8, c = n0 & 255, cc = c & 127; c0 = (tile >> 2) * 1024 + (2 * (tile & 3) + (cc >> 6)) * 128 + (cc & 63) + ((c >> 7) ? 64 : 0); }
    if (J.mode == 2) { const int tile = n0 >> 8, w = n0 & 255; if (w < 128) { c0 = tile * 128 + w; } else { src = J.src1; c0 = tile * 128 + w - 128; } }
    f32x4 ld[8];
#pragma unroll
    for (int i = 0; i < 8; ++i) ld[i] = *(const f32x4*)(src + (size_t)(k0 + 8 * i + (lane >> 3)) * J.Nsrc + c0 + 4 * (lane & 7));
#pragma unroll
    for (int i = 0; i < 8; ++i) { const int kk = 8 * i + (lane >> 3); float gsc = J.wscale; if (J.gain) gsc *= J.gain[k0 + kk];
#pragma unroll
        for (int e = 0; e < 4; ++e) scr[kk * 33 + 4 * (lane & 7) + e] = ld[i][e] * gsc; }
    asm volatile("s_waitcnt lgkmcnt(0)" ::: "memory");
    const int c = lane & 7;
#pragma unroll
    for (int j = 0; j < 4; ++j) { const int n = (lane >> 3) + 8 * j; const float* s = scr + (8 * c) * 33 + n;
        if (J.f8) { u32x2 o; o.x = pg8::pk4_fp8(s[0 * 33], s[1 * 33], s[2 * 33], s[3 * 33]); o.y = pg8::pk4_fp8(s[4 * 33], s[5 * 33], s[6 * 33], s[7 * 33]);
            *(u32x2*)((unsigned char*)J.dst + (size_t)(n0 + n) * J.K + k0 + 8 * c) = o; }
        else { u32x4 o; o.x = pk2(s[0 * 33], s[1 * 33]); o.y = pk2(s[2 * 33], s[3 * 33]); o.z = pk2(s[4 * 33], s[5 * 33]); o.w = pk2(s[6 * 33], s[7 * 33]);
            *(u32x4*)(J.dst + (size_t)(n0 + n) * J.K + k0 + 8 * c) = o; } }
    asm volatile("s_waitcnt lgkmcnt(0)" ::: "memory");
}
__device__ __forceinline__ int ph_transpose_job(const TJob J, int base, float* scr, int gw, int NGW, int lane) {
    const int nitems = (J.K / 64) * (J.nrows / 32);
    const int first = (gw - base % NGW + NGW) % NGW;
    for (int it = first; it < nitems; it += NGW) transpose_item(J, scr, it, lane);
    return base + nitems;
}

__device__ __forceinline__ void rms_row_bf16(const float* xrow, const float* g, bf16_t* orow, int lane) {
    const f32x4* xr = (const f32x4*)xrow + lane; const f32x4* gr = (const f32x4*)g + lane;
    f32x4 v[8]; float s = 0.f;
#pragma unroll
    for (int j = 0; j < 8; ++j) { v[j] = xr[64 * j]; s += (v[j].x * v[j].x + v[j].y * v[j].y) + (v[j].z * v[j].z + v[j].w * v[j].w); }
    const float rinv = rsqrtf(wave_sum(s) * (1.f / DM) + EPS);
    u32x2* o8 = (u32x2*)orow + lane;
#pragma unroll
    for (int j = 0; j < 8; ++j) { const f32x4 gg = gr[64 * j]; u32x2 w; w.x = pk2(v[j].x * rinv * gg.x, v[j].y * rinv * gg.y); w.y = pk2(v[j].z * rinv * gg.z, v[j].w * rinv * gg.w); o8[64 * j] = w; }
}
__device__ __forceinline__ void ph_rms_bf16(const float* X, const float* g, bf16_t* O, int rows, int gw, int NGW, int lane) {
    f32x4 v[8], nx[8];
    int r = gw;
    if (r < rows) {
#pragma unroll
        for (int j = 0; j < 8; ++j) v[j] = ((const f32x4*)(X + (size_t)r * DM) + lane)[64 * j]; }
    for (; r < rows; r += NGW) {
        const int rn = r + NGW;
        if (rn < rows) {
#pragma unroll
            for (int j = 0; j < 8; ++j) nx[j] = ((const f32x4*)(X + (size_t)rn * DM) + lane)[64 * j]; }
        float s = 0.f;
#pragma unroll
        for (int j = 0; j < 8; ++j) s += (v[j].x * v[j].x + v[j].y * v[j].y) + (v[j].z * v[j].z + v[j].w * v[j].w);
        const float rinv = rsqrtf(wave_sum(s) * (1.f / DM) + EPS);
        u32x2* o8 = (u32x2*)(O + (size_t)r * DM) + lane; const f32x4* gr = (const f32x4*)g + lane;
#pragma unroll
        for (int j = 0; j < 8; ++j) { const f32x4 gg = gr[64 * j]; u32x2 w; w.x = pk2(v[j].x * rinv * gg.x, v[j].y * rinv * gg.y); w.y = pk2(v[j].z * rinv * gg.z, v[j].w * rinv * gg.w); o8[64 * j] = w; }
#pragma unroll
        for (int j = 0; j < 8; ++j) v[j] = nx[j];
    }
}
__device__ __forceinline__ void ph_final_norm(float* X, const float* g, const float* ss, int rows, int gw, int NGW, int lane) {
    for (int r = gw; r < rows; r += NGW) {
        f32x4* xr = (f32x4*)(X + (size_t)r * DM) + lane; const f32x4* gr = (const f32x4*)g + lane;
        const float part = (lane < 32) ? ss[(size_t)r * 32 + lane] : 0.f;
        const float rinv = rsqrtf(wave_sum(part) * (1.f / DM) + EPS);
#pragma unroll
        for (int j = 0; j < 8; ++j) xr[64 * j] = xr[64 * j] * rinv * gr[64 * j];
    }
}

__device__ __forceinline__ void sincos_small(double r, double& s, double& c) {
    const double r2 = r * r;
    double a = -1.0 / 10888869450418352160768000000.0;
    a = a * r2 + 1.0 / 15511210043330985984000000.0;
    a = a * r2 - 1.0 / 25852016738884976640000.0;
    a = a * r2 + 1.0 / 51090942171709440000.0;
    a = a * r2 - 1.0 / 121645100408832000.0;
    a = a * r2 + 1.0 / 355687428096000.0;
    a = a * r2 - 1.0 / 1307674368000.0;
    a = a * r2 + 1.0 / 6227020800.0;
    a = a * r2 - 1.0 / 39916800.0;
    a = a * r2 + 1.0 / 362880.0;
    a = a * r2 - 1.0 / 5040.0;
    a = a * r2 + 1.0 / 120.0;
    a = a * r2 - 1.0 / 6.0;
    a = a * r2 + 1.0;
    s = a * r;
    double b = 1.0 / 403291461126605635584000000.0;
    b = b * r2 - 1.0 / 620448401733239439360000.0;
    b = b * r2 + 1.0 / 1124000727777607680000.0;
    b = b * r2 - 1.0 / 2432902008176640000.0;
    b = b * r2 + 1.0 / 6402373705728000.0;
    b = b * r2 - 1.0 / 20922789888000.0;
    b = b * r2 + 1.0 / 87178291200.0;
    b = b * r2 - 1.0 / 479001600.0;
    b = b * r2 + 1.0 / 3628800.0;
    b = b * r2 - 1.0 / 40320.0;
    b = b * r2 + 1.0 / 720.0;
    b = b * r2 - 1.0 / 24.0;
    b = b * r2 + 1.0 / 2.0;
    c = 1.0 - b * r2;
}
__device__ __forceinline__ void cs_entry(const int* pos, float* cs, int idx) {
    const int t = idx >> 6, f = idx & 63;
    double p = 1.0, bs = 0.8659643233600653;
#pragma unroll
    for (int bit = 0; bit < 6; ++bit) { if ((f >> bit) & 1) p *= bs; bs *= bs; }
    const double ang = (double)pos[t] * p;
    const double TWO_PI = 6.283185307179586;
    const double n = rint(ang / TWO_PI);
    const double r = fma(-n, TWO_PI, ang);
    double s, c; sincos_small(r, s, c);
    cs[2 * idx] = (float)c; cs[2 * idx + 1] = (float)s;
}
__device__ __forceinline__ void ph_cs(const int* pos, float* cs, int gtid, int NT) {
    for (int idx = gtid; idx < MT * 64; idx += NT) cs_entry(pos, cs, idx);
}
__device__ __forceinline__ void ph_rope_naive(bf16_t* proj, const float* cs, int gtid, int NT) {
    const long total = (long)MT * 2 * NH * 64;
    for (long i = gtid; i < total; i += NT) {
        const int d = (int)(i & 63), h = (int)((i >> 6) & 7), sec = (int)((i >> 9) & 1); const long t = i >> 10;
        bf16_t* p = proj + t * NPROJ + sec * 1024 + h * HD + d;
        const float a = bf2f(p[0]), b = bf2f(p[64]); const float c = cs[(t * 64 + d) * 2], s = cs[(t * 64 + d) * 2 + 1];
        p[0] = (bf16_t)f2bf(a * c - b * s); p[64] = (bf16_t)f2bf(b * c + a * s);
    }
}
__device__ __forceinline__ void ph_kmean_naive(const bf16_t* proj, float* kmean, int gtid, int NT) {
    for (int i = gtid; i < NB * NH * NBLK * HD; i += NT) {
        const int d = i & 127, blkid = i >> 7;
        const int blk = blkid & 15, h = (blkid >> 4) & 7, b = blkid >> 7;
        float s = 0.f;
        for (int j = 0; j < MBLK; ++j) s += bf2f(proj[(size_t)(b * SEQ + blk * MBLK + j) * NPROJ + 1024 + h * HD + d]);
        kmean[(size_t)blkid * HD + d] = s * (1.f / MBLK);
    }
}
__device__ __forceinline__ float dot_q_row(const float* sq, const bf16_t* krow) {
    float a = 0.f;
#pragma unroll
    for (int d = 0; d < 128; d += 8) { const u32x4 kk = *(const u32x4*)(krow + d);
        a += sq[d + 0] * bf2f(kk.x & 0xffffu) + sq[d + 1] * bf2f(kk.x >> 16) + sq[d + 2] * bf2f(kk.y & 0xffffu) + sq[d + 3] * bf2f(kk.y >> 16)
           + sq[d + 4] * bf2f(kk.z & 0xffffu) + sq[d + 5] * bf2f(kk.z >> 16) + sq[d + 6] * bf2f(kk.w & 0xffffu) + sq[d + 7] * bf2f(kk.w >> 16); }
    return a;
}
__device__ __forceinline__ void ph_moba_naive(const bf16_t* proj, const float* kmean, const float* g_attn, bf16_t* merged, float qscale_inv, float* scr, int gw, int NGW, int lane) {
    float* sq = scr; float* sp = scr + 128;
    for (int item = gw; item < MT * NH; item += NGW) {
        const int t = item >> 3, h = item & 7, b = t >> 12, ts = t & 4095, qb = ts >> 8, tq = ts & 255;
        const bf16_t* qrow = proj + (size_t)t * NPROJ + h * HD;
        const unsigned qq = *(const unsigned*)(qrow + 2 * lane);
        const float q0 = bf2f(qq & 0xffffu) * qscale_inv, q1 = bf2f(qq >> 16) * qscale_inv;
        asm volatile("s_waitcnt lgkmcnt(0)" ::: "memory");
        sq[2 * lane] = q0; sq[2 * lane + 1] = q1;
        float g[16];
#pragma unroll
        for (int i = 0; i < 16; ++i) { const float* km = kmean + (size_t)((b * 8 + h) * 16 + i) * HD; const float p = wave_sum(q0 * km[2 * lane] + q1 * km[2 * lane + 1]); g[i] = (i < qb) ? p : -INFINITY; }
        int sel[4];
#pragma unroll
        for (int r = 0; r < 3; ++r) { float best = -INFINITY; int bi = -1;
#pragma unroll
            for (int i = 0; i < 16; ++i) if (g[i] > best) { best = g[i]; bi = i; }
            sel[r] = bi;
#pragma unroll
            for (int i = 0; i < 16; ++i) if (i == bi) g[i] = -INFINITY; }
        sel[3] = qb;
        asm volatile("s_waitcnt lgkmcnt(0)" ::: "memory");
#pragma unroll
        for (int s = 0; s < 4; ++s) { const int blk = sel[s];
            for (int jj = 0; jj < 4; ++jj) { const int j = jj * 64 + lane; float sc = -INFINITY;
                if (blk >= 0 && (s < 3 || j <= tq)) sc = dot_q_row(sq, proj + (size_t)(b * SEQ + blk * MBLK + j) * NPROJ + 1024 + h * HD) * SM_SCALE;
                sp[s * 256 + j] = sc; } }
        asm volatile("s_waitcnt lgkmcnt(0)" ::: "memory");
        float m = -INFINITY; for (int i = lane; i < 1024; i += 64) m = fmaxf(m, sp[i]); m = wave_max(m);
        float l = 0.f; for (int i = lane; i < 1024; i += 64) { const float p = __expf(sp[i] - m); sp[i] = p; l += p; } l = wave_sum(l);
        asm volatile("s_waitcnt lgkmcnt(0)" ::: "memory");
        float o0 = 0.f, o1 = 0.f;
#pragma unroll
        for (int s = 0; s < 4; ++s) { const int blk = sel[s]; if (blk < 0) continue;
            const bf16_t* vb = proj + (size_t)(b * SEQ + blk * MBLK) * NPROJ + 2048 + h * HD + 2 * lane;
            for (int j = 0; j < 256; ++j) { const float p = sp[s * 256 + j]; const unsigned vv = *(const unsigned*)(vb + (size_t)j * NPROJ); o0 += p * bf2f(vv & 0xffffu); o1 += p * bf2f(vv >> 16); } }
        const float li = 1.f / l; o0 *= li; o1 *= li;
        const float rinv = rsqrtf(wave_sum(o0 * o0 + o1 * o1) * (1.f / HD) + EPS);
        *(unsigned*)(merged + (size_t)t * DM + h * HD + 2 * lane) = pk2(o0 * rinv * g_attn[h * HD + 2 * lane], o1 * rinv * g_attn[h * HD + 2 * lane + 1]);
    }
}
__device__ __forceinline__ void ph_conv_naive(const bf16_t* proj, const float* w_conv, const float* b_conv, const float* g_conv, bf16_t* merged, int gw, int NGW, int lane) {
    for (int item = gw; item < MT * 8; item += NGW) {
        const int t = item >> 3, grp = item & 7, ts = t & 4095; const int c = grp * 128 + 2 * lane;
        float y[2];
#pragma unroll
        for (int e = 0; e < 2; ++e) { float acc = b_conv[c + e];
#pragma unroll
            for (int k = 0; k < 3; ++k) { const int back = 2 - k; if (ts - back >= 0) { const bf16_t* r = proj + (size_t)(t - back) * NPROJ; acc += w_conv[k * CW + c + e] * (bf2f(r[3072 + c + e]) * bf2f(r[5120 + c + e])); } }
            y[e] = bf2f(proj[(size_t)t * NPROJ + 4096 + c + e]) * acc; }
        const float rinv = rsqrtf(wave_sum(y[0] * y[0] + y[1] * y[1]) * (1.f / HD) + EPS);
        *(unsigned*)(merged + (size_t)t * DM + AW + c) = pk2(y[0] * rinv * g_conv[c], y[1] * rinv * g_conv[c + 1]);
    }
}
__device__ __forceinline__ void ph_conv(const bf16_t* __restrict__ proj, const float* __restrict__ w_conv, const float* __restrict__ b_conv, const float* __restrict__ g_conv, bf16_t* __restrict__ merged, int gw, int NGW, int lane) {
    const int l16 = lane & 15, sub = lane >> 4, grp = gw & 7, c = grp * 128 + l16 * 8;
    float w0[8], w1[8], w2[8], bc[8], gc[8];
#pragma unroll
    for (int h = 0; h < 2; ++h) { const f32x4 a0 = *(const f32x4*)(w_conv + c + 4 * h), a1 = *(const f32x4*)(w_conv + CW + c + 4 * h), a2 = *(const f32x4*)(w_conv + 2 * CW + c + 4 * h), bb = *(const f32x4*)(b_conv + c + 4 * h), gg = *(const f32x4*)(g_conv + c + 4 * h);
#pragma unroll
        for (int e = 0; e < 4; ++e) { w0[4 * h + e] = a0[e]; w1[4 * h + e] = a1[e]; w2[4 * h + e] = a2[e]; bc[4 * h + e] = bb[e]; gc[4 * h + e] = gg[e]; } }
    const int step = (NGW >> 3) * 4;
    for (int t = (gw >> 3) * 4 + sub; t < MT; t += step) {
        const int ts = t & (SEQ - 1); const bf16_t* r0 = proj + (size_t)t * NPROJ + c;
        const u32x4 vb = *(const u32x4*)(r0 + 4096), c0 = *(const u32x4*)(r0 + 3072), x0 = *(const u32x4*)(r0 + 5120);
        u32x4 c1 = {0u, 0u, 0u, 0u}, x1 = c1, c2 = c1, x2 = c1;
        if (ts >= 1) { c1 = *(const u32x4*)(r0 - NPROJ + 3072); x1 = *(const u32x4*)(r0 - NPROJ + 5120); }
        if (ts >= 2) { c2 = *(const u32x4*)(r0 - 2 * NPROJ + 3072); x2 = *(const u32x4*)(r0 - 2 * NPROJ + 5120); }
        float y[8]; float ss = 0.f;
#pragma unroll
        for (int q = 0; q < 4; ++q)
#pragma unroll
            for (int hh = 0; hh < 2; ++hh) { const int e = 2 * q + hh;
                const float C0 = hh ? __uint_as_float(c0[q] & 0xffff0000u) : __uint_as_float(c0[q] << 16), X0 = hh ? __uint_as_float(x0[q] & 0xffff0000u) : __uint_as_float(x0[q] << 16);
                const float C1 = hh ? __uint_as_float(c1[q] & 0xffff0000u) : __uint_as_float(c1[q] << 16), X1 = hh ? __uint_as_float(x1[q] & 0xffff0000u) : __uint_as_float(x1[q] << 16);
                const float C2 = hh ? __uint_as_float(c2[q] & 0xffff0000u) : __uint_as_float(c2[q] << 16), X2 = hh ? __uint_as_float(x2[q] & 0xffff0000u) : __uint_as_float(x2[q] << 16);
                const float Bv = hh ? __uint_as_float(vb[q] & 0xffff0000u) : __uint_as_float(vb[q] << 16);
                const float acc = bc[e] + w2[e] * (C0 * X0) + w1[e] * (C1 * X1) + w0[e] * (C2 * X2);
                y[e] = Bv * acc; ss += y[e] * y[e]; }
        ss += __shfl_xor(ss, 1); ss += __shfl_xor(ss, 2); ss += __shfl_xor(ss, 4); ss += __shfl_xor(ss, 8);
        const float rinv = rsqrtf(ss * (1.f / HD) + EPS);
        u32x4 o; o.x = pk2(y[0] * rinv * gc[0], y[1] * rinv * gc[1]); o.y = pk2(y[2] * rinv * gc[2], y[3] * rinv * gc[3]); o.z = pk2(y[4] * rinv * gc[4], y[5] * rinv * gc[5]); o.w = pk2(y[6] * rinv * gc[6], y[7] * rinv * gc[7]);
        *(u32x4*)(merged + (size_t)t * DM + AW + c) = o;
    }
}
__device__ __forceinline__ void ph_xattn_naive(const bf16_t* qx, const bf16_t* kvx, bf16_t* ox, float qscale_inv, float* scr, int gw, int NGW, int lane) {
    float* sq = scr; float* sp = scr + 128;
    for (int item = gw; item < MT * XH; item += NGW) {
        const int t = item >> 2, h = item & 3, b = t >> 12;
        const unsigned qq = *(const unsigned*)(qx + (size_t)t * XW + h * HD + 2 * lane);
        asm volatile("s_waitcnt lgkmcnt(0)" ::: "memory");
        sq[2 * lane] = bf2f(qq & 0xffffu) * qscale_inv; sq[2 * lane + 1] = bf2f(qq >> 16) * qscale_inv;
        asm volatile("s_waitcnt lgkmcnt(0)" ::: "memory");
        float m = -INFINITY;
        for (int jj = 0; jj < 4; ++jj) { const int j = jj * 64 + lane; const float sc = dot_q_row(sq, kvx + (size_t)(b * NMEM + j) * 1024 + h * HD) * SM_SCALE; sp[j] = sc; m = fmaxf(m, sc); }
        m = wave_max(m);
        asm volatile("s_waitcnt lgkmcnt(0)" ::: "memory");
        float l = 0.f; for (int i = lane; i < 256; i += 64) { const float p = __expf(sp[i] - m); sp[i] = p; l += p; } l = wave_sum(l);
        asm volatile("s_waitcnt lgkmcnt(0)" ::: "memory");
        float o0 = 0.f, o1 = 0.f; const bf16_t* vb = kvx + (size_t)(b * NMEM) * 1024 + 512 + h * HD + 2 * lane;
        for (int j = 0; j < 256; ++j) { const float p = sp[j]; const unsigned vv = *(const unsigned*)(vb + (size_t)j * 1024); o0 += p * bf2f(vv & 0xffffu); o1 += p * bf2f(vv >> 16); }
        const float li = 1.f / l;
        *(unsigned*)(ox + (size_t)t * XW + h * HD + 2 * lane) = pk2(o0 * li, o1 * li);
    }
}

namespace moba {
using bf16x8 = __attribute__((ext_vector_type(8))) short;
using s16x4  = __attribute__((ext_vector_type(4))) short;
using f32x16 = __attribute__((ext_vector_type(16))) float;
using u32x4v = __attribute__((ext_vector_type(4))) unsigned;
using f32x4v = __attribute__((ext_vector_type(4))) float;
constexpr int D = 128, NW = 8, QBLK = 32, KVBLK = 64;
constexpr float SCALE = 0.088388347648318440f, THR = 8.f;
constexpr int SHM_V = KVBLK * D * 2, SHM_K = KVBLK * D * 2;
constexpr int OFF_V = 0, OFF_K = 2 * SHM_V, OFF_WS = OFF_K + 2 * SHM_K, OFF_KM = OFF_WS + NW * 256, OFF_RS = OFF_KM + 16 * 128 * 4, RS_BYTES = (32 * 33 + 32) * 4, LDS_END = OFF_RS + NW * RS_BYTES;
static_assert(LDS_END <= 131072, "moba LDS");
#define KSWZ(row, colB) ((row) * 256 + ((colB) ^ (((row) & 7) << 4)))
#define SBAR() __builtin_amdgcn_sched_barrier(0)
__device__ __forceinline__ int crow(int r, int hi) { return (r & 3) + 8 * (r >> 2) + 4 * hi; }
__device__ __forceinline__ unsigned cvtpk(float lo, float hi) { unsigned r; asm volatile("v_cvt_pk_bf16_f32 %0, %1, %2" : "=v"(r) : "v"(lo), "v"(hi)); return r; }
__device__ __forceinline__ void partialSM(f32x16& p0, f32x16& p1, float& m_reg, float& mn, float& alpha) {
  constexpr float C = SCALE * 1.4426950408889634f;
  float pmax = p0[0];
#pragma unroll
  for (int r = 1; r < 16; ++r) pmax = fmaxf(pmax, p0[r]);
#pragma unroll
  for (int r = 0; r < 16; ++r) pmax = fmaxf(pmax, p1[r]);
  { auto rr = __builtin_amdgcn_permlane32_swap(__float_as_uint(pmax), __float_as_uint(pmax), false, false);
    pmax = fmaxf(__uint_as_float(rr[0]), __uint_as_float(rr[1])); }
  if (__builtin_expect(__all(pmax - m_reg <= THR / SCALE), 1)) { mn = m_reg; alpha = 1.f; }
  else { mn = fmaxf(m_reg, pmax); alpha = __builtin_amdgcn_exp2f((m_reg - mn) * C); m_reg = mn; }
  float mnC = -mn * C;
#pragma unroll
  for (int r = 0; r < 16; ++r) p0[r] = fmaf(p0[r], C, mnC);
#pragma unroll
  for (int r = 0; r < 16; ++r) p1[r] = fmaf(p1[r], C, mnC);
#pragma unroll
  for (int r = 0; r < 16; ++r) p0[r] = __builtin_amdgcn_exp2f(p0[r]);
}
__device__ __forceinline__ void finishSM(f32x16& p0, f32x16& p1, float alpha, float& l_reg, bf16x8& pa0, bf16x8& pa1, bf16x8& pa2, bf16x8& pa3) {
#pragma unroll
  for (int r = 0; r < 16; ++r) p1[r] = __builtin_amdgcn_exp2f(p1[r]);
  float ps = 0;
#pragma unroll
  for (int r = 0; r < 16; ++r) ps += p0[r];
#pragma unroll
  for (int r = 0; r < 16; ++r) ps += p1[r];
  { auto rr = __builtin_amdgcn_permlane32_swap(__float_as_uint(ps), __float_as_uint(ps), false, false);
    ps = __uint_as_float(rr[0]) + __uint_as_float(rr[1]); }
  l_reg = l_reg * alpha + ps;
#define PK4(P, BASE, OUT) do { unsigned a0 = cvtpk(P[BASE + 0], P[BASE + 1]), a1 = cvtpk(P[BASE + 2], P[BASE + 3]);   \
    unsigned b0 = cvtpk(P[BASE + 4], P[BASE + 5]), b1 = cvtpk(P[BASE + 6], P[BASE + 7]);                              \
    auto r0 = __builtin_amdgcn_permlane32_swap(a0, b0, false, false); auto r1 = __builtin_amdgcn_permlane32_swap(a1, b1, false, false); \
    u32x4v w = {r0[0], r1[0], r0[1], r1[1]}; OUT = *reinterpret_cast<bf16x8*>(&w); } while (0)
  PK4(p0, 0, pa0); PK4(p0, 8, pa1); PK4(p1, 0, pa2); PK4(p1, 8, pa3);
#undef PK4
}
__device__ __forceinline__ void qkt(f32x16& p0, f32x16& p1, const char* Ks, const bf16x8* qr, int r32, int hi) {
  p0 = f32x16{}; p1 = f32x16{};
#pragma unroll
  for (int d0 = 0; d0 < 8; ++d0) { int cb = (d0 * 16 + hi * 8) * 2;
    bf16x8 b0 = *reinterpret_cast<const bf16x8*>(Ks + KSWZ(r32, cb));
    bf16x8 b1 = *reinterpret_cast<const bf16x8*>(Ks + KSWZ(32 + r32, cb));
    p0 = __builtin_amdgcn_mfma_f32_32x32x16_bf16(b0, qr[d0], p0, 0, 0, 0);
    p1 = __builtin_amdgcn_mfma_f32_32x32x16_bf16(b1, qr[d0], p1, 0, 0, 0); }
}
__device__ __forceinline__ int v_st(int k, int c) { const int kk = (k & ~0xC) | ((k & 4) << 1) | ((k & 8) >> 1); return ((kk >> 3) * 4 + (c >> 5)) * 512 + ((kk & 7) * 32 + (c & 31)) * 2; }
__device__ __forceinline__ int v_rd_base(int lane) { return ((lane & 3) << 3) | (((lane >> 2) & 3) << 6) | (((lane >> 4) & 1) << 5) | (((lane >> 5) & 1) << 8); }
constexpr int v_rd_off(int d0, int ks, int half) { return d0 * 512 + ks * 4096 + half * 2048; }
template <int OFF> __device__ __forceinline__ s16x4 tr_read(int vb) {
  s16x4 r; asm volatile("ds_read_b64_tr_b16 %0, %1 offset:%2" : "=&v"(r) : "v"(vb), "i"(OFF) : "memory"); return r;
}
template <int D0> __device__ __forceinline__ void pv_one(f32x16& od, int vb, bf16x8 pa0, bf16x8 pa1, bf16x8 pa2, bf16x8 pa3) {
  const s16x4 l0 = tr_read<v_rd_off(D0, 0, 0)>(vb), h0 = tr_read<v_rd_off(D0, 0, 1)>(vb), l1 = tr_read<v_rd_off(D0, 1, 0)>(vb), h1 = tr_read<v_rd_off(D0, 1, 1)>(vb);
  const s16x4 l2 = tr_read<v_rd_off(D0, 2, 0)>(vb), h2 = tr_read<v_rd_off(D0, 2, 1)>(vb), l3 = tr_read<v_rd_off(D0, 3, 0)>(vb), h3 = tr_read<v_rd_off(D0, 3, 1)>(vb);
  asm volatile("s_waitcnt lgkmcnt(0)" ::: "memory"); SBAR();
#define PK(L, H) (bf16x8){L[0], L[1], L[2], L[3], H[0], H[1], H[2], H[3]}
  od = __builtin_amdgcn_mfma_f32_32x32x16_bf16(pa0, PK(l0, h0), od, 0, 0, 0);
  od = __builtin_amdgcn_mfma_f32_32x32x16_bf16(pa1, PK(l1, h1), od, 0, 0, 0);
  od = __builtin_amdgcn_mfma_f32_32x32x16_bf16(pa2, PK(l2, h2), od, 0, 0, 0);
  od = __builtin_amdgcn_mfma_f32_32x32x16_bf16(pa3, PK(l3, h3), od, 0, 0, 0);
#undef PK
}
__device__ __forceinline__ void pv_d0(f32x16* o, int vb, bf16x8 pa0, bf16x8 pa1, bf16x8 pa2, bf16x8 pa3) {
  pv_one<0>(o[0], vb, pa0, pa1, pa2, pa3); pv_one<1>(o[1], vb, pa0, pa1, pa2, pa3); pv_one<2>(o[2], vb, pa0, pa1, pa2, pa3); pv_one<3>(o[3], vb, pa0, pa1, pa2, pa3);
}
template <int MODE> __device__ __forceinline__ void tile_mask(f32x16& p0, f32x16& p1, int j, int qb, unsigned selmask, int qrow, int hi) {
  if constexpr (MODE != 0) return;
  const int kb = j >> 2;
  if (kb < qb) {
    if (!((selmask >> kb) & 1u)) {
#pragma unroll
      for (int r = 0; r < 16; ++r) { p0[r] = -INFINITY; p1[r] = -INFINITY; } }
  } else {
    const int kbase = (j & 3) * 64;
#pragma unroll
    for (int r = 0; r < 16; ++r) { const int key = kbase + crow(r, hi); if (key > qrow) p0[r] = -INFINITY; if (key + 32 > qrow) p1[r] = -INFINITY; }
  }
}
template <int MODE> __device__ __forceinline__ void unit(int b, int h, int qb, const bf16_t* __restrict__ proj, const bf16_t* __restrict__ kvp, const float* __restrict__ kmean, const float* __restrict__ gain, bf16_t* __restrict__ merged, char* lds) {
  constexpr int LDQ = MODE == 0 ? NPROJ : XW, LDK = MODE == 0 ? NPROJ : 2 * XW, LDO = MODE == 0 ? DM : XW;
  const int tid = otid(), wid = tid >> 6, lane = tid & 63, r32 = lane & 31, hi = lane >> 5;
  char* V_lds = lds + OFF_V; char* K_lds = lds + OFF_K;
  float* ws = (float*)(lds + OFF_WS) + wid * 64; float* li_l = ws; float* al_l = ws + 32;
  char* KM = lds + OFF_KM; float* RS = (float*)(lds + OFF_RS + wid * RS_BYTES); float* RV = RS + 32 * 33;
  const long rowbase = (long)b * SEQ;
  const bf16_t* Qw = proj + (rowbase + qb * 256 + wid * QBLK + r32) * LDQ + h * D + hi * 8;
  const bf16_t* Kh = MODE == 0 ? proj + rowbase * LDK + 1024 + h * D : kvp + (long)b * NMEM * LDK + h * D;
  const bf16_t* Vh = MODE == 0 ? proj + rowbase * LDK + 2048 + h * D : kvp + (long)b * NMEM * LDK + XW + h * D;
  __syncthreads();
  if constexpr (MODE == 0)
  { const int blk = tid >> 5, c4 = (tid & 31) * 4;
    const f32x4v kv = *(const f32x4v*)(kmean + (size_t)((b * 8 + h) * 16 + blk) * D + c4);
    unsigned hb[4], lb[4];
#pragma unroll
    for (int e = 0; e < 4; ++e) { hb[e] = f2bf(kv[e]); lb[e] = f2bf(kv[e] - __uint_as_float(hb[e] << 16)); }
    typedef unsigned u32x2v __attribute__((ext_vector_type(2)));
    *(u32x2v*)(KM + KSWZ(blk, c4 * 2)) = (u32x2v){hb[0] | (hb[1] << 16), hb[2] | (hb[3] << 16)};
    *(u32x2v*)(KM + KSWZ(16 + blk, c4 * 2)) = (u32x2v){lb[0] | (lb[1] << 16), lb[2] | (lb[3] << 16)}; }
  float m_reg = -1e30f, l_reg = 0; f32x16 o[4] = {}; bf16x8 qr[8];
#pragma unroll
  for (int d0 = 0; d0 < 8; ++d0) qr[d0] = *reinterpret_cast<const bf16x8*>(Qw + d0 * 16);
  const int sr = tid >> 4, sc = (tid & 15) * 8, vst0 = v_st(sr, sc), vst1 = v_st(32 + sr, sc);
  const int vb0 = (int)(uintptr_t)V_lds + v_rd_base(lane);
  struct { bf16x8 vs0, vs1, ks0, ks1; } sr_[1];
#define SLOAD(i, k0) do { sr_[i].vs0 = *reinterpret_cast<const bf16x8*>(&Vh[(long)((k0) + sr) * LDK + sc]); sr_[i].vs1 = *reinterpret_cast<const bf16x8*>(&Vh[(long)((k0) + 32 + sr) * LDK + sc]); \
    sr_[i].ks0 = *reinterpret_cast<const bf16x8*>(&Kh[(long)((k0) + sr) * LDK + sc]); sr_[i].ks1 = *reinterpret_cast<const bf16x8*>(&Kh[(long)((k0) + 32 + sr) * LDK + sc]); } while (0)
#define SWRITE(bb, i) do { *(bf16x8*)(V_lds + (bb) * SHM_V + vst0) = sr_[i].vs0;          \
    *(bf16x8*)(V_lds + (bb) * SHM_V + vst1) = sr_[i].vs1; int kc = sc * 2;               \
    *(bf16x8*)(K_lds + (bb) * SHM_K + KSWZ(sr, kc)) = sr_[i].ks0;                       \
    *(bf16x8*)(K_lds + (bb) * SHM_K + KSWZ(32 + sr, kc)) = sr_[i].ks1; } while (0)
#define SWAIT() asm volatile("s_waitcnt vmcnt(0)" ::: "memory")
#define RESC(a) do { if (__any((a) < 1.f)) { if (hi == 0) al_l[r32] = (a); asm volatile("s_waitcnt lgkmcnt(0)" ::: "memory"); \
    _Pragma("unroll") for (int d = 0; d < 4; ++d) _Pragma("unroll") for (int r = 0; r < 16; ++r) o[d][r] *= al_l[crow(r, hi)]; } } while (0)
  const int NT = MODE == 0 ? 4 * (qb + 1) : 4;
  constexpr int SE = 0, SO = 0;
  SLOAD(SE, 0);
  __syncthreads();
  unsigned selmask = 0u;
  if constexpr (MODE == 0) {
    f32x16 gp = f32x16{};
#pragma unroll
    for (int d0 = 0; d0 < 8; ++d0) { const int cb = (d0 * 16 + hi * 8) * 2;
      const bf16x8 b0 = *reinterpret_cast<const bf16x8*>(KM + KSWZ(r32, cb));
      gp = __builtin_amdgcn_mfma_f32_32x32x16_bf16(b0, qr[d0], gp, 0, 0, 0); }
    float g[16];
#pragma unroll
    for (int r = 0; r < 8; ++r) { const float v = gp[r] + gp[r + 8];
      auto rr = __builtin_amdgcn_permlane32_swap(__float_as_uint(v), __float_as_uint(v), false, false);
      const int blo = (r < 4) ? r : 8 + (r - 4);
      g[blo] = __uint_as_float(rr[0]); g[blo + 4] = __uint_as_float(rr[1]); }
#pragma unroll
    for (int i = 0; i < 16; ++i) g[i] = (i < qb) ? g[i] : -INFINITY;
#pragma unroll
    for (int rnd = 0; rnd < 3; ++rnd) { float best = -INFINITY; int bi = -1;
#pragma unroll
      for (int i = 0; i < 16; ++i) if (g[i] > best) { best = g[i]; bi = i; }
      if (bi >= 0) selmask |= 1u << bi;
#pragma unroll
      for (int i = 0; i < 16; ++i) if (i == bi) g[i] = -INFINITY; }
  }
  const int qrow = wid * QBLK + r32;
  f32x16 pA0, pA1, pB0, pB1; float mnA, mnB, alA, alB; bf16x8 pa0, pa1, pa2, pa3;
  asm volatile("s_waitcnt vmcnt(0)" ::: "memory"); SWRITE(0, SE); __syncthreads();
  qkt(pA0, pA1, K_lds, qr, r32, hi); tile_mask<MODE>(pA0, pA1, 0, qb, selmask, qrow, hi); partialSM(pA0, pA1, m_reg, mnA, alA);
  SLOAD(SO, KVBLK);
  SWAIT(); SWRITE(1, SO); __syncthreads();
  for (int j = 1; j + 1 < NT; j += 2) {
    SBAR(); qkt(pB0, pB1, K_lds + SHM_K, qr, r32, hi); tile_mask<MODE>(pB0, pB1, j, qb, selmask, qrow, hi);
    finishSM(pA0, pA1, alA, l_reg, pa0, pa1, pa2, pa3); SBAR();
    SLOAD(SE, (j + 1) * KVBLK); SBAR();
    pv_d0(o, vb0, pa0, pa1, pa2, pa3); partialSM(pB0, pB1, m_reg, mnB, alB);
    __syncthreads(); SWAIT(); SWRITE(0, SE);
    RESC(alB); __syncthreads();
    SBAR(); qkt(pA0, pA1, K_lds, qr, r32, hi); tile_mask<MODE>(pA0, pA1, j + 1, qb, selmask, qrow, hi);
    finishSM(pB0, pB1, alB, l_reg, pa0, pa1, pa2, pa3); SBAR();
    SLOAD(SO, (j + 2) * KVBLK); SBAR();
    pv_d0(o, vb0 + SHM_V, pa0, pa1, pa2, pa3); partialSM(pA0, pA1, m_reg, mnA, alA);
    __syncthreads(); SWAIT(); SWRITE(1, SO);
    RESC(alA); __syncthreads();
  }
  SBAR(); qkt(pB0, pB1, K_lds + SHM_K, qr, r32, hi); tile_mask<MODE>(pB0, pB1, NT - 1, qb, selmask, qrow, hi);
  finishSM(pA0, pA1, alA, l_reg, pa0, pa1, pa2, pa3); SBAR();
  pv_d0(o, vb0, pa0, pa1, pa2, pa3); partialSM(pB0, pB1, m_reg, mnB, alB);
  __syncthreads(); RESC(alB);
  finishSM(pB0, pB1, alB, l_reg, pa0, pa1, pa2, pa3); SBAR();
  pv_d0(o, vb0 + SHM_V, pa0, pa1, pa2, pa3);
  if (hi == 0) li_l[r32] = l_reg; asm volatile("s_waitcnt lgkmcnt(0)" ::: "memory");
  float rli[16];
#pragma unroll
  for (int r = 0; r < 16; ++r) rli[r] = __builtin_amdgcn_rcpf(li_l[crow(r, hi)]);
  if constexpr (MODE == 0) {
#pragma unroll
  for (int r = 0; r < 16; ++r) { float s = 0.f;
#pragma unroll
    for (int d0 = 0; d0 < 4; ++d0) { o[d0][r] *= rli[r]; s += o[d0][r] * o[d0][r]; }
    RS[crow(r, hi) * 33 + r32] = s; }
  asm volatile("s_waitcnt lgkmcnt(0)" ::: "memory");
  { float s = 0.f;
#pragma unroll
    for (int c = 0; c < 32; ++c) s += RS[r32 * 33 + c];
    if (hi == 0) RV[r32] = rsqrtf(s * (1.f / D) + EPS); }
  asm volatile("s_waitcnt lgkmcnt(0)" ::: "memory");
  float gn[4];
#pragma unroll
  for (int d0 = 0; d0 < 4; ++d0) gn[d0] = gain[h * D + d0 * 32 + r32];
  bf16_t* Ow = merged + (rowbase + qb * 256 + wid * QBLK) * LDO + h * D;
#pragma unroll
  for (int r = 0; r < 16; ++r) { const int orow = crow(r, hi); const float rv = RV[orow];
#pragma unroll
    for (int d0 = 0; d0 < 4; ++d0) Ow[(long)orow * LDO + d0 * 32 + r32] = (bf16_t)f2bf(o[d0][r] * rv * gn[d0]); }
  } else {
    bf16_t* Ow = merged + (rowbase + qb * 256 + wid * QBLK) * LDO + h * D;
#pragma unroll
    for (int r = 0; r < 16; ++r) { const int orow = crow(r, hi);
#pragma unroll
      for (int d0 = 0; d0 < 4; ++d0) Ow[(long)orow * LDO + d0 * 32 + r32] = (bf16_t)f2bf(o[d0][r] * rli[r]); }
  }
#undef SLOAD
#undef SWRITE
#undef SWAIT
#undef RESC
}
#undef KSWZ
#undef SBAR
}

#define LAS __attribute__((address_space(3)))
#define XB_TMO      128
#define XB_XCNT(j)  (256  + 64 * (j))
#define XB_XSUB(j)  (1280 + 64 * (j))
#define XB_XGEN(j)  (2304 + 64 * (j))
#define XB_TOP      3328
#define XB_TOPGEN   3392
#define XCD_BAR_WORDS 3456
#define XB_SPIN_CAP (1u << 18)

__device__ __forceinline__ unsigned xb_ld(unsigned* p)              { return __hip_atomic_load(p, __ATOMIC_RELAXED, __HIP_MEMORY_SCOPE_AGENT); }
__device__ __forceinline__ unsigned xb_add(unsigned* p, unsigned v) { return __hip_atomic_fetch_add(p, v, __ATOMIC_RELAXED, __HIP_MEMORY_SCOPE_AGENT); }
__device__ __forceinline__ unsigned xb_xcc_id() { return (unsigned)__builtin_amdgcn_s_getreg((3 << 11) | 20) & 0xFu; }
#define XB_SPIN(cond, bar) do { unsigned _sp = 0; while (cond) { __builtin_amdgcn_s_sleep(1); \
    if ((++_sp & 255u) == 0u) { if (xb_ld(&(bar)[XB_TMO])) break; if (_sp > XB_SPIN_CAP) { atomicAdd(&(bar)[XB_TMO], 1u); break; } } } } while (0)

struct XcdBarrier {
    unsigned* bar; unsigned x;
    volatile LAS unsigned* st;
};

__device__ __forceinline__ XcdBarrier xcd_barrier_post(unsigned* bar, volatile LAS unsigned* st) {
    XcdBarrier b; b.bar = bar; b.x = xb_xcc_id(); b.st = st;
    if (threadIdx.x == 0) (void)xb_add(&bar[XB_XCNT(b.x)], 1u);
    return b;
}
__device__ __forceinline__ void xcd_barrier_complete(unsigned* bar, unsigned x, unsigned& nloc, unsigned& nx) {
    const unsigned G = gridDim.x * gridDim.y * gridDim.z;
    unsigned sum, cnt, mine, sp = 0u;
    for (;;) {
        sum = 0u; cnt = 0u; mine = 0u;
#pragma unroll
        for (unsigned j = 0; j < 16; ++j) { const unsigned c = xb_ld(&bar[XB_XCNT(j)]); sum += c; cnt += (c > 0u) ? 1u : 0u; mine = (j == x) ? c : mine; }
        if (sum == G) break;
        __builtin_amdgcn_s_sleep(1);
        if ((++sp & 255u) == 0u) { if (xb_ld(&bar[XB_TMO])) break; if (sp > XB_SPIN_CAP) { atomicAdd(&bar[XB_TMO], 1u); break; } }
    }
    nloc = mine > 0u ? mine : 1u; nx = cnt > 0u ? cnt : 1u;
}

__device__ __forceinline__ void xcd_barrier(const XcdBarrier& b) {
    asm volatile("s_waitcnt vmcnt(0)" ::: "memory");
    __syncthreads();
    if (threadIdx.x == 0) {
        unsigned* bar = b.bar;
        __builtin_amdgcn_s_waitcnt(0);
        unsigned nloc = b.st[0], nx = b.st[1];
        if (nloc == 0u) { xcd_barrier_complete(bar, b.x, nloc, nx); b.st[0] = nloc; b.st[1] = nx; }
        const unsigned old = xb_add(&bar[XB_XSUB(b.x)], 1u);
        const unsigned gen = old / nloc;
        if (old + 1u == (gen + 1u) * nloc) {
            __builtin_amdgcn_fence(__ATOMIC_RELEASE, "agent");
            asm volatile("s_waitcnt vmcnt(0)" ::: "memory");
            const unsigned og = xb_add(&bar[XB_TOP], 1u);
            const unsigned tg = og / nx;
            if (og + 1u == (tg + 1u) * nx) xb_add(&bar[XB_TOPGEN], 1u);
            else XB_SPIN(xb_ld(&bar[XB_TOPGEN]) == tg, bar);
            __builtin_amdgcn_fence(__ATOMIC_ACQUIRE, "agent");
            xb_add(&bar[XB_XGEN(b.x)], 1u);
            asm volatile("s_waitcnt vmcnt(0)" ::: "memory");
        } else {
            XB_SPIN(xb_ld(&bar[XB_XGEN(b.x)]) == gen, bar);
            __builtin_amdgcn_fence(__ATOMIC_ACQUIRE, "agent");
            asm volatile("s_waitcnt vmcnt(0)" ::: "memory");
        }
    }
    __syncthreads();
}

namespace cg = cooperative_groups;
constexpr int LDS_BYTES = 147456;
struct Args { const void* in[20]; float* out; unsigned char* ws; };
__global__ void __launch_bounds__(512, 2) mk_fwd(Args a) {
    extern __shared__ __attribute__((aligned(16))) unsigned char lds[];
    cg::grid_group grid = cg::this_grid();
    const int G = (int)gridDim.x, bx = (int)blockIdx.x;
    const int NGW = G * 8, NT = G * 512;
    volatile LAS unsigned* bar_st = (volatile LAS unsigned*)((LAS unsigned char*)lds + 131072 + 64);
    { const int t0 = otid(); if (bx == 0) for (int i = t0; i < XCD_BAR_WORDS; i += 512) __hip_atomic_store((unsigned*)(a.ws + WS_BAR) + i, 0u, __ATOMIC_RELAXED, __HIP_MEMORY_SCOPE_AGENT); if (t0 < 2) bar_st[t0] = 0u; }
    __syncthreads();
#define IDS() const int tid = otid(), lane = tid & 63, wave = __builtin_amdgcn_readfirstlane(tid >> 6); const int gw = bx * 8 + wave, gtid = bx * 512 + tid; float* wscr = (float*)(lds + wave * 16384); (void)lane; (void)gw; (void)gtid; (void)wscr
#define IN_F(k) ((const float*)a.in[k])
#define WSP(T, off) ((T)(a.ws + (off)))
#define x IN_F(0)
#define mem IN_F(1)
#define pos ((const int*)a.in[2])
#define g_mix IN_F(3)
#define w_in IN_F(4)
#define w_conv IN_F(5)
#define b_conv IN_F(6)
#define g_attn IN_F(7)
#define g_conv IN_F(8)
#define w_out IN_F(9)
#define g_xattn IN_F(10)
#define g_mem IN_F(11)
#define w_xq IN_F(12)
#define w_xkv IN_F(13)
#define w_xo IN_F(14)
#define g_ffn IN_F(15)
#define w_gate IN_F(16)
#define w_up IN_F(17)
#define w_down IN_F(18)
#define g_final IN_F(19)
#define out (a.out)
#define Win WSP(bf16_t*, WS_WIN)
#define Wout WSP(bf16_t*, WS_WOUT)
#define Wxq WSP(bf16_t*, WS_WXQ)
#define Wxkv WSP(bf16_t*, WS_WXKV)
#define Wxo WSP(bf16_t*, WS_WXO)
#define Wgu WSP(bf16_t*, WS_WGU)
#define Wdn WSP(bf16_t*, WS_WDN)
#define H WSP(bf16_t*, WS_H)
#define MRG WSP(bf16_t*, WS_MRG)
#define PROJ WSP(bf16_t*, WS_PROJ)
#define ACT WSP(bf16_t*, WS_ACT)
#define QX WSP(bf16_t*, WS_QX)
#define OX WSP(bf16_t*, WS_OX)
#define KVX WSP(bf16_t*, WS_KVX)
#define MEMN WSP(bf16_t*, WS_MEMN)
#define CS WSP(float*, WS_CS)
#define KMEAN WSP(float*, WS_KMEAN)
#define SS1 WSP(float*, WS_SS)
#define SS2 WSP(float*, WS_SS + 2 * MiB)
#define SS3 WSP(float*, WS_SS + 4 * MiB)
    PG8_LAS unsigned char* ldsg = (PG8_LAS unsigned char*)lds;

#define GEMM(EpiT, Aop, Bop, Mr, Nc, Kd, ...) do { pg8::Gemm g_{Aop, Bop, Mr, Nc, Kd, 0}; pg8::StaticOrder S_; S_.init(Mr, Nc, G, bx); EpiT E_{__VA_ARGS__}; \
        pg8::gemm_phase<EpiT, pg8::StaticOrder, true, true>(ldsg, g_, S_, E_); } while (0)
#define GEMM8(EpiT, Aop, Bop, Mr, Nc, Kd, ...) do { pg8::Gemm g_{Aop, Bop, Mr, Nc, Kd, 0}; pg8::StaticOrder S_; S_.init(Mr, Nc, G, bx); EpiT E_{__VA_ARGS__}; \
        pg8::gemm_phase<EpiT, pg8::StaticOrder, true, true, true, 0x77777777>(ldsg, g_, S_, E_); } while (0)

    {
        IDS();
        int base = 0;
        base = ph_transpose_job(TJob{w_in, nullptr, nullptr, Win, DM, NPROJ, NPROJ, 1, 1.f, 0}, base, wscr, gw, NGW, lane);
        base = ph_transpose_job(TJob{w_out, nullptr, nullptr, Wout, DM, DM, DM, 0, 1.f, 0}, base, wscr, gw, NGW, lane);
        base = ph_transpose_job(TJob{w_xq, nullptr, g_xattn, Wxq, DM, XW, XW, 0, 1.f, 0}, base, wscr, gw, NGW, lane);
        base = ph_transpose_job(TJob{w_xkv, nullptr, nullptr, Wxkv, DM, 2 * XW, 2 * XW, 0, 1.f, 0}, base, wscr, gw, NGW, lane);
        base = ph_transpose_job(TJob{w_xo, nullptr, nullptr, Wxo, XW, DM, DM, 0, 1.f, 0}, base, wscr, gw, NGW, lane);
    }
    { IDS(); ph_cs(pos, CS, gtid, NT); for (int i = gtid; i < NB * NH * NBLK * HD; i += NT) KMEAN[i] = 0.f; }
    { IDS(); ph_rms_bf16(x, g_mix, H, MT, gw, NGW, lane); ph_rms_bf16(mem, g_mem, MEMN, NB * NMEM, gw, NGW, lane); }
    grid.sync();
    const XcdBarrier bar = xcd_barrier_post((unsigned*)(a.ws + WS_BAR), bar_st);
    GEMM(pg8::EpiInProj, H, Win, MT, NPROJ, DM, PROJ, CS, KMEAN);
    xcd_barrier(bar);
    {
        const int vcu = (G % 8 == 0) ? (bx % 8) * (G / 8) + bx / 8 : bx;
        for (int p = vcu; p < NB * NH * 8; p += G) {
            const int bh = p >> 3, s = p & 7;
            moba::unit<0>(bh >> 3, bh & 7, s, PROJ, nullptr, KMEAN, g_attn, MRG, (char*)lds);
            moba::unit<0>(bh >> 3, bh & 7, 15 - s, PROJ, nullptr, KMEAN, g_attn, MRG, (char*)lds);
        }
        __syncthreads();
    }
    { IDS(); ph_conv(PROJ, w_conv, b_conv, g_conv, MRG, gw, NGW, lane); }
    xcd_barrier(bar);
    GEMM(pg8::EpiResNorm<1>, MRG, Wout, MT, DM, DM, x, out, H, SS1);
    xcd_barrier(bar);
    GEMM(pg8::EpiRowScaleBf16, H, Wxq, MT, XW, DM, QX, SS1, XW, 0);
    { pg8::Gemm g_{MEMN, Wxkv, NB * NMEM, 2 * XW, DM, 0}; pg8::StaticOrder S_; S_.init(NB * NMEM, 2 * XW, G, (bx + G - 128 % G) % G); pg8::EpiStoreBf16 E_{KVX, 2 * XW, 0};
      pg8::gemm_phase<pg8::EpiStoreBf16, pg8::StaticOrder, true, true>(ldsg, g_, S_, E_); }
    {
        IDS();
        const int nidle = (G > 144 + 16) ? G - 144 : G, first = (G > 144 + 16) ? 144 : 0;
        if (bx >= first) {
            const int gw2 = (bx - first) * 8 + wave, NGW2 = nidle * 8; int base = 0;
            base = ph_transpose_job(TJob{w_gate, w_up, g_ffn, Wgu, DM, DFF, 2 * DFF, 2, 256.f, 1}, base, wscr, gw2, NGW2, lane);
            base = ph_transpose_job(TJob{w_down, nullptr, nullptr, Wdn, DFF, DM, DM, 0, 256.f, 1}, base, wscr, gw2, NGW2, lane);
        }
    }
    xcd_barrier(bar);
    {
        const int vcu = (G % 8 == 0) ? (bx % 8) * (G / 8) + bx / 8 : bx;
        for (int p = vcu; p < NB * XH * (SEQ / 256); p += G) { const int bh = p >> 4, qt = p & 15; moba::unit<1>(bh >> 2, bh & 3, qt, QX, KVX, nullptr, nullptr, OX, (char*)lds); }
        __syncthreads();
    }
    xcd_barrier(bar);
    GEMM(pg8::EpiResNorm<2>, OX, Wxo, MT, DM, XW, out, out, H, SS2);
    xcd_barrier(bar);
    GEMM8(pg8::EpiSwiGLUNorm<true>, H, Wgu, MT, 2 * DFF, DM, ACT, SS2, DFF, 0);
    xcd_barrier(bar);
    GEMM8(pg8::EpiResNorm<0>, ACT, Wdn, MT, DM, DFF, out, out, nullptr, SS3);
    xcd_barrier(bar);
    { IDS(); ph_final_norm(out, g_final, SS3, MT, gw, NGW, lane); }
#undef GEMM
#undef GEMM8
#undef IDS
#undef x
#undef mem
#undef pos
#undef g_mix
#undef w_in
#undef w_conv
#undef b_conv
#undef g_attn
#undef g_conv
#undef w_out
#undef g_xattn
#undef g_mem
#undef w_xq
#undef w_xkv
#undef w_xo
#undef g_ffn
#undef w_gate
#undef w_up
#undef w_down
#undef g_final
#undef out
#undef Win
#undef Wout
#undef Wxq
#undef Wxkv
#undef Wxo
#undef Wgu
#undef Wdn
#undef H
#undef MRG
#undef PROJ
#undef ACT
#undef QX
#undef OX
#undef KVX
#undef MEMN
#undef CS
#undef KMEAN
#undef SS1
#undef SS2
#undef SS3
#undef IN_F
#undef WSP
}

extern "C" void kernel_launch(void* const* d_in, const int* in_sizes, int n_in, void* d_out, int out_size, void* d_ws, size_t ws_size, hipStream_t stream) {
    static int grid_blocks = 0;
    if (grid_blocks == 0) {
        if (n_in != 20 || ws_size < WS_END) { fprintf(stderr, "kernel_launch: unexpected n_in %d / ws %zu\n", n_in, ws_size); grid_blocks = -1; return; }
        int dev = 0, cus = 0, per_cu = 0;
        (void)hipGetDevice(&dev); (void)hipDeviceGetAttribute(&cus, hipDeviceAttributeMultiprocessorCount, dev);
        (void)hipFuncSetAttribute((const void*)mk_fwd, hipFuncAttributeMaxDynamicSharedMemorySize, LDS_BYTES);
        (void)hipOccupancyMaxActiveBlocksPerMultiprocessor(&per_cu, (const void*)mk_fwd, 512, LDS_BYTES);
        if (per_cu < 1) { fprintf(stderr, "kernel_launch: occupancy query says %d blocks per CU\n", per_cu); per_cu = 1; }
        grid_blocks = cus;
        (void)hipGetLastError();
    }
    if (grid_blocks < 0) return;
    Args a{};
    for (int i = 0; i < 20; ++i) a.in[i] = d_in[i];
    a.out = (float*)d_out; a.ws = (unsigned char*)d_ws;
    void* args[] = {&a};
    hipError_t e = hipLaunchCooperativeKernel((const void*)mk_fwd, dim3(grid_blocks), dim3(512), args, LDS_BYTES, stream);
    if (e != hipSuccess) fprintf(stderr, "cooperative launch failed: %s (grid %d)\n", hipGetErrorString(e), grid_blocks);
}
```

```cpp
#include <hip/hip_runtime.h>
#include <hip/hip_cooperative_groups.h>
#include <cstdio>
#include <cstdint>
#include <cmath>
__device__ __forceinline__ int otid() { int t = (int)threadIdx.x; asm volatile("" : "+v"(t)); return t; }
namespace pg8 {
#define PG8_LAS __attribute__((address_space(3)))
typedef unsigned short bf16_t;
typedef short bf16x8 __attribute__((ext_vector_type(8)));
typedef float f32x4 __attribute__((ext_vector_type(4)));
typedef unsigned u32x4 __attribute__((ext_vector_type(4)));
constexpr int BM = 256, BK = 64, HALF = 128, HTB = HALF * BK * 2  , STAGE_BYTES = 8 * HTB, NXCD = 8, WGM = 8;

__host__ __device__ __forceinline__ int lds_byte(int r, int c) { const int st = (r >> 4) * 2 + (c >> 5), rr = r & 15, cc = c & 31, ob = rr * 64 + cc * 2; return st * 1024 + (ob ^ (((ob >> 9) & 1) << 5)); }
__host__ __device__ __forceinline__ void stage_rc(int b, int& R, int& C) { const int st = b / 1024, sb = b % 1024, swz = sb ^ (((sb >> 9) & 1) << 5); R = (st >> 1) * 16 + swz / 64; C = (st & 1) * 32 + (swz % 64) / 2; }
__host__ __device__ __forceinline__ int f8swz(int fr) { return (fr >> 1) ^ ((fr >= 4 && fr <= 11) ? 2 : 0); }
__host__ __device__ __forceinline__ void stage_rc8(int b, int& R, int& C) { const int fr = (b >> 7) & 15; R = (b >> 11) * 16 + fr; C = ((((b >> 4) & 7) ^ f8swz(fr)) * 8); }
__host__ __device__ __forceinline__ int perm32(int rho) { const int n = rho >> 4, i = rho & 15; return 8 * (i >> 2) + 4 * n + (i & 3); }

struct Unit { int pm, pn; };
struct Gemm { const bf16_t* A; const bf16_t* Bt; int M, N, K, pad; };

struct StaticOrder {
    int nM, nN, nwg, G, c;
    __host__ __device__ void init(int M, int N, int G_, int c_) { nM = M / BM; nN = N / BM; nwg = nM * nN; G = G_; c = c_; }
    __host__ __device__ bool next(int i, Unit& u) const {
        const long L = (long)i * G + c; if (L >= nwg) return false;
        int wgid = (int)L; { const int q = nwg / NXCD, r = nwg % NXCD, xcd = wgid % NXCD, off = wgid / NXCD; wgid = (xcd < r ? xcd * (q + 1) : r * (q + 1) + (xcd - r) * q) + off; }
        const int nig = WGM * nN, gid = wgid / nig, fm = gid * WGM, gsz = (nM - fm) < WGM ? (nM - fm) : WGM;
        u.pm = fm + ((wgid % nig) % gsz); u.pn = (wgid % nig) / gsz; return true;
    }
    __device__ __forceinline__ void a_ready(const Unit&) const {}
    __device__ __forceinline__ void done(const Unit&) const {}
};
__device__ __forceinline__ unsigned cvt_pk_bf16(float lo, float hi) { unsigned r; asm volatile("v_cvt_pk_bf16_f32 %0, %1, %2" : "=v"(r) : "v"(lo), "v"(hi)); return r; }
__device__ __forceinline__ unsigned pk4_fp8(float a, float b, float c, float d) {
    a = __builtin_amdgcn_fmed3f(a, -448.f, 448.f); b = __builtin_amdgcn_fmed3f(b, -448.f, 448.f); c = __builtin_amdgcn_fmed3f(c, -448.f, 448.f); d = __builtin_amdgcn_fmed3f(d, -448.f, 448.f);
    int r = 0; r = __builtin_amdgcn_cvt_pk_fp8_f32(a, b, r, false); r = __builtin_amdgcn_cvt_pk_fp8_f32(c, d, r, true); return (unsigned)r;
}
__device__ __forceinline__ void mfma_f8(f32x4& acc, const bf16x8& w0, const bf16x8& w1, const bf16x8& a0, const bf16x8& a1, int scale_w, int scale_a) {
    typedef int i32x8_ __attribute__((ext_vector_type(8))); typedef int i32x4_ __attribute__((ext_vector_type(4)));
    const i32x4_ p0 = __builtin_bit_cast(i32x4_, w0), p1 = __builtin_bit_cast(i32x4_, w1), q0 = __builtin_bit_cast(i32x4_, a0), q1 = __builtin_bit_cast(i32x4_, a1);
    const i32x8_ W = {p0[0], p0[1], p0[2], p0[3], p1[0], p1[1], p1[2], p1[3]}, A = {q0[0], q0[1], q0[2], q0[3], q1[0], q1[1], q1[2], q1[3]};
    asm volatile("v_mfma_scale_f32_16x16x128_f8f6f4 %0, %1, %2, %0, %3, %4 op_sel_hi:[0,0,0]" : "+v"(acc) : "v"(W), "v"(A), "v"(scale_w), "v"(scale_a));
}
template <class Epi, class Sched, bool ALIGN_EPI = false, bool SP2 = false, bool F8 = false, int SCALE_W = 0x7f7f7f7f>
__device__ __forceinline__ void gemm_phase(PG8_LAS unsigned char* lds, const Gemm g, const Sched& S, const Epi& E) {
    const int tid = otid(), wid = __builtin_amdgcn_readfirstlane(tid >> 6), lane = tid & 63, wr = wid >> 2, wc = wid & 3, fr = lane & 15, fq = lane >> 4;
    const int K = F8 ? g.K / 2 : g.K, nt = K / BK;
    unsigned voffA[2], voffB[2];
#pragma unroll
    for (int i = 0; i < 2; ++i) { int R, C; if constexpr (F8) stage_rc8(tid * 16 + i * 8192, R, C); else stage_rc(tid * 16 + i * 8192, R, C); const int Rb = Epi::PERM ? ((R & ~31) + perm32(R & 31)) : R;
        voffA[i] = (unsigned)(R * K + C) * 2u; voffB[i] = (unsigned)(Rb * K + C) * 2u; }
    const size_t kstep = (size_t)(BK * 2);
    const size_t hstep = (size_t)HALF * K * 2;
    const size_t tstep = 2 * hstep;
    const unsigned ldsw = (unsigned)wid * 1024u;
    int aoffk[2], boffk[2];
#pragma unroll
    for (int k = 0; k < 2; ++k) {
        if constexpr (F8) { const int ch = (((2 * fq + k) ^ f8swz(fr)) << 4); aoffk[k] = wr * 4 * 2048 + fr * 128 + ch; boffk[k] = wc * 2 * 2048 + fr * 128 + ch; }
        else { aoffk[k] = lds_byte(wr * 64 + fr, fq * 8) + k * 1024; boffk[k] = lds_byte(wc * 32 + fr, fq * 8) + k * 1024; } }
#define PG8_SA(b, h) (((b) * 2 + (h)) * HTB)
#define PG8_SB(b, h) ((4 + (b) * 2 + (h)) * HTB)
#define PG8_STAGE(bufoff, gbase, voff) do { _Pragma("unroll") for (int _i = 0; _i < 2; ++_i) \
        __builtin_amdgcn_global_load_lds((const unsigned*)((const char*)(gbase) + (voff)[_i]), (PG8_LAS unsigned*)(lds + (bufoff) + ldsw + _i * 8192), 16, 0, 0); } while (0)
#define PG8_LDA(dst, b, h) do { _Pragma("unroll") for (int m = 0; m < 4; ++m) _Pragma("unroll") for (int k = 0; k < 2; ++k) dst[m][k] = *(const PG8_LAS bf16x8*)(lds + PG8_SA(b, h) + aoffk[k] + m * 2048); } while (0)
#define PG8_LDB(dst, b, h) do { _Pragma("unroll") for (int n = 0; n < 2; ++n) _Pragma("unroll") for (int k = 0; k < 2; ++k) dst[n][k] = *(const PG8_LAS bf16x8*)(lds + PG8_SB(b, h) + boffk[k] + n * 2048); } while (0)
#define PG8_MMA(ai, bj, At, Bt) do { __builtin_amdgcn_s_setprio(1); _Pragma("unroll") for (int m = 0; m < 4; ++m) _Pragma("unroll") for (int n = 0; n < 2; ++n) { \
        if constexpr (F8) { mfma_f8(acc[ai][bj][m][n], Bt[n][0], Bt[n][1], At[m][0], At[m][1], SCALE_W, 0x7f7f7f7f); } \
        else { _Pragma("unroll") for (int k = 0; k < 2; ++k) acc[ai][bj][m][n] = __builtin_amdgcn_mfma_f32_16x16x32_bf16(Bt[n][k], At[m][k], acc[ai][bj][m][n], 0, 0, 0); } } \
        __builtin_amdgcn_s_setprio(0); } while (0)
#define PG8_WAIT_V(n) asm volatile("s_waitcnt vmcnt(" #n ")" ::: "memory")
#define PG8_WAIT_L(n) asm volatile("s_waitcnt lgkmcnt(" #n ")" ::: "memory")
#define PG8_BAR __builtin_amdgcn_s_barrier()
#define PG8_SCHED __builtin_amdgcn_sched_barrier(0)
    Unit cur, nxt; int ui = 0;
    if (!S.next(0, cur)) return;
    f32x4 acc[2][2][4][2];
#pragma unroll
    for (int a = 0; a < 2; ++a)
#pragma unroll
        for (int b = 0; b < 2; ++b)
#pragma unroll
            for (int m = 0; m < 4; ++m)
#pragma unroll
                for (int n = 0; n < 2; ++n) acc[a][b][m][n] = (f32x4){0.f, 0.f, 0.f, 0.f};
    bf16x8 At[4][2], B0[2][2], B1[2][2];
    const char* cA = (const char*)g.A + (size_t)cur.pm * tstep; const char* cB = (const char*)g.Bt + (size_t)cur.pn * tstep;
    S.a_ready(cur);
    if constexpr (SP2) {
        PG8_STAGE(PG8_SB(0, 0), cB, voffB); PG8_STAGE(PG8_SB(0, 1), cB + hstep, voffB); PG8_STAGE(PG8_SA(0, 0), cA, voffA); PG8_STAGE(PG8_SA(0, 1), cA + hstep, voffA);
        if (wr == 1) PG8_BAR;
        PG8_WAIT_V(2); PG8_BAR;
        PG8_STAGE(PG8_SB(1, 0), cB + kstep, voffB); PG8_STAGE(PG8_SA(1, 0), cA + kstep, voffA); PG8_STAGE(PG8_SB(1, 1), cB + hstep + kstep, voffB);
        PG8_WAIT_V(6); PG8_BAR;
    } else {
        PG8_STAGE(PG8_SB(0, 0), cB, voffB); PG8_STAGE(PG8_SA(0, 0), cA, voffA); PG8_STAGE(PG8_SB(0, 1), cB + hstep, voffB); PG8_STAGE(PG8_SA(0, 1), cA + hstep, voffA);
        if (wr == 1) PG8_BAR;
        PG8_WAIT_V(4); PG8_BAR;
        PG8_STAGE(PG8_SB(1, 0), cB + kstep, voffB); PG8_STAGE(PG8_SA(1, 0), cA + kstep, voffA); PG8_STAGE(PG8_SB(1, 1), cB + hstep + kstep, voffB);
        PG8_WAIT_V(6); PG8_BAR;
    }
    for (;;) {
        const bool has_next = S.next(ui + 1, nxt);
        const char* nA = has_next ? (const char*)g.A + (size_t)nxt.pm * tstep : cA; const char* nB = has_next ? (const char*)g.Bt + (size_t)nxt.pn * tstep : cB;
        for (int t = 0; t < nt; t += 2) {
            const bool last = (t == nt - 2);
            const char* a1 = cA + (size_t)(t + 1) * kstep;
            const char* a2 = last ? nA : cA + (size_t)(t + 2) * kstep; const char* b2 = last ? nB : cB + (size_t)(t + 2) * kstep;
            const char* a3 = a2 + kstep; const char* b3 = b2 + kstep;
            if (last && has_next) S.a_ready(nxt);
            if constexpr (SP2) {
            PG8_LDB(B0, 0, 0); PG8_LDB(B1, 0, 1); PG8_SCHED; PG8_LDA(At, 0, 0); PG8_STAGE(PG8_SA(1, 1), a1 + hstep, voffA);
            PG8_WAIT_V(8); PG8_WAIT_L(0); PG8_BAR; PG8_MMA(0, 0, At, B0); PG8_MMA(0, 1, At, B1); PG8_BAR; PG8_SCHED;
            PG8_LDA(At, 0, 1); PG8_STAGE(PG8_SB(0, 0), b2, voffB); PG8_STAGE(PG8_SB(0, 1), b2 + hstep, voffB); PG8_STAGE(PG8_SA(0, 0), a2, voffA);
            PG8_WAIT_V(8); PG8_WAIT_L(0); PG8_BAR; PG8_MMA(1, 0, At, B0); PG8_MMA(1, 1, At, B1); PG8_BAR; PG8_SCHED;
            PG8_LDB(B0, 1, 0); PG8_LDB(B1, 1, 1); PG8_SCHED; PG8_LDA(At, 1, 0); PG8_STAGE(PG8_SA(0, 1), a2 + hstep, voffA);
            PG8_WAIT_V(8); PG8_WAIT_L(0); PG8_BAR; PG8_MMA(0, 0, At, B0); PG8_MMA(0, 1, At, B1); PG8_BAR; PG8_SCHED;
            PG8_LDA(At, 1, 1); PG8_STAGE(PG8_SB(1, 0), b3, voffB); PG8_STAGE(PG8_SB(1, 1), b3 + hstep, voffB); PG8_STAGE(PG8_SA(1, 0), a3, voffA);
            PG8_WAIT_V(8); PG8_WAIT_L(0); PG8_BAR; PG8_MMA(1, 0, At, B0); PG8_MMA(1, 1, At, B1); PG8_BAR; PG8_SCHED;
            } else {
            PG8_LDB(B0, 0, 0); PG8_SCHED; PG8_LDA(At, 0, 0); PG8_STAGE(PG8_SA(1, 1), a1 + hstep, voffA);
            PG8_WAIT_L(8); PG8_BAR; PG8_WAIT_L(0); PG8_MMA(0, 0, At, B0); PG8_BAR; PG8_SCHED;
            PG8_LDB(B1, 0, 1); PG8_STAGE(PG8_SB(0, 0), b2, voffB);
            PG8_BAR; PG8_WAIT_L(0); PG8_MMA(0, 1, At, B1); PG8_BAR;
            PG8_LDA(At, 0, 1); PG8_STAGE(PG8_SA(0, 0), a2, voffA);
            PG8_BAR; PG8_WAIT_L(0); PG8_MMA(1, 0, At, B0); PG8_BAR; PG8_SCHED;
            PG8_STAGE(PG8_SB(0, 1), b2 + hstep, voffB);
            PG8_WAIT_V(6); PG8_BAR; PG8_MMA(1, 1, At, B1); PG8_BAR;
            PG8_LDB(B0, 1, 0); PG8_SCHED; PG8_LDA(At, 1, 0); PG8_STAGE(PG8_SA(0, 1), a2 + hstep, voffA);
            PG8_WAIT_L(8); PG8_BAR; PG8_WAIT_L(0); PG8_MMA(0, 0, At, B0); PG8_BAR; PG8_SCHED;
            PG8_LDB(B1, 1, 1); PG8_STAGE(PG8_SB(1, 0), b3, voffB);
            PG8_BAR; PG8_WAIT_L(0); PG8_MMA(0, 1, At, B1); PG8_BAR;
            PG8_LDA(At, 1, 1); PG8_STAGE(PG8_SA(1, 0), a3, voffA);
            PG8_BAR; PG8_WAIT_L(0); PG8_MMA(1, 0, At, B0); PG8_BAR; PG8_SCHED;
            PG8_STAGE(PG8_SB(1, 1), b3 + hstep, voffB);
            PG8_WAIT_V(6); PG8_BAR; PG8_MMA(1, 1, At, B1); PG8_BAR;
            }
        }
        if constexpr (ALIGN_EPI) { if (wr == 0) PG8_BAR; }
        if constexpr (F8) asm volatile("s_nop 15\n\ts_nop 15" ::: "memory");
        if constexpr (!Epi::AFTER_DRAIN) { E(acc, cur, wr, wc, fr, fq); S.done(cur); }
        if (!has_next) break;
#pragma unroll
        for (int a = 0; a < 2; ++a)
#pragma unroll
            for (int b = 0; b < 2; ++b)
#pragma unroll
                for (int m = 0; m < 4; ++m)
#pragma unroll
                    for (int n = 0; n < 2; ++n) acc[a][b][m][n] = (f32x4){0.f, 0.f, 0.f, 0.f};
        cur = nxt; cA = nA; cB = nB; ++ui;
        if constexpr (ALIGN_EPI) { if (wr == 1) PG8_BAR; }
    }
    PG8_WAIT_V(0);
    if constexpr (!ALIGN_EPI) { if (wr == 0) PG8_BAR; }
    PG8_BAR;
    if constexpr (Epi::AFTER_DRAIN) { E.fused(acc, cur, wr, wc, fr, fq, lds, wid, lane); S.done(cur); }
#undef PG8_SA
#undef PG8_SB
#undef PG8_STAGE
#undef PG8_LDA
#undef PG8_LDB
#undef PG8_MMA
#undef PG8_WAIT_V
#undef PG8_WAIT_L
#undef PG8_BAR
#undef PG8_SCHED
}
}

namespace pg8 {
struct EpiStoreBf16 {
    static constexpr bool PERM = true, AFTER_DRAIN = false;
    bf16_t* O; int ldc, pad;
    __device__ __forceinline__ void operator()(const f32x4 (&acc)[2][2][4][2], const Unit& u, int wr, int wc, int fr, int fq) const {
        const int row0 = u.pm * BM + wr * 64 + fr, col0 = u.pn * BM + wc * 32 + 8 * fq;
#pragma unroll
        for (int ai = 0; ai < 2; ++ai)
#pragma unroll
            for (int m = 0; m < 4; ++m) { bf16_t* rowp = O + (size_t)(row0 + ai * HALF + m * 16) * ldc + col0;
#pragma unroll
                for (int bj = 0; bj < 2; ++bj) { const f32x4 v0 = acc[ai][bj][m][0], v1 = acc[ai][bj][m][1];
                    u32x4 w; w.x = cvt_pk_bf16(v0[0], v0[1]); w.y = cvt_pk_bf16(v0[2], v0[3]); w.z = cvt_pk_bf16(v1[0], v1[1]); w.w = cvt_pk_bf16(v1[2], v1[3]);
                    *(u32x4*)(rowp + bj * HALF) = w; } }
    }
};
struct EpiResF32 {
    static constexpr bool PERM = false, AFTER_DRAIN = false;
    const float* base; float* out; int ldc, pad;
    __device__ __forceinline__ void operator()(const f32x4 (&acc)[2][2][4][2], const Unit& u, int wr, int wc, int fr, int fq) const {
        const int row0 = u.pm * BM + wr * 64 + fr, col0 = u.pn * BM + wc * 32 + 4 * fq;
#pragma unroll
        for (int ai = 0; ai < 2; ++ai)
#pragma unroll
            for (int m = 0; m < 4; ++m) { const size_t off = (size_t)(row0 + ai * HALF + m * 16) * ldc + col0;
#pragma unroll
                for (int bj = 0; bj < 2; ++bj)
#pragma unroll
                    for (int n = 0; n < 2; ++n) { const f32x4 b = *(const f32x4*)(base + off + bj * HALF + n * 16); *(f32x4*)(out + off + bj * HALF + n * 16) = b + acc[ai][bj][m][n]; } }
    }
};
struct EpiSwiGLU {
    static constexpr bool PERM = true, AFTER_DRAIN = false;
    bf16_t* O; int ldc, pad;
    __device__ __forceinline__ void operator()(const f32x4 (&acc)[2][2][4][2], const Unit& u, int wr, int wc, int fr, int fq) const {
        const int row0 = u.pm * BM + wr * 64 + fr, col0 = u.pn * HALF + wc * 32 + 8 * fq;
#pragma unroll
        for (int ai = 0; ai < 2; ++ai)
#pragma unroll
            for (int m = 0; m < 4; ++m) { bf16_t* rowp = O + (size_t)(row0 + ai * HALF + m * 16) * ldc + col0;
                float r[8];
#pragma unroll
                for (int n = 0; n < 2; ++n)
#pragma unroll
                    for (int e = 0; e < 4; ++e) { const float g = acc[ai][0][m][n][e], up = acc[ai][1][m][n][e]; r[n * 4 + e] = g * up / (1.0f + __expf(-g)); }
                u32x4 w; w.x = cvt_pk_bf16(r[0], r[1]); w.y = cvt_pk_bf16(r[2], r[3]); w.z = cvt_pk_bf16(r[4], r[5]); w.w = cvt_pk_bf16(r[6], r[7]);
                *(u32x4*)rowp = w; }
    }
};
}

namespace pg8 {
struct EpiInProj {
    static constexpr bool PERM = true, AFTER_DRAIN = false;
    bf16_t* O; const float* cs; float* kmean;
    __device__ __forceinline__ void operator()(const f32x4 (&acc)[2][2][4][2], const Unit& u, int wr, int wc, int fr, int fq) const {
        const int row0 = u.pm * BM + wr * 64 + fr;
        if (u.pn >= 8) {
            const int col0 = u.pn * BM + wc * 32 + 8 * fq;
#pragma unroll
            for (int ai = 0; ai < 2; ++ai)
#pragma unroll
                for (int m = 0; m < 4; ++m) { bf16_t* rowp = O + (size_t)(row0 + ai * HALF + m * 16) * 6144 + col0;
#pragma unroll
                    for (int bj = 0; bj < 2; ++bj) { const f32x4 v0 = acc[ai][bj][m][0], v1 = acc[ai][bj][m][1];
                        u32x4 w; w.x = cvt_pk_bf16(v0[0], v0[1]); w.y = cvt_pk_bf16(v0[2], v0[3]); w.z = cvt_pk_bf16(v1[0], v1[1]); w.w = cvt_pk_bf16(v1[2], v1[3]);
                        *(u32x4*)(rowp + bj * HALF) = w; } }
        } else {
            const int sec = u.pn >> 2, head = 2 * (u.pn & 3) + (wc >> 1), d0 = (wc & 1) * 32 + 8 * fq;
            bf16_t* obase = O + sec * 1024 + head * 128 + d0;
            float csum[16];
#pragma unroll
            for (int i = 0; i < 16; ++i) csum[i] = 0.f;
#pragma unroll
            for (int ai = 0; ai < 2; ++ai)
#pragma unroll
                for (int m = 0; m < 4; ++m) { const int row = row0 + ai * HALF + m * 16;
                    const f32x4* cp = (const f32x4*)(cs + ((size_t)row * 64 + d0) * 2);
                    float ol[8], oh[8];
#pragma unroll
                    for (int n = 0; n < 2; ++n) { const f32x4 t0 = cp[2 * n], t1 = cp[2 * n + 1]; const f32x4 lo = acc[ai][0][m][n], hi = acc[ai][1][m][n];
                        ol[4 * n + 0] = lo[0] * t0[0] - hi[0] * t0[1]; oh[4 * n + 0] = hi[0] * t0[0] + lo[0] * t0[1];
                        ol[4 * n + 1] = lo[1] * t0[2] - hi[1] * t0[3]; oh[4 * n + 1] = hi[1] * t0[2] + lo[1] * t0[3];
                        ol[4 * n + 2] = lo[2] * t1[0] - hi[2] * t1[1]; oh[4 * n + 2] = hi[2] * t1[0] + lo[2] * t1[1];
                        ol[4 * n + 3] = lo[3] * t1[2] - hi[3] * t1[3]; oh[4 * n + 3] = hi[3] * t1[2] + lo[3] * t1[3]; }
                    u32x4 w; w.x = cvt_pk_bf16(ol[0], ol[1]); w.y = cvt_pk_bf16(ol[2], ol[3]); w.z = cvt_pk_bf16(ol[4], ol[5]); w.w = cvt_pk_bf16(ol[6], ol[7]);
                    *(u32x4*)(obase + (size_t)row * 6144) = w;
                    w.x = cvt_pk_bf16(oh[0], oh[1]); w.y = cvt_pk_bf16(oh[2], oh[3]); w.z = cvt_pk_bf16(oh[4], oh[5]); w.w = cvt_pk_bf16(oh[6], oh[7]);
                    *(u32x4*)(obase + (size_t)row * 6144 + 64) = w;
                    if (sec == 1) {
#pragma unroll
                        for (int i = 0; i < 8; ++i) { csum[i] += ol[i]; csum[8 + i] += oh[i]; } } }
            if (sec == 1) {
                float* km = kmean + (size_t)(((u.pm >> 4) * 8 + head) * 16 + (u.pm & 15)) * 128 + d0;
#pragma unroll
                for (int i = 0; i < 16; ++i) { float v = csum[i]; v += __shfl_xor(v, 1); v += __shfl_xor(v, 2); v += __shfl_xor(v, 4); v += __shfl_xor(v, 8);
                    if (fr == 0) atomicAdd(km + (i & 7) + (i >> 3) * 64, v * (1.f / 256.f)); }
            }
        }
    }
};
__device__ __forceinline__ float row_rinv(const float* ss, int row, int fq) {
    const f32x4* p = (const f32x4*)(ss + (size_t)row * 32 + fq * 8); const f32x4 a = p[0], b = p[1];
    float s = ((a[0] + a[1]) + (a[2] + a[3])) + ((b[0] + b[1]) + (b[2] + b[3]));
    s += __shfl_xor(s, 16); s += __shfl_xor(s, 32);
    return rsqrtf(s * (1.f / 2048.f) + 1e-6f);
}
template <bool BASE_F32, bool OUT_F8> struct EpiRes {
    static constexpr bool PERM = true, AFTER_DRAIN = false;
    const void* base; bf16_t* outb; unsigned char* out8; float* ss;
    __device__ __forceinline__ void operator()(const f32x4 (&acc)[2][2][4][2], const Unit& u, int wr, int wc, int fr, int fq) const {
        const int row0 = u.pm * BM + wr * 64 + fr, col0 = u.pn * BM + wc * 32 + 8 * fq;
#pragma unroll
        for (int ai = 0; ai < 2; ++ai)
#pragma unroll
            for (int m = 0; m < 4; ++m) { const int row = row0 + ai * HALF + m * 16; const size_t off = (size_t)row * 2048 + col0; float s = 0.f;
#pragma unroll
                for (int bj = 0; bj < 2; ++bj) { f32x4 v0, v1;
                    if (BASE_F32) { v0 = *(const f32x4*)((const float*)base + off + bj * HALF); v1 = *(const f32x4*)((const float*)base + off + bj * HALF + 4); }
                    else { const u32x4 bb = *(const u32x4*)((const bf16_t*)base + off + bj * HALF);
                        v0 = (f32x4){__uint_as_float(bb.x << 16), __uint_as_float(bb.x & 0xffff0000u), __uint_as_float(bb.y << 16), __uint_as_float(bb.y & 0xffff0000u)};
                        v1 = (f32x4){__uint_as_float(bb.z << 16), __uint_as_float(bb.z & 0xffff0000u), __uint_as_float(bb.w << 16), __uint_as_float(bb.w & 0xffff0000u)}; }
                    v0 = v0 + acc[ai][bj][m][0]; v1 = v1 + acc[ai][bj][m][1];
                    s += ((v0[0] * v0[0] + v0[1] * v0[1]) + (v0[2] * v0[2] + v0[3] * v0[3])) + ((v1[0] * v1[0] + v1[1] * v1[1]) + (v1[2] * v1[2] + v1[3] * v1[3]));
                    { u32x4 w; w.x = cvt_pk_bf16(v0[0], v0[1]); w.y = cvt_pk_bf16(v0[2], v0[3]); w.z = cvt_pk_bf16(v1[0], v1[1]); w.w = cvt_pk_bf16(v1[2], v1[3]);
                      *(u32x4*)(outb + off + bj * HALF) = w; }
                    if (OUT_F8) { typedef unsigned u32x2_ __attribute__((ext_vector_type(2))); u32x2_ w; w.x = pk4_fp8(v0[0], v0[1], v0[2], v0[3]); w.y = pk4_fp8(v1[0], v1[1], v1[2], v1[3]);
                        *(u32x2_*)(out8 + off + bj * HALF) = w; } }
                s += __shfl_xor(s, 16); s += __shfl_xor(s, 32);
                if (fq == 0) ss[(size_t)row * 32 + u.pn * 4 + wc] = s; }
    }
};
struct EpiRowScaleBf16 {
    static constexpr bool PERM = true, AFTER_DRAIN = false;
    bf16_t* O; const float* ss; int ldc, pad;
    __device__ __forceinline__ void operator()(const f32x4 (&acc)[2][2][4][2], const Unit& u, int wr, int wc, int fr, int fq) const {
        const int row0 = u.pm * BM + wr * 64 + fr, col0 = u.pn * BM + wc * 32 + 8 * fq;
#pragma unroll
        for (int ai = 0; ai < 2; ++ai)
#pragma unroll
            for (int m = 0; m < 4; ++m) { const int row = row0 + ai * HALF + m * 16; const float ri = row_rinv(ss, row, fq); bf16_t* rowp = O + (size_t)row * ldc + col0;
#pragma unroll
                for (int bj = 0; bj < 2; ++bj) { const f32x4 v0 = acc[ai][bj][m][0] * ri, v1 = acc[ai][bj][m][1] * ri;
                    u32x4 w; w.x = cvt_pk_bf16(v0[0], v0[1]); w.y = cvt_pk_bf16(v0[2], v0[3]); w.z = cvt_pk_bf16(v1[0], v1[1]); w.w = cvt_pk_bf16(v1[2], v1[3]);
                    *(u32x4*)(rowp + bj * HALF) = w; } }
    }
};
template <bool F8OUT> struct EpiSwiGLUNorm {
    static constexpr bool PERM = true, AFTER_DRAIN = false;
    bf16_t* O; const float* ss; int ldc, pad;
    __device__ __forceinline__ void operator()(const f32x4 (&acc)[2][2][4][2], const Unit& u, int wr, int wc, int fr, int fq) const {
        const int row0 = u.pm * BM + wr * 64 + fr, col0 = u.pn * HALF + wc * 32 + 8 * fq;
#pragma unroll
        for (int ai = 0; ai < 2; ++ai)
#pragma unroll
            for (int m = 0; m < 4; ++m) { const int row = row0 + ai * HALF + m * 16; const float ri = row_rinv(ss, row, fq); bf16_t* rowp = O + (size_t)row * ldc + col0;
                float r[8];
#pragma unroll
                for (int n = 0; n < 2; ++n)
#pragma unroll
                    for (int e = 0; e < 4; ++e) { const float g = acc[ai][0][m][n][e] * ri, up = acc[ai][1][m][n][e] * ri; r[n * 4 + e] = g * up / (1.0f + __expf(-g)); }
                if (F8OUT) { typedef unsigned u32x2_ __attribute__((ext_vector_type(2))); u32x2_ w; w.x = pk4_fp8(r[0], r[1], r[2], r[3]); w.y = pk4_fp8(r[4], r[5], r[6], r[7]);
                    *(u32x2_*)((unsigned char*)O + (size_t)row * ldc + col0) = w; }
                else { u32x4 w; w.x = cvt_pk_bf16(r[0], r[1]); w.y = cvt_pk_bf16(r[2], r[3]); w.z = cvt_pk_bf16(r[4], r[5]); w.w = cvt_pk_bf16(r[6], r[7]);
                    *(u32x4*)rowp = w; } }
    }
};
}
typedef unsigned short bf16_t;
constexpr int DM = 2048, NB = 4, SEQ = 4096, MT = NB * SEQ;
constexpr int HD = 128, NH = 8, AW = 1024, CW = 1024, NPROJ = 6144;
constexpr int NBLK = 16, MBLK = 256;
constexpr int NMEM = 256, XH = 4, XW = 512, DFF = 5632;
constexpr float EPS = 1e-6f;
constexpr float SM_SCALE = 0.088388347648318440f;
constexpr size_t MiB = 1u << 20;
constexpr size_t WS_WIN = 0;
constexpr size_t WS_WOUT = 24 * MiB;
constexpr size_t WS_WXQ = 32 * MiB;
constexpr size_t WS_WXKV = 34 * MiB;
constexpr size_t WS_WXO = 38 * MiB;
constexpr size_t WS_WGU = 40 * MiB;
constexpr size_t WS_WDN = 84 * MiB;
constexpr size_t WS_H = 112 * MiB;
constexpr size_t WS_MRG = 176 * MiB;
constexpr size_t WS_PROJ = 240 * MiB;
constexpr size_t WS_ACT = 240 * MiB;
constexpr size_t WS_X8 = 330 * MiB;
constexpr size_t WS_QX = 432 * MiB;
constexpr size_t WS_OX = 448 * MiB;
constexpr size_t WS_KVX = 464 * MiB;
constexpr size_t WS_MEMN = 466 * MiB;
constexpr size_t WS_CS = 470 * MiB;
constexpr size_t WS_KMEAN = 478 * MiB;
constexpr size_t WS_SS = 479 * MiB;
constexpr size_t WS_BAR = 485 * MiB;
constexpr size_t WS_END = 486 * MiB;

__device__ __forceinline__ float bf2f(unsigned v) { return __uint_as_float(v << 16); }
__device__ __forceinline__ unsigned f2bf(float f) { unsigned u = __float_as_uint(f); return (u + 0x7fffu + ((u >> 16) & 1u)) >> 16; }
__device__ __forceinline__ unsigned pk2(float lo, float hi) { return f2bf(lo) | (f2bf(hi) << 16); }
__device__ __forceinline__ float wave_sum(float v) {
#pragma unroll
    for (int o = 1; o < 64; o <<= 1) v += __shfl_xor(v, o);
    return v;
}
__device__ __forceinline__ float wave_max(float v) {
#pragma unroll
    for (int o = 1; o < 64; o <<= 1) v = fmaxf(v, __shfl_xor(v, o));
    return v;
}
typedef float f32x4 __attribute__((ext_vector_type(4)));
typedef unsigned u32x4 __attribute__((ext_vector_type(4)));
typedef unsigned u32x2 __attribute__((ext_vector_type(2)));

struct TJob { const float* src0; const float* src1; const float* gain; bf16_t* dst; int K, Nsrc, nrows, mode; float wscale; int f8; };
__device__ __forceinline__ void transpose_item(const TJob& J, float* scr, int item, int lane) {
    const int nblk = J.nrows / 32, kb = item / nblk, nb = item % nblk, k0 = 64 * kb, n0 = 32 * nb;
    const float* src = J.src0; int c0 = n0;
    if (J.mode == 1 && n0 < 2048) { const int tile = n0 >> 8, c = n0 & 255, cc = c & 127; c0 = (tile >> 2) * 1024 + (2 * (tile & 3) + (cc >> 6)) * 128 + (cc & 63) + ((c >> 7) ? 64 : 0); }
    if (J.mode == 2) { const int tile = n0 >> 8, w = n0 & 255; if (w < 128) { c0 = tile * 128 + w; } else { src = J.src1; c0 = tile * 128 + w - 128; } }
    f32x4 ld[8];
#pragma unroll
    for (int i = 0; i < 8; ++i) ld[i] = *(const f32x4*)(src + (size_t)(k0 + 8 * i + (lane >> 3)) * J.Nsrc + c0 + 4 * (lane & 7));
#pragma unroll
    for (int i = 0; i < 8; ++i) { const int kk = 8 * i + (lane >> 3); float gsc = J.wscale; if (J.gain) gsc *= J.gain[k0 + kk];
#pragma unroll
        for (int e = 0; e < 4; ++e) scr[kk * 33 + 4 * (lane & 7) + e] = ld[i][e] * gsc; }
    asm volatile("s_waitcnt lgkmcnt(0)" ::: "memory");
    const int c = lane & 7;
#pragma unroll
    for (int j = 0; j < 4; ++j) { const int n = (lane >> 3) + 8 * j; const float* s = scr + (8 * c) * 33 + n;
        if (J.f8) { u32x2 o; o.x = pg8::pk4_fp8(s[0 * 33], s[1 * 33], s[2 * 33], s[3 * 33]); o.y = pg8::pk4_fp8(s[4 * 33], s[5 * 33], s[6 * 33], s[7 * 33]);
            *(u32x2*)((unsigned char*)J.dst + (size_t)(n0 + n) * J.K + k0 + 8 * c) = o; }
        else { u32x4 o; o.x = pk2(s[0 * 33], s[1 * 33]); o.y = pk2(s[2 * 33], s[3 * 33]); o.z = pk2(s[4 * 33], s[5 * 33]); o.w = pk2(s[6 * 33], s[7 * 33]);
            *(u32x4*)(J.dst + (size_t)(n0 + n) * J.K + k0 + 8 * c) = o; } }
    asm volatile("s_waitcnt lgkmcnt(0)" ::: "memory");
}
__device__ __forceinline__ int ph_transpose_job(const TJob J, int base, float* scr, int gw, int NGW, int lane) {
    const int nitems = (J.K / 64) * (J.nrows / 32);
    const int first = (gw - base % NGW + NGW) % NGW;
    for (int it = first; it < nitems; it += NGW) transpose_item(J, scr, it, lane);
    return base + nitems;
}

__device__ __forceinline__ void rms_row_bf16(const float* xrow, const float* g, bf16_t* orow, int lane) {
    const f32x4* xr = (const f32x4*)xrow + lane; const f32x4* gr = (const f32x4*)g + lane;
    f32x4 v[8]; float s = 0.f;
#pragma unroll
    for (int j = 0; j < 8; ++j) { v[j] = xr[64 * j]; s += (v[j].x * v[j].x + v[j].y * v[j].y) + (v[j].z * v[j].z + v[j].w * v[j].w); }
    const float rinv = rsqrtf(wave_sum(s) * (1.f / DM) + EPS);
    u32x2* o8 = (u32x2*)orow + lane;
#pragma unroll
    for (int j = 0; j < 8; ++j) { const f32x4 gg = gr[64 * j]; u32x2 w; w.x = pk2(v[j].x * rinv * gg.x, v[j].y * rinv * gg.y); w.y = pk2(v[j].z * rinv * gg.z, v[j].w * rinv * gg.w); o8[64 * j] = w; }
}
__device__ __forceinline__ void ph_rms_bf16(const float* X, const float* g, bf16_t* O, int rows, int gw, int NGW, int lane) {
    f32x4 v[8], nx[8];
    int r = gw;
    if (r < rows) {
#pragma unroll
        for (int j = 0; j < 8; ++j) v[j] = ((const f32x4*)(X + (size_t)r * DM) + lane)[64 * j]; }
    for (; r < rows; r += NGW) {
        const int rn = r + NGW;
        if (rn < rows) {
#pragma unroll
            for (int j = 0; j < 8; ++j) nx[j] = ((const f32x4*)(X + (size_t)rn * DM) + lane)[64 * j]; }
        float s = 0.f;
#pragma unroll
        for (int j = 0; j < 8; ++j) s += (v[j].x * v[j].x + v[j].y * v[j].y) + (v[j].z * v[j].z + v[j].w * v[j].w);
        const float rinv = rsqrtf(wave_sum(s) * (1.f / DM) + EPS);
        u32x2* o8 = (u32x2*)(O + (size_t)r * DM) + lane; const f32x4* gr = (const f32x4*)g + lane;
#pragma unroll
        for (int j = 0; j < 8; ++j) { const f32x4 gg = gr[64 * j]; u32x2 w; w.x = pk2(v[j].x * rinv * gg.x, v[j].y * rinv * gg.y); w.y = pk2(v[j].z * rinv * gg.z, v[j].w * rinv * gg.w); o8[64 * j] = w; }
#pragma unroll
        for (int j = 0; j < 8; ++j) v[j] = nx[j];
    }
}
__device__ __forceinline__ void ph_final_norm(const bf16_t* X, float* O, const float* g, const float* ss, int rows, int gw, int NGW, int lane) {
    for (int r = gw; r < rows; r += NGW) {
        const u32x4* xr = (const u32x4*)(X + (size_t)r * DM) + lane; f32x4* orow = (f32x4*)(O + (size_t)r * DM); const f32x4* gr = (const f32x4*)g;
        u32x4 v[4];
#pragma unroll
        for (int j = 0; j < 4; ++j) v[j] = xr[64 * j];
        const float part = (lane < 32) ? ss[(size_t)r * 32 + lane] : 0.f;
        const float rinv = rsqrtf(wave_sum(part) * (1.f / DM) + EPS);
#pragma unroll
        for (int j = 0; j < 4; ++j) { const int c4 = 2 * (64 * j + lane);
            const f32x4 lo = {__uint_as_float(v[j].x << 16), __uint_as_float(v[j].x & 0xffff0000u), __uint_as_float(v[j].y << 16), __uint_as_float(v[j].y & 0xffff0000u)};
            const f32x4 hi = {__uint_as_float(v[j].z << 16), __uint_as_float(v[j].z & 0xffff0000u), __uint_as_float(v[j].w << 16), __uint_as_float(v[j].w & 0xffff0000u)};
            orow[c4] = lo * rinv * gr[c4]; orow[c4 + 1] = hi * rinv * gr[c4 + 1]; }
    }
}

__device__ __forceinline__ void sincos_small(double r, double& s, double& c) {
    const double r2 = r * r;
    double a = -1.0 / 10888869450418352160768000000.0;
    a = a * r2 + 1.0 / 15511210043330985984000000.0;
    a = a * r2 - 1.0 / 25852016738884976640000.0;
    a = a * r2 + 1.0 / 51090942171709440000.0;
    a = a * r2 - 1.0 / 121645100408832000.0;
    a = a * r2 + 1.0 / 355687428096000.0;
    a = a * r2 - 1.0 / 1307674368000.0;
    a = a * r2 + 1.0 / 6227020800.0;
    a = a * r2 - 1.0 / 39916800.0;
    a = a * r2 + 1.0 / 362880.0;
    a = a * r2 - 1.0 / 5040.0;
    a = a * r2 + 1.0 / 120.0;
    a = a * r2 - 1.0 / 6.0;
    a = a * r2 + 1.0;
    s = a * r;
    double b = 1.0 / 403291461126605635584000000.0;
    b = b * r2 - 1.0 / 620448401733239439360000.0;
    b = b * r2 + 1.0 / 1124000727777607680000.0;
    b = b * r2 - 1.0 / 2432902008176640000.0;
    b = b * r2 + 1.0 / 6402373705728000.0;
    b = b * r2 - 1.0 / 20922789888000.0;
    b = b * r2 + 1.0 / 87178291200.0;
    b = b * r2 - 1.0 / 479001600.0;
    b = b * r2 + 1.0 / 3628800.0;
    b = b * r2 - 1.0 / 40320.0;
    b = b * r2 + 1.0 / 720.0;
    b = b * r2 - 1.0 / 24.0;
    b = b * r2 + 1.0 / 2.0;
    c = 1.0 - b * r2;
}
__device__ __forceinline__ void cs_entry(const int* pos, float* cs, int idx) {
    const int t = idx >> 6, f = idx & 63;
    double p = 1.0, bs = 0.8659643233600653;
#pragma unroll
    for (int bit = 0; bit < 6; ++bit) { if ((f >> bit) & 1) p *= bs; bs *= bs; }
    const double ang = (double)pos[t] * p;
    const double TWO_PI = 6.283185307179586;
    const double n = rint(ang / TWO_PI);
    const double r = fma(-n, TWO_PI, ang);
    double s, c; sincos_small(r, s, c);
    cs[2 * idx] = (float)c; cs[2 * idx + 1] = (float)s;
}
__device__ __forceinline__ void ph_cs(const int* pos, float* cs, int gtid, int NT) {
    for (int idx = gtid; idx < MT * 64; idx += NT) cs_entry(pos, cs, idx);
}
__device__ __forceinline__ void ph_rope_naive(bf16_t* proj, const float* cs, int gtid, int NT) {
    const long total = (long)MT * 2 * NH * 64;
    for (long i = gtid; i < total; i += NT) {
        const int d = (int)(i & 63), h = (int)((i >> 6) & 7), sec = (int)((i >> 9) & 1); const long t = i >> 10;
        bf16_t* p = proj + t * NPROJ + sec * 1024 + h * HD + d;
        const float a = bf2f(p[0]), b = bf2f(p[64]); const float c = cs[(t * 64 + d) * 2], s = cs[(t * 64 + d) * 2 + 1];
        p[0] = (bf16_t)f2bf(a * c - b * s); p[64] = (bf16_t)f2bf(b * c + a * s);
    }
}
__device__ __forceinline__ void ph_kmean_naive(const bf16_t* proj, float* kmean, int gtid, int NT) {
    for (int i = gtid; i < NB * NH * NBLK * HD; i += NT) {
        const int d = i & 127, blkid = i >> 7;
        const int blk = blkid & 15, h = (blkid >> 4) & 7, b = blkid >> 7;
        float s = 0.f;
        for (int j = 0; j < MBLK; ++j) s += bf2f(proj[(size_t)(b * SEQ + blk * MBLK + j) * NPROJ + 1024 + h * HD + d]);
        kmean[(size_t)blkid * HD + d] = s * (1.f / MBLK);
    }
}
__device__ __forceinline__ float dot_q_row(const float* sq, const bf16_t* krow) {
    float a = 0.f;
#pragma unroll
    for (int d = 0; d < 128; d += 8) { const u32x4 kk = *(const u32x4*)(krow + d);
        a += sq[d + 0] * bf2f(kk.x & 0xffffu) + sq[d + 1] * bf2f(kk.x >> 16) + sq[d + 2] * bf2f(kk.y & 0xffffu) + sq[d + 3] * bf2f(kk.y >> 16)
           + sq[d + 4] * bf2f(kk.z & 0xffffu) + sq[d + 5] * bf2f(kk.z >> 16) + sq[d + 6] * bf2f(kk.w & 0xffffu) + sq[d + 7] * bf2f(kk.w >> 16); }
    return a;
}
__device__ __forceinline__ void ph_moba_naive(const bf16_t* proj, const float* kmean, const float* g_attn, bf16_t* merged, float qscale_inv, float* scr, int gw, int NGW, int lane) {
    float* sq = scr; float* sp = scr + 128;
    for (int item = gw; item < MT * NH; item += NGW) {
        const int t = item >> 3, h = item & 7, b = t >> 12, ts = t & 4095, qb = ts >> 8, tq = ts & 255;
        const bf16_t* qrow = proj + (size_t)t * NPROJ + h * HD;
        const unsigned qq = *(const unsigned*)(qrow + 2 * lane);
        const float q0 = bf2f(qq & 0xffffu) * qscale_inv, q1 = bf2f(qq >> 16) * qscale_inv;
        asm volatile("s_waitcnt lgkmcnt(0)" ::: "memory");
        sq[2 * lane] = q0; sq[2 * lane + 1] = q1;
        float g[16];
#pragma unroll
        for (int i = 0; i < 16; ++i) { const float* km = kmean + (size_t)((b * 8 + h) * 16 + i) * HD; const float p = wave_sum(q0 * km[2 * lane] + q1 * km[2 * lane + 1]); g[i] = (i < qb) ? p : -INFINITY; }
        int sel[4];
#pragma unroll
        for (int r = 0; r < 3; ++r) { float best = -INFINITY; int bi = -1;
#pragma unroll
            for (int i = 0; i < 16; ++i) if (g[i] > best) { best = g[i]; bi = i; }
            sel[r] = bi;
#pragma unroll
            for (int i = 0; i < 16; ++i) if (i == bi) g[i] = -INFINITY; }
        sel[3] = qb;
        asm volatile("s_waitcnt lgkmcnt(0)" ::: "memory");
#pragma unroll
        for (int s = 0; s < 4; ++s) { const int blk = sel[s];
            for (int jj = 0; jj < 4; ++jj) { const int j = jj * 64 + lane; float sc = -INFINITY;
                if (blk >= 0 && (s < 3 || j <= tq)) sc = dot_q_row(sq, proj + (size_t)(b * SEQ + blk * MBLK + j) * NPROJ + 1024 + h * HD) * SM_SCALE;
                sp[s * 256 + j] = sc; } }
        asm volatile("s_waitcnt lgkmcnt(0)" ::: "memory");
        float m = -INFINITY; for (int i = lane; i < 1024; i += 64) m = fmaxf(m, sp[i]); m = wave_max(m);
        float l = 0.f; for (int i = lane; i < 1024; i += 64) { const float p = __expf(sp[i] - m); sp[i] = p; l += p; } l = wave_sum(l);
        asm volatile("s_waitcnt lgkmcnt(0)" ::: "memory");
        float o0 = 0.f, o1 = 0.f;
#pragma unroll
        for (int s = 0; s < 4; ++s) { const int blk = sel[s]; if (blk < 0) continue;
            const bf16_t* vb = proj + (size_t)(b * SEQ + blk * MBLK) * NPROJ + 2048 + h * HD + 2 * lane;
            for (int j = 0; j < 256; ++j) { const float p = sp[s * 256 + j]; const unsigned vv = *(const unsigned*)(vb + (size_t)j * NPROJ); o0 += p * bf2f(vv & 0xffffu); o1 += p * bf2f(vv >> 16); } }
        const float li = 1.f / l; o0 *= li; o1 *= li;
        const float rinv = rsqrtf(wave_sum(o0 * o0 + o1 * o1) * (1.f / HD) + EPS);
        *(unsigned*)(merged + (size_t)t * DM + h * HD + 2 * lane) = pk2(o0 * rinv * g_attn[h * HD + 2 * lane], o1 * rinv * g_attn[h * HD + 2 * lane + 1]);
    }
}
__device__ __forceinline__ void ph_conv_naive(const bf16_t* proj, const float* w_conv, const float* b_conv, const float* g_conv, bf16_t* merged, int gw, int NGW, int lane) {
    for (int item = gw; item < MT * 8; item += NGW) {
        const int t = item >> 3, grp = item & 7, ts = t & 4095; const int c = grp * 128 + 2 * lane;
        float y[2];
#pragma unroll
        for (int e = 0; e < 2; ++e) { float acc = b_conv[c + e];
#pragma unroll
            for (int k = 0; k < 3; ++k) { const int back = 2 - k; if (ts - back >= 0) { const bf16_t* r = proj + (size_t)(t - back) * NPROJ; acc += w_conv[k * CW + c + e] * (bf2f(r[3072 + c + e]) * bf2f(r[5120 + c + e])); } }
            y[e] = bf2f(proj[(size_t)t * NPROJ + 4096 + c + e]) * acc; }
        const float rinv = rsqrtf(wave_sum(y[0] * y[0] + y[1] * y[1]) * (1.f / HD) + EPS);
        *(unsigned*)(merged + (size_t)t * DM + AW + c) = pk2(y[0] * rinv * g_conv[c], y[1] * rinv * g_conv[c + 1]);
    }
}
__device__ __forceinline__ void ph_conv(const bf16_t* __restrict__ proj, const float* __restrict__ w_conv, const float* __restrict__ b_conv, const float* __restrict__ g_conv, bf16_t* __restrict__ merged, int gw, int NGW, int lane) {
    const int l16 = lane & 15, sub = lane >> 4, grp = gw & 7, c = grp * 128 + l16 * 8;
    float w0[8], w1[8], w2[8], bc[8], gc[8];
#pragma unroll
    for (int h = 0; h < 2; ++h) { const f32x4 a0 = *(const f32x4*)(w_conv + c + 4 * h), a1 = *(const f32x4*)(w_conv + CW + c + 4 * h), a2 = *(const f32x4*)(w_conv + 2 * CW + c + 4 * h), bb = *(const f32x4*)(b_conv + c + 4 * h), gg = *(const f32x4*)(g_conv + c + 4 * h);
#pragma unroll
        for (int e = 0; e < 4; ++e) { w0[4 * h + e] = a0[e]; w1[4 * h + e] = a1[e]; w2[4 * h + e] = a2[e]; bc[4 * h + e] = bb[e]; gc[4 * h + e] = gg[e]; } }
    const int step = (NGW >> 3) * 4;
    for (int t = (gw >> 3) * 4 + sub; t < MT; t += step) {
        const int ts = t & (SEQ - 1); const bf16_t* r0 = proj + (size_t)t * NPROJ + c;
        const u32x4 vb = *(const u32x4*)(r0 + 4096), c0 = *(const u32x4*)(r0 + 3072), x0 = *(const u32x4*)(r0 + 5120);
        u32x4 c1 = {0u, 0u, 0u, 0u}, x1 = c1, c2 = c1, x2 = c1;
        if (ts >= 1) { c1 = *(const u32x4*)(r0 - NPROJ + 3072); x1 = *(const u32x4*)(r0 - NPROJ + 5120); }
        if (ts >= 2) { c2 = *(const u32x4*)(r0 - 2 * NPROJ + 3072); x2 = *(const u32x4*)(r0 - 2 * NPROJ + 5120); }
        float y[8]; float ss = 0.f;
#pragma unroll
        for (int q = 0; q < 4; ++q)
#pragma unroll
            for (int hh = 0; hh < 2; ++hh) { const int e = 2 * q + hh;
                const float C0 = hh ? __uint_as_float(c0[q] & 0xffff0000u) : __uint_as_float(c0[q] << 16), X0 = hh ? __uint_as_float(x0[q] & 0xffff0000u) : __uint_as_float(x0[q] << 16);
                const float C1 = hh ? __uint_as_float(c1[q] & 0xffff0000u) : __uint_as_float(c1[q] << 16), X1 = hh ? __uint_as_float(x1[q] & 0xffff0000u) : __uint_as_float(x1[q] << 16);
                const float C2 = hh ? __uint_as_float(c2[q] & 0xffff0000u) : __uint_as_float(c2[q] << 16), X2 = hh ? __uint_as_float(x2[q] & 0xffff0000u) : __uint_as_float(x2[q] << 16);
                const float Bv = hh ? __uint_as_float(vb[q] & 0xffff0000u) : __uint_as_float(vb[q] << 16);
                const float acc = bc[e] + w2[e] * (C0 * X0) + w1[e] * (C1 * X1) + w0[e] * (C2 * X2);
                y[e] = Bv * acc; ss += y[e] * y[e]; }
        ss += __shfl_xor(ss, 1); ss += __shfl_xor(ss, 2); ss += __shfl_xor(ss, 4); ss += __shfl_xor(ss, 8);
        const float rinv = rsqrtf(ss * (1.f / HD) + EPS);
        u32x4 o; o.x = pk2(y[0] * rinv * gc[0], y[1] * rinv * gc[1]); o.y = pk2(y[2] * rinv * gc[2], y[3] * rinv * gc[3]); o.z = pk2(y[4] * rinv * gc[4], y[5] * rinv * gc[5]); o.w = pk2(y[6] * rinv * gc[6], y[7] * rinv * gc[7]);
        *(u32x4*)(merged + (size_t)t * DM + AW + c) = o;
    }
}
__device__ __forceinline__ void ph_xattn_naive(const bf16_t* qx, const bf16_t* kvx, bf16_t* ox, float qscale_inv, float* scr, int gw, int NGW, int lane) {
    float* sq = scr; float* sp = scr + 128;
    for (int item = gw; item < MT * XH; item += NGW) {
        const int t = item >> 2, h = item & 3, b = t >> 12;
        const unsigned qq = *(const unsigned*)(qx + (size_t)t * XW + h * HD + 2 * lane);
        asm volatile("s_waitcnt lgkmcnt(0)" ::: "memory");
        sq[2 * lane] = bf2f(qq & 0xffffu) * qscale_inv; sq[2 * lane + 1] = bf2f(qq >> 16) * qscale_inv;
        asm volatile("s_waitcnt lgkmcnt(0)" ::: "memory");
        float m = -INFINITY;
        for (int jj = 0; jj < 4; ++jj) { const int j = jj * 64 + lane; const float sc = dot_q_row(sq, kvx + (size_t)(b * NMEM + j) * 1024 + h * HD) * SM_SCALE; sp[j] = sc; m = fmaxf(m, sc); }
        m = wave_max(m);
        asm volatile("s_waitcnt lgkmcnt(0)" ::: "memory");
        float l = 0.f; for (int i = lane; i < 256; i += 64) { const float p = __expf(sp[i] - m); sp[i] = p; l += p; } l = wave_sum(l);
        asm volatile("s_waitcnt lgkmcnt(0)" ::: "memory");
        float o0 = 0.f, o1 = 0.f; const bf16_t* vb = kvx + (size_t)(b * NMEM) * 1024 + 512 + h * HD + 2 * lane;
        for (int j = 0; j < 256; ++j) { const float p = sp[j]; const unsigned vv = *(const unsigned*)(vb + (size_t)j * 1024); o0 += p * bf2f(vv & 0xffffu); o1 += p * bf2f(vv >> 16); }
        const float li = 1.f / l;
        *(unsigned*)(ox + (size_t)t * XW + h * HD + 2 * lane) = pk2(o0 * li, o1 * li);
    }
}

namespace moba {
using bf16x8 = __attribute__((ext_vector_type(8))) short;
using s16x4  = __attribute__((ext_vector_type(4))) short;
using f32x16 = __attribute__((ext_vector_type(16))) float;
using u32x4v = __attribute__((ext_vector_type(4))) unsigned;
using f32x4v = __attribute__((ext_vector_type(4))) float;
constexpr int D = 128, NW = 8, QBLK = 32, KVBLK = 64;
constexpr float SCALE = 0.088388347648318440f, THR = 8.f;
constexpr int SHM_V = KVBLK * D * 2, SHM_K = KVBLK * D * 2;
constexpr int OFF_V = 0, OFF_K = 2 * SHM_V, OFF_WS = OFF_K + 2 * SHM_K, OFF_KM = OFF_WS + NW * 256, OFF_RS = OFF_KM + 16 * 128 * 4, RS_BYTES = (32 * 33 + 32) * 4, LDS_END = OFF_RS + NW * RS_BYTES;
static_assert(LDS_END <= 131072, "moba LDS");
#define KSWZ(row, colB) ((row) * 256 + ((colB) ^ (((row) & 7) << 4)))
#define SBAR() __builtin_amdgcn_sched_barrier(0)
__device__ __forceinline__ int crow(int r, int hi) { return (r & 3) + 8 * (r >> 2) + 4 * hi; }
__device__ __forceinline__ unsigned cvtpk(float lo, float hi) { unsigned r; asm volatile("v_cvt_pk_bf16_f32 %0, %1, %2" : "=v"(r) : "v"(lo), "v"(hi)); return r; }
__device__ __forceinline__ void partialSM(f32x16& p0, f32x16& p1, float& m_reg, float& mn, float& alpha) {
  constexpr float C = SCALE * 1.4426950408889634f;
  float pmax = p0[0];
#pragma unroll
  for (int r = 1; r < 16; ++r) pmax = fmaxf(pmax, p0[r]);
#pragma unroll
  for (int r = 0; r < 16; ++r) pmax = fmaxf(pmax, p1[r]);
  { auto rr = __builtin_amdgcn_permlane32_swap(__float_as_uint(pmax), __float_as_uint(pmax), false, false);
    pmax = fmaxf(__uint_as_float(rr[0]), __uint_as_float(rr[1])); }
  if (__builtin_expect(__all(pmax - m_reg <= THR / SCALE), 1)) { mn = m_reg; alpha = 1.f; }
  else { mn = fmaxf(m_reg, pmax); alpha = __builtin_amdgcn_exp2f((m_reg - mn) * C); m_reg = mn; }
  float mnC = -mn * C;
#pragma unroll
  for (int r = 0; r < 16; ++r) p0[r] = fmaf(p0[r], C, mnC);
#pragma unroll
  for (int r = 0; r < 16; ++r) p1[r] = fmaf(p1[r], C, mnC);
#pragma unroll
  for (int r = 0; r < 16; ++r) p0[r] = __builtin_amdgcn_exp2f(p0[r]);
}
__device__ __forceinline__ void finishSM(f32x16& p0, f32x16& p1, float alpha, float& l_reg, bf16x8& pa0, bf16x8& pa1, bf16x8& pa2, bf16x8& pa3) {
#pragma unroll
  for (int r = 0; r < 16; ++r) p1[r] = __builtin_amdgcn_exp2f(p1[r]);
  float ps = 0;
#pragma unroll
  for (int r = 0; r < 16; ++r) ps += p0[r];
#pragma unroll
  for (int r = 0; r < 16; ++r) ps += p1[r];
  { auto rr = __builtin_amdgcn_permlane32_swap(__float_as_uint(ps), __float_as_uint(ps), false, false);
    ps = __uint_as_float(rr[0]) + __uint_as_float(rr[1]); }
  l_reg = l_reg * alpha + ps;
#define PK4(P, BASE, OUT) do { unsigned a0 = cvtpk(P[BASE + 0], P[BASE + 1]), a1 = cvtpk(P[BASE + 2], P[BASE + 3]);   \
    unsigned b0 = cvtpk(P[BASE + 4], P[BASE + 5]), b1 = cvtpk(P[BASE + 6], P[BASE + 7]);                              \
    auto r0 = __builtin_amdgcn_permlane32_swap(a0, b0, false, false); auto r1 = __builtin_amdgcn_permlane32_swap(a1, b1, false, false); \
    u32x4v w = {r0[0], r1[0], r0[1], r1[1]}; OUT = *reinterpret_cast<bf16x8*>(&w); } while (0)
  PK4(p0, 0, pa0); PK4(p0, 8, pa1); PK4(p1, 0, pa2); PK4(p1, 8, pa3);
#undef PK4
}
__device__ __forceinline__ void qkt(f32x16& p0, f32x16& p1, const char* Ks, const bf16x8* qr, int r32, int hi) {
  p0 = f32x16{}; p1 = f32x16{};
#pragma unroll
  for (int d0 = 0; d0 < 8; ++d0) { int cb = (d0 * 16 + hi * 8) * 2;
    bf16x8 b0 = *reinterpret_cast<const bf16x8*>(Ks + KSWZ(r32, cb));
    bf16x8 b1 = *reinterpret_cast<const bf16x8*>(Ks + KSWZ(32 + r32, cb));
    p0 = __builtin_amdgcn_mfma_f32_32x32x16_bf16(b0, qr[d0], p0, 0, 0, 0);
    p1 = __builtin_amdgcn_mfma_f32_32x32x16_bf16(b1, qr[d0], p1, 0, 0, 0); }
}
__device__ __forceinline__ int v_st(int k, int c) { const int kk = (k & ~0xC) | ((k & 4) << 1) | ((k & 8) >> 1); return ((kk >> 3) * 4 + (c >> 5)) * 512 + ((kk & 7) * 32 + (c & 31)) * 2; }
__device__ __forceinline__ int v_rd_base(int lane) { return ((lane & 3) << 3) | (((lane >> 2) & 3) << 6) | (((lane >> 4) & 1) << 5) | (((lane >> 5) & 1) << 8); }
constexpr int v_rd_off(int d0, int ks, int half) { return d0 * 512 + ks * 4096 + half * 2048; }
template <int OFF> __device__ __forceinline__ s16x4 tr_read(int vb) {
  s16x4 r; asm volatile("ds_read_b64_tr_b16 %0, %1 offset:%2" : "=&v"(r) : "v"(vb), "i"(OFF) : "memory"); return r;
}
template <int D0> __device__ __forceinline__ void pv_one(f32x16& od, int vb, bf16x8 pa0, bf16x8 pa1, bf16x8 pa2, bf16x8 pa3) {
  const s16x4 l0 = tr_read<v_rd_off(D0, 0, 0)>(vb), h0 = tr_read<v_rd_off(D0, 0, 1)>(vb), l1 = tr_read<v_rd_off(D0, 1, 0)>(vb), h1 = tr_read<v_rd_off(D0, 1, 1)>(vb);
  const s16x4 l2 = tr_read<v_rd_off(D0, 2, 0)>(vb), h2 = tr_read<v_rd_off(D0, 2, 1)>(vb), l3 = tr_read<v_rd_off(D0, 3, 0)>(vb), h3 = tr_read<v_rd_off(D0, 3, 1)>(vb);
  asm volatile("s_waitcnt lgkmcnt(0)" ::: "memory"); SBAR();
#define PK(L, H) (bf16x8){L[0], L[1], L[2], L[3], H[0], H[1], H[2], H[3]}
  od = __builtin_amdgcn_mfma_f32_32x32x16_bf16(pa0, PK(l0, h0), od, 0, 0, 0);
  od = __builtin_amdgcn_mfma_f32_32x32x16_bf16(pa1, PK(l1, h1), od, 0, 0, 0);
  od = __builtin_amdgcn_mfma_f32_32x32x16_bf16(pa2, PK(l2, h2), od, 0, 0, 0);
  od = __builtin_amdgcn_mfma_f32_32x32x16_bf16(pa3, PK(l3, h3), od, 0, 0, 0);
#undef PK
}
__device__ __forceinline__ void pv_d0(f32x16* o, int vb, bf16x8 pa0, bf16x8 pa1, bf16x8 pa2, bf16x8 pa3) {
  pv_one<0>(o[0], vb, pa0, pa1, pa2, pa3); pv_one<1>(o[1], vb, pa0, pa1, pa2, pa3); pv_one<2>(o[2], vb, pa0, pa1, pa2, pa3); pv_one<3>(o[3], vb, pa0, pa1, pa2, pa3);
}
template <int MODE> __device__ __forceinline__ void tile_mask(f32x16& p0, f32x16& p1, int j, int qb, unsigned selmask, int qrow, int hi) {
  if constexpr (MODE != 0) return;
  const int kb = j >> 2;
  if (kb < qb) {
    if (!((selmask >> kb) & 1u)) {
#pragma unroll
      for (int r = 0; r < 16; ++r) { p0[r] = -INFINITY; p1[r] = -INFINITY; } }
  } else {
    const int kbase = (j & 3) * 64;
#pragma unroll
    for (int r = 0; r < 16; ++r) { const int key = kbase + crow(r, hi); if (key > qrow) p0[r] = -INFINITY; if (key + 32 > qrow) p1[r] = -INFINITY; }
  }
}
template <int MODE> __device__ __forceinline__ void unit(int b, int h, int qb, const bf16_t* __restrict__ proj, const bf16_t* __restrict__ kvp, const float* __restrict__ kmean, const float* __restrict__ gain, bf16_t* __restrict__ merged, char* lds) {
  constexpr int LDQ = MODE == 0 ? NPROJ : XW, LDK = MODE == 0 ? NPROJ : 2 * XW, LDO = MODE == 0 ? DM : XW;
  const int tid = otid(), wid = tid >> 6, lane = tid & 63, r32 = lane & 31, hi = lane >> 5;
  char* V_lds = lds + OFF_V; char* K_lds = lds + OFF_K;
  float* ws = (float*)(lds + OFF_WS) + wid * 64; float* li_l = ws; float* al_l = ws + 32;
  char* KM = lds + OFF_KM; float* RS = (float*)(lds + OFF_RS + wid * RS_BYTES); float* RV = RS + 32 * 33;
  const long rowbase = (long)b * SEQ;
  const bf16_t* Qw = proj + (rowbase + qb * 256 + wid * QBLK + r32) * LDQ + h * D + hi * 8;
  const bf16_t* Kh = MODE == 0 ? proj + rowbase * LDK + 1024 + h * D : kvp + (long)b * NMEM * LDK + h * D;
  const bf16_t* Vh = MODE == 0 ? proj + rowbase * LDK + 2048 + h * D : kvp + (long)b * NMEM * LDK + XW + h * D;
  __syncthreads();
  if constexpr (MODE == 0)
  { const int blk = tid >> 5, c4 = (tid & 31) * 4;
    const f32x4v kv = *(const f32x4v*)(kmean + (size_t)((b * 8 + h) * 16 + blk) * D + c4);
    unsigned hb[4], lb[4];
#pragma unroll
    for (int e = 0; e < 4; ++e) { hb[e] = f2bf(kv[e]); lb[e] = f2bf(kv[e] - __uint_as_float(hb[e] << 16)); }
    typedef unsigned u32x2v __attribute__((ext_vector_type(2)));
    *(u32x2v*)(KM + KSWZ(blk, c4 * 2)) = (u32x2v){hb[0] | (hb[1] << 16), hb[2] | (hb[3] << 16)};
    *(u32x2v*)(KM + KSWZ(16 + blk, c4 * 2)) = (u32x2v){lb[0] | (lb[1] << 16), lb[2] | (lb[3] << 16)}; }
  float m_reg = -1e30f, l_reg = 0; f32x16 o[4] = {}; bf16x8 qr[8];
#pragma unroll
  for (int d0 = 0; d0 < 8; ++d0) qr[d0] = *reinterpret_cast<const bf16x8*>(Qw + d0 * 16);
  const int sr = tid >> 4, sc = (tid & 15) * 8, vst0 = v_st(sr, sc), vst1 = v_st(32 + sr, sc);
  const int vb0 = (int)(uintptr_t)V_lds + v_rd_base(lane);
  struct { bf16x8 vs0, vs1, ks0, ks1; } sr_[1];
#define SLOAD(i, k0) do { sr_[i].vs0 = *reinterpret_cast<const bf16x8*>(&Vh[(long)((k0) + sr) * LDK + sc]); sr_[i].vs1 = *reinterpret_cast<const bf16x8*>(&Vh[(long)((k0) + 32 + sr) * LDK + sc]); \
    sr_[i].ks0 = *reinterpret_cast<const bf16x8*>(&Kh[(long)((k0) + sr) * LDK + sc]); sr_[i].ks1 = *reinterpret_cast<const bf16x8*>(&Kh[(long)((k0) + 32 + sr) * LDK + sc]); } while (0)
#define SWRITE(bb, i) do { *(bf16x8*)(V_lds + (bb) * SHM_V + vst0) = sr_[i].vs0;          \
    *(bf16x8*)(V_lds + (bb) * SHM_V + vst1) = sr_[i].vs1; int kc = sc * 2;               \
    *(bf16x8*)(K_lds + (bb) * SHM_K + KSWZ(sr, kc)) = sr_[i].ks0;                       \
    *(bf16x8*)(K_lds + (bb) * SHM_K + KSWZ(32 + sr, kc)) = sr_[i].ks1; } while (0)
#define SWAIT() asm volatile("s_waitcnt vmcnt(0)" ::: "memory")
#define RESC(a) do { if (__any((a) < 1.f)) { if (hi == 0) al_l[r32] = (a); asm volatile("s_waitcnt lgkmcnt(0)" ::: "memory"); \
    _Pragma("unroll") for (int d = 0; d < 4; ++d) _Pragma("unroll") for (int r = 0; r < 16; ++r) o[d][r] *= al_l[crow(r, hi)]; } } while (0)
  const int NT = MODE == 0 ? 4 * (qb + 1) : 4;
  constexpr int SE = 0, SO = 0;
  SLOAD(SE, 0);
  __syncthreads();
  unsigned selmask = 0u;
  if constexpr (MODE == 0) {
    f32x16 gp = f32x16{};
#pragma unroll
    for (int d0 = 0; d0 < 8; ++d0) { const int cb = (d0 * 16 + hi * 8) * 2;
      const bf16x8 b0 = *reinterpret_cast<const bf16x8*>(KM + KSWZ(r32, cb));
      gp = __builtin_amdgcn_mfma_f32_32x32x16_bf16(b0, qr[d0], gp, 0, 0, 0); }
    float g[16];
#pragma unroll
    for (int r = 0; r < 8; ++r) { const float v = gp[r] + gp[r + 8];
      auto rr = __builtin_amdgcn_permlane32_swap(__float_as_uint(v), __float_as_uint(v), false, false);
      const int blo = (r < 4) ? r : 8 + (r - 4);
      g[blo] = __uint_as_float(rr[0]); g[blo + 4] = __uint_as_float(rr[1]); }
#pragma unroll
    for (int i = 0; i < 16; ++i) g[i] = (i < qb) ? g[i] : -INFINITY;
#pragma unroll
    for (int rnd = 0; rnd < 3; ++rnd) { float best = -INFINITY; int bi = -1;
#pragma unroll
      for (int i = 0; i < 16; ++i) if (g[i] > best) { best = g[i]; bi = i; }
      if (bi >= 0) selmask |= 1u << bi;
#pragma unroll
      for (int i = 0; i < 16; ++i) if (i == bi) g[i] = -INFINITY; }
  }
  const int qrow = wid * QBLK + r32;
  f32x16 pA0, pA1, pB0, pB1; float mnA, mnB, alA, alB; bf16x8 pa0, pa1, pa2, pa3;
  asm volatile("s_waitcnt vmcnt(0)" ::: "memory"); SWRITE(0, SE); __syncthreads();
  qkt(pA0, pA1, K_lds, qr, r32, hi); tile_mask<MODE>(pA0, pA1, 0, qb, selmask, qrow, hi); partialSM(pA0, pA1, m_reg, mnA, alA);
  SLOAD(SO, KVBLK);
  SWAIT(); SWRITE(1, SO); __syncthreads();
  for (int j = 1; j + 1 < NT; j += 2) {
    SBAR(); qkt(pB0, pB1, K_lds + SHM_K, qr, r32, hi); tile_mask<MODE>(pB0, pB1, j, qb, selmask, qrow, hi);
    finishSM(pA0, pA1, alA, l_reg, pa0, pa1, pa2, pa3); SBAR();
    SLOAD(SE, (j + 1) * KVBLK); SBAR();
    pv_d0(o, vb0, pa0, pa1, pa2, pa3); partialSM(pB0, pB1, m_reg, mnB, alB);
    __syncthreads(); SWAIT(); SWRITE(0, SE);
    RESC(alB); __syncthreads();
    SBAR(); qkt(pA0, pA1, K_lds, qr, r32, hi); tile_mask<MODE>(pA0, pA1, j + 1, qb, selmask, qrow, hi);
    finishSM(pB0, pB1, alB, l_reg, pa0, pa1, pa2, pa3); SBAR();
    SLOAD(SO, (j + 2) * KVBLK); SBAR();
    pv_d0(o, vb0 + SHM_V, pa0, pa1, pa2, pa3); partialSM(pA0, pA1, m_reg, mnA, alA);
    __syncthreads(); SWAIT(); SWRITE(1, SO);
    RESC(alA); __syncthreads();
  }
  SBAR(); qkt(pB0, pB1, K_lds + SHM_K, qr, r32, hi); tile_mask<MODE>(pB0, pB1, NT - 1, qb, selmask, qrow, hi);
  finishSM(pA0, pA1, alA, l_reg, pa0, pa1, pa2, pa3); SBAR();
  pv_d0(o, vb0, pa0, pa1, pa2, pa3); partialSM(pB0, pB1, m_reg, mnB, alB);
  __syncthreads(); RESC(alB);
  finishSM(pB0, pB1, alB, l_reg, pa0, pa1, pa2, pa3); SBAR();
  pv_d0(o, vb0 + SHM_V, pa0, pa1, pa2, pa3);
  if (hi == 0) li_l[r32] = l_reg; asm volatile("s_waitcnt lgkmcnt(0)" ::: "memory");
  float rli[16];
#pragma unroll
  for (int r = 0; r < 16; ++r) rli[r] = __builtin_amdgcn_rcpf(li_l[crow(r, hi)]);
  if constexpr (MODE == 0) {
#pragma unroll
  for (int r = 0; r < 16; ++r) { float s = 0.f;
#pragma unroll
    for (int d0 = 0; d0 < 4; ++d0) { o[d0][r] *= rli[r]; s += o[d0][r] * o[d0][r]; }
    RS[crow(r, hi) * 33 + r32] = s; }
  asm volatile("s_waitcnt lgkmcnt(0)" ::: "memory");
  { float s = 0.f;
#pragma unroll
    for (int c = 0; c < 32; ++c) s += RS[r32 * 33 + c];
    if (hi == 0) RV[r32] = rsqrtf(s * (1.f / D) + EPS); }
  asm volatile("s_waitcnt lgkmcnt(0)" ::: "memory");
  float gn[4];
#pragma unroll
  for (int d0 = 0; d0 < 4; ++d0) gn[d0] = gain[h * D + d0 * 32 + r32];
  bf16_t* Ow = merged + (rowbase + qb * 256 + wid * QBLK) * LDO + h * D;
#pragma unroll
  for (int r = 0; r < 16; ++r) { const int orow = crow(r, hi); const float rv = RV[orow];
#pragma unroll
    for (int d0 = 0; d0 < 4; ++d0) Ow[(long)orow * LDO + d0 * 32 + r32] = (bf16_t)f2bf(o[d0][r] * rv * gn[d0]); }
  } else {
    bf16_t* Ow = merged + (rowbase + qb * 256 + wid * QBLK) * LDO + h * D;
#pragma unroll
    for (int r = 0; r < 16; ++r) { const int orow = crow(r, hi);
#pragma unroll
      for (int d0 = 0; d0 < 4; ++d0) Ow[(long)orow * LDO + d0 * 32 + r32] = (bf16_t)f2bf(o[d0][r] * rli[r]); }
  }
#undef SLOAD
#undef SWRITE
#undef SWAIT
#undef RESC
}
#undef KSWZ
#undef SBAR
}

#define LAS __attribute__((address_space(3)))
#define XB_TMO      128
#define XB_XCNT(j)  (256  + 64 * (j))
#define XB_XSUB(j)  (1280 + 64 * (j))
#define XB_XGEN(j)  (2304 + 64 * (j))
#define XB_TOP      3328
#define XB_TOPGEN   3392
#define XCD_BAR_WORDS 3456
#define XB_SPIN_CAP (1u << 18)

__device__ __forceinline__ unsigned xb_ld(unsigned* p)              { return __hip_atomic_load(p, __ATOMIC_RELAXED, __HIP_MEMORY_SCOPE_AGENT); }
__device__ __forceinline__ unsigned xb_add(unsigned* p, unsigned v) { return __hip_atomic_fetch_add(p, v, __ATOMIC_RELAXED, __HIP_MEMORY_SCOPE_AGENT); }
__device__ __forceinline__ unsigned xb_xcc_id() { return (unsigned)__builtin_amdgcn_s_getreg((3 << 11) | 20) & 0xFu; }
#define XB_SPIN(cond, bar) do { unsigned _sp = 0; while (cond) { __builtin_amdgcn_s_sleep(1); \
    if ((++_sp & 255u) == 0u) { if (xb_ld(&(bar)[XB_TMO])) break; if (_sp > XB_SPIN_CAP) { atomicAdd(&(bar)[XB_TMO], 1u); break; } } } } while (0)

struct XcdBarrier {
    unsigned* bar; unsigned x;
    volatile LAS unsigned* st;
};

__device__ __forceinline__ XcdBarrier xcd_barrier_post(unsigned* bar, volatile LAS unsigned* st) {
    XcdBarrier b; b.bar = bar; b.x = xb_xcc_id(); b.st = st;
    if (threadIdx.x == 0) (void)xb_add(&bar[XB_XCNT(b.x)], 1u);
    return b;
}
__device__ __forceinline__ void xcd_barrier_complete(unsigned* bar, unsigned x, unsigned& nloc, unsigned& nx) {
    const unsigned G = gridDim.x * gridDim.y * gridDim.z;
    unsigned sum, cnt, mine, sp = 0u;
    for (;;) {
        sum = 0u; cnt = 0u; mine = 0u;
#pragma unroll
        for (unsigned j = 0; j < 16; ++j) { const unsigned c = xb_ld(&bar[XB_XCNT(j)]); sum += c; cnt += (c > 0u) ? 1u : 0u; mine = (j == x) ? c : mine; }
        if (sum == G) break;
        __builtin_amdgcn_s_sleep(1);
        if ((++sp & 255u) == 0u) { if (xb_ld(&bar[XB_TMO])) break; if (sp > XB_SPIN_CAP) { atomicAdd(&bar[XB_TMO], 1u); break; } }
    }
    nloc = mine > 0u ? mine : 1u; nx = cnt > 0u ? cnt : 1u;
}

__device__ __forceinline__ void xcd_barrier(const XcdBarrier& b) {
    asm volatile("s_waitcnt vmcnt(0)" ::: "memory");
    __syncthreads();
    if (threadIdx.x == 0) {
        unsigned* bar = b.bar;
        __builtin_amdgcn_s_waitcnt(0);
        unsigned nloc = b.st[0], nx = b.st[1];
        if (nloc == 0u) { xcd_barrier_complete(bar, b.x, nloc, nx); b.st[0] = nloc; b.st[1] = nx; }
        const unsigned old = xb_add(&bar[XB_XSUB(b.x)], 1u);
        const unsigned gen = old / nloc;
        if (old + 1u == (gen + 1u) * nloc) {
            __builtin_amdgcn_fence(__ATOMIC_RELEASE, "agent");
            asm volatile("s_waitcnt vmcnt(0)" ::: "memory");
            const unsigned og = xb_add(&bar[XB_TOP], 1u);
            const unsigned tg = og / nx;
            if (og + 1u == (tg + 1u) * nx) xb_add(&bar[XB_TOPGEN], 1u);
            else XB_SPIN(xb_ld(&bar[XB_TOPGEN]) == tg, bar);
            __builtin_amdgcn_fence(__ATOMIC_ACQUIRE, "agent");
            xb_add(&bar[XB_XGEN(b.x)], 1u);
            asm volatile("s_waitcnt vmcnt(0)" ::: "memory");
        } else {
            XB_SPIN(xb_ld(&bar[XB_XGEN(b.x)]) == gen, bar);
            __builtin_amdgcn_fence(__ATOMIC_ACQUIRE, "agent");
            asm volatile("s_waitcnt vmcnt(0)" ::: "memory");
        }
    }
    __syncthreads();
}

namespace cg = cooperative_groups;
constexpr int LDS_BYTES = 147456;
struct Args { const void* in[20]; float* out; unsigned char* ws; int flags, pad; };
__global__ void __launch_bounds__(512, 2) mk_fwd(Args a) {
    extern __shared__ __attribute__((aligned(16))) unsigned char lds[];
    cg::grid_group grid = cg::this_grid();
    const int G = (int)gridDim.x, bx = (int)blockIdx.x;
    const int NGW = G * 8, NT = G * 512;
    volatile LAS unsigned* bar_st = (volatile LAS unsigned*)((LAS unsigned char*)lds + 131072 + 64);
    { const int t0 = otid(); if (t0 < 2) bar_st[t0] = 0u; }
    __syncthreads();
    const XcdBarrier bar = xcd_barrier_post((unsigned*)(a.ws + WS_BAR), bar_st);
    if (a.flags != 0) grid.sync();
#define IDS() const int tid = otid(), lane = tid & 63, wave = __builtin_amdgcn_readfirstlane(tid >> 6); const int gw = bx * 8 + wave, gtid = bx * 512 + tid; float* wscr = (float*)(lds + wave * 16384); (void)lane; (void)gw; (void)gtid; (void)wscr
#define IN_F(k) ((const float*)a.in[k])
#define WSP(T, off) ((T)(a.ws + (off)))
#define x IN_F(0)
#define mem IN_F(1)
#define pos ((const int*)a.in[2])
#define g_mix IN_F(3)
#define w_in IN_F(4)
#define w_conv IN_F(5)
#define b_conv IN_F(6)
#define g_attn IN_F(7)
#define g_conv IN_F(8)
#define w_out IN_F(9)
#define g_xattn IN_F(10)
#define g_mem IN_F(11)
#define w_xq IN_F(12)
#define w_xkv IN_F(13)
#define w_xo IN_F(14)
#define g_ffn IN_F(15)
#define w_gate IN_F(16)
#define w_up IN_F(17)
#define w_down IN_F(18)
#define g_final IN_F(19)
#define out (a.out)
#define Win WSP(bf16_t*, WS_WIN)
#define Wout WSP(bf16_t*, WS_WOUT)
#define Wxq WSP(bf16_t*, WS_WXQ)
#define Wxkv WSP(bf16_t*, WS_WXKV)
#define Wxo WSP(bf16_t*, WS_WXO)
#define Wgu WSP(bf16_t*, WS_WGU)
#define Wdn WSP(bf16_t*, WS_WDN)
#define H WSP(bf16_t*, WS_H)
#define MRG WSP(bf16_t*, WS_MRG)
#define PROJ WSP(bf16_t*, WS_PROJ)
#define ACT WSP(bf16_t*, WS_ACT)
#define QX WSP(bf16_t*, WS_QX)
#define OX WSP(bf16_t*, WS_OX)
#define KVX WSP(bf16_t*, WS_KVX)
#define MEMN WSP(bf16_t*, WS_MEMN)
#define CS WSP(float*, WS_CS)
#define KMEAN WSP(float*, WS_KMEAN)
#define X8 WSP(unsigned char*, WS_X8)
#define SS1 WSP(float*, WS_SS)
#define SS2 WSP(float*, WS_SS + 2 * MiB)
#define SS3 WSP(float*, WS_SS + 4 * MiB)
    PG8_LAS unsigned char* ldsg = (PG8_LAS unsigned char*)lds;

#define COMMA ,
#define GEMM(EpiT, Aop, Bop, Mr, Nc, Kd, ...) do { pg8::Gemm g_{Aop, Bop, Mr, Nc, Kd, 0}; pg8::StaticOrder S_; S_.init(Mr, Nc, G, bx); EpiT E_{__VA_ARGS__}; \
        pg8::gemm_phase<EpiT, pg8::StaticOrder, true, true>(ldsg, g_, S_, E_); } while (0)
#define GEMM8(EpiT, Aop, Bop, Mr, Nc, Kd, ...) do { pg8::Gemm g_{Aop, Bop, Mr, Nc, Kd, 0}; pg8::StaticOrder S_; S_.init(Mr, Nc, G, bx); EpiT E_{__VA_ARGS__}; \
        pg8::gemm_phase<EpiT, pg8::StaticOrder, true, true, true, 0x77777777>(ldsg, g_, S_, E_); } while (0)

    {
        IDS();
        int base = 0;
        base = ph_transpose_job(TJob{w_in, nullptr, nullptr, Win, DM, NPROJ, NPROJ, 1, 1.f, 0}, base, wscr, gw, NGW, lane);
        base = ph_transpose_job(TJob{w_out, nullptr, nullptr, Wout, DM, DM, DM, 0, 1.f, 0}, base, wscr, gw, NGW, lane);
        base = ph_transpose_job(TJob{w_xq, nullptr, g_xattn, Wxq, DM, XW, XW, 0, 256.f, 1}, base, wscr, gw, NGW, lane);
        base = ph_transpose_job(TJob{w_xkv, nullptr, nullptr, Wxkv, DM, 2 * XW, 2 * XW, 0, 1.f, 0}, base, wscr, gw, NGW, lane);
        base = ph_transpose_job(TJob{w_xo, nullptr, nullptr, Wxo, XW, DM, DM, 0, 1.f, 0}, base, wscr, gw, NGW, lane);
    }
    { IDS(); ph_cs(pos, CS, gtid, NT); for (int i = gtid; i < NB * NH * NBLK * HD; i += NT) KMEAN[i] = 0.f; }
    { IDS(); ph_rms_bf16(x, g_mix, H, MT, gw, NGW, lane); ph_rms_bf16(mem, g_mem, MEMN, NB * NMEM, gw, NGW, lane); }
    xcd_barrier(bar);
    GEMM(pg8::EpiInProj, H, Win, MT, NPROJ, DM, PROJ, CS, KMEAN);
    xcd_barrier(bar);
    {
        const int vcu = (G % 8 == 0) ? (bx % 8) * (G / 8) + bx / 8 : bx;
        for (int p = vcu; p < NB * NH * 8; p += G) {
            const int bh = p >> 3, s = p & 7;
            moba::unit<0>(bh >> 3, bh & 7, s, PROJ, nullptr, KMEAN, g_attn, MRG, (char*)lds);
            moba::unit<0>(bh >> 3, bh & 7, 15 - s, PROJ, nullptr, KMEAN, g_attn, MRG, (char*)lds);
        }
        __syncthreads();
    }
    { IDS(); ph_conv(PROJ, w_conv, b_conv, g_conv, MRG, gw, NGW, lane); }
    xcd_barrier(bar);
    GEMM(pg8::EpiRes<true COMMA true>, MRG, Wout, MT, DM, DM, x, H, X8, SS1);
    xcd_barrier(bar);
    GEMM8(pg8::EpiRowScaleBf16, (const bf16_t*)X8, Wxq, MT, XW, DM, QX, SS1, XW, 0);
    { pg8::Gemm g_{MEMN, Wxkv, NB * NMEM, 2 * XW, DM, 0}; pg8::StaticOrder S_; S_.init(NB * NMEM, 2 * XW, G, (bx + G - 128 % G) % G); pg8::EpiStoreBf16 E_{KVX, 2 * XW, 0};
      pg8::gemm_phase<pg8::EpiStoreBf16, pg8::StaticOrder, true, true>(ldsg, g_, S_, E_); }
    {
        IDS();
        const int nidle = (G > 144 + 16) ? G - 144 : G, first = (G > 144 + 16) ? 144 : 0;
        if (bx >= first) {
            const int gw2 = (bx - first) * 8 + wave, NGW2 = nidle * 8; int base = 0;
            base = ph_transpose_job(TJob{w_gate, w_up, g_ffn, Wgu, DM, DFF, 2 * DFF, 2, 256.f, 1}, base, wscr, gw2, NGW2, lane);
            base = ph_transpose_job(TJob{w_down, nullptr, nullptr, Wdn, DFF, DM, DM, 0, 256.f, 1}, base, wscr, gw2, NGW2, lane);
        }
    }
    xcd_barrier(bar);
    {
        const int vcu = (G % 8 == 0) ? (bx % 8) * (G / 8) + bx / 8 : bx;
        for (int p = vcu; p < NB * XH * (SEQ / 256); p += G) { const int bh = p >> 4, qt = p & 15; moba::unit<1>(bh >> 2, bh & 3, qt, QX, KVX, nullptr, nullptr, OX, (char*)lds); }
        __syncthreads();
    }
    xcd_barrier(bar);
    GEMM(pg8::EpiRes<false COMMA true>, OX, Wxo, MT, DM, XW, H, H, X8, SS2);
    xcd_barrier(bar);
    GEMM8(pg8::EpiSwiGLUNorm<true>, (const bf16_t*)X8, Wgu, MT, 2 * DFF, DM, ACT, SS2, DFF, 0);
    xcd_barrier(bar);
    GEMM8(pg8::EpiRes<false COMMA false>, ACT, Wdn, MT, DM, DFF, H, H, nullptr, SS3);
    xcd_barrier(bar);
    { IDS(); ph_final_norm(H, out, g_final, SS3, MT, gw, NGW, lane); }
#undef GEMM
#undef COMMA
#undef GEMM8
#undef IDS
#undef x
#undef mem
#undef pos
#undef g_mix
#undef w_in
#undef w_conv
#undef b_conv
#undef g_attn
#undef g_conv
#undef w_out
#undef g_xattn
#undef g_mem
#undef w_xq
#undef w_xkv
#undef w_xo
#undef g_ffn
#undef w_gate
#undef w_up
#undef w_down
#undef g_final
#undef out
#undef Win
#undef Wout
#undef Wxq
#undef Wxkv
#undef Wxo
#undef Wgu
#undef Wdn
#undef H
#undef MRG
#undef PROJ
#undef ACT
#undef QX
#undef OX
#undef KVX
#undef MEMN
#undef CS
#undef KMEAN
#undef SS1
#undef X8
#undef SS2
#undef SS3
#undef IN_F
#undef WSP
}

extern "C" void kernel_launch(void* const* d_in, const int* in_sizes, int n_in, void* d_out, int out_size, void* d_ws, size_t ws_size, hipStream_t stream) {
    static int grid_blocks = 0;
    if (grid_blocks == 0) {
        if (n_in != 20 || ws_size < WS_END) { fprintf(stderr, "kernel_launch: unexpected n_in %d / ws %zu\n", n_in, ws_size); grid_blocks = -1; return; }
        int dev = 0, cus = 0, per_cu = 0;
        (void)hipGetDevice(&dev); (void)hipDeviceGetAttribute(&cus, hipDeviceAttributeMultiprocessorCount, dev);
        (void)hipFuncSetAttribute((const void*)mk_fwd, hipFuncAttributeMaxDynamicSharedMemorySize, LDS_BYTES);
        (void)hipOccupancyMaxActiveBlocksPerMultiprocessor(&per_cu, (const void*)mk_fwd, 512, LDS_BYTES);
        if (per_cu < 1) { fprintf(stderr, "kernel_launch: occupancy query says %d blocks per CU\n", per_cu); per_cu = 1; }
        grid_blocks = cus;
        (void)hipGetLastError();
    }
    if (grid_blocks < 0) return;
    Args a{};
    for (int i = 0; i < 20; ++i) a.in[i] = d_in[i];
    a.out = (float*)d_out; a.ws = (unsigned char*)d_ws;
    (void)hipMemsetAsync((unsigned char*)d_ws + WS_BAR, 0, XCD_BAR_WORDS * 4, stream);
    void* args[] = {&a};
    hipError_t e = hipLaunchCooperativeKernel((const void*)mk_fwd, dim3(grid_blocks), dim3(512), args, LDS_BYTES, stream);
    if (e != hipSuccess) fprintf(stderr, "cooperative launch failed: %s (grid %d)\n", hipGetErrorString(e), grid_blocks);
}
```

```cpp
#include <hip/hip_runtime.h>
#include <hip/hip_cooperative_groups.h>
#include <cstdio>
#include <cstdint>
#include <cmath>
__device__ __forceinline__ int otid() { int t = (int)threadIdx.x; asm volatile("" : "+v"(t)); return t; }
namespace pg8 {
#define PG8_LAS __attribute__((address_space(3)))
typedef unsigned short bf16_t;
typedef short bf16x8 __attribute__((ext_vector_type(8)));
typedef float f32x4 __attribute__((ext_vector_type(4)));
typedef unsigned u32x4 __attribute__((ext_vector_type(4)));
constexpr int BM = 256, BK = 64, HALF = 128, HTB = HALF * BK * 2  , STAGE_BYTES = 8 * HTB, NXCD = 8, WGM = 8;

__host__ __device__ __forceinline__ int lds_byte(int r, int c) { const int st = (r >> 4) * 2 + (c >> 5), rr = r & 15, cc = c & 31, ob = rr * 64 + cc * 2; return st * 1024 + (ob ^ (((ob >> 9) & 1) << 5)); }
__host__ __device__ __forceinline__ void stage_rc(int b, int& R, int& C) { const int st = b / 1024, sb = b % 1024, swz = sb ^ (((sb >> 9) & 1) << 5); R = (st >> 1) * 16 + swz / 64; C = (st & 1) * 32 + (swz % 64) / 2; }
__host__ __device__ __forceinline__ int f8swz(int fr) { return (fr >> 1) ^ ((fr >= 4 && fr <= 11) ? 2 : 0); }
__host__ __device__ __forceinline__ void stage_rc8(int b, int& R, int& C) { const int fr = (b >> 7) & 15; R = (b >> 11) * 16 + fr; C = ((((b >> 4) & 7) ^ f8swz(fr)) * 8); }
__host__ __device__ __forceinline__ int perm32(int rho) { const int n = rho >> 4, i = rho & 15; return 8 * (i >> 2) + 4 * n + (i & 3); }

struct Unit { int pm, pn; };
struct Gemm { const bf16_t* A; const bf16_t* Bt; int M, N, K, pad; };

struct StaticOrder {
    int nM, nN, nwg, G, c;
    __host__ __device__ void init(int M, int N, int G_, int c_) { nM = M / BM; nN = N / BM; nwg = nM * nN; G = G_; c = c_; }
    __host__ __device__ bool next(int i, Unit& u) const {
        const long L = (long)i * G + c; if (L >= nwg) return false;
        int wgid = (int)L; { const int q = nwg / NXCD, r = nwg % NXCD, xcd = wgid % NXCD, off = wgid / NXCD; wgid = (xcd < r ? xcd * (q + 1) : r * (q + 1) + (xcd - r) * q) + off; }
        const int nig = WGM * nN, gid = wgid / nig, fm = gid * WGM, gsz = (nM - fm) < WGM ? (nM - fm) : WGM;
        u.pm = fm + ((wgid % nig) % gsz); u.pn = (wgid % nig) / gsz; return true;
    }
    __device__ __forceinline__ void a_ready(const Unit&) const {}
    __device__ __forceinline__ void done(const Unit&) const {}
};
__device__ __forceinline__ unsigned cvt_pk_bf16(float lo, float hi) { unsigned r; asm volatile("v_cvt_pk_bf16_f32 %0, %1, %2" : "=v"(r) : "v"(lo), "v"(hi)); return r; }
__device__ __forceinline__ unsigned pk4_fp8(float a, float b, float c, float d) {
    a = __builtin_amdgcn_fmed3f(a, -448.f, 448.f); b = __builtin_amdgcn_fmed3f(b, -448.f, 448.f); c = __builtin_amdgcn_fmed3f(c, -448.f, 448.f); d = __builtin_amdgcn_fmed3f(d, -448.f, 448.f);
    int r = 0; r = __builtin_amdgcn_cvt_pk_fp8_f32(a, b, r, false); r = __builtin_amdgcn_cvt_pk_fp8_f32(c, d, r, true); return (unsigned)r;
}
__device__ __forceinline__ void mfma_f8(f32x4& acc, const bf16x8& w0, const bf16x8& w1, const bf16x8& a0, const bf16x8& a1, int scale_w, int scale_a) {
    typedef int i32x8_ __attribute__((ext_vector_type(8))); typedef int i32x4_ __attribute__((ext_vector_type(4)));
    const i32x4_ p0 = __builtin_bit_cast(i32x4_, w0), p1 = __builtin_bit_cast(i32x4_, w1), q0 = __builtin_bit_cast(i32x4_, a0), q1 = __builtin_bit_cast(i32x4_, a1);
    const i32x8_ W = {p0[0], p0[1], p0[2], p0[3], p1[0], p1[1], p1[2], p1[3]}, A = {q0[0], q0[1], q0[2], q0[3], q1[0], q1[1], q1[2], q1[3]};
    asm volatile("v_mfma_scale_f32_16x16x128_f8f6f4 %0, %1, %2, %0, %3, %4 op_sel_hi:[0,0,0]" : "+v"(acc) : "v"(W), "v"(A), "v"(scale_w), "v"(scale_a));
}
template <class Epi, class Sched, bool ALIGN_EPI = false, bool SP2 = false, bool F8 = false, int SCALE_W = 0x7f7f7f7f>
__device__ __forceinline__ void gemm_phase(PG8_LAS unsigned char* lds, const Gemm g, const Sched& S, const Epi& E) {
    const int tid = otid(), wid = __builtin_amdgcn_readfirstlane(tid >> 6), lane = tid & 63, wr = wid >> 2, wc = wid & 3, fr = lane & 15, fq = lane >> 4;
    const int K = F8 ? g.K / 2 : g.K, nt = K / BK;
    unsigned voffA[2], voffB[2];
#pragma unroll
    for (int i = 0; i < 2; ++i) { int R, C; if constexpr (F8) stage_rc8(tid * 16 + i * 8192, R, C); else stage_rc(tid * 16 + i * 8192, R, C); const int Rb = Epi::PERM ? ((R & ~31) + perm32(R & 31)) : R;
        voffA[i] = (unsigned)(R * K + C) * 2u; voffB[i] = (unsigned)(Rb * K + C) * 2u; }
    const size_t kstep = (size_t)(BK * 2);
    const size_t hstep = (size_t)HALF * K * 2;
    const size_t tstep = 2 * hstep;
    const unsigned ldsw = (unsigned)wid * 1024u;
    int aoffk[2], boffk[2];
#pragma unroll
    for (int k = 0; k < 2; ++k) {
        if constexpr (F8) { const int ch = (((2 * fq + k) ^ f8swz(fr)) << 4); aoffk[k] = wr * 4 * 2048 + fr * 128 + ch; boffk[k] = wc * 2 * 2048 + fr * 128 + ch; }
        else { aoffk[k] = lds_byte(wr * 64 + fr, fq * 8) + k * 1024; boffk[k] = lds_byte(wc * 32 + fr, fq * 8) + k * 1024; } }
#define PG8_SA(b, h) (((b) * 2 + (h)) * HTB)
#define PG8_SB(b, h) ((4 + (b) * 2 + (h)) * HTB)
#define PG8_STAGE(bufoff, gbase, voff) do { _Pragma("unroll") for (int _i = 0; _i < 2; ++_i) \
        __builtin_amdgcn_global_load_lds((const unsigned*)((const char*)(gbase) + (voff)[_i]), (PG8_LAS unsigned*)(lds + (bufoff) + ldsw + _i * 8192), 16, 0, 0); } while (0)
#define PG8_LDA(dst, b, h) do { _Pragma("unroll") for (int m = 0; m < 4; ++m) _Pragma("unroll") for (int k = 0; k < 2; ++k) dst[m][k] = *(const PG8_LAS bf16x8*)(lds + PG8_SA(b, h) + aoffk[k] + m * 2048); } while (0)
#define PG8_LDB(dst, b, h) do { _Pragma("unroll") for (int n = 0; n < 2; ++n) _Pragma("unroll") for (int k = 0; k < 2; ++k) dst[n][k] = *(const PG8_LAS bf16x8*)(lds + PG8_SB(b, h) + boffk[k] + n * 2048); } while (0)
#define PG8_MMA(ai, bj, At, Bt) do { __builtin_amdgcn_s_setprio(1); _Pragma("unroll") for (int m = 0; m < 4; ++m) _Pragma("unroll") for (int n = 0; n < 2; ++n) { \
        if constexpr (F8) { mfma_f8(acc[ai][bj][m][n], Bt[n][0], Bt[n][1], At[m][0], At[m][1], SCALE_W, 0x7f7f7f7f); } \
        else { _Pragma("unroll") for (int k = 0; k < 2; ++k) acc[ai][bj][m][n] = __builtin_amdgcn_mfma_f32_16x16x32_bf16(Bt[n][k], At[m][k], acc[ai][bj][m][n], 0, 0, 0); } } \
        __builtin_amdgcn_s_setprio(0); } while (0)
#define PG8_WAIT_V(n) asm volatile("s_waitcnt vmcnt(" #n ")" ::: "memory")
#define PG8_WAIT_L(n) asm volatile("s_waitcnt lgkmcnt(" #n ")" ::: "memory")
#define PG8_BAR __builtin_amdgcn_s_barrier()
#define PG8_SCHED __builtin_amdgcn_sched_barrier(0)
    Unit cur, nxt; int ui = 0;
    if (!S.next(0, cur)) return;
    f32x4 acc[2][2][4][2];
#pragma unroll
    for (int a = 0; a < 2; ++a)
#pragma unroll
        for (int b = 0; b < 2; ++b)
#pragma unroll
            for (int m = 0; m < 4; ++m)
#pragma unroll
                for (int n = 0; n < 2; ++n) acc[a][b][m][n] = (f32x4){0.f, 0.f, 0.f, 0.f};
    bf16x8 At[4][2], B0[2][2], B1[2][2];
    const char* cA = (const char*)g.A + (size_t)cur.pm * tstep; const char* cB = (const char*)g.Bt + (size_t)cur.pn * tstep;
    S.a_ready(cur);
    if constexpr (SP2) {
        PG8_STAGE(PG8_SB(0, 0), cB, voffB); PG8_STAGE(PG8_SB(0, 1), cB + hstep, voffB); PG8_STAGE(PG8_SA(0, 0), cA, voffA); PG8_STAGE(PG8_SA(0, 1), cA + hstep, voffA);
        if (wr == 1) PG8_BAR;
        PG8_WAIT_V(2); PG8_BAR;
        PG8_STAGE(PG8_SB(1, 0), cB + kstep, voffB); PG8_STAGE(PG8_SA(1, 0), cA + kstep, voffA); PG8_STAGE(PG8_SB(1, 1), cB + hstep + kstep, voffB);
        PG8_WAIT_V(6); PG8_BAR;
    } else {
        PG8_STAGE(PG8_SB(0, 0), cB, voffB); PG8_STAGE(PG8_SA(0, 0), cA, voffA); PG8_STAGE(PG8_SB(0, 1), cB + hstep, voffB); PG8_STAGE(PG8_SA(0, 1), cA + hstep, voffA);
        if (wr == 1) PG8_BAR;
        PG8_WAIT_V(4); PG8_BAR;
        PG8_STAGE(PG8_SB(1, 0), cB + kstep, voffB); PG8_STAGE(PG8_SA(1, 0), cA + kstep, voffA); PG8_STAGE(PG8_SB(1, 1), cB + hstep + kstep, voffB);
        PG8_WAIT_V(6); PG8_BAR;
    }
    for (;;) {
        const bool has_next = S.next(ui + 1, nxt);
        const char* nA = has_next ? (const char*)g.A + (size_t)nxt.pm * tstep : cA; const char* nB = has_next ? (const char*)g.Bt + (size_t)nxt.pn * tstep : cB;
        for (int t = 0; t < nt; t += 2) {
            const bool last = (t == nt - 2);
            const char* a1 = cA + (size_t)(t + 1) * kstep;
            const char* a2 = last ? nA : cA + (size_t)(t + 2) * kstep; const char* b2 = last ? nB : cB + (size_t)(t + 2) * kstep;
            const char* a3 = a2 + kstep; const char* b3 = b2 + kstep;
            if (last && has_next) S.a_ready(nxt);
            if constexpr (SP2) {
            PG8_LDB(B0, 0, 0); PG8_LDB(B1, 0, 1); PG8_SCHED; PG8_LDA(At, 0, 0); PG8_STAGE(PG8_SA(1, 1), a1 + hstep, voffA);
            PG8_WAIT_V(8); PG8_WAIT_L(0); PG8_BAR; PG8_MMA(0, 0, At, B0); PG8_MMA(0, 1, At, B1); PG8_BAR; PG8_SCHED;
            PG8_LDA(At, 0, 1); PG8_STAGE(PG8_SB(0, 0), b2, voffB); PG8_STAGE(PG8_SB(0, 1), b2 + hstep, voffB); PG8_STAGE(PG8_SA(0, 0), a2, voffA);
            PG8_WAIT_V(8); PG8_WAIT_L(0); PG8_BAR; PG8_MMA(1, 0, At, B0); PG8_MMA(1, 1, At, B1); PG8_BAR; PG8_SCHED;
            PG8_LDB(B0, 1, 0); PG8_LDB(B1, 1, 1); PG8_SCHED; PG8_LDA(At, 1, 0); PG8_STAGE(PG8_SA(0, 1), a2 + hstep, voffA);
            PG8_WAIT_V(8); PG8_WAIT_L(0); PG8_BAR; PG8_MMA(0, 0, At, B0); PG8_MMA(0, 1, At, B1); PG8_BAR; PG8_SCHED;
            PG8_LDA(At, 1, 1); PG8_STAGE(PG8_SB(1, 0), b3, voffB); PG8_STAGE(PG8_SB(1, 1), b3 + hstep, voffB); PG8_STAGE(PG8_SA(1, 0), a3, voffA);
            PG8_WAIT_V(8); PG8_WAIT_L(0); PG8_BAR; PG8_MMA(1, 0, At, B0); PG8_MMA(1, 1, At, B1); PG8_BAR; PG8_SCHED;
            } else {
            PG8_LDB(B0, 0, 0); PG8_SCHED; PG8_LDA(At, 0, 0); PG8_STAGE(PG8_SA(1, 1), a1 + hstep, voffA);
            PG8_WAIT_L(8); PG8_BAR; PG8_WAIT_L(0); PG8_MMA(0, 0, At, B0); PG8_BAR; PG8_SCHED;
            PG8_LDB(B1, 0, 1); PG8_STAGE(PG8_SB(0, 0), b2, voffB);
            PG8_BAR; PG8_WAIT_L(0); PG8_MMA(0, 1, At, B1); PG8_BAR;
            PG8_LDA(At, 0, 1); PG8_STAGE(PG8_SA(0, 0), a2, voffA);
            PG8_BAR; PG8_WAIT_L(0); PG8_MMA(1, 0, At, B0); PG8_BAR; PG8_SCHED;
            PG8_STAGE(PG8_SB(0, 1), b2 + hstep, voffB);
            PG8_WAIT_V(6); PG8_BAR; PG8_MMA(1, 1, At, B1); PG8_BAR;
            PG8_LDB(B0, 1, 0); PG8_SCHED; PG8_LDA(At, 1, 0); PG8_STAGE(PG8_SA(0, 1), a2 + hstep, voffA);
            PG8_WAIT_L(8); PG8_BAR; PG8_WAIT_L(0); PG8_MMA(0, 0, At, B0); PG8_BAR; PG8_SCHED;
            PG8_LDB(B1, 1, 1); PG8_STAGE(PG8_SB(1, 0), b3, voffB);
            PG8_BAR; PG8_WAIT_L(0); PG8_MMA(0, 1, At, B1); PG8_BAR;
            PG8_LDA(At, 1, 1); PG8_STAGE(PG8_SA(1, 0), a3, voffA);
            PG8_BAR; PG8_WAIT_L(0); PG8_MMA(1, 0, At, B0); PG8_BAR; PG8_SCHED;
            PG8_STAGE(PG8_SB(1, 1), b3 + hstep, voffB);
            PG8_WAIT_V(6); PG8_BAR; PG8_MMA(1, 1, At, B1); PG8_BAR;
            }
        }
        if constexpr (ALIGN_EPI) { if (wr == 0) PG8_BAR; }
        if constexpr (F8) asm volatile("s_nop 15\n\ts_nop 15" ::: "memory");
        if constexpr (!Epi::AFTER_DRAIN) { E(acc, cur, wr, wc, fr, fq); S.done(cur); }
        if (!has_next) break;
#pragma unroll
        for (int a = 0; a < 2; ++a)
#pragma unroll
            for (int b = 0; b < 2; ++b)
#pragma unroll
                for (int m = 0; m < 4; ++m)
#pragma unroll
                    for (int n = 0; n < 2; ++n) acc[a][b][m][n] = (f32x4){0.f, 0.f, 0.f, 0.f};
        cur = nxt; cA = nA; cB = nB; ++ui;
        if constexpr (ALIGN_EPI) { if (wr == 1) PG8_BAR; }
    }
    PG8_WAIT_V(0);
    if constexpr (!ALIGN_EPI) { if (wr == 0) PG8_BAR; }
    PG8_BAR;
    if constexpr (Epi::AFTER_DRAIN) { E.fused(acc, cur, wr, wc, fr, fq, lds, wid, lane); S.done(cur); }
#undef PG8_SA
#undef PG8_SB
#undef PG8_STAGE
#undef PG8_LDA
#undef PG8_LDB
#undef PG8_MMA
#undef PG8_WAIT_V
#undef PG8_WAIT_L
#undef PG8_BAR
#undef PG8_SCHED
}
}

namespace pg8 {
struct EpiStoreBf16 {
    static constexpr bool PERM = true, AFTER_DRAIN = false;
    bf16_t* O; int ldc, pad;
    __device__ __forceinline__ void operator()(const f32x4 (&acc)[2][2][4][2], const Unit& u, int wr, int wc, int fr, int fq) const {
        const int row0 = u.pm * BM + wr * 64 + fr, col0 = u.pn * BM + wc * 32 + 8 * fq;
#pragma unroll
        for (int ai = 0; ai < 2; ++ai)
#pragma unroll
            for (int m = 0; m < 4; ++m) { bf16_t* rowp = O + (size_t)(row0 + ai * HALF + m * 16) * ldc + col0;
#pragma unroll
                for (int bj = 0; bj < 2; ++bj) { const f32x4 v0 = acc[ai][bj][m][0], v1 = acc[ai][bj][m][1];
                    u32x4 w; w.x = cvt_pk_bf16(v0[0], v0[1]); w.y = cvt_pk_bf16(v0[2], v0[3]); w.z = cvt_pk_bf16(v1[0], v1[1]); w.w = cvt_pk_bf16(v1[2], v1[3]);
                    *(u32x4*)(rowp + bj * HALF) = w; } }
    }
};
struct EpiResF32 {
    static constexpr bool PERM = false, AFTER_DRAIN = false;
    const float* base; float* out; int ldc, pad;
    __device__ __forceinline__ void operator()(const f32x4 (&acc)[2][2][4][2], const Unit& u, int wr, int wc, int fr, int fq) const {
        const int row0 = u.pm * BM + wr * 64 + fr, col0 = u.pn * BM + wc * 32 + 4 * fq;
#pragma unroll
        for (int ai = 0; ai < 2; ++ai)
#pragma unroll
            for (int m = 0; m < 4; ++m) { const size_t off = (size_t)(row0 + ai * HALF + m * 16) * ldc + col0;
#pragma unroll
                for (int bj = 0; bj < 2; ++bj)
#pragma unroll
                    for (int n = 0; n < 2; ++n) { const f32x4 b = *(const f32x4*)(base + off + bj * HALF + n * 16); *(f32x4*)(out + off + bj * HALF + n * 16) = b + acc[ai][bj][m][n]; } }
    }
};
struct EpiSwiGLU {
    static constexpr bool PERM = true, AFTER_DRAIN = false;
    bf16_t* O; int ldc, pad;
    __device__ __forceinline__ void operator()(const f32x4 (&acc)[2][2][4][2], const Unit& u, int wr, int wc, int fr, int fq) const {
        const int row0 = u.pm * BM + wr * 64 + fr, col0 = u.pn * HALF + wc * 32 + 8 * fq;
#pragma unroll
        for (int ai = 0; ai < 2; ++ai)
#pragma unroll
            for (int m = 0; m < 4; ++m) { bf16_t* rowp = O + (size_t)(row0 + ai * HALF + m * 16) * ldc + col0;
                float r[8];
#pragma unroll
                for (int n = 0; n < 2; ++n)
#pragma unroll
                    for (int e = 0; e < 4; ++e) { const float g = acc[ai][0][m][n][e], up = acc[ai][1][m][n][e]; r[n * 4 + e] = g * up / (1.0f + __expf(-g)); }
                u32x4 w; w.x = cvt_pk_bf16(r[0], r[1]); w.y = cvt_pk_bf16(r[2], r[3]); w.z = cvt_pk_bf16(r[4], r[5]); w.w = cvt_pk_bf16(r[6], r[7]);
                *(u32x4*)rowp = w; }
    }
};
}

namespace pg8 {
struct EpiInProj {
    static constexpr bool PERM = true, AFTER_DRAIN = false;
    bf16_t* O; const float* cs; float* kmean;
    __device__ __forceinline__ void operator()(const f32x4 (&acc)[2][2][4][2], const Unit& u, int wr, int wc, int fr, int fq) const {
        const int row0 = u.pm * BM + wr * 64 + fr;
        if (u.pn >= 8) {
            const int col0 = u.pn * BM + wc * 32 + 8 * fq;
#pragma unroll
            for (int ai = 0; ai < 2; ++ai)
#pragma unroll
                for (int m = 0; m < 4; ++m) { bf16_t* rowp = O + (size_t)(row0 + ai * HALF + m * 16) * 6144 + col0;
#pragma unroll
                    for (int bj = 0; bj < 2; ++bj) { const f32x4 v0 = acc[ai][bj][m][0], v1 = acc[ai][bj][m][1];
                        u32x4 w; w.x = cvt_pk_bf16(v0[0], v0[1]); w.y = cvt_pk_bf16(v0[2], v0[3]); w.z = cvt_pk_bf16(v1[0], v1[1]); w.w = cvt_pk_bf16(v1[2], v1[3]);
                        *(u32x4*)(rowp + bj * HALF) = w; } }
        } else {
            const int sec = u.pn >> 2, head = 2 * (u.pn & 3) + (wc >> 1), d0 = (wc & 1) * 32 + 8 * fq;
            bf16_t* obase = O + sec * 1024 + head * 128 + d0;
            float csum[16];
#pragma unroll
            for (int i = 0; i < 16; ++i) csum[i] = 0.f;
#pragma unroll
            for (int ai = 0; ai < 2; ++ai)
#pragma unroll
                for (int m = 0; m < 4; ++m) { const int row = row0 + ai * HALF + m * 16;
                    const f32x4* cp = (const f32x4*)(cs + ((size_t)row * 64 + d0) * 2);
                    float ol[8], oh[8];
#pragma unroll
                    for (int n = 0; n < 2; ++n) { const f32x4 t0 = cp[2 * n], t1 = cp[2 * n + 1]; const f32x4 lo = acc[ai][0][m][n], hi = acc[ai][1][m][n];
                        ol[4 * n + 0] = lo[0] * t0[0] - hi[0] * t0[1]; oh[4 * n + 0] = hi[0] * t0[0] + lo[0] * t0[1];
                        ol[4 * n + 1] = lo[1] * t0[2] - hi[1] * t0[3]; oh[4 * n + 1] = hi[1] * t0[2] + lo[1] * t0[3];
                        ol[4 * n + 2] = lo[2] * t1[0] - hi[2] * t1[1]; oh[4 * n + 2] = hi[2] * t1[0] + lo[2] * t1[1];
                        ol[4 * n + 3] = lo[3] * t1[2] - hi[3] * t1[3]; oh[4 * n + 3] = hi[3] * t1[2] + lo[3] * t1[3]; }
                    u32x4 w; w.x = cvt_pk_bf16(ol[0], ol[1]); w.y = cvt_pk_bf16(ol[2], ol[3]); w.z = cvt_pk_bf16(ol[4], ol[5]); w.w = cvt_pk_bf16(ol[6], ol[7]);
                    *(u32x4*)(obase + (size_t)row * 6144) = w;
                    w.x = cvt_pk_bf16(oh[0], oh[1]); w.y = cvt_pk_bf16(oh[2], oh[3]); w.z = cvt_pk_bf16(oh[4], oh[5]); w.w = cvt_pk_bf16(oh[6], oh[7]);
                    *(u32x4*)(obase + (size_t)row * 6144 + 64) = w;
                    if (sec == 1) {
#pragma unroll
                        for (int i = 0; i < 8; ++i) { csum[i] += ol[i]; csum[8 + i] += oh[i]; } } }
            if (sec == 1) {
                float* km = kmean + (size_t)(((u.pm >> 4) * 8 + head) * 16 + (u.pm & 15)) * 128 + d0;
#pragma unroll
                for (int i = 0; i < 16; ++i) { float v = csum[i]; v += __shfl_xor(v, 1); v += __shfl_xor(v, 2); v += __shfl_xor(v, 4); v += __shfl_xor(v, 8);
                    if (fr == 0) atomicAdd(km + (i & 7) + (i >> 3) * 64, v * (1.f / 256.f)); }
            }
        }
    }
};
__device__ __forceinline__ float row_rinv(const float* ss, int row, int fq) {
    const f32x4* p = (const f32x4*)(ss + (size_t)row * 32 + fq * 8); const f32x4 a = p[0], b = p[1];
    float s = ((a[0] + a[1]) + (a[2] + a[3])) + ((b[0] + b[1]) + (b[2] + b[3]));
    s += __shfl_xor(s, 16); s += __shfl_xor(s, 32);
    return rsqrtf(s * (1.f / 2048.f) + 1e-6f);
}
template <bool BASE_F32, bool OUT_F8> struct EpiRes {
    static constexpr bool PERM = true, AFTER_DRAIN = false;
    const void* base; bf16_t* outb; unsigned char* out8; float* ss;
    __device__ __forceinline__ void operator()(const f32x4 (&acc)[2][2][4][2], const Unit& u, int wr, int wc, int fr, int fq) const {
        const int row0 = u.pm * BM + wr * 64 + fr, col0 = u.pn * BM + wc * 32 + 8 * fq;
#pragma unroll
        for (int ai = 0; ai < 2; ++ai)
#pragma unroll
            for (int m = 0; m < 4; ++m) { const int row = row0 + ai * HALF + m * 16; const size_t off = (size_t)row * 2048 + col0; float s = 0.f;
#pragma unroll
                for (int bj = 0; bj < 2; ++bj) { f32x4 v0, v1;
                    if (BASE_F32) { v0 = *(const f32x4*)((const float*)base + off + bj * HALF); v1 = *(const f32x4*)((const float*)base + off + bj * HALF + 4); }
                    else { const u32x4 bb = *(const u32x4*)((const bf16_t*)base + off + bj * HALF);
                        v0 = (f32x4){__uint_as_float(bb.x << 16), __uint_as_float(bb.x & 0xffff0000u), __uint_as_float(bb.y << 16), __uint_as_float(bb.y & 0xffff0000u)};
                        v1 = (f32x4){__uint_as_float(bb.z << 16), __uint_as_float(bb.z & 0xffff0000u), __uint_as_float(bb.w << 16), __uint_as_float(bb.w & 0xffff0000u)}; }
                    v0 = v0 + acc[ai][bj][m][0]; v1 = v1 + acc[ai][bj][m][1];
                    s += ((v0[0] * v0[0] + v0[1] * v0[1]) + (v0[2] * v0[2] + v0[3] * v0[3])) + ((v1[0] * v1[0] + v1[1] * v1[1]) + (v1[2] * v1[2] + v1[3] * v1[3]));
                    { u32x4 w; w.x = cvt_pk_bf16(v0[0], v0[1]); w.y = cvt_pk_bf16(v0[2], v0[3]); w.z = cvt_pk_bf16(v1[0], v1[1]); w.w = cvt_pk_bf16(v1[2], v1[3]);
                      *(u32x4*)(outb + off + bj * HALF) = w; }
                    if (OUT_F8) { typedef unsigned u32x2_ __attribute__((ext_vector_type(2))); u32x2_ w; w.x = pk4_fp8(v0[0], v0[1], v0[2], v0[3]); w.y = pk4_fp8(v1[0], v1[1], v1[2], v1[3]);
                        *(u32x2_*)(out8 + off + bj * HALF) = w; } }
                s += __shfl_xor(s, 16); s += __shfl_xor(s, 32);
                if (fq == 0) ss[(size_t)row * 32 + u.pn * 4 + wc] = s; }
    }
};
struct EpiRowScaleBf16 {
    static constexpr bool PERM = true, AFTER_DRAIN = false;
    bf16_t* O; const float* ss; int ldc, pad;
    __device__ __forceinline__ void operator()(const f32x4 (&acc)[2][2][4][2], const Unit& u, int wr, int wc, int fr, int fq) const {
        const int row0 = u.pm * BM + wr * 64 + fr, col0 = u.pn * BM + wc * 32 + 8 * fq;
#pragma unroll
        for (int ai = 0; ai < 2; ++ai)
#pragma unroll
            for (int m = 0; m < 4; ++m) { const int row = row0 + ai * HALF + m * 16; const float ri = row_rinv(ss, row, fq); bf16_t* rowp = O + (size_t)row * ldc + col0;
#pragma unroll
                for (int bj = 0; bj < 2; ++bj) { const f32x4 v0 = acc[ai][bj][m][0] * ri, v1 = acc[ai][bj][m][1] * ri;
                    u32x4 w; w.x = cvt_pk_bf16(v0[0], v0[1]); w.y = cvt_pk_bf16(v0[2], v0[3]); w.z = cvt_pk_bf16(v1[0], v1[1]); w.w = cvt_pk_bf16(v1[2], v1[3]);
                    *(u32x4*)(rowp + bj * HALF) = w; } }
    }
};
template <bool F8OUT> struct EpiSwiGLUNorm {
    static constexpr bool PERM = true, AFTER_DRAIN = false;
    bf16_t* O; const float* ss; int ldc, pad;
    __device__ __forceinline__ void operator()(const f32x4 (&acc)[2][2][4][2], const Unit& u, int wr, int wc, int fr, int fq) const {
        const int row0 = u.pm * BM + wr * 64 + fr, col0 = u.pn * HALF + wc * 32 + 8 * fq;
#pragma unroll
        for (int ai = 0; ai < 2; ++ai)
#pragma unroll
            for (int m = 0; m < 4; ++m) { const int row = row0 + ai * HALF + m * 16; const float ri = row_rinv(ss, row, fq); bf16_t* rowp = O + (size_t)row * ldc + col0;
                float r[8];
#pragma unroll
                for (int n = 0; n < 2; ++n)
#pragma unroll
                    for (int e = 0; e < 4; ++e) { const float g = acc[ai][0][m][n][e] * ri, up = acc[ai][1][m][n][e] * ri; r[n * 4 + e] = g * up / (1.0f + __expf(-g)); }
                if (F8OUT) { typedef unsigned u32x2_ __attribute__((ext_vector_type(2))); u32x2_ w; w.x = pk4_fp8(r[0], r[1], r[2], r[3]); w.y = pk4_fp8(r[4], r[5], r[6], r[7]);
                    *(u32x2_*)((unsigned char*)O + (size_t)row * ldc + col0) = w; }
                else { u32x4 w; w.x = cvt_pk_bf16(r[0], r[1]); w.y = cvt_pk_bf16(r[2], r[3]); w.z = cvt_pk_bf16(r[4], r[5]); w.w = cvt_pk_bf16(r[6], r[7]);
                    *(u32x4*)rowp = w; } }
    }
};
}
typedef unsigned short bf16_t;
constexpr int DM = 2048, NB = 4, SEQ = 4096, MT = NB * SEQ;
constexpr int HD = 128, NH = 8, AW = 1024, CW = 1024, NPROJ = 6144;
constexpr int NBLK = 16, MBLK = 256;
constexpr int NMEM = 256, XH = 4, XW = 512, DFF = 5632;
constexpr float EPS = 1e-6f;
constexpr float SM_SCALE = 0.088388347648318440f;
constexpr size_t MiB = 1u << 20;
constexpr size_t WS_WIN = 0;
constexpr size_t WS_WOUT = 24 * MiB;
constexpr size_t WS_WXQ = 32 * MiB;
constexpr size_t WS_WXKV = 34 * MiB;
constexpr size_t WS_WXO = 38 * MiB;
constexpr size_t WS_WGU = 40 * MiB;
constexpr size_t WS_WDN = 84 * MiB;
constexpr size_t WS_H = 112 * MiB;
constexpr size_t WS_MRG = 176 * MiB;
constexpr size_t WS_PROJ = 240 * MiB;
constexpr size_t WS_ACT = 240 * MiB;
constexpr size_t WS_H8 = 208 * MiB;
constexpr size_t WS_X8 = 330 * MiB;
constexpr size_t WS_QX = 432 * MiB;
constexpr size_t WS_OX = 448 * MiB;
constexpr size_t WS_KVX = 464 * MiB;
constexpr size_t WS_MEMN = 466 * MiB;
constexpr size_t WS_CS = 470 * MiB;
constexpr size_t WS_KMEAN = 478 * MiB;
constexpr size_t WS_SS = 479 * MiB;
constexpr size_t WS_BAR = 485 * MiB;
constexpr size_t WS_END = 486 * MiB;

__device__ __forceinline__ float bf2f(unsigned v) { return __uint_as_float(v << 16); }
__device__ __forceinline__ unsigned f2bf(float f) { unsigned u = __float_as_uint(f); return (u + 0x7fffu + ((u >> 16) & 1u)) >> 16; }
__device__ __forceinline__ unsigned pk2(float lo, float hi) { return f2bf(lo) | (f2bf(hi) << 16); }
__device__ __forceinline__ float wave_sum(float v) {
#pragma unroll
    for (int o = 1; o < 64; o <<= 1) v += __shfl_xor(v, o);
    return v;
}
__device__ __forceinline__ float wave_max(float v) {
#pragma unroll
    for (int o = 1; o < 64; o <<= 1) v = fmaxf(v, __shfl_xor(v, o));
    return v;
}
typedef float f32x4 __attribute__((ext_vector_type(4)));
typedef unsigned u32x4 __attribute__((ext_vector_type(4)));
typedef unsigned u32x2 __attribute__((ext_vector_type(2)));

struct TJob { const float* src0; const float* src1; const float* gain; bf16_t* dst; int K, Nsrc, nrows, mode; float wscale; int f8; };
__device__ __forceinline__ void transpose_item(const TJob& J, float* scr, int item, int lane) {
    const int nblk = J.nrows / 32, kb = item / nblk, nb = item % nblk, k0 = 64 * kb, n0 = 32 * nb;
    const float* src = J.src0; int c0 = n0;
    if (J.mode == 1 && n0 < 2048) { const int tile = n0 >> 8, c = n0 & 255, cc = c & 127; c0 = (tile >> 2) * 1024 + (2 * (tile & 3) + (cc >> 6)) * 128 + (cc & 63) + ((c >> 7) ? 64 : 0); }
    if (J.mode == 2) { const int tile = n0 >> 8, w = n0 & 255; if (w < 128) { c0 = tile * 128 + w; } else { src = J.src1; c0 = tile * 128 + w - 128; } }
    f32x4 ld[8];
#pragma unroll
    for (int i = 0; i < 8; ++i) ld[i] = *(const f32x4*)(src + (size_t)(k0 + 8 * i + (lane >> 3)) * J.Nsrc + c0 + 4 * (lane & 7));
#pragma unroll
    for (int i = 0; i < 8; ++i) { const int kk = 8 * i + (lane >> 3); float gsc = J.wscale; if (J.gain) gsc *= J.gain[k0 + kk];
#pragma unroll
        for (int e = 0; e < 4; ++e) scr[kk * 33 + 4 * (lane & 7) + e] = ld[i][e] * gsc; }
    asm volatile("s_waitcnt lgkmcnt(0)" ::: "memory");
    const int c = lane & 7;
#pragma unroll
    for (int j = 0; j < 4; ++j) { const int n = (lane >> 3) + 8 * j; const float* s = scr + (8 * c) * 33 + n;
        if (J.f8) { u32x2 o; o.x = pg8::pk4_fp8(s[0 * 33], s[1 * 33], s[2 * 33], s[3 * 33]); o.y = pg8::pk4_fp8(s[4 * 33], s[5 * 33], s[6 * 33], s[7 * 33]);
            *(u32x2*)((unsigned char*)J.dst + (size_t)(n0 + n) * J.K + k0 + 8 * c) = o; }
        else { u32x4 o; o.x = pk2(s[0 * 33], s[1 * 33]); o.y = pk2(s[2 * 33], s[3 * 33]); o.z = pk2(s[4 * 33], s[5 * 33]); o.w = pk2(s[6 * 33], s[7 * 33]);
            *(u32x4*)(J.dst + (size_t)(n0 + n) * J.K + k0 + 8 * c) = o; } }
    asm volatile("s_waitcnt lgkmcnt(0)" ::: "memory");
}
__device__ __forceinline__ int ph_transpose_job(const TJob J, int base, float* scr, int gw, int NGW, int lane) {
    const int nitems = (J.K / 64) * (J.nrows / 32);
    const int first = (gw - base % NGW + NGW) % NGW;
    for (int it = first; it < nitems; it += NGW) transpose_item(J, scr, it, lane);
    return base + nitems;
}

__device__ __forceinline__ void rms_row_bf16(const float* xrow, const float* g, bf16_t* orow, int lane) {
    const f32x4* xr = (const f32x4*)xrow + lane; const f32x4* gr = (const f32x4*)g + lane;
    f32x4 v[8]; float s = 0.f;
#pragma unroll
    for (int j = 0; j < 8; ++j) { v[j] = xr[64 * j]; s += (v[j].x * v[j].x + v[j].y * v[j].y) + (v[j].z * v[j].z + v[j].w * v[j].w); }
    const float rinv = rsqrtf(wave_sum(s) * (1.f / DM) + EPS);
    u32x2* o8 = (u32x2*)orow + lane;
#pragma unroll
    for (int j = 0; j < 8; ++j) { const f32x4 gg = gr[64 * j]; u32x2 w; w.x = pk2(v[j].x * rinv * gg.x, v[j].y * rinv * gg.y); w.y = pk2(v[j].z * rinv * gg.z, v[j].w * rinv * gg.w); o8[64 * j] = w; }
}
__device__ __forceinline__ void ph_rms_bf16(const float* X, const float* g, bf16_t* O, unsigned char* O8, int rows, int gw, int NGW, int lane) {
    f32x4 v[8], nx[8];
    int r = gw;
    if (r < rows) {
#pragma unroll
        for (int j = 0; j < 8; ++j) v[j] = ((const f32x4*)(X + (size_t)r * DM) + lane)[64 * j]; }
    for (; r < rows; r += NGW) {
        const int rn = r + NGW;
        if (rn < rows) {
#pragma unroll
            for (int j = 0; j < 8; ++j) nx[j] = ((const f32x4*)(X + (size_t)rn * DM) + lane)[64 * j]; }
        float s = 0.f;
#pragma unroll
        for (int j = 0; j < 8; ++j) s += (v[j].x * v[j].x + v[j].y * v[j].y) + (v[j].z * v[j].z + v[j].w * v[j].w);
        const float rinv = rsqrtf(wave_sum(s) * (1.f / DM) + EPS);
        u32x2* o8 = (u32x2*)(O + (size_t)r * DM) + lane; const f32x4* gr = (const f32x4*)g + lane;
#pragma unroll
        for (int j = 0; j < 8; ++j) { const f32x4 gg = gr[64 * j]; const f32x4 y = v[j] * rinv * gg; u32x2 w; w.x = pk2(y.x, y.y); w.y = pk2(y.z, y.w); o8[64 * j] = w;
            if (O8) ((unsigned*)(O8 + (size_t)r * DM))[64 * j + lane] = pg8::pk4_fp8(y.x, y.y, y.z, y.w); }
#pragma unroll
        for (int j = 0; j < 8; ++j) v[j] = nx[j];
    }
}
__device__ __forceinline__ void ph_final_norm(const bf16_t* X, float* O, const float* g, const float* ss, int rows, int gw, int NGW, int lane) {
    for (int r = gw; r < rows; r += NGW) {
        const u32x4* xr = (const u32x4*)(X + (size_t)r * DM) + lane; f32x4* orow = (f32x4*)(O + (size_t)r * DM); const f32x4* gr = (const f32x4*)g;
        u32x4 v[4];
#pragma unroll
        for (int j = 0; j < 4; ++j) v[j] = xr[64 * j];
        const float part = (lane < 32) ? ss[(size_t)r * 32 + lane] : 0.f;
        const float rinv = rsqrtf(wave_sum(part) * (1.f / DM) + EPS);
#pragma unroll
        for (int j = 0; j < 4; ++j) { const int c4 = 2 * (64 * j + lane);
            const f32x4 lo = {__uint_as_float(v[j].x << 16), __uint_as_float(v[j].x & 0xffff0000u), __uint_as_float(v[j].y << 16), __uint_as_float(v[j].y & 0xffff0000u)};
            const f32x4 hi = {__uint_as_float(v[j].z << 16), __uint_as_float(v[j].z & 0xffff0000u), __uint_as_float(v[j].w << 16), __uint_as_float(v[j].w & 0xffff0000u)};
            orow[c4] = lo * rinv * gr[c4]; orow[c4 + 1] = hi * rinv * gr[c4 + 1]; }
    }
}

__device__ __forceinline__ void sincos_small(double r, double& s, double& c) {
    const double r2 = r * r;
    double a = -1.0 / 10888869450418352160768000000.0;
    a = a * r2 + 1.0 / 15511210043330985984000000.0;
    a = a * r2 - 1.0 / 25852016738884976640000.0;
    a = a * r2 + 1.0 / 51090942171709440000.0;
    a = a * r2 - 1.0 / 121645100408832000.0;
    a = a * r2 + 1.0 / 355687428096000.0;
    a = a * r2 - 1.0 / 1307674368000.0;
    a = a * r2 + 1.0 / 6227020800.0;
    a = a * r2 - 1.0 / 39916800.0;
    a = a * r2 + 1.0 / 362880.0;
    a = a * r2 - 1.0 / 5040.0;
    a = a * r2 + 1.0 / 120.0;
    a = a * r2 - 1.0 / 6.0;
    a = a * r2 + 1.0;
    s = a * r;
    double b = 1.0 / 403291461126605635584000000.0;
    b = b * r2 - 1.0 / 620448401733239439360000.0;
    b = b * r2 + 1.0 / 1124000727777607680000.0;
    b = b * r2 - 1.0 / 2432902008176640000.0;
    b = b * r2 + 1.0 / 6402373705728000.0;
    b = b * r2 - 1.0 / 20922789888000.0;
    b = b * r2 + 1.0 / 87178291200.0;
    b = b * r2 - 1.0 / 479001600.0;
    b = b * r2 + 1.0 / 3628800.0;
    b = b * r2 - 1.0 / 40320.0;
    b = b * r2 + 1.0 / 720.0;
    b = b * r2 - 1.0 / 24.0;
    b = b * r2 + 1.0 / 2.0;
    c = 1.0 - b * r2;
}
__device__ __forceinline__ void cs_entry(const int* pos, float* cs, int idx) {
    const int t = idx >> 6, f = idx & 63;
    double p = 1.0, bs = 0.8659643233600653;
#pragma unroll
    for (int bit = 0; bit < 6; ++bit) { if ((f >> bit) & 1) p *= bs; bs *= bs; }
    const double ang = (double)pos[t] * p;
    const double TWO_PI = 6.283185307179586;
    const double n = rint(ang / TWO_PI);
    const double r = fma(-n, TWO_PI, ang);
    double s, c; sincos_small(r, s, c);
    cs[2 * idx] = (float)c; cs[2 * idx + 1] = (float)s;
}
__device__ __forceinline__ void ph_cs(const int* pos, float* cs, int gtid, int NT) {
    for (int idx = gtid; idx < MT * 64; idx += NT) cs_entry(pos, cs, idx);
}
__device__ __forceinline__ void ph_rope_naive(bf16_t* proj, const float* cs, int gtid, int NT) {
    const long total = (long)MT * 2 * NH * 64;
    for (long i = gtid; i < total; i += NT) {
        const int d = (int)(i & 63), h = (int)((i >> 6) & 7), sec = (int)((i >> 9) & 1); const long t = i >> 10;
        bf16_t* p = proj + t * NPROJ + sec * 1024 + h * HD + d;
        const float a = bf2f(p[0]), b = bf2f(p[64]); const float c = cs[(t * 64 + d) * 2], s = cs[(t * 64 + d) * 2 + 1];
        p[0] = (bf16_t)f2bf(a * c - b * s); p[64] = (bf16_t)f2bf(b * c + a * s);
    }
}
__device__ __forceinline__ void ph_kmean_naive(const bf16_t* proj, float* kmean, int gtid, int NT) {
    for (int i = gtid; i < NB * NH * NBLK * HD; i += NT) {
        const int d = i & 127, blkid = i >> 7;
        const int blk = blkid & 15, h = (blkid >> 4) & 7, b = blkid >> 7;
        float s = 0.f;
        for (int j = 0; j < MBLK; ++j) s += bf2f(proj[(size_t)(b * SEQ + blk * MBLK + j) * NPROJ + 1024 + h * HD + d]);
        kmean[(size_t)blkid * HD + d] = s * (1.f / MBLK);
    }
}
__device__ __forceinline__ float dot_q_row(const float* sq, const bf16_t* krow) {
    float a = 0.f;
#pragma unroll
    for (int d = 0; d < 128; d += 8) { const u32x4 kk = *(const u32x4*)(krow + d);
        a += sq[d + 0] * bf2f(kk.x & 0xffffu) + sq[d + 1] * bf2f(kk.x >> 16) + sq[d + 2] * bf2f(kk.y & 0xffffu) + sq[d + 3] * bf2f(kk.y >> 16)
           + sq[d + 4] * bf2f(kk.z & 0xffffu) + sq[d + 5] * bf2f(kk.z >> 16) + sq[d + 6] * bf2f(kk.w & 0xffffu) + sq[d + 7] * bf2f(kk.w >> 16); }
    return a;
}
__device__ __forceinline__ void ph_moba_naive(const bf16_t* proj, const float* kmean, const float* g_attn, bf16_t* merged, float qscale_inv, float* scr, int gw, int NGW, int lane) {
    float* sq = scr; float* sp = scr + 128;
    for (int item = gw; item < MT * NH; item += NGW) {
        const int t = item >> 3, h = item & 7, b = t >> 12, ts = t & 4095, qb = ts >> 8, tq = ts & 255;
        const bf16_t* qrow = proj + (size_t)t * NPROJ + h * HD;
        const unsigned qq = *(const unsigned*)(qrow + 2 * lane);
        const float q0 = bf2f(qq & 0xffffu) * qscale_inv, q1 = bf2f(qq >> 16) * qscale_inv;
        asm volatile("s_waitcnt lgkmcnt(0)" ::: "memory");
        sq[2 * lane] = q0; sq[2 * lane + 1] = q1;
        float g[16];
#pragma unroll
        for (int i = 0; i < 16; ++i) { const float* km = kmean + (size_t)((b * 8 + h) * 16 + i) * HD; const float p = wave_sum(q0 * km[2 * lane] + q1 * km[2 * lane + 1]); g[i] = (i < qb) ? p : -INFINITY; }
        int sel[4];
#pragma unroll
        for (int r = 0; r < 3; ++r) { float best = -INFINITY; int bi = -1;
#pragma unroll
            for (int i = 0; i < 16; ++i) if (g[i] > best) { best = g[i]; bi = i; }
            sel[r] = bi;
#pragma unroll
            for (int i = 0; i < 16; ++i) if (i == bi) g[i] = -INFINITY; }
        sel[3] = qb;
        asm volatile("s_waitcnt lgkmcnt(0)" ::: "memory");
#pragma unroll
        for (int s = 0; s < 4; ++s) { const int blk = sel[s];
            for (int jj = 0; jj < 4; ++jj) { const int j = jj * 64 + lane; float sc = -INFINITY;
                if (blk >= 0 && (s < 3 || j <= tq)) sc = dot_q_row(sq, proj + (size_t)(b * SEQ + blk * MBLK + j) * NPROJ + 1024 + h * HD) * SM_SCALE;
                sp[s * 256 + j] = sc; } }
        asm volatile("s_waitcnt lgkmcnt(0)" ::: "memory");
        float m = -INFINITY; for (int i = lane; i < 1024; i += 64) m = fmaxf(m, sp[i]); m = wave_max(m);
        float l = 0.f; for (int i = lane; i < 1024; i += 64) { const float p = __expf(sp[i] - m); sp[i] = p; l += p; } l = wave_sum(l);
        asm volatile("s_waitcnt lgkmcnt(0)" ::: "memory");
        float o0 = 0.f, o1 = 0.f;
#pragma unroll
        for (int s = 0; s < 4; ++s) { const int blk = sel[s]; if (blk < 0) continue;
            const bf16_t* vb = proj + (size_t)(b * SEQ + blk * MBLK) * NPROJ + 2048 + h * HD + 2 * lane;
            for (int j = 0; j < 256; ++j) { const float p = sp[s * 256 + j]; const unsigned vv = *(const unsigned*)(vb + (size_t)j * NPROJ); o0 += p * bf2f(vv & 0xffffu); o1 += p * bf2f(vv >> 16); } }
        const float li = 1.f / l; o0 *= li; o1 *= li;
        const float rinv = rsqrtf(wave_sum(o0 * o0 + o1 * o1) * (1.f / HD) + EPS);
        *(unsigned*)(merged + (size_t)t * DM + h * HD + 2 * lane) = pk2(o0 * rinv * g_attn[h * HD + 2 * lane], o1 * rinv * g_attn[h * HD + 2 * lane + 1]);
    }
}
__device__ __forceinline__ void ph_conv_naive(const bf16_t* proj, const float* w_conv, const float* b_conv, const float* g_conv, bf16_t* merged, int gw, int NGW, int lane) {
    for (int item = gw; item < MT * 8; item += NGW) {
        const int t = item >> 3, grp = item & 7, ts = t & 4095; const int c = grp * 128 + 2 * lane;
        float y[2];
#pragma unroll
        for (int e = 0; e < 2; ++e) { float acc = b_conv[c + e];
#pragma unroll
            for (int k = 0; k < 3; ++k) { const int back = 2 - k; if (ts - back >= 0) { const bf16_t* r = proj + (size_t)(t - back) * NPROJ; acc += w_conv[k * CW + c + e] * (bf2f(r[3072 + c + e]) * bf2f(r[5120 + c + e])); } }
            y[e] = bf2f(proj[(size_t)t * NPROJ + 4096 + c + e]) * acc; }
        const float rinv = rsqrtf(wave_sum(y[0] * y[0] + y[1] * y[1]) * (1.f / HD) + EPS);
        *(unsigned*)(merged + (size_t)t * DM + AW + c) = pk2(y[0] * rinv * g_conv[c], y[1] * rinv * g_conv[c + 1]);
    }
}
__device__ __forceinline__ void ph_conv(const bf16_t* __restrict__ proj, const float* __restrict__ w_conv, const float* __restrict__ b_conv, const float* __restrict__ g_conv, bf16_t* __restrict__ merged, int gw, int NGW, int lane) {
    const int l16 = lane & 15, sub = lane >> 4, grp = gw & 7, c = grp * 128 + l16 * 8;
    float w0[8], w1[8], w2[8], bc[8], gc[8];
#pragma unroll
    for (int h = 0; h < 2; ++h) { const f32x4 a0 = *(const f32x4*)(w_conv + c + 4 * h), a1 = *(const f32x4*)(w_conv + CW + c + 4 * h), a2 = *(const f32x4*)(w_conv + 2 * CW + c + 4 * h), bb = *(const f32x4*)(b_conv + c + 4 * h), gg = *(const f32x4*)(g_conv + c + 4 * h);
#pragma unroll
        for (int e = 0; e < 4; ++e) { w0[4 * h + e] = a0[e]; w1[4 * h + e] = a1[e]; w2[4 * h + e] = a2[e]; bc[4 * h + e] = bb[e]; gc[4 * h + e] = gg[e]; } }
    const int step = (NGW >> 3) * 4;
    for (int t = (gw >> 3) * 4 + sub; t < MT; t += step) {
        const int ts = t & (SEQ - 1); const bf16_t* r0 = proj + (size_t)t * NPROJ + c;
        const u32x4 vb = *(const u32x4*)(r0 + 4096), c0 = *(const u32x4*)(r0 + 3072), x0 = *(const u32x4*)(r0 + 5120);
        u32x4 c1 = {0u, 0u, 0u, 0u}, x1 = c1, c2 = c1, x2 = c1;
        if (ts >= 1) { c1 = *(const u32x4*)(r0 - NPROJ + 3072); x1 = *(const u32x4*)(r0 - NPROJ + 5120); }
        if (ts >= 2) { c2 = *(const u32x4*)(r0 - 2 * NPROJ + 3072); x2 = *(const u32x4*)(r0 - 2 * NPROJ + 5120); }
        float y[8]; float ss = 0.f;
#pragma unroll
        for (int q = 0; q < 4; ++q)
#pragma unroll
            for (int hh = 0; hh < 2; ++hh) { const int e = 2 * q + hh;
                const float C0 = hh ? __uint_as_float(c0[q] & 0xffff0000u) : __uint_as_float(c0[q] << 16), X0 = hh ? __uint_as_float(x0[q] & 0xffff0000u) : __uint_as_float(x0[q] << 16);
                const float C1 = hh ? __uint_as_float(c1[q] & 0xffff0000u) : __uint_as_float(c1[q] << 16), X1 = hh ? __uint_as_float(x1[q] & 0xffff0000u) : __uint_as_float(x1[q] << 16);
                const float C2 = hh ? __uint_as_float(c2[q] & 0xffff0000u) : __uint_as_float(c2[q] << 16), X2 = hh ? __uint_as_float(x2[q] & 0xffff0000u) : __uint_as_float(x2[q] << 16);
                const float Bv = hh ? __uint_as_float(vb[q] & 0xffff0000u) : __uint_as_float(vb[q] << 16);
                const float acc = bc[e] + w2[e] * (C0 * X0) + w1[e] * (C1 * X1) + w0[e] * (C2 * X2);
                y[e] = Bv * acc; ss += y[e] * y[e]; }
        ss += __shfl_xor(ss, 1); ss += __shfl_xor(ss, 2); ss += __shfl_xor(ss, 4); ss += __shfl_xor(ss, 8);
        const float rinv = rsqrtf(ss * (1.f / HD) + EPS);
        u32x2 o; o.x = pg8::pk4_fp8(y[0] * rinv * gc[0], y[1] * rinv * gc[1], y[2] * rinv * gc[2], y[3] * rinv * gc[3]); o.y = pg8::pk4_fp8(y[4] * rinv * gc[4], y[5] * rinv * gc[5], y[6] * rinv * gc[6], y[7] * rinv * gc[7]);
        *(u32x2*)((unsigned char*)merged + (size_t)t * DM + AW + c) = o;
    }
}
__device__ __forceinline__ void ph_xattn_naive(const bf16_t* qx, const bf16_t* kvx, bf16_t* ox, float qscale_inv, float* scr, int gw, int NGW, int lane) {
    float* sq = scr; float* sp = scr + 128;
    for (int item = gw; item < MT * XH; item += NGW) {
        const int t = item >> 2, h = item & 3, b = t >> 12;
        const unsigned qq = *(const unsigned*)(qx + (size_t)t * XW + h * HD + 2 * lane);
        asm volatile("s_waitcnt lgkmcnt(0)" ::: "memory");
        sq[2 * lane] = bf2f(qq & 0xffffu) * qscale_inv; sq[2 * lane + 1] = bf2f(qq >> 16) * qscale_inv;
        asm volatile("s_waitcnt lgkmcnt(0)" ::: "memory");
        float m = -INFINITY;
        for (int jj = 0; jj < 4; ++jj) { const int j = jj * 64 + lane; const float sc = dot_q_row(sq, kvx + (size_t)(b * NMEM + j) * 1024 + h * HD) * SM_SCALE; sp[j] = sc; m = fmaxf(m, sc); }
        m = wave_max(m);
        asm volatile("s_waitcnt lgkmcnt(0)" ::: "memory");
        float l = 0.f; for (int i = lane; i < 256; i += 64) { const float p = __expf(sp[i] - m); sp[i] = p; l += p; } l = wave_sum(l);
        asm volatile("s_waitcnt lgkmcnt(0)" ::: "memory");
        float o0 = 0.f, o1 = 0.f; const bf16_t* vb = kvx + (size_t)(b * NMEM) * 1024 + 512 + h * HD + 2 * lane;
        for (int j = 0; j < 256; ++j) { const float p = sp[j]; const unsigned vv = *(const unsigned*)(vb + (size_t)j * 1024); o0 += p * bf2f(vv & 0xffffu); o1 += p * bf2f(vv >> 16); }
        const float li = 1.f / l;
        *(unsigned*)(ox + (size_t)t * XW + h * HD + 2 * lane) = pk2(o0 * li, o1 * li);
    }
}

namespace moba {
using bf16x8 = __attribute__((ext_vector_type(8))) short;
using s16x4  = __attribute__((ext_vector_type(4))) short;
using f32x16 = __attribute__((ext_vector_type(16))) float;
using u32x4v = __attribute__((ext_vector_type(4))) unsigned;
using f32x4v = __attribute__((ext_vector_type(4))) float;
constexpr int D = 128, NW = 8, QBLK = 32, KVBLK = 64;
constexpr float SCALE = 0.088388347648318440f, THR = 8.f;
constexpr int SHM_V = KVBLK * D * 2, SHM_K = KVBLK * D * 2;
constexpr int OFF_V = 0, OFF_K = 2 * SHM_V, OFF_WS = OFF_K + 2 * SHM_K, OFF_KM = OFF_WS + NW * 256, OFF_RS = OFF_KM + 16 * 128 * 4, RS_BYTES = (32 * 33 + 32) * 4, LDS_END = OFF_RS + NW * RS_BYTES;
static_assert(LDS_END <= 131072, "moba LDS");
#define KSWZ(row, colB) ((row) * 256 + ((colB) ^ (((row) & 7) << 4)))
#define SBAR() __builtin_amdgcn_sched_barrier(0)
__device__ __forceinline__ int crow(int r, int hi) { return (r & 3) + 8 * (r >> 2) + 4 * hi; }
__device__ __forceinline__ unsigned cvtpk(float lo, float hi) { unsigned r; asm volatile("v_cvt_pk_bf16_f32 %0, %1, %2" : "=v"(r) : "v"(lo), "v"(hi)); return r; }
__device__ __forceinline__ void partialSM(f32x16& p0, f32x16& p1, float& m_reg, float& mn, float& alpha) {
  constexpr float C = SCALE * 1.4426950408889634f;
  float pmax = p0[0];
#pragma unroll
  for (int r = 1; r < 16; ++r) pmax = fmaxf(pmax, p0[r]);
#pragma unroll
  for (int r = 0; r < 16; ++r) pmax = fmaxf(pmax, p1[r]);
  { auto rr = __builtin_amdgcn_permlane32_swap(__float_as_uint(pmax), __float_as_uint(pmax), false, false);
    pmax = fmaxf(__uint_as_float(rr[0]), __uint_as_float(rr[1])); }
  if (__builtin_expect(__all(pmax - m_reg <= THR / SCALE), 1)) { mn = m_reg; alpha = 1.f; }
  else { mn = fmaxf(m_reg, pmax); alpha = __builtin_amdgcn_exp2f((m_reg - mn) * C); m_reg = mn; }
  float mnC = -mn * C;
#pragma unroll
  for (int r = 0; r < 16; ++r) p0[r] = fmaf(p0[r], C, mnC);
#pragma unroll
  for (int r = 0; r < 16; ++r) p1[r] = fmaf(p1[r], C, mnC);
#pragma unroll
  for (int r = 0; r < 16; ++r) p0[r] = __builtin_amdgcn_exp2f(p0[r]);
}
__device__ __forceinline__ void finishSM(f32x16& p0, f32x16& p1, float alpha, float& l_reg, bf16x8& pa0, bf16x8& pa1, bf16x8& pa2, bf16x8& pa3) {
#pragma unroll
  for (int r = 0; r < 16; ++r) p1[r] = __builtin_amdgcn_exp2f(p1[r]);
  float ps = 0;
#pragma unroll
  for (int r = 0; r < 16; ++r) ps += p0[r];
#pragma unroll
  for (int r = 0; r < 16; ++r) ps += p1[r];
  { auto rr = __builtin_amdgcn_permlane32_swap(__float_as_uint(ps), __float_as_uint(ps), false, false);
    ps = __uint_as_float(rr[0]) + __uint_as_float(rr[1]); }
  l_reg = l_reg * alpha + ps;
#define PK4(P, BASE, OUT) do { unsigned a0 = cvtpk(P[BASE + 0], P[BASE + 1]), a1 = cvtpk(P[BASE + 2], P[BASE + 3]);   \
    unsigned b0 = cvtpk(P[BASE + 4], P[BASE + 5]), b1 = cvtpk(P[BASE + 6], P[BASE + 7]);                              \
    auto r0 = __builtin_amdgcn_permlane32_swap(a0, b0, false, false); auto r1 = __builtin_amdgcn_permlane32_swap(a1, b1, false, false); \
    u32x4v w = {r0[0], r1[0], r0[1], r1[1]}; OUT = *reinterpret_cast<bf16x8*>(&w); } while (0)
  PK4(p0, 0, pa0); PK4(p0, 8, pa1); PK4(p1, 0, pa2); PK4(p1, 8, pa3);
#undef PK4
}
__device__ __forceinline__ void qkt(f32x16& p0, f32x16& p1, const char* Ks, const bf16x8* qr, int r32, int hi, float binit = 0.f) {
#pragma unroll
  for (int r = 0; r < 16; ++r) { p0[r] = binit; p1[r] = binit; }
#pragma unroll
  for (int d0 = 0; d0 < 8; ++d0) { int cb = (d0 * 16 + hi * 8) * 2;
    bf16x8 b0 = *reinterpret_cast<const bf16x8*>(Ks + KSWZ(r32, cb));
    bf16x8 b1 = *reinterpret_cast<const bf16x8*>(Ks + KSWZ(32 + r32, cb));
    p0 = __builtin_amdgcn_mfma_f32_32x32x16_bf16(b0, qr[d0], p0, 0, 0, 0);
    p1 = __builtin_amdgcn_mfma_f32_32x32x16_bf16(b1, qr[d0], p1, 0, 0, 0); }
}
__device__ __forceinline__ int v_st(int k, int c) { const int kk = (k & ~0xC) | ((k & 4) << 1) | ((k & 8) >> 1); return ((kk >> 3) * 4 + (c >> 5)) * 512 + ((kk & 7) * 32 + (c & 31)) * 2; }
__device__ __forceinline__ int v_rd_base(int lane) { return ((lane & 3) << 3) | (((lane >> 2) & 3) << 6) | (((lane >> 4) & 1) << 5) | (((lane >> 5) & 1) << 8); }
constexpr int v_rd_off(int d0, int ks, int half) { return d0 * 512 + ks * 4096 + half * 2048; }
template <int OFF> __device__ __forceinline__ s16x4 tr_read(int vb) {
  s16x4 r; asm volatile("ds_read_b64_tr_b16 %0, %1 offset:%2" : "=&v"(r) : "v"(vb), "i"(OFF) : "memory"); return r;
}
template <int D0> __device__ __forceinline__ void pv_one(f32x16& od, int vb, bf16x8 pa0, bf16x8 pa1, bf16x8 pa2, bf16x8 pa3) {
  const s16x4 l0 = tr_read<v_rd_off(D0, 0, 0)>(vb), h0 = tr_read<v_rd_off(D0, 0, 1)>(vb), l1 = tr_read<v_rd_off(D0, 1, 0)>(vb), h1 = tr_read<v_rd_off(D0, 1, 1)>(vb);
  const s16x4 l2 = tr_read<v_rd_off(D0, 2, 0)>(vb), h2 = tr_read<v_rd_off(D0, 2, 1)>(vb), l3 = tr_read<v_rd_off(D0, 3, 0)>(vb), h3 = tr_read<v_rd_off(D0, 3, 1)>(vb);
  asm volatile("s_waitcnt lgkmcnt(0)" ::: "memory"); SBAR();
#define PK(L, H) (bf16x8){L[0], L[1], L[2], L[3], H[0], H[1], H[2], H[3]}
  od = __builtin_amdgcn_mfma_f32_32x32x16_bf16(pa0, PK(l0, h0), od, 0, 0, 0);
  od = __builtin_amdgcn_mfma_f32_32x32x16_bf16(pa1, PK(l1, h1), od, 0, 0, 0);
  od = __builtin_amdgcn_mfma_f32_32x32x16_bf16(pa2, PK(l2, h2), od, 0, 0, 0);
  od = __builtin_amdgcn_mfma_f32_32x32x16_bf16(pa3, PK(l3, h3), od, 0, 0, 0);
#undef PK
}
__device__ __forceinline__ void pv_d0(f32x16* o, int vb, bf16x8 pa0, bf16x8 pa1, bf16x8 pa2, bf16x8 pa3) {
  pv_one<0>(o[0], vb, pa0, pa1, pa2, pa3); pv_one<1>(o[1], vb, pa0, pa1, pa2, pa3); pv_one<2>(o[2], vb, pa0, pa1, pa2, pa3); pv_one<3>(o[3], vb, pa0, pa1, pa2, pa3);
}
template <int MODE> __device__ __forceinline__ float tile_bias(int j, int qb, unsigned selmask) {
  if constexpr (MODE != 0) return 0.f;
  const int kb = j >> 2;
  return (kb < qb && !((selmask >> kb) & 1u)) ? -INFINITY : 0.f;
}
template <int MODE> __device__ __forceinline__ void tile_causal(f32x16& p0, f32x16& p1, int j, int qb, int qrow, int hi) {
  if constexpr (MODE != 0) return;
  if ((j >> 2) < qb) return;
  const int kbase = (j & 3) * 64;
#pragma unroll
  for (int r = 0; r < 16; ++r) { const int key = kbase + crow(r, hi); if (key > qrow) p0[r] = -INFINITY; if (key + 32 > qrow) p1[r] = -INFINITY; }
}
template <int MODE> __device__ __forceinline__ void unit(int b, int h, int qb, const bf16_t* __restrict__ proj, const bf16_t* __restrict__ kvp, const float* __restrict__ kmean, const float* __restrict__ gain, bf16_t* __restrict__ merged, char* lds) {
  constexpr int LDQ = MODE == 0 ? NPROJ : XW, LDK = MODE == 0 ? NPROJ : 2 * XW, LDO = MODE == 0 ? DM : XW;
  const int tid = otid(), wid = tid >> 6, lane = tid & 63, r32 = lane & 31, hi = lane >> 5;
  char* V_lds = lds + OFF_V; char* K_lds = lds + OFF_K;
  float* ws = (float*)(lds + OFF_WS) + wid * 64; float* li_l = ws; float* al_l = ws + 32;
  char* KM = lds + OFF_KM; float* RS = (float*)(lds + OFF_RS + wid * RS_BYTES); float* RV = RS + 32 * 33;
  const long rowbase = (long)b * SEQ;
  const bf16_t* Qw = proj + (rowbase + qb * 256 + wid * QBLK + r32) * LDQ + h * D + hi * 8;
  const bf16_t* Kh = MODE == 0 ? proj + rowbase * LDK + 1024 + h * D : kvp + (long)b * NMEM * LDK + h * D;
  const bf16_t* Vh = MODE == 0 ? proj + rowbase * LDK + 2048 + h * D : kvp + (long)b * NMEM * LDK + XW + h * D;
  __syncthreads();
  if constexpr (MODE == 0)
  { const int blk = tid >> 5, c4 = (tid & 31) * 4;
    const f32x4v kv = *(const f32x4v*)(kmean + (size_t)((b * 8 + h) * 16 + blk) * D + c4);
    unsigned hb[4], lb[4];
#pragma unroll
    for (int e = 0; e < 4; ++e) { hb[e] = f2bf(kv[e]); lb[e] = f2bf(kv[e] - __uint_as_float(hb[e] << 16)); }
    typedef unsigned u32x2v __attribute__((ext_vector_type(2)));
    *(u32x2v*)(KM + KSWZ(blk, c4 * 2)) = (u32x2v){hb[0] | (hb[1] << 16), hb[2] | (hb[3] << 16)};
    *(u32x2v*)(KM + KSWZ(16 + blk, c4 * 2)) = (u32x2v){lb[0] | (lb[1] << 16), lb[2] | (lb[3] << 16)}; }
  float m_reg = -1e30f, l_reg = 0; f32x16 o[4] = {}; bf16x8 qr[8];
#pragma unroll
  for (int d0 = 0; d0 < 8; ++d0) qr[d0] = *reinterpret_cast<const bf16x8*>(Qw + d0 * 16);
  const int sr = tid >> 4, sc = (tid & 15) * 8, vst0 = v_st(sr, sc), vst1 = v_st(32 + sr, sc);
  const int vb0 = (int)(uintptr_t)V_lds + v_rd_base(lane);
  struct { bf16x8 vs0, vs1, ks0, ks1; } sr_[1];
#define SLOAD(i, k0) do { sr_[i].vs0 = *reinterpret_cast<const bf16x8*>(&Vh[(long)((k0) + sr) * LDK + sc]); sr_[i].vs1 = *reinterpret_cast<const bf16x8*>(&Vh[(long)((k0) + 32 + sr) * LDK + sc]); \
    sr_[i].ks0 = *reinterpret_cast<const bf16x8*>(&Kh[(long)((k0) + sr) * LDK + sc]); sr_[i].ks1 = *reinterpret_cast<const bf16x8*>(&Kh[(long)((k0) + 32 + sr) * LDK + sc]); } while (0)
#define SWRITE(bb, i) do { *(bf16x8*)(V_lds + (bb) * SHM_V + vst0) = sr_[i].vs0;          \
    *(bf16x8*)(V_lds + (bb) * SHM_V + vst1) = sr_[i].vs1; int kc = sc * 2;               \
    *(bf16x8*)(K_lds + (bb) * SHM_K + KSWZ(sr, kc)) = sr_[i].ks0;                       \
    *(bf16x8*)(K_lds + (bb) * SHM_K + KSWZ(32 + sr, kc)) = sr_[i].ks1; } while (0)
#define SWAIT() asm volatile("s_waitcnt vmcnt(0)" ::: "memory")
#define RESC(a) do { if (__any((a) < 1.f)) { if (hi == 0) al_l[r32] = (a); asm volatile("s_waitcnt lgkmcnt(0)" ::: "memory"); \
    _Pragma("unroll") for (int d = 0; d < 4; ++d) _Pragma("unroll") for (int r = 0; r < 16; ++r) o[d][r] *= al_l[crow(r, hi)]; } } while (0)
  const int NT = MODE == 0 ? 4 * (qb + 1) : 4;
  constexpr int SE = 0, SO = 0;
  SLOAD(SE, 0);
  __syncthreads();
  unsigned selmask = 0u;
  if constexpr (MODE == 0) {
    f32x16 gp = f32x16{};
#pragma unroll
    for (int d0 = 0; d0 < 8; ++d0) { const int cb = (d0 * 16 + hi * 8) * 2;
      const bf16x8 b0 = *reinterpret_cast<const bf16x8*>(KM + KSWZ(r32, cb));
      gp = __builtin_amdgcn_mfma_f32_32x32x16_bf16(b0, qr[d0], gp, 0, 0, 0); }
    float g[16];
#pragma unroll
    for (int r = 0; r < 8; ++r) { const float v = gp[r] + gp[r + 8];
      auto rr = __builtin_amdgcn_permlane32_swap(__float_as_uint(v), __float_as_uint(v), false, false);
      const int blo = (r < 4) ? r : 8 + (r - 4);
      g[blo] = __uint_as_float(rr[0]); g[blo + 4] = __uint_as_float(rr[1]); }
#pragma unroll
    for (int i = 0; i < 16; ++i) g[i] = (i < qb) ? g[i] : -INFINITY;
#pragma unroll
    for (int rnd = 0; rnd < 3; ++rnd) { float best = -INFINITY; int bi = -1;
#pragma unroll
      for (int i = 0; i < 16; ++i) if (g[i] > best) { best = g[i]; bi = i; }
      if (bi >= 0) selmask |= 1u << bi;
#pragma unroll
      for (int i = 0; i < 16; ++i) if (i == bi) g[i] = -INFINITY; }
  }
  const int qrow = wid * QBLK + r32;
  f32x16 pA0, pA1, pB0, pB1; float mnA, mnB, alA, alB; bf16x8 pa0, pa1, pa2, pa3;
  asm volatile("s_waitcnt vmcnt(0)" ::: "memory"); SWRITE(0, SE); __syncthreads();
  qkt(pA0, pA1, K_lds, qr, r32, hi, tile_bias<MODE>(0, qb, selmask)); tile_causal<MODE>(pA0, pA1, 0, qb, qrow, hi); partialSM(pA0, pA1, m_reg, mnA, alA);
  SLOAD(SO, KVBLK);
  SWAIT(); SWRITE(1, SO); __syncthreads();
  for (int j = 1; j + 1 < NT; j += 2) {
    SBAR(); qkt(pB0, pB1, K_lds + SHM_K, qr, r32, hi, tile_bias<MODE>(j, qb, selmask)); tile_causal<MODE>(pB0, pB1, j, qb, qrow, hi);
    finishSM(pA0, pA1, alA, l_reg, pa0, pa1, pa2, pa3); SBAR();
    SLOAD(SE, (j + 1) * KVBLK); SBAR();
    pv_d0(o, vb0, pa0, pa1, pa2, pa3); partialSM(pB0, pB1, m_reg, mnB, alB);
    __syncthreads(); SWAIT(); SWRITE(0, SE);
    RESC(alB); __syncthreads();
    SBAR(); qkt(pA0, pA1, K_lds, qr, r32, hi, tile_bias<MODE>(j + 1, qb, selmask)); tile_causal<MODE>(pA0, pA1, j + 1, qb, qrow, hi);
    finishSM(pB0, pB1, alB, l_reg, pa0, pa1, pa2, pa3); SBAR();
    SLOAD(SO, (j + 2) * KVBLK); SBAR();
    pv_d0(o, vb0 + SHM_V, pa0, pa1, pa2, pa3); partialSM(pA0, pA1, m_reg, mnA, alA);
    __syncthreads(); SWAIT(); SWRITE(1, SO);
    RESC(alA); __syncthreads();
  }
  SBAR(); qkt(pB0, pB1, K_lds + SHM_K, qr, r32, hi, tile_bias<MODE>(NT - 1, qb, selmask)); tile_causal<MODE>(pB0, pB1, NT - 1, qb, qrow, hi);
  finishSM(pA0, pA1, alA, l_reg, pa0, pa1, pa2, pa3); SBAR();
  pv_d0(o, vb0, pa0, pa1, pa2, pa3); partialSM(pB0, pB1, m_reg, mnB, alB);
  __syncthreads(); RESC(alB);
  finishSM(pB0, pB1, alB, l_reg, pa0, pa1, pa2, pa3); SBAR();
  pv_d0(o, vb0 + SHM_V, pa0, pa1, pa2, pa3);
  if (hi == 0) li_l[r32] = l_reg; asm volatile("s_waitcnt lgkmcnt(0)" ::: "memory");
  float rli[16];
#pragma unroll
  for (int r = 0; r < 16; ++r) rli[r] = __builtin_amdgcn_rcpf(li_l[crow(r, hi)]);
  if constexpr (MODE == 0) {
#pragma unroll
  for (int r = 0; r < 16; ++r) { float s = 0.f;
#pragma unroll
    for (int d0 = 0; d0 < 4; ++d0) { o[d0][r] *= rli[r]; s += o[d0][r] * o[d0][r]; }
    RS[crow(r, hi) * 33 + r32] = s; }
  asm volatile("s_waitcnt lgkmcnt(0)" ::: "memory");
  { float s = 0.f;
#pragma unroll
    for (int c = 0; c < 32; ++c) s += RS[r32 * 33 + c];
    if (hi == 0) RV[r32] = rsqrtf(s * (1.f / D) + EPS); }
  asm volatile("s_waitcnt lgkmcnt(0)" ::: "memory");
  float gn[4];
#pragma unroll
  for (int d0 = 0; d0 < 4; ++d0) gn[d0] = gain[h * D + d0 * 32 + r32];
  unsigned char* Ow8 = (unsigned char*)merged + (rowbase + qb * 256 + wid * QBLK) * LDO + h * D;
#pragma unroll
  for (int r = 0; r < 16; ++r) { const int orow = crow(r, hi); const float rv = RV[orow];
#pragma unroll
    for (int d0 = 0; d0 < 4; ++d0) { const float vv = __builtin_amdgcn_fmed3f(o[d0][r] * rv * gn[d0], -448.f, 448.f); Ow8[(long)orow * LDO + d0 * 32 + r32] = (unsigned char)(__builtin_amdgcn_cvt_pk_fp8_f32(vv, vv, 0, false) & 0xff); } }
  } else {
    bf16_t* Ow = merged + (rowbase + qb * 256 + wid * QBLK) * LDO + h * D;
#pragma unroll
    for (int r = 0; r < 16; ++r) { const int orow = crow(r, hi);
#pragma unroll
      for (int d0 = 0; d0 < 4; ++d0) Ow[(long)orow * LDO + d0 * 32 + r32] = (bf16_t)f2bf(o[d0][r] * rli[r]); }
  }
#undef SLOAD
#undef SWRITE
#undef SWAIT
#undef RESC
}
#undef KSWZ
#undef SBAR
}

#define LAS __attribute__((address_space(3)))
#define XB_TMO      128
#define XB_XCNT(j)  (256  + 64 * (j))
#define XB_XSUB(j)  (1280 + 64 * (j))
#define XB_XGEN(j)  (2304 + 64 * (j))
#define XB_TOP      3328
#define XB_TOPGEN   3392
#define XCD_BAR_WORDS 3456
#define XB_SPIN_CAP (1u << 18)

__device__ __forceinline__ unsigned xb_ld(unsigned* p)              { return __hip_atomic_load(p, __ATOMIC_RELAXED, __HIP_MEMORY_SCOPE_AGENT); }
__device__ __forceinline__ unsigned xb_add(unsigned* p, unsigned v) { return __hip_atomic_fetch_add(p, v, __ATOMIC_RELAXED, __HIP_MEMORY_SCOPE_AGENT); }
__device__ __forceinline__ unsigned xb_xcc_id() { return (unsigned)__builtin_amdgcn_s_getreg((3 << 11) | 20) & 0xFu; }
#define XB_SPIN(cond, bar) do { unsigned _sp = 0; while (cond) { __builtin_amdgcn_s_sleep(1); \
    if ((++_sp & 255u) == 0u) { if (xb_ld(&(bar)[XB_TMO])) break; if (_sp > XB_SPIN_CAP) { atomicAdd(&(bar)[XB_TMO], 1u); break; } } } } while (0)

struct XcdBarrier {
    unsigned* bar; unsigned x;
    volatile LAS unsigned* st;
};

__device__ __forceinline__ XcdBarrier xcd_barrier_post(unsigned* bar, volatile LAS unsigned* st) {
    XcdBarrier b; b.bar = bar; b.x = xb_xcc_id(); b.st = st;
    if (threadIdx.x == 0) (void)xb_add(&bar[XB_XCNT(b.x)], 1u);
    return b;
}
__device__ __forceinline__ void xcd_barrier_complete(unsigned* bar, unsigned x, unsigned& nloc, unsigned& nx) {
    const unsigned G = gridDim.x * gridDim.y * gridDim.z;
    unsigned sum, cnt, mine, sp = 0u;
    for (;;) {
        sum = 0u; cnt = 0u; mine = 0u;
#pragma unroll
        for (unsigned j = 0; j < 16; ++j) { const unsigned c = xb_ld(&bar[XB_XCNT(j)]); sum += c; cnt += (c > 0u) ? 1u : 0u; mine = (j == x) ? c : mine; }
        if (sum == G) break;
        __builtin_amdgcn_s_sleep(1);
        if ((++sp & 255u) == 0u) { if (xb_ld(&bar[XB_TMO])) break; if (sp > XB_SPIN_CAP) { atomicAdd(&bar[XB_TMO], 1u); break; } }
    }
    nloc = mine > 0u ? mine : 1u; nx = cnt > 0u ? cnt : 1u;
}

__device__ __forceinline__ void xcd_barrier(const XcdBarrier& b) {
    asm volatile("s_waitcnt vmcnt(0)" ::: "memory");
    __syncthreads();
    if (threadIdx.x == 0) {
        unsigned* bar = b.bar;
        __builtin_amdgcn_s_waitcnt(0);
        unsigned nloc = b.st[0], nx = b.st[1];
        if (nloc == 0u) { xcd_barrier_complete(bar, b.x, nloc, nx); b.st[0] = nloc; b.st[1] = nx; }
        const unsigned old = xb_add(&bar[XB_XSUB(b.x)], 1u);
        const unsigned gen = old / nloc;
        if (old + 1u == (gen + 1u) * nloc) {
            __builtin_amdgcn_fence(__ATOMIC_RELEASE, "agent");
            asm volatile("s_waitcnt vmcnt(0)" ::: "memory");
            const unsigned og = xb_add(&bar[XB_TOP], 1u);
            const unsigned tg = og / nx;
            if (og + 1u == (tg + 1u) * nx) xb_add(&bar[XB_TOPGEN], 1u);
            else XB_SPIN(xb_ld(&bar[XB_TOPGEN]) == tg, bar);
            __builtin_amdgcn_fence(__ATOMIC_ACQUIRE, "agent");
            xb_add(&bar[XB_XGEN(b.x)], 1u);
            asm volatile("s_waitcnt vmcnt(0)" ::: "memory");
        } else {
            XB_SPIN(xb_ld(&bar[XB_XGEN(b.x)]) == gen, bar);
            __builtin_amdgcn_fence(__ATOMIC_ACQUIRE, "agent");
            asm volatile("s_waitcnt vmcnt(0)" ::: "memory");
        }
    }
    __syncthreads();
}

namespace cg = cooperative_groups;
constexpr int LDS_BYTES = 147456;
struct Args { const void* in[20]; float* out; unsigned char* ws; int flags, pad; };
__global__ void __launch_bounds__(512, 2) mk_fwd(Args a) {
    extern __shared__ __attribute__((aligned(16))) unsigned char lds[];
    cg::grid_group grid = cg::this_grid();
    const int G = (int)gridDim.x, bx = (int)blockIdx.x;
    const int NGW = G * 8, NT = G * 512;
    volatile LAS unsigned* bar_st = (volatile LAS unsigned*)((LAS unsigned char*)lds + 131072 + 64);
    { const int t0 = otid(); if (t0 < 2) bar_st[t0] = 0u; }
    __syncthreads();
    const XcdBarrier bar = xcd_barrier_post((unsigned*)(a.ws + WS_BAR), bar_st);
    if (a.flags != 0) grid.sync();
#define IDS() const int tid = otid(), lane = tid & 63, wave = __builtin_amdgcn_readfirstlane(tid >> 6); const int gw = bx * 8 + wave, gtid = bx * 512 + tid; float* wscr = (float*)(lds + wave * 16384); (void)lane; (void)gw; (void)gtid; (void)wscr
#define IN_F(k) ((const float*)a.in[k])
#define WSP(T, off) ((T)(a.ws + (off)))
#define x IN_F(0)
#define mem IN_F(1)
#define pos ((const int*)a.in[2])
#define g_mix IN_F(3)
#define w_in IN_F(4)
#define w_conv IN_F(5)
#define b_conv IN_F(6)
#define g_attn IN_F(7)
#define g_conv IN_F(8)
#define w_out IN_F(9)
#define g_xattn IN_F(10)
#define g_mem IN_F(11)
#define w_xq IN_F(12)
#define w_xkv IN_F(13)
#define w_xo IN_F(14)
#define g_ffn IN_F(15)
#define w_gate IN_F(16)
#define w_up IN_F(17)
#define w_down IN_F(18)
#define g_final IN_F(19)
#define out (a.out)
#define Win WSP(bf16_t*, WS_WIN)
#define Wout WSP(bf16_t*, WS_WOUT)
#define Wxq WSP(bf16_t*, WS_WXQ)
#define Wxkv WSP(bf16_t*, WS_WXKV)
#define Wxo WSP(bf16_t*, WS_WXO)
#define Wgu WSP(bf16_t*, WS_WGU)
#define Wdn WSP(bf16_t*, WS_WDN)
#define H WSP(bf16_t*, WS_H)
#define MRG WSP(bf16_t*, WS_MRG)
#define PROJ WSP(bf16_t*, WS_PROJ)
#define ACT WSP(bf16_t*, WS_ACT)
#define QX WSP(bf16_t*, WS_QX)
#define OX WSP(bf16_t*, WS_OX)
#define KVX WSP(bf16_t*, WS_KVX)
#define MEMN WSP(bf16_t*, WS_MEMN)
#define CS WSP(float*, WS_CS)
#define KMEAN WSP(float*, WS_KMEAN)
#define X8 WSP(unsigned char*, WS_X8)
#define H8 WSP(unsigned char*, WS_H8)
#define Win8 WSP(bf16_t*, WS_WIN + 8 * MiB)
#define SS1 WSP(float*, WS_SS)
#define SS2 WSP(float*, WS_SS + 2 * MiB)
#define SS3 WSP(float*, WS_SS + 4 * MiB)
    PG8_LAS unsigned char* ldsg = (PG8_LAS unsigned char*)lds;

#define COMMA ,
#define GEMM(EpiT, Aop, Bop, Mr, Nc, Kd, ...) do { pg8::Gemm g_{Aop, Bop, Mr, Nc, Kd, 0}; pg8::StaticOrder S_; S_.init(Mr, Nc, G, bx); EpiT E_{__VA_ARGS__}; \
        pg8::gemm_phase<EpiT, pg8::StaticOrder, true, true>(ldsg, g_, S_, E_); } while (0)
#define GEMM8(EpiT, Aop, Bop, Mr, Nc, Kd, ...) do { pg8::Gemm g_{Aop, Bop, Mr, Nc, Kd, 0}; pg8::StaticOrder S_; S_.init(Mr, Nc, G, bx); EpiT E_{__VA_ARGS__}; \
        pg8::gemm_phase<EpiT, pg8::StaticOrder, true, true, true, 0x77777777>(ldsg, g_, S_, E_); } while (0)

    {
        IDS();
        int base = 0;
        base = ph_transpose_job(TJob{w_in, nullptr, nullptr, Win, DM, NPROJ, 2048, 1, 1.f, 0}, base, wscr, gw, NGW, lane);
        base = ph_transpose_job(TJob{w_in + 2048, nullptr, nullptr, Win8, DM, NPROJ, 4096, 0, 256.f, 1}, base, wscr, gw, NGW, lane);
        base = ph_transpose_job(TJob{w_out, nullptr, nullptr, Wout, DM, DM, DM, 0, 256.f, 1}, base, wscr, gw, NGW, lane);
        base = ph_transpose_job(TJob{w_xq, nullptr, g_xattn, Wxq, DM, XW, XW, 0, 256.f, 1}, base, wscr, gw, NGW, lane);
        base = ph_transpose_job(TJob{w_xkv, nullptr, nullptr, Wxkv, DM, 2 * XW, 2 * XW, 0, 1.f, 0}, base, wscr, gw, NGW, lane);
        base = ph_transpose_job(TJob{w_xo, nullptr, nullptr, Wxo, XW, DM, DM, 0, 1.f, 0}, base, wscr, gw, NGW, lane);
    }
    { IDS(); ph_cs(pos, CS, gtid, NT); for (int i = gtid; i < NB * NH * NBLK * HD; i += NT) KMEAN[i] = 0.f; }
    { IDS(); ph_rms_bf16(x, g_mix, H, H8, MT, gw, NGW, lane); ph_rms_bf16(mem, g_mem, MEMN, nullptr, NB * NMEM, gw, NGW, lane); }
    xcd_barrier(bar);
    GEMM(pg8::EpiInProj, H, Win, MT, 2048, DM, PROJ, CS, KMEAN);
    GEMM8(pg8::EpiStoreBf16, (const bf16_t*)H8, Win8, MT, 4096, DM, PROJ + 2048, NPROJ, 0);
    xcd_barrier(bar);
    {
        const int vcu = (G % 8 == 0) ? (bx % 8) * (G / 8) + bx / 8 : bx;
        for (int p = vcu; p < NB * NH * 8; p += G) {
            const int bh = p >> 3, s = p & 7;
            moba::unit<0>(bh >> 3, bh & 7, s, PROJ, nullptr, KMEAN, g_attn, MRG, (char*)lds);
            moba::unit<0>(bh >> 3, bh & 7, 15 - s, PROJ, nullptr, KMEAN, g_attn, MRG, (char*)lds);
        }
        __syncthreads();
    }
    { IDS(); ph_conv(PROJ, w_conv, b_conv, g_conv, MRG, gw, NGW, lane); }
    xcd_barrier(bar);
    GEMM8(pg8::EpiRes<true COMMA true>, MRG, Wout, MT, DM, DM, x, H, X8, SS1);
    xcd_barrier(bar);
    GEMM8(pg8::EpiRowScaleBf16, (const bf16_t*)X8, Wxq, MT, XW, DM, QX, SS1, XW, 0);
    { pg8::Gemm g_{MEMN, Wxkv, NB * NMEM, 2 * XW, DM, 0}; pg8::StaticOrder S_; S_.init(NB * NMEM, 2 * XW, G, (bx + G - 128 % G) % G); pg8::EpiStoreBf16 E_{KVX, 2 * XW, 0};
      pg8::gemm_phase<pg8::EpiStoreBf16, pg8::StaticOrder, true, true>(ldsg, g_, S_, E_); }
    {
        IDS();
        const int nidle = (G > 144 + 16) ? G - 144 : G, first = (G > 144 + 16) ? 144 : 0;
        if (bx >= first) {
            const int gw2 = (bx - first) * 8 + wave, NGW2 = nidle * 8; int base = 0;
            base = ph_transpose_job(TJob{w_gate, w_up, g_ffn, Wgu, DM, DFF, 2 * DFF, 2, 256.f, 1}, base, wscr, gw2, NGW2, lane);
            base = ph_transpose_job(TJob{w_down, nullptr, nullptr, Wdn, DFF, DM, DM, 0, 256.f, 1}, base, wscr, gw2, NGW2, lane);
        }
    }
    xcd_barrier(bar);
    {
        const int vcu = (G % 8 == 0) ? (bx % 8) * (G / 8) + bx / 8 : bx;
        for (int p = vcu; p < NB * XH * (SEQ / 256); p += G) { const int bh = p >> 4, qt = p & 15; moba::unit<1>(bh >> 2, bh & 3, qt, QX, KVX, nullptr, nullptr, OX, (char*)lds); }
        __syncthreads();
    }
    xcd_barrier(bar);
    GEMM(pg8::EpiRes<false COMMA true>, OX, Wxo, MT, DM, XW, H, H, X8, SS2);
    xcd_barrier(bar);
    GEMM8(pg8::EpiSwiGLUNorm<true>, (const bf16_t*)X8, Wgu, MT, 2 * DFF, DM, ACT, SS2, DFF, 0);
    xcd_barrier(bar);
    GEMM8(pg8::EpiRes<false COMMA false>, ACT, Wdn, MT, DM, DFF, H, H, nullptr, SS3);
    xcd_barrier(bar);
    { IDS(); ph_final_norm(H, out, g_final, SS3, MT, gw, NGW, lane); }
#undef GEMM
#undef COMMA
#undef GEMM8
#undef IDS
#undef x
#undef mem
#undef pos
#undef g_mix
#undef w_in
#undef w_conv
#undef b_conv
#undef g_attn
#undef g_conv
#undef w_out
#undef g_xattn
#undef g_mem
#undef w_xq
#undef w_xkv
#undef w_xo
#undef g_ffn
#undef w_gate
#undef w_up
#undef w_down
#undef g_final
#undef out
#undef Win
#undef Wout
#undef Wxq
#undef Wxkv
#undef Wxo
#undef Wgu
#undef Wdn
#undef H
#undef MRG
#undef PROJ
#undef ACT
#undef QX
#undef OX
#undef KVX
#undef MEMN
#undef CS
#undef KMEAN
#undef SS1
#undef X8
#undef H8
#undef Win8
#undef SS2
#undef SS3
#undef IN_F
#undef WSP
}

extern "C" void kernel_launch(void* const* d_in, const int* in_sizes, int n_in, void* d_out, int out_size, void* d_ws, size_t ws_size, hipStream_t stream) {
    static int grid_blocks = 0;
    if (grid_blocks == 0) {
        if (n_in != 20 || ws_size < WS_END) { fprintf(stderr, "kernel_launch: unexpected n_in %d / ws %zu\n", n_in, ws_size); grid_blocks = -1; return; }
        int dev = 0, cus = 0, per_cu = 0;
        (void)hipGetDevice(&dev); (void)hipDeviceGetAttribute(&cus, hipDeviceAttributeMultiprocessorCount, dev);
        (void)hipFuncSetAttribute((const void*)mk_fwd, hipFuncAttributeMaxDynamicSharedMemorySize, LDS_BYTES);
        (void)hipOccupancyMaxActiveBlocksPerMultiprocessor(&per_cu, (const void*)mk_fwd, 512, LDS_BYTES);
        if (per_cu < 1) { fprintf(stderr, "kernel_launch: occupancy query says %d blocks per CU\n", per_cu); per_cu = 1; }
        grid_blocks = cus;
        (void)hipGetLastError();
    }
    if (grid_blocks < 0) return;
    Args a{};
    for (int i = 0; i < 20; ++i) a.in[i] = d_in[i];
    a.out = (float*)d_out; a.ws = (unsigned char*)d_ws;
    (void)hipMemsetAsync((unsigned char*)d_ws + WS_BAR, 0, XCD_BAR_WORDS * 4, stream);
    void* args[] = {&a};
    hipError_t e = hipLaunchCooperativeKernel((const void*)mk_fwd, dim3(grid_blocks), dim3(512), args, LDS_BYTES, stream);
    if (e != hipSuccess) fprintf(stderr, "cooperative launch failed: %s (grid %d)\n", hipGetErrorString(e), grid_blocks);
}
```

```cpp
#include <hip/hip_runtime.h>
#include <hip/hip_cooperative_groups.h>
#include <cstdio>
#include <cstdint>
#include <cmath>
__device__ __forceinline__ int otid() { int t = (int)threadIdx.x; asm volatile("" : "+v"(t)); return t; }
namespace pg8 {
#define PG8_LAS __attribute__((address_space(3)))
typedef unsigned short bf16_t;
typedef short bf16x8 __attribute__((ext_vector_type(8)));
typedef float f32x4 __attribute__((ext_vector_type(4)));
typedef unsigned u32x4 __attribute__((ext_vector_type(4)));
constexpr int BM = 256, BK = 64, HALF = 128, HTB = HALF * BK * 2  , STAGE_BYTES = 8 * HTB, NXCD = 8, WGM = 8;

__host__ __device__ __forceinline__ int lds_byte(int r, int c) { const int st = (r >> 4) * 2 + (c >> 5), rr = r & 15, cc = c & 31, ob = rr * 64 + cc * 2; return st * 1024 + (ob ^ (((ob >> 9) & 1) << 5)); }
__host__ __device__ __forceinline__ void stage_rc(int b, int& R, int& C) { const int st = b / 1024, sb = b % 1024, swz = sb ^ (((sb >> 9) & 1) << 5); R = (st >> 1) * 16 + swz / 64; C = (st & 1) * 32 + (swz % 64) / 2; }
__host__ __device__ __forceinline__ int f8swz(int fr) { return (fr >> 1) ^ ((fr >= 4 && fr <= 11) ? 2 : 0); }
__host__ __device__ __forceinline__ void stage_rc8(int b, int& R, int& C) { const int fr = (b >> 7) & 15; R = (b >> 11) * 16 + fr; C = ((((b >> 4) & 7) ^ f8swz(fr)) * 8); }
__host__ __device__ __forceinline__ int perm32(int rho) { const int n = rho >> 4, i = rho & 15; return 8 * (i >> 2) + 4 * n + (i & 3); }

struct Unit { int pm, pn; };
struct Gemm { const bf16_t* A; const bf16_t* Bt; int M, N, K, pad; };

struct StaticOrder {
    int nM, nN, nwg, G, c;
    __host__ __device__ void init(int M, int N, int G_, int c_) { nM = M / BM; nN = N / BM; nwg = nM * nN; G = G_; c = c_; }
    __host__ __device__ bool next(int i, Unit& u) const {
        const long L = (long)i * G + c; if (L >= nwg) return false;
        int wgid = (int)L; { const int q = nwg / NXCD, r = nwg % NXCD, xcd = wgid % NXCD, off = wgid / NXCD; wgid = (xcd < r ? xcd * (q + 1) : r * (q + 1) + (xcd - r) * q) + off; }
        const int nig = WGM * nN, gid = wgid / nig, fm = gid * WGM, gsz = (nM - fm) < WGM ? (nM - fm) : WGM;
        u.pm = fm + ((wgid % nig) % gsz); u.pn = (wgid % nig) / gsz; return true;
    }
    __device__ __forceinline__ void a_ready(const Unit&) const {}
    __device__ __forceinline__ void done(const Unit&) const {}
};
__device__ __forceinline__ unsigned cvt_pk_bf16(float lo, float hi) { unsigned r; asm volatile("v_cvt_pk_bf16_f32 %0, %1, %2" : "=v"(r) : "v"(lo), "v"(hi)); return r; }
__device__ __forceinline__ unsigned pk4_fp8(float a, float b, float c, float d) {
    a = __builtin_amdgcn_fmed3f(a, -448.f, 448.f); b = __builtin_amdgcn_fmed3f(b, -448.f, 448.f); c = __builtin_amdgcn_fmed3f(c, -448.f, 448.f); d = __builtin_amdgcn_fmed3f(d, -448.f, 448.f);
    int r = 0; r = __builtin_amdgcn_cvt_pk_fp8_f32(a, b, r, false); r = __builtin_amdgcn_cvt_pk_fp8_f32(c, d, r, true); return (unsigned)r;
}
__device__ __forceinline__ void mfma_f8(f32x4& acc, const bf16x8& w0, const bf16x8& w1, const bf16x8& a0, const bf16x8& a1, int scale_w, int scale_a) {
    typedef int i32x8_ __attribute__((ext_vector_type(8))); typedef int i32x4_ __attribute__((ext_vector_type(4)));
    const i32x4_ p0 = __builtin_bit_cast(i32x4_, w0), p1 = __builtin_bit_cast(i32x4_, w1), q0 = __builtin_bit_cast(i32x4_, a0), q1 = __builtin_bit_cast(i32x4_, a1);
    const i32x8_ W = {p0[0], p0[1], p0[2], p0[3], p1[0], p1[1], p1[2], p1[3]}, A = {q0[0], q0[1], q0[2], q0[3], q1[0], q1[1], q1[2], q1[3]};
    asm volatile("v_mfma_scale_f32_16x16x128_f8f6f4 %0, %1, %2, %0, %3, %4 op_sel_hi:[0,0,0]" : "+v"(acc) : "v"(W), "v"(A), "v"(scale_w), "v"(scale_a));
}
template <class Epi, class Sched, bool ALIGN_EPI = false, bool SP2 = false, int DT = 0, int SCALE_W = 0x7f7f7f7f>
__device__ __forceinline__ void gemm_phase(PG8_LAS unsigned char* lds, const Gemm g, const Sched& S, const Epi& E) {
    constexpr bool F8 = (DT == 1), I8 = (DT == 2);
    const int tid = otid(), wid = __builtin_amdgcn_readfirstlane(tid >> 6), lane = tid & 63, wr = wid >> 2, wc = wid & 3, fr = lane & 15, fq = lane >> 4;
    const int K = (DT != 0) ? g.K / 2 : g.K, nt = K / BK;
    unsigned voffA[2], voffB[2];
#pragma unroll
    for (int i = 0; i < 2; ++i) { int R, C; if constexpr (F8) stage_rc8(tid * 16 + i * 8192, R, C); else stage_rc(tid * 16 + i * 8192, R, C); const int Rb = Epi::PERM ? ((R & ~31) + perm32(R & 31)) : R;
        voffA[i] = (unsigned)(R * K + C) * 2u; voffB[i] = (unsigned)(Rb * K + C) * 2u; }
    const size_t kstep = (size_t)(BK * 2);
    const size_t hstep = (size_t)HALF * K * 2;
    const size_t tstep = 2 * hstep;
    const unsigned ldsw = (unsigned)wid * 1024u;
    int aoffk[2], boffk[2];
#pragma unroll
    for (int k = 0; k < 2; ++k) {
        if constexpr (F8) { const int ch = (((2 * fq + k) ^ f8swz(fr)) << 4); aoffk[k] = wr * 4 * 2048 + fr * 128 + ch; boffk[k] = wc * 2 * 2048 + fr * 128 + ch; }
        else { aoffk[k] = lds_byte(wr * 64 + fr, fq * 8) + k * 1024; boffk[k] = lds_byte(wc * 32 + fr, fq * 8) + k * 1024; } }
#define PG8_SA(b, h) (((b) * 2 + (h)) * HTB)
#define PG8_SB(b, h) ((4 + (b) * 2 + (h)) * HTB)
#define PG8_STAGE(bufoff, gbase, voff) do { _Pragma("unroll") for (int _i = 0; _i < 2; ++_i) \
        __builtin_amdgcn_global_load_lds((const unsigned*)((const char*)(gbase) + (voff)[_i]), (PG8_LAS unsigned*)(lds + (bufoff) + ldsw + _i * 8192), 16, 0, 0); } while (0)
#define PG8_LDA(dst, b, h) do { _Pragma("unroll") for (int m = 0; m < 4; ++m) _Pragma("unroll") for (int k = 0; k < 2; ++k) dst[m][k] = *(const PG8_LAS bf16x8*)(lds + PG8_SA(b, h) + aoffk[k] + m * 2048); } while (0)
#define PG8_LDB(dst, b, h) do { _Pragma("unroll") for (int n = 0; n < 2; ++n) _Pragma("unroll") for (int k = 0; k < 2; ++k) dst[n][k] = *(const PG8_LAS bf16x8*)(lds + PG8_SB(b, h) + boffk[k] + n * 2048); } while (0)
#define PG8_MMA(ai, bj, At, Bt) do { __builtin_amdgcn_s_setprio(1); _Pragma("unroll") for (int m = 0; m < 4; ++m) _Pragma("unroll") for (int n = 0; n < 2; ++n) { \
        if constexpr (F8) { mfma_f8(acc[ai][bj][m][n], Bt[n][0], Bt[n][1], At[m][0], At[m][1], SCALE_W, 0x7f7f7f7f); } \
        else if constexpr (I8) { typedef int i32x4_ __attribute__((ext_vector_type(4))); _Pragma("unroll") for (int k = 0; k < 2; ++k) acc[ai][bj][m][n] = __builtin_bit_cast(f32x4, __builtin_amdgcn_mfma_i32_16x16x64_i8(__builtin_bit_cast(i32x4_, Bt[n][k]), __builtin_bit_cast(i32x4_, At[m][k]), __builtin_bit_cast(i32x4_, acc[ai][bj][m][n]), 0, 0, 0)); } \
        else { _Pragma("unroll") for (int k = 0; k < 2; ++k) acc[ai][bj][m][n] = __builtin_amdgcn_mfma_f32_16x16x32_bf16(Bt[n][k], At[m][k], acc[ai][bj][m][n], 0, 0, 0); } } \
        __builtin_amdgcn_s_setprio(0); } while (0)
#define PG8_WAIT_V(n) asm volatile("s_waitcnt vmcnt(" #n ")" ::: "memory")
#define PG8_WAIT_L(n) asm volatile("s_waitcnt lgkmcnt(" #n ")" ::: "memory")
#define PG8_BAR __builtin_amdgcn_s_barrier()
#define PG8_SCHED __builtin_amdgcn_sched_barrier(0)
    Unit cur, nxt; int ui = 0;
    if (!S.next(0, cur)) return;
    f32x4 acc[2][2][4][2];
#pragma unroll
    for (int a = 0; a < 2; ++a)
#pragma unroll
        for (int b = 0; b < 2; ++b)
#pragma unroll
            for (int m = 0; m < 4; ++m)
#pragma unroll
                for (int n = 0; n < 2; ++n) acc[a][b][m][n] = (f32x4){0.f, 0.f, 0.f, 0.f};
    bf16x8 At[4][2], B0[2][2], B1[2][2];
    const char* cA = (const char*)g.A + (size_t)cur.pm * tstep; const char* cB = (const char*)g.Bt + (size_t)cur.pn * tstep;
    S.a_ready(cur);
    if constexpr (SP2) {
        PG8_STAGE(PG8_SB(0, 0), cB, voffB); PG8_STAGE(PG8_SB(0, 1), cB + hstep, voffB); PG8_STAGE(PG8_SA(0, 0), cA, voffA); PG8_STAGE(PG8_SA(0, 1), cA + hstep, voffA);
        if (wr == 1) PG8_BAR;
        PG8_WAIT_V(2); PG8_BAR;
        PG8_STAGE(PG8_SB(1, 0), cB + kstep, voffB); PG8_STAGE(PG8_SA(1, 0), cA + kstep, voffA); PG8_STAGE(PG8_SB(1, 1), cB + hstep + kstep, voffB);
        PG8_WAIT_V(6); PG8_BAR;
    } else {
        PG8_STAGE(PG8_SB(0, 0), cB, voffB); PG8_STAGE(PG8_SA(0, 0), cA, voffA); PG8_STAGE(PG8_SB(0, 1), cB + hstep, voffB); PG8_STAGE(PG8_SA(0, 1), cA + hstep, voffA);
        if (wr == 1) PG8_BAR;
        PG8_WAIT_V(4); PG8_BAR;
        PG8_STAGE(PG8_SB(1, 0), cB + kstep, voffB); PG8_STAGE(PG8_SA(1, 0), cA + kstep, voffA); PG8_STAGE(PG8_SB(1, 1), cB + hstep + kstep, voffB);
        PG8_WAIT_V(6); PG8_BAR;
    }
    for (;;) {
        const bool has_next = S.next(ui + 1, nxt);
        const char* nA = has_next ? (const char*)g.A + (size_t)nxt.pm * tstep : cA; const char* nB = has_next ? (const char*)g.Bt + (size_t)nxt.pn * tstep : cB;
        for (int t = 0; t < nt; t += 2) {
            const bool last = (t == nt - 2);
            const char* a1 = cA + (size_t)(t + 1) * kstep;
            const char* a2 = last ? nA : cA + (size_t)(t + 2) * kstep; const char* b2 = last ? nB : cB + (size_t)(t + 2) * kstep;
            const char* a3 = a2 + kstep; const char* b3 = b2 + kstep;
            if (last && has_next) S.a_ready(nxt);
            if constexpr (SP2) {
            PG8_LDB(B0, 0, 0); PG8_LDB(B1, 0, 1); PG8_SCHED; PG8_LDA(At, 0, 0); PG8_STAGE(PG8_SA(1, 1), a1 + hstep, voffA);
            PG8_WAIT_V(8); PG8_WAIT_L(0); PG8_BAR; PG8_MMA(0, 0, At, B0); PG8_MMA(0, 1, At, B1); PG8_BAR; PG8_SCHED;
            PG8_LDA(At, 0, 1); PG8_STAGE(PG8_SB(0, 0), b2, voffB); PG8_STAGE(PG8_SB(0, 1), b2 + hstep, voffB); PG8_STAGE(PG8_SA(0, 0), a2, voffA);
            PG8_WAIT_V(8); PG8_WAIT_L(0); PG8_BAR; PG8_MMA(1, 0, At, B0); PG8_MMA(1, 1, At, B1); PG8_BAR; PG8_SCHED;
            PG8_LDB(B0, 1, 0); PG8_LDB(B1, 1, 1); PG8_SCHED; PG8_LDA(At, 1, 0); PG8_STAGE(PG8_SA(0, 1), a2 + hstep, voffA);
            PG8_WAIT_V(8); PG8_WAIT_L(0); PG8_BAR; PG8_MMA(0, 0, At, B0); PG8_MMA(0, 1, At, B1); PG8_BAR; PG8_SCHED;
            PG8_LDA(At, 1, 1); PG8_STAGE(PG8_SB(1, 0), b3, voffB); PG8_STAGE(PG8_SB(1, 1), b3 + hstep, voffB); PG8_STAGE(PG8_SA(1, 0), a3, voffA);
            PG8_WAIT_V(8); PG8_WAIT_L(0); PG8_BAR; PG8_MMA(1, 0, At, B0); PG8_MMA(1, 1, At, B1); PG8_BAR; PG8_SCHED;
            } else {
            PG8_LDB(B0, 0, 0); PG8_SCHED; PG8_LDA(At, 0, 0); PG8_STAGE(PG8_SA(1, 1), a1 + hstep, voffA);
            PG8_WAIT_L(8); PG8_BAR; PG8_WAIT_L(0); PG8_MMA(0, 0, At, B0); PG8_BAR; PG8_SCHED;
            PG8_LDB(B1, 0, 1); PG8_STAGE(PG8_SB(0, 0), b2, voffB);
            PG8_BAR; PG8_WAIT_L(0); PG8_MMA(0, 1, At, B1); PG8_BAR;
            PG8_LDA(At, 0, 1); PG8_STAGE(PG8_SA(0, 0), a2, voffA);
            PG8_BAR; PG8_WAIT_L(0); PG8_MMA(1, 0, At, B0); PG8_BAR; PG8_SCHED;
            PG8_STAGE(PG8_SB(0, 1), b2 + hstep, voffB);
            PG8_WAIT_V(6); PG8_BAR; PG8_MMA(1, 1, At, B1); PG8_BAR;
            PG8_LDB(B0, 1, 0); PG8_SCHED; PG8_LDA(At, 1, 0); PG8_STAGE(PG8_SA(0, 1), a2 + hstep, voffA);
            PG8_WAIT_L(8); PG8_BAR; PG8_WAIT_L(0); PG8_MMA(0, 0, At, B0); PG8_BAR; PG8_SCHED;
            PG8_LDB(B1, 1, 1); PG8_STAGE(PG8_SB(1, 0), b3, voffB);
            PG8_BAR; PG8_WAIT_L(0); PG8_MMA(0, 1, At, B1); PG8_BAR;
            PG8_LDA(At, 1, 1); PG8_STAGE(PG8_SA(1, 0), a3, voffA);
            PG8_BAR; PG8_WAIT_L(0); PG8_MMA(1, 0, At, B0); PG8_BAR; PG8_SCHED;
            PG8_STAGE(PG8_SB(1, 1), b3 + hstep, voffB);
            PG8_WAIT_V(6); PG8_BAR; PG8_MMA(1, 1, At, B1); PG8_BAR;
            }
        }
        if constexpr (ALIGN_EPI) { if (wr == 0) PG8_BAR; }
        if constexpr (I8) {
#pragma unroll
            for (int a_ = 0; a_ < 2; ++a_)
#pragma unroll
                for (int b_ = 0; b_ < 2; ++b_)
#pragma unroll
                    for (int m_ = 0; m_ < 4; ++m_)
#pragma unroll
                        for (int n_ = 0; n_ < 2; ++n_)
#pragma unroll
                            for (int e_ = 0; e_ < 4; ++e_) acc[a_][b_][m_][n_][e_] = (float)__float_as_int(acc[a_][b_][m_][n_][e_]); }
        if constexpr (F8) asm volatile("s_nop 15\n\ts_nop 15" ::: "memory");
        if constexpr (!Epi::AFTER_DRAIN) { E(acc, cur, wr, wc, fr, fq); S.done(cur); }
        if (!has_next) break;
#pragma unroll
        for (int a = 0; a < 2; ++a)
#pragma unroll
            for (int b = 0; b < 2; ++b)
#pragma unroll
                for (int m = 0; m < 4; ++m)
#pragma unroll
                    for (int n = 0; n < 2; ++n) acc[a][b][m][n] = (f32x4){0.f, 0.f, 0.f, 0.f};
        cur = nxt; cA = nA; cB = nB; ++ui;
        if constexpr (ALIGN_EPI) { if (wr == 1) PG8_BAR; }
    }
    PG8_WAIT_V(0);
    if constexpr (!ALIGN_EPI) { if (wr == 0) PG8_BAR; }
    PG8_BAR;
    if constexpr (Epi::AFTER_DRAIN) { E.fused(acc, cur, wr, wc, fr, fq, lds, wid, lane); S.done(cur); }
#undef PG8_SA
#undef PG8_SB
#undef PG8_STAGE
#undef PG8_LDA
#undef PG8_LDB
#undef PG8_MMA
#undef PG8_WAIT_V
#undef PG8_WAIT_L
#undef PG8_BAR
#undef PG8_SCHED
}
}

namespace pg8 {
struct EpiStoreBf16 {
    static constexpr bool PERM = true, AFTER_DRAIN = false;
    bf16_t* O; int ldc, pad;
    __device__ __forceinline__ void operator()(const f32x4 (&acc)[2][2][4][2], const Unit& u, int wr, int wc, int fr, int fq) const {
        const int row0 = u.pm * BM + wr * 64 + fr, col0 = u.pn * BM + wc * 32 + 8 * fq;
#pragma unroll
        for (int ai = 0; ai < 2; ++ai)
#pragma unroll
            for (int m = 0; m < 4; ++m) { bf16_t* rowp = O + (size_t)(row0 + ai * HALF + m * 16) * ldc + col0;
#pragma unroll
                for (int bj = 0; bj < 2; ++bj) { const f32x4 v0 = acc[ai][bj][m][0], v1 = acc[ai][bj][m][1];
                    u32x4 w; w.x = cvt_pk_bf16(v0[0], v0[1]); w.y = cvt_pk_bf16(v0[2], v0[3]); w.z = cvt_pk_bf16(v1[0], v1[1]); w.w = cvt_pk_bf16(v1[2], v1[3]);
                    *(u32x4*)(rowp + bj * HALF) = w; } }
    }
};
struct EpiResF32 {
    static constexpr bool PERM = false, AFTER_DRAIN = false;
    const float* base; float* out; int ldc, pad;
    __device__ __forceinline__ void operator()(const f32x4 (&acc)[2][2][4][2], const Unit& u, int wr, int wc, int fr, int fq) const {
        const int row0 = u.pm * BM + wr * 64 + fr, col0 = u.pn * BM + wc * 32 + 4 * fq;
#pragma unroll
        for (int ai = 0; ai < 2; ++ai)
#pragma unroll
            for (int m = 0; m < 4; ++m) { const size_t off = (size_t)(row0 + ai * HALF + m * 16) * ldc + col0;
#pragma unroll
                for (int bj = 0; bj < 2; ++bj)
#pragma unroll
                    for (int n = 0; n < 2; ++n) { const f32x4 b = *(const f32x4*)(base + off + bj * HALF + n * 16); *(f32x4*)(out + off + bj * HALF + n * 16) = b + acc[ai][bj][m][n]; } }
    }
};
struct EpiSwiGLU {
    static constexpr bool PERM = true, AFTER_DRAIN = false;
    bf16_t* O; int ldc, pad;
    __device__ __forceinline__ void operator()(const f32x4 (&acc)[2][2][4][2], const Unit& u, int wr, int wc, int fr, int fq) const {
        const int row0 = u.pm * BM + wr * 64 + fr, col0 = u.pn * HALF + wc * 32 + 8 * fq;
#pragma unroll
        for (int ai = 0; ai < 2; ++ai)
#pragma unroll
            for (int m = 0; m < 4; ++m) { bf16_t* rowp = O + (size_t)(row0 + ai * HALF + m * 16) * ldc + col0;
                float r[8];
#pragma unroll
                for (int n = 0; n < 2; ++n)
#pragma unroll
                    for (int e = 0; e < 4; ++e) { const float g = acc[ai][0][m][n][e], up = acc[ai][1][m][n][e]; r[n * 4 + e] = g * up / (1.0f + __expf(-g)); }
                u32x4 w; w.x = cvt_pk_bf16(r[0], r[1]); w.y = cvt_pk_bf16(r[2], r[3]); w.z = cvt_pk_bf16(r[4], r[5]); w.w = cvt_pk_bf16(r[6], r[7]);
                *(u32x4*)rowp = w; }
    }
};
}

namespace pg8 {
struct EpiInProj {
    static constexpr bool PERM = true, AFTER_DRAIN = false;
    bf16_t* O; const float* cs; float* kmean;
    __device__ __forceinline__ void operator()(const f32x4 (&acc)[2][2][4][2], const Unit& u, int wr, int wc, int fr, int fq) const {
        const int row0 = u.pm * BM + wr * 64 + fr;
        if (u.pn >= 8) {
            const int col0 = u.pn * BM + wc * 32 + 8 * fq;
#pragma unroll
            for (int ai = 0; ai < 2; ++ai)
#pragma unroll
                for (int m = 0; m < 4; ++m) { bf16_t* rowp = O + (size_t)(row0 + ai * HALF + m * 16) * 6144 + col0;
#pragma unroll
                    for (int bj = 0; bj < 2; ++bj) { const f32x4 v0 = acc[ai][bj][m][0], v1 = acc[ai][bj][m][1];
                        u32x4 w; w.x = cvt_pk_bf16(v0[0], v0[1]); w.y = cvt_pk_bf16(v0[2], v0[3]); w.z = cvt_pk_bf16(v1[0], v1[1]); w.w = cvt_pk_bf16(v1[2], v1[3]);
                        *(u32x4*)(rowp + bj * HALF) = w; } }
        } else {
            const int sec = u.pn >> 2, head = 2 * (u.pn & 3) + (wc >> 1), d0 = (wc & 1) * 32 + 8 * fq;
            bf16_t* obase = O + sec * 1024 + head * 128 + d0;
            float csum[16];
#pragma unroll
            for (int i = 0; i < 16; ++i) csum[i] = 0.f;
#pragma unroll
            for (int ai = 0; ai < 2; ++ai)
#pragma unroll
                for (int m = 0; m < 4; ++m) { const int row = row0 + ai * HALF + m * 16;
                    const f32x4* cp = (const f32x4*)(cs + ((size_t)row * 64 + d0) * 2);
                    float ol[8], oh[8];
#pragma unroll
                    for (int n = 0; n < 2; ++n) { const f32x4 t0 = cp[2 * n], t1 = cp[2 * n + 1]; const f32x4 lo = acc[ai][0][m][n], hi = acc[ai][1][m][n];
                        ol[4 * n + 0] = lo[0] * t0[0] - hi[0] * t0[1]; oh[4 * n + 0] = hi[0] * t0[0] + lo[0] * t0[1];
                        ol[4 * n + 1] = lo[1] * t0[2] - hi[1] * t0[3]; oh[4 * n + 1] = hi[1] * t0[2] + lo[1] * t0[3];
                        ol[4 * n + 2] = lo[2] * t1[0] - hi[2] * t1[1]; oh[4 * n + 2] = hi[2] * t1[0] + lo[2] * t1[1];
                        ol[4 * n + 3] = lo[3] * t1[2] - hi[3] * t1[3]; oh[4 * n + 3] = hi[3] * t1[2] + lo[3] * t1[3]; }
                    u32x4 w; w.x = cvt_pk_bf16(ol[0], ol[1]); w.y = cvt_pk_bf16(ol[2], ol[3]); w.z = cvt_pk_bf16(ol[4], ol[5]); w.w = cvt_pk_bf16(ol[6], ol[7]);
                    *(u32x4*)(obase + (size_t)row * 6144) = w;
                    w.x = cvt_pk_bf16(oh[0], oh[1]); w.y = cvt_pk_bf16(oh[2], oh[3]); w.z = cvt_pk_bf16(oh[4], oh[5]); w.w = cvt_pk_bf16(oh[6], oh[7]);
                    *(u32x4*)(obase + (size_t)row * 6144 + 64) = w;
                    if (sec == 1) {
#pragma unroll
                        for (int i = 0; i < 8; ++i) { csum[i] += ol[i]; csum[8 + i] += oh[i]; } } }
            if (sec == 1) {
                float* km = kmean + (size_t)(((u.pm >> 4) * 8 + head) * 16 + (u.pm & 15)) * 128 + d0;
#pragma unroll
                for (int i = 0; i < 16; ++i) { float v = csum[i]; v += __shfl_xor(v, 1); v += __shfl_xor(v, 2); v += __shfl_xor(v, 4); v += __shfl_xor(v, 8);
                    if (fr == 0) atomicAdd(km + (i & 7) + (i >> 3) * 64, v * (1.f / 256.f)); }
            }
        }
    }
};
struct EpiScaledBf16 {
    static constexpr bool PERM = true, AFTER_DRAIN = false;
    bf16_t* O; const float* ra; const float* cw; int ldc, pad;
    __device__ __forceinline__ void operator()(const f32x4 (&acc)[2][2][4][2], const Unit& u, int wr, int wc, int fr, int fq) const {
        const int row0 = u.pm * BM + wr * 64 + fr, col0 = u.pn * BM + wc * 32 + 8 * fq;
        f32x4 cs_[2][2];
#pragma unroll
        for (int bj = 0; bj < 2; ++bj)
#pragma unroll
            for (int n = 0; n < 2; ++n) cs_[bj][n] = *(const f32x4*)(cw + col0 + bj * HALF + 4 * n) * (1.f / (127.f * 127.f));
#pragma unroll
        for (int ai = 0; ai < 2; ++ai)
#pragma unroll
            for (int m = 0; m < 4; ++m) { const int row = row0 + ai * HALF + m * 16; const float rs = ra[row]; bf16_t* rowp = O + (size_t)row * ldc + col0;
#pragma unroll
                for (int bj = 0; bj < 2; ++bj) { const f32x4 v0 = acc[ai][bj][m][0] * cs_[bj][0] * rs, v1 = acc[ai][bj][m][1] * cs_[bj][1] * rs;
                    u32x4 w; w.x = cvt_pk_bf16(v0[0], v0[1]); w.y = cvt_pk_bf16(v0[2], v0[3]); w.z = cvt_pk_bf16(v1[0], v1[1]); w.w = cvt_pk_bf16(v1[2], v1[3]);
                    *(u32x4*)(rowp + bj * HALF) = w; } }
    }
};
__device__ __forceinline__ float row_rinv(const float* ss, int row, int fq) {
    const f32x4* p = (const f32x4*)(ss + (size_t)row * 32 + fq * 8); const f32x4 a = p[0], b = p[1];
    float s = ((a[0] + a[1]) + (a[2] + a[3])) + ((b[0] + b[1]) + (b[2] + b[3]));
    s += __shfl_xor(s, 16); s += __shfl_xor(s, 32);
    return rsqrtf(s * (1.f / 2048.f) + 1e-6f);
}
template <bool BASE_F32, bool OUT_F8> struct EpiRes {
    static constexpr bool PERM = true, AFTER_DRAIN = false;
    const void* base; bf16_t* outb; unsigned char* out8; float* ss;
    __device__ __forceinline__ void operator()(const f32x4 (&acc)[2][2][4][2], const Unit& u, int wr, int wc, int fr, int fq) const {
        const int row0 = u.pm * BM + wr * 64 + fr, col0 = u.pn * BM + wc * 32 + 8 * fq;
#pragma unroll
        for (int ai = 0; ai < 2; ++ai)
#pragma unroll
            for (int m = 0; m < 4; ++m) { const int row = row0 + ai * HALF + m * 16; const size_t off = (size_t)row * 2048 + col0; float s = 0.f;
#pragma unroll
                for (int bj = 0; bj < 2; ++bj) { f32x4 v0, v1;
                    if (BASE_F32) { v0 = *(const f32x4*)((const float*)base + off + bj * HALF); v1 = *(const f32x4*)((const float*)base + off + bj * HALF + 4); }
                    else { const u32x4 bb = *(const u32x4*)((const bf16_t*)base + off + bj * HALF);
                        v0 = (f32x4){__uint_as_float(bb.x << 16), __uint_as_float(bb.x & 0xffff0000u), __uint_as_float(bb.y << 16), __uint_as_float(bb.y & 0xffff0000u)};
                        v1 = (f32x4){__uint_as_float(bb.z << 16), __uint_as_float(bb.z & 0xffff0000u), __uint_as_float(bb.w << 16), __uint_as_float(bb.w & 0xffff0000u)}; }
                    v0 = v0 + acc[ai][bj][m][0]; v1 = v1 + acc[ai][bj][m][1];
                    s += ((v0[0] * v0[0] + v0[1] * v0[1]) + (v0[2] * v0[2] + v0[3] * v0[3])) + ((v1[0] * v1[0] + v1[1] * v1[1]) + (v1[2] * v1[2] + v1[3] * v1[3]));
                    { u32x4 w; w.x = cvt_pk_bf16(v0[0], v0[1]); w.y = cvt_pk_bf16(v0[2], v0[3]); w.z = cvt_pk_bf16(v1[0], v1[1]); w.w = cvt_pk_bf16(v1[2], v1[3]);
                      *(u32x4*)(outb + off + bj * HALF) = w; }
                    if (OUT_F8) { typedef unsigned u32x2_ __attribute__((ext_vector_type(2))); u32x2_ w; w.x = pk4_fp8(v0[0], v0[1], v0[2], v0[3]); w.y = pk4_fp8(v1[0], v1[1], v1[2], v1[3]);
                        *(u32x2_*)(out8 + off + bj * HALF) = w; } }
                s += __shfl_xor(s, 16); s += __shfl_xor(s, 32);
                if (fq == 0) ss[(size_t)row * 32 + u.pn * 4 + wc] = s; }
    }
};
struct EpiRowScaleBf16 {
    static constexpr bool PERM = true, AFTER_DRAIN = false;
    bf16_t* O; const float* ss; int ldc, pad;
    __device__ __forceinline__ void operator()(const f32x4 (&acc)[2][2][4][2], const Unit& u, int wr, int wc, int fr, int fq) const {
        const int row0 = u.pm * BM + wr * 64 + fr, col0 = u.pn * BM + wc * 32 + 8 * fq;
#pragma unroll
        for (int ai = 0; ai < 2; ++ai)
#pragma unroll
            for (int m = 0; m < 4; ++m) { const int row = row0 + ai * HALF + m * 16; const float ri = row_rinv(ss, row, fq); bf16_t* rowp = O + (size_t)row * ldc + col0;
#pragma unroll
                for (int bj = 0; bj < 2; ++bj) { const f32x4 v0 = acc[ai][bj][m][0] * ri, v1 = acc[ai][bj][m][1] * ri;
                    u32x4 w; w.x = cvt_pk_bf16(v0[0], v0[1]); w.y = cvt_pk_bf16(v0[2], v0[3]); w.z = cvt_pk_bf16(v1[0], v1[1]); w.w = cvt_pk_bf16(v1[2], v1[3]);
                    *(u32x4*)(rowp + bj * HALF) = w; } }
    }
};
template <bool F8OUT> struct EpiSwiGLUNorm {
    static constexpr bool PERM = true, AFTER_DRAIN = false;
    bf16_t* O; const float* ss; int ldc, pad;
    __device__ __forceinline__ void operator()(const f32x4 (&acc)[2][2][4][2], const Unit& u, int wr, int wc, int fr, int fq) const {
        const int row0 = u.pm * BM + wr * 64 + fr, col0 = u.pn * HALF + wc * 32 + 8 * fq;
#pragma unroll
        for (int ai = 0; ai < 2; ++ai)
#pragma unroll
            for (int m = 0; m < 4; ++m) { const int row = row0 + ai * HALF + m * 16; const float ri = row_rinv(ss, row, fq); bf16_t* rowp = O + (size_t)row * ldc + col0;
                float r[8];
#pragma unroll
                for (int n = 0; n < 2; ++n)
#pragma unroll
                    for (int e = 0; e < 4; ++e) { const float g = acc[ai][0][m][n][e] * ri, up = acc[ai][1][m][n][e] * ri; r[n * 4 + e] = (g * up) * __builtin_amdgcn_rcpf(1.0f + __builtin_amdgcn_exp2f(g * -1.4426950408889634f)); }
                if (F8OUT) { typedef unsigned u32x2_ __attribute__((ext_vector_type(2))); u32x2_ w; w.x = pk4_fp8(r[0], r[1], r[2], r[3]); w.y = pk4_fp8(r[4], r[5], r[6], r[7]);
                    *(u32x2_*)((unsigned char*)O + (size_t)row * ldc + col0) = w; }
                else { u32x4 w; w.x = cvt_pk_bf16(r[0], r[1]); w.y = cvt_pk_bf16(r[2], r[3]); w.z = cvt_pk_bf16(r[4], r[5]); w.w = cvt_pk_bf16(r[6], r[7]);
                    *(u32x4*)rowp = w; } }
    }
};
}
typedef unsigned short bf16_t;
constexpr int DM = 2048, NB = 4, SEQ = 4096, MT = NB * SEQ;
constexpr int HD = 128, NH = 8, AW = 1024, CW = 1024, NPROJ = 6144;
constexpr int NBLK = 16, MBLK = 256;
constexpr int NMEM = 256, XH = 4, XW = 512, DFF = 5632;
constexpr float EPS = 1e-6f;
constexpr float SM_SCALE = 0.088388347648318440f;
constexpr size_t MiB = 1u << 20;
constexpr size_t WS_WIN = 0;
constexpr size_t WS_WOUT = 24 * MiB;
constexpr size_t WS_WXQ = 32 * MiB;
constexpr size_t WS_WXKV = 34 * MiB;
constexpr size_t WS_WXO = 38 * MiB;
constexpr size_t WS_WGU = 40 * MiB;
constexpr size_t WS_WDN = 84 * MiB;
constexpr size_t WS_H = 112 * MiB;
constexpr size_t WS_MRG = 176 * MiB;
constexpr size_t WS_PROJ = 240 * MiB;
constexpr size_t WS_ACT = 240 * MiB;
constexpr size_t WS_H8 = 208 * MiB;
constexpr size_t WS_X8 = 330 * MiB;
constexpr size_t WS_QX = 432 * MiB;
constexpr size_t WS_OX = 448 * MiB;
constexpr size_t WS_KVX = 464 * MiB;
constexpr size_t WS_MEMN = 466 * MiB;
constexpr size_t WS_CS = 470 * MiB;
constexpr size_t WS_KMEAN = 478 * MiB;
constexpr size_t WS_SS = 479 * MiB;
constexpr size_t WS_RMAX = 486 * MiB;
constexpr size_t WS_BAR = 485 * MiB;
constexpr size_t WS_CMAX = 485 * MiB + 16384;
constexpr size_t WS_END = 487 * MiB;

__device__ __forceinline__ float bf2f(unsigned v) { return __uint_as_float(v << 16); }
__device__ __forceinline__ unsigned f2bf(float f) { unsigned u = __float_as_uint(f); return (u + 0x7fffu + ((u >> 16) & 1u)) >> 16; }
__device__ __forceinline__ unsigned pk2(float lo, float hi) { return f2bf(lo) | (f2bf(hi) << 16); }
__device__ __forceinline__ float wave_sum(float v) {
#pragma unroll
    for (int o = 1; o < 64; o <<= 1) v += __shfl_xor(v, o);
    return v;
}
__device__ __forceinline__ float wave_max(float v) {
#pragma unroll
    for (int o = 1; o < 64; o <<= 1) v = fmaxf(v, __shfl_xor(v, o));
    return v;
}
typedef float f32x4 __attribute__((ext_vector_type(4)));
typedef unsigned u32x4 __attribute__((ext_vector_type(4)));
typedef unsigned u32x2 __attribute__((ext_vector_type(2)));

struct TJob { const float* src0; const float* src1; const float* gain; bf16_t* dst; int K, Nsrc, nrows, mode; float wscale; int f8; const float* colmax; };
__device__ __forceinline__ void transpose_item(const TJob& J, float* scr, int item, int lane) {
    const int nblk = J.nrows / 32, kb = item / nblk, nb = item % nblk, k0 = 64 * kb, n0 = 32 * nb;
    const float* src = J.src0; int c0 = n0;
    if (J.mode == 1 && n0 < 2048) { const int tile = n0 >> 8, c = n0 & 255, cc = c & 127; c0 = (tile >> 2) * 1024 + (2 * (tile & 3) + (cc >> 6)) * 128 + (cc & 63) + ((c >> 7) ? 64 : 0); }
    if (J.mode == 2) { const int tile = n0 >> 8, w = n0 & 255; if (w < 128) { c0 = tile * 128 + w; } else { src = J.src1; c0 = tile * 128 + w - 128; } }
    f32x4 ld[8];
#pragma unroll
    for (int i = 0; i < 8; ++i) ld[i] = *(const f32x4*)(src + (size_t)(k0 + 8 * i + (lane >> 3)) * J.Nsrc + c0 + 4 * (lane & 7));
#pragma unroll
    for (int i = 0; i < 8; ++i) { const int kk = 8 * i + (lane >> 3); float gsc = J.wscale; if (J.gain) gsc *= J.gain[k0 + kk];
#pragma unroll
        for (int e = 0; e < 4; ++e) scr[kk * 33 + 4 * (lane & 7) + e] = ld[i][e] * gsc; }
    asm volatile("s_waitcnt lgkmcnt(0)" ::: "memory");
    const int c = lane & 7;
#pragma unroll
    for (int j = 0; j < 4; ++j) { const int n = (lane >> 3) + 8 * j; const float* s = scr + (8 * c) * 33 + n;
        if (J.f8 == 2) { const float cm = J.colmax[n0 + n], qs = cm > 0.f ? 127.f / cm : 0.f; unsigned q[8];
#pragma unroll
            for (int e = 0; e < 8; ++e) q[e] = (unsigned)((int)__builtin_rintf(__builtin_amdgcn_fmed3f(s[e * 33] * qs, -127.f, 127.f))) & 0xffu;
            u32x2 o; o.x = q[0] | (q[1] << 8) | (q[2] << 16) | (q[3] << 24); o.y = q[4] | (q[5] << 8) | (q[6] << 16) | (q[7] << 24);
            *(u32x2*)((unsigned char*)J.dst + (size_t)(n0 + n) * J.K + k0 + 8 * c) = o; }
        else if (J.f8) { u32x2 o; o.x = pg8::pk4_fp8(s[0 * 33], s[1 * 33], s[2 * 33], s[3 * 33]); o.y = pg8::pk4_fp8(s[4 * 33], s[5 * 33], s[6 * 33], s[7 * 33]);
            *(u32x2*)((unsigned char*)J.dst + (size_t)(n0 + n) * J.K + k0 + 8 * c) = o; }
        else { u32x4 o; o.x = pk2(s[0 * 33], s[1 * 33]); o.y = pk2(s[2 * 33], s[3 * 33]); o.z = pk2(s[4 * 33], s[5 * 33]); o.w = pk2(s[6 * 33], s[7 * 33]);
            *(u32x4*)(J.dst + (size_t)(n0 + n) * J.K + k0 + 8 * c) = o; } }
    asm volatile("s_waitcnt lgkmcnt(0)" ::: "memory");
}
__device__ __forceinline__ void ph_colmax(const float* W, int K, int Nsrc, int ncols, float* cmax, int gw, int NGW, int lane) {
    const int nstrip = ncols / 256, nitems = (K / 64) * nstrip;
    for (int it = gw; it < nitems; it += NGW) { const int kb = it / nstrip, sb = it % nstrip; const float* p = W + (size_t)(kb * 64) * Nsrc + sb * 256 + lane * 4;
        f32x4 mx = {0.f, 0.f, 0.f, 0.f};
#pragma unroll 8
        for (int r = 0; r < 64; ++r) { const f32x4 v = *(const f32x4*)(p + (size_t)r * Nsrc); mx[0] = fmaxf(mx[0], fabsf(v[0])); mx[1] = fmaxf(mx[1], fabsf(v[1])); mx[2] = fmaxf(mx[2], fabsf(v[2])); mx[3] = fmaxf(mx[3], fabsf(v[3])); }
#pragma unroll
        for (int e = 0; e < 4; ++e) atomicMax((unsigned*)cmax + sb * 256 + lane * 4 + e, __float_as_uint(mx[e])); }
}
__device__ __forceinline__ int ph_transpose_job(const TJob J, int base, float* scr, int gw, int NGW, int lane) {
    const int nitems = (J.K / 64) * (J.nrows / 32);
    const int first = (gw - base % NGW + NGW) % NGW;
    for (int it = first; it < nitems; it += NGW) transpose_item(J, scr, it, lane);
    return base + nitems;
}

__device__ __forceinline__ void rms_row_bf16(const float* xrow, const float* g, bf16_t* orow, int lane) {
    const f32x4* xr = (const f32x4*)xrow + lane; const f32x4* gr = (const f32x4*)g + lane;
    f32x4 v[8]; float s = 0.f;
#pragma unroll
    for (int j = 0; j < 8; ++j) { v[j] = xr[64 * j]; s += (v[j].x * v[j].x + v[j].y * v[j].y) + (v[j].z * v[j].z + v[j].w * v[j].w); }
    const float rinv = rsqrtf(wave_sum(s) * (1.f / DM) + EPS);
    u32x2* o8 = (u32x2*)orow + lane;
#pragma unroll
    for (int j = 0; j < 8; ++j) { const f32x4 gg = gr[64 * j]; u32x2 w; w.x = pk2(v[j].x * rinv * gg.x, v[j].y * rinv * gg.y); w.y = pk2(v[j].z * rinv * gg.z, v[j].w * rinv * gg.w); o8[64 * j] = w; }
}
__device__ __forceinline__ void ph_rms_bf16(const float* X, const float* g, bf16_t* O, unsigned char* O8, float* rmax, int rows, int gw, int NGW, int lane) {
    f32x4 v[8], nx[8];
    int r = gw;
    if (r < rows) {
#pragma unroll
        for (int j = 0; j < 8; ++j) v[j] = ((const f32x4*)(X + (size_t)r * DM) + lane)[64 * j]; }
    for (; r < rows; r += NGW) {
        const int rn = r + NGW;
        if (rn < rows) {
#pragma unroll
            for (int j = 0; j < 8; ++j) nx[j] = ((const f32x4*)(X + (size_t)rn * DM) + lane)[64 * j]; }
        float s = 0.f;
#pragma unroll
        for (int j = 0; j < 8; ++j) s += (v[j].x * v[j].x + v[j].y * v[j].y) + (v[j].z * v[j].z + v[j].w * v[j].w);
        const float rinv = rsqrtf(wave_sum(s) * (1.f / DM) + EPS);
        u32x2* o8 = (u32x2*)(O + (size_t)r * DM) + lane; const f32x4* gr = (const f32x4*)g + lane;
        float am = 0.f;
#pragma unroll
        for (int j = 0; j < 8; ++j) { const f32x4 gg = gr[64 * j]; v[j] = v[j] * rinv * gg; u32x2 w; w.x = pk2(v[j].x, v[j].y); w.y = pk2(v[j].z, v[j].w); o8[64 * j] = w;
            am = fmaxf(fmaxf(am, fmaxf(fabsf(v[j].x), fabsf(v[j].y))), fmaxf(fabsf(v[j].z), fabsf(v[j].w))); }
        if (O8) { am = wave_max(am); const float qs = am > 0.f ? 127.f / am : 0.f; if (lane == 0) rmax[r] = am;
#pragma unroll
            for (int j = 0; j < 8; ++j) { const unsigned q0 = (unsigned)((int)__builtin_rintf(v[j].x * qs)) & 0xffu, q1 = (unsigned)((int)__builtin_rintf(v[j].y * qs)) & 0xffu, q2 = (unsigned)((int)__builtin_rintf(v[j].z * qs)) & 0xffu, q3 = (unsigned)((int)__builtin_rintf(v[j].w * qs)) & 0xffu;
                ((unsigned*)(O8 + (size_t)r * DM))[64 * j + lane] = q0 | (q1 << 8) | (q2 << 16) | (q3 << 24); } }
#pragma unroll
        for (int j = 0; j < 8; ++j) v[j] = nx[j];
    }
}
__device__ __forceinline__ void ph_final_norm(const bf16_t* X, float* O, const float* g, const float* ss, int rows, int gw, int NGW, int lane) {
    for (int r = gw; r < rows; r += NGW) {
        const u32x4* xr = (const u32x4*)(X + (size_t)r * DM) + lane; f32x4* orow = (f32x4*)(O + (size_t)r * DM); const f32x4* gr = (const f32x4*)g;
        u32x4 v[4];
#pragma unroll
        for (int j = 0; j < 4; ++j) v[j] = xr[64 * j];
        const float part = (lane < 32) ? ss[(size_t)r * 32 + lane] : 0.f;
        const float rinv = rsqrtf(wave_sum(part) * (1.f / DM) + EPS);
#pragma unroll
        for (int j = 0; j < 4; ++j) { const int c4 = 2 * (64 * j + lane);
            const f32x4 lo = {__uint_as_float(v[j].x << 16), __uint_as_float(v[j].x & 0xffff0000u), __uint_as_float(v[j].y << 16), __uint_as_float(v[j].y & 0xffff0000u)};
            const f32x4 hi = {__uint_as_float(v[j].z << 16), __uint_as_float(v[j].z & 0xffff0000u), __uint_as_float(v[j].w << 16), __uint_as_float(v[j].w & 0xffff0000u)};
            orow[c4] = lo * rinv * gr[c4]; orow[c4 + 1] = hi * rinv * gr[c4 + 1]; }
    }
}

__device__ __forceinline__ void sincos_small(double r, double& s, double& c) {
    const double r2 = r * r;
    double a = -1.0 / 10888869450418352160768000000.0;
    a = a * r2 + 1.0 / 15511210043330985984000000.0;
    a = a * r2 - 1.0 / 25852016738884976640000.0;
    a = a * r2 + 1.0 / 51090942171709440000.0;
    a = a * r2 - 1.0 / 121645100408832000.0;
    a = a * r2 + 1.0 / 355687428096000.0;
    a = a * r2 - 1.0 / 1307674368000.0;
    a = a * r2 + 1.0 / 6227020800.0;
    a = a * r2 - 1.0 / 39916800.0;
    a = a * r2 + 1.0 / 362880.0;
    a = a * r2 - 1.0 / 5040.0;
    a = a * r2 + 1.0 / 120.0;
    a = a * r2 - 1.0 / 6.0;
    a = a * r2 + 1.0;
    s = a * r;
    double b = 1.0 / 403291461126605635584000000.0;
    b = b * r2 - 1.0 / 620448401733239439360000.0;
    b = b * r2 + 1.0 / 1124000727777607680000.0;
    b = b * r2 - 1.0 / 2432902008176640000.0;
    b = b * r2 + 1.0 / 6402373705728000.0;
    b = b * r2 - 1.0 / 20922789888000.0;
    b = b * r2 + 1.0 / 87178291200.0;
    b = b * r2 - 1.0 / 479001600.0;
    b = b * r2 + 1.0 / 3628800.0;
    b = b * r2 - 1.0 / 40320.0;
    b = b * r2 + 1.0 / 720.0;
    b = b * r2 - 1.0 / 24.0;
    b = b * r2 + 1.0 / 2.0;
    c = 1.0 - b * r2;
}
__device__ __forceinline__ void cs_entry(const int* pos, float* cs, int idx) {
    const int t = idx >> 6, f = idx & 63;
    double p = 1.0, bs = 0.8659643233600653;
#pragma unroll
    for (int bit = 0; bit < 6; ++bit) { if ((f >> bit) & 1) p *= bs; bs *= bs; }
    const double ang = (double)pos[t] * p;
    const double TWO_PI = 6.283185307179586;
    const double n = rint(ang / TWO_PI);
    const double r = fma(-n, TWO_PI, ang);
    double s, c; sincos_small(r, s, c);
    cs[2 * idx] = (float)c; cs[2 * idx + 1] = (float)s;
}
__device__ __forceinline__ void ph_cs(const int* pos, float* cs, int gtid, int NT) {
    for (int idx = gtid; idx < MT * 64; idx += NT) cs_entry(pos, cs, idx);
}
__device__ __forceinline__ void ph_rope_naive(bf16_t* proj, const float* cs, int gtid, int NT) {
    const long total = (long)MT * 2 * NH * 64;
    for (long i = gtid; i < total; i += NT) {
        const int d = (int)(i & 63), h = (int)((i >> 6) & 7), sec = (int)((i >> 9) & 1); const long t = i >> 10;
        bf16_t* p = proj + t * NPROJ + sec * 1024 + h * HD + d;
        const float a = bf2f(p[0]), b = bf2f(p[64]); const float c = cs[(t * 64 + d) * 2], s = cs[(t * 64 + d) * 2 + 1];
        p[0] = (bf16_t)f2bf(a * c - b * s); p[64] = (bf16_t)f2bf(b * c + a * s);
    }
}
__device__ __forceinline__ void ph_kmean_naive(const bf16_t* proj, float* kmean, int gtid, int NT) {
    for (int i = gtid; i < NB * NH * NBLK * HD; i += NT) {
        const int d = i & 127, blkid = i >> 7;
        const int blk = blkid & 15, h = (blkid >> 4) & 7, b = blkid >> 7;
        float s = 0.f;
        for (int j = 0; j < MBLK; ++j) s += bf2f(proj[(size_t)(b * SEQ + blk * MBLK + j) * NPROJ + 1024 + h * HD + d]);
        kmean[(size_t)blkid * HD + d] = s * (1.f / MBLK);
    }
}
__device__ __forceinline__ float dot_q_row(const float* sq, const bf16_t* krow) {
    float a = 0.f;
#pragma unroll
    for (int d = 0; d < 128; d += 8) { const u32x4 kk = *(const u32x4*)(krow + d);
        a += sq[d + 0] * bf2f(kk.x & 0xffffu) + sq[d + 1] * bf2f(kk.x >> 16) + sq[d + 2] * bf2f(kk.y & 0xffffu) + sq[d + 3] * bf2f(kk.y >> 16)
           + sq[d + 4] * bf2f(kk.z & 0xffffu) + sq[d + 5] * bf2f(kk.z >> 16) + sq[d + 6] * bf2f(kk.w & 0xffffu) + sq[d + 7] * bf2f(kk.w >> 16); }
    return a;
}
__device__ __forceinline__ void ph_moba_naive(const bf16_t* proj, const float* kmean, const float* g_attn, bf16_t* merged, float qscale_inv, float* scr, int gw, int NGW, int lane) {
    float* sq = scr; float* sp = scr + 128;
    for (int item = gw; item < MT * NH; item += NGW) {
        const int t = item >> 3, h = item & 7, b = t >> 12, ts = t & 4095, qb = ts >> 8, tq = ts & 255;
        const bf16_t* qrow = proj + (size_t)t * NPROJ + h * HD;
        const unsigned qq = *(const unsigned*)(qrow + 2 * lane);
        const float q0 = bf2f(qq & 0xffffu) * qscale_inv, q1 = bf2f(qq >> 16) * qscale_inv;
        asm volatile("s_waitcnt lgkmcnt(0)" ::: "memory");
        sq[2 * lane] = q0; sq[2 * lane + 1] = q1;
        float g[16];
#pragma unroll
        for (int i = 0; i < 16; ++i) { const float* km = kmean + (size_t)((b * 8 + h) * 16 + i) * HD; const float p = wave_sum(q0 * km[2 * lane] + q1 * km[2 * lane + 1]); g[i] = (i < qb) ? p : -INFINITY; }
        int sel[4];
#pragma unroll
        for (int r = 0; r < 3; ++r) { float best = -INFINITY; int bi = -1;
#pragma unroll
            for (int i = 0; i < 16; ++i) if (g[i] > best) { best = g[i]; bi = i; }
            sel[r] = bi;
#pragma unroll
            for (int i = 0; i < 16; ++i) if (i == bi) g[i] = -INFINITY; }
        sel[3] = qb;
        asm volatile("s_waitcnt lgkmcnt(0)" ::: "memory");
#pragma unroll
        for (int s = 0; s < 4; ++s) { const int blk = sel[s];
            for (int jj = 0; jj < 4; ++jj) { const int j = jj * 64 + lane; float sc = -INFINITY;
                if (blk >= 0 && (s < 3 || j <= tq)) sc = dot_q_row(sq, proj + (size_t)(b * SEQ + blk * MBLK + j) * NPROJ + 1024 + h * HD) * SM_SCALE;
                sp[s * 256 + j] = sc; } }
        asm volatile("s_waitcnt lgkmcnt(0)" ::: "memory");
        float m = -INFINITY; for (int i = lane; i < 1024; i += 64) m = fmaxf(m, sp[i]); m = wave_max(m);
        float l = 0.f; for (int i = lane; i < 1024; i += 64) { const float p = __expf(sp[i] - m); sp[i] = p; l += p; } l = wave_sum(l);
        asm volatile("s_waitcnt lgkmcnt(0)" ::: "memory");
        float o0 = 0.f, o1 = 0.f;
#pragma unroll
        for (int s = 0; s < 4; ++s) { const int blk = sel[s]; if (blk < 0) continue;
            const bf16_t* vb = proj + (size_t)(b * SEQ + blk * MBLK) * NPROJ + 2048 + h * HD + 2 * lane;
            for (int j = 0; j < 256; ++j) { const float p = sp[s * 256 + j]; const unsigned vv = *(const unsigned*)(vb + (size_t)j * NPROJ); o0 += p * bf2f(vv & 0xffffu); o1 += p * bf2f(vv >> 16); } }
        const float li = 1.f / l; o0 *= li; o1 *= li;
        const float rinv = rsqrtf(wave_sum(o0 * o0 + o1 * o1) * (1.f / HD) + EPS);
        *(unsigned*)(merged + (size_t)t * DM + h * HD + 2 * lane) = pk2(o0 * rinv * g_attn[h * HD + 2 * lane], o1 * rinv * g_attn[h * HD + 2 * lane + 1]);
    }
}
__device__ __forceinline__ void ph_conv_naive(const bf16_t* proj, const float* w_conv, const float* b_conv, const float* g_conv, bf16_t* merged, int gw, int NGW, int lane) {
    for (int item = gw; item < MT * 8; item += NGW) {
        const int t = item >> 3, grp = item & 7, ts = t & 4095; const int c = grp * 128 + 2 * lane;
        float y[2];
#pragma unroll
        for (int e = 0; e < 2; ++e) { float acc = b_conv[c + e];
#pragma unroll
            for (int k = 0; k < 3; ++k) { const int back = 2 - k; if (ts - back >= 0) { const bf16_t* r = proj + (size_t)(t - back) * NPROJ; acc += w_conv[k * CW + c + e] * (bf2f(r[3072 + c + e]) * bf2f(r[5120 + c + e])); } }
            y[e] = bf2f(proj[(size_t)t * NPROJ + 4096 + c + e]) * acc; }
        const float rinv = rsqrtf(wave_sum(y[0] * y[0] + y[1] * y[1]) * (1.f / HD) + EPS);
        *(unsigned*)(merged + (size_t)t * DM + AW + c) = pk2(y[0] * rinv * g_conv[c], y[1] * rinv * g_conv[c + 1]);
    }
}
__device__ __forceinline__ void ph_conv(const bf16_t* __restrict__ proj, const float* __restrict__ w_conv, const float* __restrict__ b_conv, const float* __restrict__ g_conv, bf16_t* __restrict__ merged, int gw, int NGW, int lane) {
    const int l16 = lane & 15, sub = lane >> 4, grp = gw & 7, c = grp * 128 + l16 * 8;
    float w0[8], w1[8], w2[8], bc[8], gc[8];
#pragma unroll
    for (int h = 0; h < 2; ++h) { const f32x4 a0 = *(const f32x4*)(w_conv + c + 4 * h), a1 = *(const f32x4*)(w_conv + CW + c + 4 * h), a2 = *(const f32x4*)(w_conv + 2 * CW + c + 4 * h), bb = *(const f32x4*)(b_conv + c + 4 * h), gg = *(const f32x4*)(g_conv + c + 4 * h);
#pragma unroll
        for (int e = 0; e < 4; ++e) { w0[4 * h + e] = a0[e]; w1[4 * h + e] = a1[e]; w2[4 * h + e] = a2[e]; bc[4 * h + e] = bb[e]; gc[4 * h + e] = gg[e]; } }
    const int step = (NGW >> 3) * 4;
    for (int t = (gw >> 3) * 4 + sub; t < MT; t += step) {
        const int ts = t & (SEQ - 1); const bf16_t* r0 = proj + (size_t)t * NPROJ + c;
        const u32x4 vb = *(const u32x4*)(r0 + 4096), c0 = *(const u32x4*)(r0 + 3072), x0 = *(const u32x4*)(r0 + 5120);
        u32x4 c1 = {0u, 0u, 0u, 0u}, x1 = c1, c2 = c1, x2 = c1;
        if (ts >= 1) { c1 = *(const u32x4*)(r0 - NPROJ + 3072); x1 = *(const u32x4*)(r0 - NPROJ + 5120); }
        if (ts >= 2) { c2 = *(const u32x4*)(r0 - 2 * NPROJ + 3072); x2 = *(const u32x4*)(r0 - 2 * NPROJ + 5120); }
        float y[8]; float ss = 0.f;
#pragma unroll
        for (int q = 0; q < 4; ++q)
#pragma unroll
            for (int hh = 0; hh < 2; ++hh) { const int e = 2 * q + hh;
                const float C0 = hh ? __uint_as_float(c0[q] & 0xffff0000u) : __uint_as_float(c0[q] << 16), X0 = hh ? __uint_as_float(x0[q] & 0xffff0000u) : __uint_as_float(x0[q] << 16);
                const float C1 = hh ? __uint_as_float(c1[q] & 0xffff0000u) : __uint_as_float(c1[q] << 16), X1 = hh ? __uint_as_float(x1[q] & 0xffff0000u) : __uint_as_float(x1[q] << 16);
                const float C2 = hh ? __uint_as_float(c2[q] & 0xffff0000u) : __uint_as_float(c2[q] << 16), X2 = hh ? __uint_as_float(x2[q] & 0xffff0000u) : __uint_as_float(x2[q] << 16);
                const float Bv = hh ? __uint_as_float(vb[q] & 0xffff0000u) : __uint_as_float(vb[q] << 16);
                const float acc = bc[e] + w2[e] * (C0 * X0) + w1[e] * (C1 * X1) + w0[e] * (C2 * X2);
                y[e] = Bv * acc; ss += y[e] * y[e]; }
        ss += __shfl_xor(ss, 1); ss += __shfl_xor(ss, 2); ss += __shfl_xor(ss, 4); ss += __shfl_xor(ss, 8);
        const float rinv = rsqrtf(ss * (1.f / HD) + EPS);
        u32x2 o; o.x = pg8::pk4_fp8(y[0] * rinv * gc[0], y[1] * rinv * gc[1], y[2] * rinv * gc[2], y[3] * rinv * gc[3]); o.y = pg8::pk4_fp8(y[4] * rinv * gc[4], y[5] * rinv * gc[5], y[6] * rinv * gc[6], y[7] * rinv * gc[7]);
        *(u32x2*)((unsigned char*)merged + (size_t)t * DM + AW + c) = o;
    }
}
__device__ __forceinline__ void ph_xattn_naive(const bf16_t* qx, const bf16_t* kvx, bf16_t* ox, float qscale_inv, float* scr, int gw, int NGW, int lane) {
    float* sq = scr; float* sp = scr + 128;
    for (int item = gw; item < MT * XH; item += NGW) {
        const int t = item >> 2, h = item & 3, b = t >> 12;
        const unsigned qq = *(const unsigned*)(qx + (size_t)t * XW + h * HD + 2 * lane);
        asm volatile("s_waitcnt lgkmcnt(0)" ::: "memory");
        sq[2 * lane] = bf2f(qq & 0xffffu) * qscale_inv; sq[2 * lane + 1] = bf2f(qq >> 16) * qscale_inv;
        asm volatile("s_waitcnt lgkmcnt(0)" ::: "memory");
        float m = -INFINITY;
        for (int jj = 0; jj < 4; ++jj) { const int j = jj * 64 + lane; const float sc = dot_q_row(sq, kvx + (size_t)(b * NMEM + j) * 1024 + h * HD) * SM_SCALE; sp[j] = sc; m = fmaxf(m, sc); }
        m = wave_max(m);
        asm volatile("s_waitcnt lgkmcnt(0)" ::: "memory");
        float l = 0.f; for (int i = lane; i < 256; i += 64) { const float p = __expf(sp[i] - m); sp[i] = p; l += p; } l = wave_sum(l);
        asm volatile("s_waitcnt lgkmcnt(0)" ::: "memory");
        float o0 = 0.f, o1 = 0.f; const bf16_t* vb = kvx + (size_t)(b * NMEM) * 1024 + 512 + h * HD + 2 * lane;
        for (int j = 0; j < 256; ++j) { const float p = sp[j]; const unsigned vv = *(const unsigned*)(vb + (size_t)j * 1024); o0 += p * bf2f(vv & 0xffffu); o1 += p * bf2f(vv >> 16); }
        const float li = 1.f / l;
        *(unsigned*)(ox + (size_t)t * XW + h * HD + 2 * lane) = pk2(o0 * li, o1 * li);
    }
}

namespace moba {
using bf16x8 = __attribute__((ext_vector_type(8))) short;
using s16x4  = __attribute__((ext_vector_type(4))) short;
using f32x16 = __attribute__((ext_vector_type(16))) float;
using u32x4v = __attribute__((ext_vector_type(4))) unsigned;
using f32x4v = __attribute__((ext_vector_type(4))) float;
constexpr int D = 128, NW = 8, QBLK = 32, KVBLK = 64;
constexpr float SCALE = 0.088388347648318440f, THR = 8.f;
constexpr int SHM_V = KVBLK * D * 2, SHM_K = KVBLK * D * 2;
constexpr int OFF_V = 0, OFF_K = 2 * SHM_V, OFF_WS = OFF_K + 2 * SHM_K, OFF_KM = OFF_WS + NW * 256, OFF_RS = OFF_KM + 16 * 128 * 4, RS_BYTES = (32 * 33 + 32) * 4, LDS_END = OFF_RS + NW * RS_BYTES;
static_assert(LDS_END <= 131072, "moba LDS");
#define KSWZ(row, colB) ((row) * 256 + ((colB) ^ (((row) & 7) << 4)))
#define SBAR() __builtin_amdgcn_sched_barrier(0)
__device__ __forceinline__ int crow(int r, int hi) { return (r & 3) + 8 * (r >> 2) + 4 * hi; }
__device__ __forceinline__ unsigned cvtpk(float lo, float hi) { unsigned r; asm volatile("v_cvt_pk_bf16_f32 %0, %1, %2" : "=v"(r) : "v"(lo), "v"(hi)); return r; }
__device__ __forceinline__ void partialSM(f32x16& p0, f32x16& p1, float& m_reg, float& mn, float& alpha) {
  constexpr float C = SCALE * 1.4426950408889634f;
  float pmax = p0[0];
#pragma unroll
  for (int r = 1; r < 16; ++r) pmax = fmaxf(pmax, p0[r]);
#pragma unroll
  for (int r = 0; r < 16; ++r) pmax = fmaxf(pmax, p1[r]);
  { auto rr = __builtin_amdgcn_permlane32_swap(__float_as_uint(pmax), __float_as_uint(pmax), false, false);
    pmax = fmaxf(__uint_as_float(rr[0]), __uint_as_float(rr[1])); }
  if (__builtin_expect(__all(pmax - m_reg <= THR / SCALE), 1)) { mn = m_reg; alpha = 1.f; }
  else { mn = fmaxf(m_reg, pmax); alpha = __builtin_amdgcn_exp2f((m_reg - mn) * C); m_reg = mn; }
  float mnC = -mn * C;
#pragma unroll
  for (int r = 0; r < 16; ++r) p0[r] = fmaf(p0[r], C, mnC);
#pragma unroll
  for (int r = 0; r < 16; ++r) p1[r] = fmaf(p1[r], C, mnC);
#pragma unroll
  for (int r = 0; r < 16; ++r) p0[r] = __builtin_amdgcn_exp2f(p0[r]);
}
__device__ __forceinline__ void finishSM(f32x16& p0, f32x16& p1, float alpha, float& l_reg, bf16x8& pa0, bf16x8& pa1, bf16x8& pa2, bf16x8& pa3) {
#pragma unroll
  for (int r = 0; r < 16; ++r) p1[r] = __builtin_amdgcn_exp2f(p1[r]);
  float ps = 0;
#pragma unroll
  for (int r = 0; r < 16; ++r) ps += p0[r];
#pragma unroll
  for (int r = 0; r < 16; ++r) ps += p1[r];
  { auto rr = __builtin_amdgcn_permlane32_swap(__float_as_uint(ps), __float_as_uint(ps), false, false);
    ps = __uint_as_float(rr[0]) + __uint_as_float(rr[1]); }
  l_reg = l_reg * alpha + ps;
#define PK4(P, BASE, OUT) do { unsigned a0 = cvtpk(P[BASE + 0], P[BASE + 1]), a1 = cvtpk(P[BASE + 2], P[BASE + 3]);   \
    unsigned b0 = cvtpk(P[BASE + 4], P[BASE + 5]), b1 = cvtpk(P[BASE + 6], P[BASE + 7]);                              \
    auto r0 = __builtin_amdgcn_permlane32_swap(a0, b0, false, false); auto r1 = __builtin_amdgcn_permlane32_swap(a1, b1, false, false); \
    u32x4v w = {r0[0], r1[0], r0[1], r1[1]}; OUT = *reinterpret_cast<bf16x8*>(&w); } while (0)
  PK4(p0, 0, pa0); PK4(p0, 8, pa1); PK4(p1, 0, pa2); PK4(p1, 8, pa3);
#undef PK4
}
__device__ __forceinline__ void qkt(f32x16& p0, f32x16& p1, const char* Ks, const bf16x8* qr, int r32, int hi, float binit = 0.f) {
#pragma unroll
  for (int r = 0; r < 16; ++r) { p0[r] = binit; p1[r] = binit; }
#pragma unroll
  for (int d0 = 0; d0 < 8; ++d0) { int cb = (d0 * 16 + hi * 8) * 2;
    bf16x8 b0 = *reinterpret_cast<const bf16x8*>(Ks + KSWZ(r32, cb));
    bf16x8 b1 = *reinterpret_cast<const bf16x8*>(Ks + KSWZ(32 + r32, cb));
    p0 = __builtin_amdgcn_mfma_f32_32x32x16_bf16(b0, qr[d0], p0, 0, 0, 0);
    p1 = __builtin_amdgcn_mfma_f32_32x32x16_bf16(b1, qr[d0], p1, 0, 0, 0); }
}
__device__ __forceinline__ int v_st(int k, int c) { const int kk = (k & ~0xC) | ((k & 4) << 1) | ((k & 8) >> 1); return ((kk >> 3) * 4 + (c >> 5)) * 512 + ((kk & 7) * 32 + (c & 31)) * 2; }
__device__ __forceinline__ int v_rd_base(int lane) { return ((lane & 3) << 3) | (((lane >> 2) & 3) << 6) | (((lane >> 4) & 1) << 5) | (((lane >> 5) & 1) << 8); }
constexpr int v_rd_off(int d0, int ks, int half) { return d0 * 512 + ks * 4096 + half * 2048; }
template <int OFF> __device__ __forceinline__ s16x4 tr_read(int vb) {
  s16x4 r; asm volatile("ds_read_b64_tr_b16 %0, %1 offset:%2" : "=&v"(r) : "v"(vb), "i"(OFF) : "memory"); return r;
}
template <int D0> __device__ __forceinline__ void pv_one(f32x16& od, int vb, bf16x8 pa0, bf16x8 pa1, bf16x8 pa2, bf16x8 pa3) {
  const s16x4 l0 = tr_read<v_rd_off(D0, 0, 0)>(vb), h0 = tr_read<v_rd_off(D0, 0, 1)>(vb), l1 = tr_read<v_rd_off(D0, 1, 0)>(vb), h1 = tr_read<v_rd_off(D0, 1, 1)>(vb);
  const s16x4 l2 = tr_read<v_rd_off(D0, 2, 0)>(vb), h2 = tr_read<v_rd_off(D0, 2, 1)>(vb), l3 = tr_read<v_rd_off(D0, 3, 0)>(vb), h3 = tr_read<v_rd_off(D0, 3, 1)>(vb);
  asm volatile("s_waitcnt lgkmcnt(0)" ::: "memory"); SBAR();
#define PK(L, H) (bf16x8){L[0], L[1], L[2], L[3], H[0], H[1], H[2], H[3]}
  od = __builtin_amdgcn_mfma_f32_32x32x16_bf16(pa0, PK(l0, h0), od, 0, 0, 0);
  od = __builtin_amdgcn_mfma_f32_32x32x16_bf16(pa1, PK(l1, h1), od, 0, 0, 0);
  od = __builtin_amdgcn_mfma_f32_32x32x16_bf16(pa2, PK(l2, h2), od, 0, 0, 0);
  od = __builtin_amdgcn_mfma_f32_32x32x16_bf16(pa3, PK(l3, h3), od, 0, 0, 0);
#undef PK
}
__device__ __forceinline__ void pv_d0(f32x16* o, int vb, bf16x8 pa0, bf16x8 pa1, bf16x8 pa2, bf16x8 pa3) {
  pv_one<0>(o[0], vb, pa0, pa1, pa2, pa3); pv_one<1>(o[1], vb, pa0, pa1, pa2, pa3); pv_one<2>(o[2], vb, pa0, pa1, pa2, pa3); pv_one<3>(o[3], vb, pa0, pa1, pa2, pa3);
}
template <int MODE> __device__ __forceinline__ float tile_bias(int j, int qb, unsigned selmask) {
  if constexpr (MODE != 0) return 0.f;
  const int kb = j >> 2;
  return (kb < qb && !((selmask >> kb) & 1u)) ? -INFINITY : 0.f;
}
template <int MODE> __device__ __forceinline__ void tile_causal(f32x16& p0, f32x16& p1, int j, int qb, int qrow, int hi) {
  if constexpr (MODE != 0) return;
  if ((j >> 2) < qb) return;
  const int kbase = (j & 3) * 64;
#pragma unroll
  for (int r = 0; r < 16; ++r) { const int key = kbase + crow(r, hi); if (key > qrow) p0[r] = -INFINITY; if (key + 32 > qrow) p1[r] = -INFINITY; }
}
template <int MODE> __device__ __forceinline__ void unit(int b, int h, int qb, const bf16_t* __restrict__ proj, const bf16_t* __restrict__ kvp, const float* __restrict__ kmean, const float* __restrict__ gain, bf16_t* __restrict__ merged, char* lds) {
  constexpr int LDQ = MODE == 0 ? NPROJ : XW, LDK = MODE == 0 ? NPROJ : 2 * XW, LDO = MODE == 0 ? DM : XW;
  const int tid = otid(), wid = tid >> 6, lane = tid & 63, r32 = lane & 31, hi = lane >> 5;
  char* V_lds = lds + OFF_V; char* K_lds = lds + OFF_K;
  float* ws = (float*)(lds + OFF_WS) + wid * 64; float* li_l = ws; float* al_l = ws + 32;
  char* KM = lds + OFF_KM; float* RS = (float*)(lds + OFF_RS + wid * RS_BYTES); float* RV = RS + 32 * 33;
  const long rowbase = (long)b * SEQ;
  const bf16_t* Qw = proj + (rowbase + qb * 256 + wid * QBLK + r32) * LDQ + h * D + hi * 8;
  const bf16_t* Kh = MODE == 0 ? proj + rowbase * LDK + 1024 + h * D : kvp + (long)b * NMEM * LDK + h * D;
  const bf16_t* Vh = MODE == 0 ? proj + rowbase * LDK + 2048 + h * D : kvp + (long)b * NMEM * LDK + XW + h * D;
  __syncthreads();
  if constexpr (MODE == 0)
  { const int blk = tid >> 5, c4 = (tid & 31) * 4;
    const f32x4v kv = *(const f32x4v*)(kmean + (size_t)((b * 8 + h) * 16 + blk) * D + c4);
    unsigned hb[4], lb[4];
#pragma unroll
    for (int e = 0; e < 4; ++e) { hb[e] = f2bf(kv[e]); lb[e] = f2bf(kv[e] - __uint_as_float(hb[e] << 16)); }
    typedef unsigned u32x2v __attribute__((ext_vector_type(2)));
    *(u32x2v*)(KM + KSWZ(blk, c4 * 2)) = (u32x2v){hb[0] | (hb[1] << 16), hb[2] | (hb[3] << 16)};
    *(u32x2v*)(KM + KSWZ(16 + blk, c4 * 2)) = (u32x2v){lb[0] | (lb[1] << 16), lb[2] | (lb[3] << 16)}; }
  float m_reg = -1e30f, l_reg = 0; f32x16 o[4] = {}; bf16x8 qr[8];
#pragma unroll
  for (int d0 = 0; d0 < 8; ++d0) qr[d0] = *reinterpret_cast<const bf16x8*>(Qw + d0 * 16);
  const int sr = tid >> 4, sc = (tid & 15) * 8, vst0 = v_st(sr, sc), vst1 = v_st(32 + sr, sc);
  const int vb0 = (int)(uintptr_t)V_lds + v_rd_base(lane);
  struct { bf16x8 vs0, vs1, ks0, ks1; } sr_[1];
#define SLOAD(i, k0) do { sr_[i].vs0 = *reinterpret_cast<const bf16x8*>(&Vh[(long)((k0) + sr) * LDK + sc]); sr_[i].vs1 = *reinterpret_cast<const bf16x8*>(&Vh[(long)((k0) + 32 + sr) * LDK + sc]); \
    sr_[i].ks0 = *reinterpret_cast<const bf16x8*>(&Kh[(long)((k0) + sr) * LDK + sc]); sr_[i].ks1 = *reinterpret_cast<const bf16x8*>(&Kh[(long)((k0) + 32 + sr) * LDK + sc]); } while (0)
#define SWRITE(bb, i) do { *(bf16x8*)(V_lds + (bb) * SHM_V + vst0) = sr_[i].vs0;          \
    *(bf16x8*)(V_lds + (bb) * SHM_V + vst1) = sr_[i].vs1; int kc = sc * 2;               \
    *(bf16x8*)(K_lds + (bb) * SHM_K + KSWZ(sr, kc)) = sr_[i].ks0;                       \
    *(bf16x8*)(K_lds + (bb) * SHM_K + KSWZ(32 + sr, kc)) = sr_[i].ks1; } while (0)
#define SWAIT() asm volatile("s_waitcnt vmcnt(0)" ::: "memory")
#define RESC(a) do { if (__any((a) < 1.f)) { if (hi == 0) al_l[r32] = (a); asm volatile("s_waitcnt lgkmcnt(0)" ::: "memory"); \
    _Pragma("unroll") for (int d = 0; d < 4; ++d) _Pragma("unroll") for (int r = 0; r < 16; ++r) o[d][r] *= al_l[crow(r, hi)]; } } while (0)
  const int NT = MODE == 0 ? 4 * (qb + 1) : 4;
  constexpr int SE = 0, SO = 0;
  SLOAD(SE, 0);
  __syncthreads();
  unsigned selmask = 0u;
  if constexpr (MODE == 0) {
    f32x16 gp = f32x16{};
#pragma unroll
    for (int d0 = 0; d0 < 8; ++d0) { const int cb = (d0 * 16 + hi * 8) * 2;
      const bf16x8 b0 = *reinterpret_cast<const bf16x8*>(KM + KSWZ(r32, cb));
      gp = __builtin_amdgcn_mfma_f32_32x32x16_bf16(b0, qr[d0], gp, 0, 0, 0); }
    float g[16];
#pragma unroll
    for (int r = 0; r < 8; ++r) { const float v = gp[r] + gp[r + 8];
      auto rr = __builtin_amdgcn_permlane32_swap(__float_as_uint(v), __float_as_uint(v), false, false);
      const int blo = (r < 4) ? r : 8 + (r - 4);
      g[blo] = __uint_as_float(rr[0]); g[blo + 4] = __uint_as_float(rr[1]); }
#pragma unroll
    for (int i = 0; i < 16; ++i) g[i] = (i < qb) ? g[i] : -INFINITY;
#pragma unroll
    for (int rnd = 0; rnd < 3; ++rnd) { float best = -INFINITY; int bi = -1;
#pragma unroll
      for (int i = 0; i < 16; ++i) if (g[i] > best) { best = g[i]; bi = i; }
      if (bi >= 0) selmask |= 1u << bi;
#pragma unroll
      for (int i = 0; i < 16; ++i) if (i == bi) g[i] = -INFINITY; }
  }
  const int qrow = wid * QBLK + r32;
  f32x16 pA0, pA1, pB0, pB1; float mnA, mnB, alA, alB; bf16x8 pa0, pa1, pa2, pa3;
  asm volatile("s_waitcnt vmcnt(0)" ::: "memory"); SWRITE(0, SE); __syncthreads();
  qkt(pA0, pA1, K_lds, qr, r32, hi, tile_bias<MODE>(0, qb, selmask)); tile_causal<MODE>(pA0, pA1, 0, qb, qrow, hi); partialSM(pA0, pA1, m_reg, mnA, alA);
  SLOAD(SO, KVBLK);
  SWAIT(); SWRITE(1, SO); __syncthreads();
  for (int j = 1; j + 1 < NT; j += 2) {
    SBAR(); qkt(pB0, pB1, K_lds + SHM_K, qr, r32, hi, tile_bias<MODE>(j, qb, selmask)); tile_causal<MODE>(pB0, pB1, j, qb, qrow, hi);
    finishSM(pA0, pA1, alA, l_reg, pa0, pa1, pa2, pa3); SBAR();
    SLOAD(SE, (j + 1) * KVBLK); SBAR();
    pv_d0(o, vb0, pa0, pa1, pa2, pa3); partialSM(pB0, pB1, m_reg, mnB, alB);
    __syncthreads(); SWAIT(); SWRITE(0, SE);
    RESC(alB); __syncthreads();
    SBAR(); qkt(pA0, pA1, K_lds, qr, r32, hi, tile_bias<MODE>(j + 1, qb, selmask)); tile_causal<MODE>(pA0, pA1, j + 1, qb, qrow, hi);
    finishSM(pB0, pB1, alB, l_reg, pa0, pa1, pa2, pa3); SBAR();
    SLOAD(SO, (j + 2) * KVBLK); SBAR();
    pv_d0(o, vb0 + SHM_V, pa0, pa1, pa2, pa3); partialSM(pA0, pA1, m_reg, mnA, alA);
    __syncthreads(); SWAIT(); SWRITE(1, SO);
    RESC(alA); __syncthreads();
  }
  SBAR(); qkt(pB0, pB1, K_lds + SHM_K, qr, r32, hi, tile_bias<MODE>(NT - 1, qb, selmask)); tile_causal<MODE>(pB0, pB1, NT - 1, qb, qrow, hi);
  finishSM(pA0, pA1, alA, l_reg, pa0, pa1, pa2, pa3); SBAR();
  pv_d0(o, vb0, pa0, pa1, pa2, pa3); partialSM(pB0, pB1, m_reg, mnB, alB);
  __syncthreads(); RESC(alB);
  finishSM(pB0, pB1, alB, l_reg, pa0, pa1, pa2, pa3); SBAR();
  pv_d0(o, vb0 + SHM_V, pa0, pa1, pa2, pa3);
  if (hi == 0) li_l[r32] = l_reg; asm volatile("s_waitcnt lgkmcnt(0)" ::: "memory");
  float rli[16];
#pragma unroll
  for (int r = 0; r < 16; ++r) rli[r] = __builtin_amdgcn_rcpf(li_l[crow(r, hi)]);
  if constexpr (MODE == 0) {
#pragma unroll
  for (int r = 0; r < 16; ++r) { float s = 0.f;
#pragma unroll
    for (int d0 = 0; d0 < 4; ++d0) { o[d0][r] *= rli[r]; s += o[d0][r] * o[d0][r]; }
    RS[crow(r, hi) * 33 + r32] = s; }
  asm volatile("s_waitcnt lgkmcnt(0)" ::: "memory");
  { float s = 0.f;
#pragma unroll
    for (int c = 0; c < 32; ++c) s += RS[r32 * 33 + c];
    if (hi == 0) RV[r32] = rsqrtf(s * (1.f / D) + EPS); }
  asm volatile("s_waitcnt lgkmcnt(0)" ::: "memory");
  float gn[4];
#pragma unroll
  for (int d0 = 0; d0 < 4; ++d0) gn[d0] = gain[h * D + d0 * 32 + r32];
  unsigned char* Ow8 = (unsigned char*)merged + (rowbase + qb * 256 + wid * QBLK) * LDO + h * D;
#pragma unroll
  for (int r = 0; r < 16; ++r) { const int orow = crow(r, hi); const float rv = RV[orow];
#pragma unroll
    for (int d0 = 0; d0 < 4; ++d0) { const float vv = __builtin_amdgcn_fmed3f(o[d0][r] * rv * gn[d0], -448.f, 448.f); Ow8[(long)orow * LDO + d0 * 32 + r32] = (unsigned char)(__builtin_amdgcn_cvt_pk_fp8_f32(vv, vv, 0, false) & 0xff); } }
  } else {
    bf16_t* Ow = merged + (rowbase + qb * 256 + wid * QBLK) * LDO + h * D;
#pragma unroll
    for (int r = 0; r < 16; ++r) { const int orow = crow(r, hi);
#pragma unroll
      for (int d0 = 0; d0 < 4; ++d0) Ow[(long)orow * LDO + d0 * 32 + r32] = (bf16_t)f2bf(o[d0][r] * rli[r]); }
  }
#undef SLOAD
#undef SWRITE
#undef SWAIT
#undef RESC
}
#undef KSWZ
#undef SBAR
}

#define LAS __attribute__((address_space(3)))
#define XB_TMO      128
#define XB_XCNT(j)  (256  + 64 * (j))
#define XB_XSUB(j)  (1280 + 64 * (j))
#define XB_XGEN(j)  (2304 + 64 * (j))
#define XB_TOP      3328
#define XB_TOPGEN   3392
#define XCD_BAR_WORDS 3456
#define XB_SPIN_CAP (1u << 18)

__device__ __forceinline__ unsigned xb_ld(unsigned* p)              { return __hip_atomic_load(p, __ATOMIC_RELAXED, __HIP_MEMORY_SCOPE_AGENT); }
__device__ __forceinline__ unsigned xb_add(unsigned* p, unsigned v) { return __hip_atomic_fetch_add(p, v, __ATOMIC_RELAXED, __HIP_MEMORY_SCOPE_AGENT); }
__device__ __forceinline__ unsigned xb_xcc_id() { return (unsigned)__builtin_amdgcn_s_getreg((3 << 11) | 20) & 0xFu; }
#define XB_SPIN(cond, bar) do { unsigned _sp = 0; while (cond) { __builtin_amdgcn_s_sleep(1); \
    if ((++_sp & 255u) == 0u) { if (xb_ld(&(bar)[XB_TMO])) break; if (_sp > XB_SPIN_CAP) { atomicAdd(&(bar)[XB_TMO], 1u); break; } } } } while (0)

struct XcdBarrier {
    unsigned* bar; unsigned x;
    volatile LAS unsigned* st;
};

__device__ __forceinline__ XcdBarrier xcd_barrier_post(unsigned* bar, volatile LAS unsigned* st) {
    XcdBarrier b; b.bar = bar; b.x = xb_xcc_id(); b.st = st;
    if (threadIdx.x == 0) (void)xb_add(&bar[XB_XCNT(b.x)], 1u);
    return b;
}
__device__ __forceinline__ void xcd_barrier_complete(unsigned* bar, unsigned x, unsigned& nloc, unsigned& nx) {
    const unsigned G = gridDim.x * gridDim.y * gridDim.z;
    unsigned sum, cnt, mine, sp = 0u;
    for (;;) {
        sum = 0u; cnt = 0u; mine = 0u;
#pragma unroll
        for (unsigned j = 0; j < 16; ++j) { const unsigned c = xb_ld(&bar[XB_XCNT(j)]); sum += c; cnt += (c > 0u) ? 1u : 0u; mine = (j == x) ? c : mine; }
        if (sum == G) break;
        __builtin_amdgcn_s_sleep(1);
        if ((++sp & 255u) == 0u) { if (xb_ld(&bar[XB_TMO])) break; if (sp > XB_SPIN_CAP) { atomicAdd(&bar[XB_TMO], 1u); break; } }
    }
    nloc = mine > 0u ? mine : 1u; nx = cnt > 0u ? cnt : 1u;
}

__device__ __forceinline__ void xcd_barrier(const XcdBarrier& b) {
    asm volatile("s_waitcnt vmcnt(0)" ::: "memory");
    __syncthreads();
    if (threadIdx.x == 0) {
        unsigned* bar = b.bar;
        __builtin_amdgcn_s_waitcnt(0);
        unsigned nloc = b.st[0], nx = b.st[1];
        if (nloc == 0u) { xcd_barrier_complete(bar, b.x, nloc, nx); b.st[0] = nloc; b.st[1] = nx; }
        const unsigned old = xb_add(&bar[XB_XSUB(b.x)], 1u);
        const unsigned gen = old / nloc;
        if (old + 1u == (gen + 1u) * nloc) {
            __builtin_amdgcn_fence(__ATOMIC_RELEASE, "agent");
            asm volatile("s_waitcnt vmcnt(0)" ::: "memory");
            const unsigned og = xb_add(&bar[XB_TOP], 1u);
            const unsigned tg = og / nx;
            if (og + 1u == (tg + 1u) * nx) xb_add(&bar[XB_TOPGEN], 1u);
            else XB_SPIN(xb_ld(&bar[XB_TOPGEN]) == tg, bar);
            __builtin_amdgcn_fence(__ATOMIC_ACQUIRE, "agent");
            xb_add(&bar[XB_XGEN(b.x)], 1u);
            asm volatile("s_waitcnt vmcnt(0)" ::: "memory");
        } else {
            XB_SPIN(xb_ld(&bar[XB_XGEN(b.x)]) == gen, bar);
            __builtin_amdgcn_fence(__ATOMIC_ACQUIRE, "agent");
            asm volatile("s_waitcnt vmcnt(0)" ::: "memory");
        }
    }
    __syncthreads();
}

namespace cg = cooperative_groups;
constexpr int LDS_BYTES = 147456;
struct Args { const void* in[20]; float* out; unsigned char* ws; int flags, pad; };
__global__ void __launch_bounds__(512, 2) mk_fwd(Args a) {
    extern __shared__ __attribute__((aligned(16))) unsigned char lds[];
    cg::grid_group grid = cg::this_grid();
    const int G = (int)gridDim.x, bx = (int)blockIdx.x;
    const int NGW = G * 8, NT = G * 512;
    volatile LAS unsigned* bar_st = (volatile LAS unsigned*)((LAS unsigned char*)lds + 131072 + 64);
    { const int t0 = otid(); if (t0 < 2) bar_st[t0] = 0u; }
    __syncthreads();
    const XcdBarrier bar = xcd_barrier_post((unsigned*)(a.ws + WS_BAR), bar_st);
    if (a.flags != 0) grid.sync();
#define IDS() const int tid = otid(), lane = tid & 63, wave = __builtin_amdgcn_readfirstlane(tid >> 6); const int gw = bx * 8 + wave, gtid = bx * 512 + tid; float* wscr = (float*)(lds + wave * 16384); (void)lane; (void)gw; (void)gtid; (void)wscr
#define IN_F(k) ((const float*)a.in[k])
#define WSP(T, off) ((T)(a.ws + (off)))
#define x IN_F(0)
#define mem IN_F(1)
#define pos ((const int*)a.in[2])
#define g_mix IN_F(3)
#define w_in IN_F(4)
#define w_conv IN_F(5)
#define b_conv IN_F(6)
#define g_attn IN_F(7)
#define g_conv IN_F(8)
#define w_out IN_F(9)
#define g_xattn IN_F(10)
#define g_mem IN_F(11)
#define w_xq IN_F(12)
#define w_xkv IN_F(13)
#define w_xo IN_F(14)
#define g_ffn IN_F(15)
#define w_gate IN_F(16)
#define w_up IN_F(17)
#define w_down IN_F(18)
#define g_final IN_F(19)
#define out (a.out)
#define Win WSP(bf16_t*, WS_WIN)
#define Wout WSP(bf16_t*, WS_WOUT)
#define Wxq WSP(bf16_t*, WS_WXQ)
#define Wxkv WSP(bf16_t*, WS_WXKV)
#define Wxo WSP(bf16_t*, WS_WXO)
#define Wgu WSP(bf16_t*, WS_WGU)
#define Wdn WSP(bf16_t*, WS_WDN)
#define H WSP(bf16_t*, WS_H)
#define MRG WSP(bf16_t*, WS_MRG)
#define PROJ WSP(bf16_t*, WS_PROJ)
#define ACT WSP(bf16_t*, WS_ACT)
#define QX WSP(bf16_t*, WS_QX)
#define OX WSP(bf16_t*, WS_OX)
#define KVX WSP(bf16_t*, WS_KVX)
#define MEMN WSP(bf16_t*, WS_MEMN)
#define CS WSP(float*, WS_CS)
#define KMEAN WSP(float*, WS_KMEAN)
#define X8 WSP(unsigned char*, WS_X8)
#define RMAX WSP(float*, WS_RMAX)
#define CMAX WSP(float*, WS_CMAX)
#define H8 WSP(unsigned char*, WS_H8)
#define Win8 WSP(bf16_t*, WS_WIN + 8 * MiB)
#define SS1 WSP(float*, WS_SS)
#define SS2 WSP(float*, WS_SS + 2 * MiB)
#define SS3 WSP(float*, WS_SS + 4 * MiB)
    PG8_LAS unsigned char* ldsg = (PG8_LAS unsigned char*)lds;

#define COMMA ,
#define GEMM(EpiT, Aop, Bop, Mr, Nc, Kd, ...) do { pg8::Gemm g_{Aop, Bop, Mr, Nc, Kd, 0}; pg8::StaticOrder S_; S_.init(Mr, Nc, G, bx); EpiT E_{__VA_ARGS__}; \
        pg8::gemm_phase<EpiT, pg8::StaticOrder, true, true>(ldsg, g_, S_, E_); } while (0)
#define GEMM8(EpiT, Aop, Bop, Mr, Nc, Kd, ...) do { pg8::Gemm g_{Aop, Bop, Mr, Nc, Kd, 0}; pg8::StaticOrder S_; S_.init(Mr, Nc, G, bx); EpiT E_{__VA_ARGS__}; \
        pg8::gemm_phase<EpiT, pg8::StaticOrder, true, true, 1, 0x77777777>(ldsg, g_, S_, E_); } while (0)
#define GEMMI8(EpiT, Aop, Bop, Mr, Nc, Kd, ...) do { pg8::Gemm g_{Aop, Bop, Mr, Nc, Kd, 0}; pg8::StaticOrder S_; S_.init(Mr, Nc, G, bx); EpiT E_{__VA_ARGS__}; \
        pg8::gemm_phase<EpiT, pg8::StaticOrder, true, true, 2>(ldsg, g_, S_, E_); } while (0)

    {
        IDS();
        int base = 0;
        base = ph_transpose_job(TJob{w_in, nullptr, nullptr, Win, DM, NPROJ, 2048, 1, 1.f, 0, nullptr}, base, wscr, gw, NGW, lane);
        base = ph_transpose_job(TJob{w_out, nullptr, nullptr, Wout, DM, DM, DM, 0, 256.f, 1, nullptr}, base, wscr, gw, NGW, lane);
        base = ph_transpose_job(TJob{w_xq, nullptr, g_xattn, Wxq, DM, XW, XW, 0, 256.f, 1, nullptr}, base, wscr, gw, NGW, lane);
        base = ph_transpose_job(TJob{w_xkv, nullptr, nullptr, Wxkv, DM, 2 * XW, 2 * XW, 0, 1.f, 0, nullptr}, base, wscr, gw, NGW, lane);
        base = ph_transpose_job(TJob{w_xo, nullptr, nullptr, Wxo, XW, DM, DM, 0, 1.f, 0, nullptr}, base, wscr, gw, NGW, lane);
    }
    { IDS(); ph_colmax(w_in + 2048, DM, NPROJ, 4096, CMAX, gw, NGW, lane); }
    { IDS(); ph_cs(pos, CS, gtid, NT); for (int i = gtid; i < NB * NH * NBLK * HD; i += NT) KMEAN[i] = 0.f; }
    xcd_barrier(bar);
    { IDS(); ph_rms_bf16(x, g_mix, H, H8, RMAX, MT, gw, NGW, lane); ph_rms_bf16(mem, g_mem, MEMN, nullptr, nullptr, NB * NMEM, gw, NGW, lane); }
    { IDS(); (void)ph_transpose_job(TJob{w_in + 2048, nullptr, nullptr, Win8, DM, NPROJ, 4096, 0, 1.f, 2, CMAX}, 0, wscr, gw, NGW, lane); }
    xcd_barrier(bar);
    GEMM(pg8::EpiInProj, H, Win, MT, 2048, DM, PROJ, CS, KMEAN);
    GEMMI8(pg8::EpiScaledBf16, (const bf16_t*)H8, Win8, MT, 4096, DM, PROJ + 2048, RMAX, CMAX, NPROJ, 0);
    xcd_barrier(bar);
    {
        const int vcu = (G % 8 == 0) ? (bx % 8) * (G / 8) + bx / 8 : bx;
        for (int p = vcu; p < NB * NH * 8; p += G) {
            const int bh = p >> 3, s = p & 7;
            moba::unit<0>(bh >> 3, bh & 7, s, PROJ, nullptr, KMEAN, g_attn, MRG, (char*)lds);
            moba::unit<0>(bh >> 3, bh & 7, 15 - s, PROJ, nullptr, KMEAN, g_attn, MRG, (char*)lds);
        }
        __syncthreads();
    }
    { IDS(); ph_conv(PROJ, w_conv, b_conv, g_conv, MRG, gw, NGW, lane); }
    xcd_barrier(bar);
    GEMM8(pg8::EpiRes<true COMMA true>, MRG, Wout, MT, DM, DM, x, H, X8, SS1);
    xcd_barrier(bar);
    GEMM8(pg8::EpiRowScaleBf16, (const bf16_t*)X8, Wxq, MT, XW, DM, QX, SS1, XW, 0);
    { pg8::Gemm g_{MEMN, Wxkv, NB * NMEM, 2 * XW, DM, 0}; pg8::StaticOrder S_; S_.init(NB * NMEM, 2 * XW, G, (bx + G - 128 % G) % G); pg8::EpiStoreBf16 E_{KVX, 2 * XW, 0};
      pg8::gemm_phase<pg8::EpiStoreBf16, pg8::StaticOrder, true, true>(ldsg, g_, S_, E_); }
    {
        IDS();
        const int nidle = (G > 144 + 16) ? G - 144 : G, first = (G > 144 + 16) ? 144 : 0;
        if (bx >= first) {
            const int gw2 = (bx - first) * 8 + wave, NGW2 = nidle * 8; int base = 0;
            base = ph_transpose_job(TJob{w_gate, w_up, g_ffn, Wgu, DM, DFF, 2 * DFF, 2, 256.f, 1, nullptr}, base, wscr, gw2, NGW2, lane);
            base = ph_transpose_job(TJob{w_down, nullptr, nullptr, Wdn, DFF, DM, DM, 0, 256.f, 1, nullptr}, base, wscr, gw2, NGW2, lane);
        }
    }
    xcd_barrier(bar);
    {
        const int vcu = (G % 8 == 0) ? (bx % 8) * (G / 8) + bx / 8 : bx;
        for (int p = vcu; p < NB * XH * (SEQ / 256); p += G) { const int bh = p >> 4, qt = p & 15; moba::unit<1>(bh >> 2, bh & 3, qt, QX, KVX, nullptr, nullptr, OX, (char*)lds); }
        __syncthreads();
    }
    xcd_barrier(bar);
    GEMM(pg8::EpiRes<false COMMA true>, OX, Wxo, MT, DM, XW, H, H, X8, SS2);
    xcd_barrier(bar);
    GEMM8(pg8::EpiSwiGLUNorm<true>, (const bf16_t*)X8, Wgu, MT, 2 * DFF, DM, ACT, SS2, DFF, 0);
    xcd_barrier(bar);
    GEMM8(pg8::EpiRes<false COMMA false>, ACT, Wdn, MT, DM, DFF, H, H, nullptr, SS3);
    xcd_barrier(bar);
    { IDS(); ph_final_norm(H, out, g_final, SS3, MT, gw, NGW, lane); }
#undef GEMM
#undef COMMA
#undef GEMM8
#undef GEMMI8
#undef IDS
#undef x
#undef mem
#undef pos
#undef g_mix
#undef w_in
#undef w_conv
#undef b_conv
#undef g_attn
#undef g_conv
#undef w_out
#undef g_xattn
#undef g_mem
#undef w_xq
#undef w_xkv
#undef w_xo
#undef g_ffn
#undef w_gate
#undef w_up
#undef w_down
#undef g_final
#undef out
#undef Win
#undef Wout
#undef Wxq
#undef Wxkv
#undef Wxo
#undef Wgu
#undef Wdn
#undef H
#undef MRG
#undef PROJ
#undef ACT
#undef QX
#undef OX
#undef KVX
#undef MEMN
#undef CS
#undef KMEAN
#undef SS1
#undef X8
#undef RMAX
#undef CMAX
#undef H8
#undef Win8
#undef SS2
#undef SS3
#undef IN_F
#undef WSP
}

extern "C" void kernel_launch(void* const* d_in, const int* in_sizes, int n_in, void* d_out, int out_size, void* d_ws, size_t ws_size, hipStream_t stream) {
    static int grid_blocks = 0;
    if (grid_blocks == 0) {
        if (n_in != 20 || ws_size < WS_END) { fprintf(stderr, "kernel_launch: unexpected n_in %d / ws %zu\n", n_in, ws_size); grid_blocks = -1; return; }
        int dev = 0, cus = 0, per_cu = 0;
        (void)hipGetDevice(&dev); (void)hipDeviceGetAttribute(&cus, hipDeviceAttributeMultiprocessorCount, dev);
        (void)hipFuncSetAttribute((const void*)mk_fwd, hipFuncAttributeMaxDynamicSharedMemorySize, LDS_BYTES);
        (void)hipOccupancyMaxActiveBlocksPerMultiprocessor(&per_cu, (const void*)mk_fwd, 512, LDS_BYTES);
        if (per_cu < 1) { fprintf(stderr, "kernel_launch: occupancy query says %d blocks per CU\n", per_cu); per_cu = 1; }
        grid_blocks = cus;
        (void)hipGetLastError();
    }
    if (grid_blocks < 0) return;
    Args a{};
    for (int i = 0; i < 20; ++i) a.in[i] = d_in[i];
    a.out = (float*)d_out; a.ws = (unsigned char*)d_ws;
    (void)hipMemsetAsync((unsigned char*)d_ws + WS_BAR, 0, 32768, stream);
    void* args[] = {&a};
    hipError_t e = hipLaunchCooperativeKernel((const void*)mk_fwd, dim3(grid_blocks), dim3(512), args, LDS_BYTES, stream);
    if (e != hipSuccess) fprintf(stderr, "cooperative launch failed: %s (grid %d)\n", hipGetErrorString(e), grid_blocks);
}
```

```cpp
#include <hip/hip_runtime.h>
#include <hip/hip_cooperative_groups.h>
#include <cstdio>
#include <cstdint>
#include <cmath>
__device__ __forceinline__ int otid() { int t = (int)threadIdx.x; asm volatile("" : "+v"(t)); return t; }
namespace pg8 {
#define PG8_LAS __attribute__((address_space(3)))
typedef unsigned short bf16_t;
typedef short bf16x8 __attribute__((ext_vector_type(8)));
typedef float f32x4 __attribute__((ext_vector_type(4)));
typedef unsigned u32x4 __attribute__((ext_vector_type(4)));
constexpr int BM = 256, BK = 64, HALF = 128, HTB = HALF * BK * 2  , STAGE_BYTES = 8 * HTB, NXCD = 8, WGM = 8;

__host__ __device__ __forceinline__ int lds_byte(int r, int c) { const int st = (r >> 4) * 2 + (c >> 5), rr = r & 15, cc = c & 31, ob = rr * 64 + cc * 2; return st * 1024 + (ob ^ (((ob >> 9) & 1) << 5)); }
__host__ __device__ __forceinline__ void stage_rc(int b, int& R, int& C) { const int st = b / 1024, sb = b % 1024, swz = sb ^ (((sb >> 9) & 1) << 5); R = (st >> 1) * 16 + swz / 64; C = (st & 1) * 32 + (swz % 64) / 2; }
__host__ __device__ __forceinline__ int f8swz(int fr) { return (fr >> 1) ^ ((fr >= 4 && fr <= 11) ? 2 : 0); }
__host__ __device__ __forceinline__ void stage_rc8(int b, int& R, int& C) { const int fr = (b >> 7) & 15; R = (b >> 11) * 16 + fr; C = ((((b >> 4) & 7) ^ f8swz(fr)) * 8); }
__host__ __device__ __forceinline__ int perm32(int rho) { const int n = rho >> 4, i = rho & 15; return 8 * (i >> 2) + 4 * n + (i & 3); }

struct Unit { int pm, pn; };
struct Gemm { const bf16_t* A; const bf16_t* Bt; int M, N, K, pad; };

struct StaticOrder {
    int nM, nN, nwg, G, c;
    __host__ __device__ void init(int M, int N, int G_, int c_) { nM = M / BM; nN = N / BM; nwg = nM * nN; G = G_; c = c_; }
    __host__ __device__ bool next(int i, Unit& u) const {
        const long L = (long)i * G + c; if (L >= nwg) return false;
        int wgid = (int)L; { const int q = nwg / NXCD, r = nwg % NXCD, xcd = wgid % NXCD, off = wgid / NXCD; wgid = (xcd < r ? xcd * (q + 1) : r * (q + 1) + (xcd - r) * q) + off; }
        const int nig = WGM * nN, gid = wgid / nig, fm = gid * WGM, gsz = (nM - fm) < WGM ? (nM - fm) : WGM;
        u.pm = fm + ((wgid % nig) % gsz); u.pn = (wgid % nig) / gsz; return true;
    }
    __device__ __forceinline__ void a_ready(const Unit&) const {}
    __device__ __forceinline__ void done(const Unit&) const {}
};
__device__ __forceinline__ unsigned cvt_pk_bf16(float lo, float hi) { unsigned r; asm volatile("v_cvt_pk_bf16_f32 %0, %1, %2" : "=v"(r) : "v"(lo), "v"(hi)); return r; }
__device__ __forceinline__ unsigned pk4_fp8(float a, float b, float c, float d) {
    a = __builtin_amdgcn_fmed3f(a, -448.f, 448.f); b = __builtin_amdgcn_fmed3f(b, -448.f, 448.f); c = __builtin_amdgcn_fmed3f(c, -448.f, 448.f); d = __builtin_amdgcn_fmed3f(d, -448.f, 448.f);
    int r = 0; r = __builtin_amdgcn_cvt_pk_fp8_f32(a, b, r, false); r = __builtin_amdgcn_cvt_pk_fp8_f32(c, d, r, true); return (unsigned)r;
}
__device__ __forceinline__ void mfma_f8(f32x4& acc, const bf16x8& w0, const bf16x8& w1, const bf16x8& a0, const bf16x8& a1, int scale_w, int scale_a) {
    typedef int i32x8_ __attribute__((ext_vector_type(8))); typedef int i32x4_ __attribute__((ext_vector_type(4)));
    const i32x4_ p0 = __builtin_bit_cast(i32x4_, w0), p1 = __builtin_bit_cast(i32x4_, w1), q0 = __builtin_bit_cast(i32x4_, a0), q1 = __builtin_bit_cast(i32x4_, a1);
    const i32x8_ W = {p0[0], p0[1], p0[2], p0[3], p1[0], p1[1], p1[2], p1[3]}, A = {q0[0], q0[1], q0[2], q0[3], q1[0], q1[1], q1[2], q1[3]};
    asm volatile("v_mfma_scale_f32_16x16x128_f8f6f4 %0, %1, %2, %0, %3, %4 op_sel_hi:[0,0,0]" : "+v"(acc) : "v"(W), "v"(A), "v"(scale_w), "v"(scale_a));
}
template <class Epi, class Sched, bool ALIGN_EPI = false, bool SP2 = false, int DT = 0, int SCALE_W = 0x7f7f7f7f>
__device__ __forceinline__ void gemm_phase(PG8_LAS unsigned char* lds, const Gemm g, const Sched& S, const Epi& E) {
    constexpr bool F8 = (DT == 1), I8 = (DT == 2);
    const int tid = otid(), wid = __builtin_amdgcn_readfirstlane(tid >> 6), lane = tid & 63, wr = wid >> 2, wc = wid & 3, fr = lane & 15, fq = lane >> 4;
    const int K = (DT != 0) ? g.K / 2 : g.K, nt = K / BK;
    unsigned voffA[2], voffB[2];
#pragma unroll
    for (int i = 0; i < 2; ++i) { int R, C; if constexpr (F8) stage_rc8(tid * 16 + i * 8192, R, C); else stage_rc(tid * 16 + i * 8192, R, C); const int Rb = Epi::PERM ? ((R & ~31) + perm32(R & 31)) : R;
        voffA[i] = (unsigned)(R * K + C) * 2u; voffB[i] = (unsigned)(Rb * K + C) * 2u; }
    const size_t kstep = (size_t)(BK * 2);
    const size_t hstep = (size_t)HALF * K * 2;
    const size_t tstep = 2 * hstep;
    const unsigned ldsw = (unsigned)wid * 1024u;
    int aoffk[2], boffk[2];
#pragma unroll
    for (int k = 0; k < 2; ++k) {
        if constexpr (F8) { const int ch = (((2 * fq + k) ^ f8swz(fr)) << 4); aoffk[k] = wr * 4 * 2048 + fr * 128 + ch; boffk[k] = wc * 2 * 2048 + fr * 128 + ch; }
        else { aoffk[k] = lds_byte(wr * 64 + fr, fq * 8) + k * 1024; boffk[k] = lds_byte(wc * 32 + fr, fq * 8) + k * 1024; } }
#define PG8_SA(b, h) (((b) * 2 + (h)) * HTB)
#define PG8_SB(b, h) ((4 + (b) * 2 + (h)) * HTB)
#define PG8_STAGE(bufoff, gbase, voff) do { _Pragma("unroll") for (int _i = 0; _i < 2; ++_i) \
        __builtin_amdgcn_global_load_lds((const unsigned*)((const char*)(gbase) + (voff)[_i]), (PG8_LAS unsigned*)(lds + (bufoff) + ldsw + _i * 8192), 16, 0, 0); } while (0)
#define PG8_LDA(dst, b, h) do { _Pragma("unroll") for (int m = 0; m < 4; ++m) _Pragma("unroll") for (int k = 0; k < 2; ++k) dst[m][k] = *(const PG8_LAS bf16x8*)(lds + PG8_SA(b, h) + aoffk[k] + m * 2048); } while (0)
#define PG8_LDB(dst, b, h) do { _Pragma("unroll") for (int n = 0; n < 2; ++n) _Pragma("unroll") for (int k = 0; k < 2; ++k) dst[n][k] = *(const PG8_LAS bf16x8*)(lds + PG8_SB(b, h) + boffk[k] + n * 2048); } while (0)
#define PG8_MMA(ai, bj, At, Bt) do { __builtin_amdgcn_s_setprio(1); _Pragma("unroll") for (int m = 0; m < 4; ++m) _Pragma("unroll") for (int n = 0; n < 2; ++n) { \
        if constexpr (F8) { mfma_f8(acc[ai][bj][m][n], Bt[n][0], Bt[n][1], At[m][0], At[m][1], SCALE_W, 0x7f7f7f7f); } \
        else if constexpr (I8) { typedef int i32x4_ __attribute__((ext_vector_type(4))); _Pragma("unroll") for (int k = 0; k < 2; ++k) acc[ai][bj][m][n] = __builtin_bit_cast(f32x4, __builtin_amdgcn_mfma_i32_16x16x64_i8(__builtin_bit_cast(i32x4_, Bt[n][k]), __builtin_bit_cast(i32x4_, At[m][k]), __builtin_bit_cast(i32x4_, acc[ai][bj][m][n]), 0, 0, 0)); } \
        else { _Pragma("unroll") for (int k = 0; k < 2; ++k) acc[ai][bj][m][n] = __builtin_amdgcn_mfma_f32_16x16x32_bf16(Bt[n][k], At[m][k], acc[ai][bj][m][n], 0, 0, 0); } } \
        __builtin_amdgcn_s_setprio(0); } while (0)
#define PG8_WAIT_V(n) asm volatile("s_waitcnt vmcnt(" #n ")" ::: "memory")
#define PG8_WAIT_L(n) asm volatile("s_waitcnt lgkmcnt(" #n ")" ::: "memory")
#define PG8_BAR __builtin_amdgcn_s_barrier()
#define PG8_SCHED __builtin_amdgcn_sched_barrier(0)
    Unit cur, nxt; int ui = 0;
    if (!S.next(0, cur)) return;
    f32x4 acc[2][2][4][2];
#pragma unroll
    for (int a = 0; a < 2; ++a)
#pragma unroll
        for (int b = 0; b < 2; ++b)
#pragma unroll
            for (int m = 0; m < 4; ++m)
#pragma unroll
                for (int n = 0; n < 2; ++n) acc[a][b][m][n] = (f32x4){0.f, 0.f, 0.f, 0.f};
    bf16x8 At[4][2], B0[2][2], B1[2][2];
    const char* cA = (const char*)g.A + (size_t)cur.pm * tstep; const char* cB = (const char*)g.Bt + (size_t)cur.pn * tstep;
    S.a_ready(cur);
    if constexpr (SP2) {
        PG8_STAGE(PG8_SB(0, 0), cB, voffB); PG8_STAGE(PG8_SB(0, 1), cB + hstep, voffB); PG8_STAGE(PG8_SA(0, 0), cA, voffA); PG8_STAGE(PG8_SA(0, 1), cA + hstep, voffA);
        if (wr == 1) PG8_BAR;
        PG8_WAIT_V(2); PG8_BAR;
        PG8_STAGE(PG8_SB(1, 0), cB + kstep, voffB); PG8_STAGE(PG8_SA(1, 0), cA + kstep, voffA); PG8_STAGE(PG8_SB(1, 1), cB + hstep + kstep, voffB);
        PG8_WAIT_V(6); PG8_BAR;
    } else {
        PG8_STAGE(PG8_SB(0, 0), cB, voffB); PG8_STAGE(PG8_SA(0, 0), cA, voffA); PG8_STAGE(PG8_SB(0, 1), cB + hstep, voffB); PG8_STAGE(PG8_SA(0, 1), cA + hstep, voffA);
        if (wr == 1) PG8_BAR;
        PG8_WAIT_V(4); PG8_BAR;
        PG8_STAGE(PG8_SB(1, 0), cB + kstep, voffB); PG8_STAGE(PG8_SA(1, 0), cA + kstep, voffA); PG8_STAGE(PG8_SB(1, 1), cB + hstep + kstep, voffB);
        PG8_WAIT_V(6); PG8_BAR;
    }
    for (;;) {
        const bool has_next = S.next(ui + 1, nxt);
        const char* nA = has_next ? (const char*)g.A + (size_t)nxt.pm * tstep : cA; const char* nB = has_next ? (const char*)g.Bt + (size_t)nxt.pn * tstep : cB;
        for (int t = 0; t < nt; t += 2) {
            const bool last = (t == nt - 2);
            const char* a1 = cA + (size_t)(t + 1) * kstep;
            const char* a2 = last ? nA : cA + (size_t)(t + 2) * kstep; const char* b2 = last ? nB : cB + (size_t)(t + 2) * kstep;
            const char* a3 = a2 + kstep; const char* b3 = b2 + kstep;
            if (last && has_next) S.a_ready(nxt);
            if constexpr (SP2) {
            PG8_LDB(B0, 0, 0); PG8_LDB(B1, 0, 1); PG8_SCHED; PG8_LDA(At, 0, 0); PG8_STAGE(PG8_SA(1, 1), a1 + hstep, voffA);
            PG8_WAIT_V(8); PG8_WAIT_L(0); PG8_BAR; PG8_MMA(0, 0, At, B0); PG8_MMA(0, 1, At, B1); PG8_BAR; PG8_SCHED;
            PG8_LDA(At, 0, 1); PG8_STAGE(PG8_SB(0, 0), b2, voffB); PG8_STAGE(PG8_SB(0, 1), b2 + hstep, voffB); PG8_STAGE(PG8_SA(0, 0), a2, voffA);
            PG8_WAIT_V(8); PG8_WAIT_L(0); PG8_BAR; PG8_MMA(1, 0, At, B0); PG8_MMA(1, 1, At, B1); PG8_BAR; PG8_SCHED;
            PG8_LDB(B0, 1, 0); PG8_LDB(B1, 1, 1); PG8_SCHED; PG8_LDA(At, 1, 0); PG8_STAGE(PG8_SA(0, 1), a2 + hstep, voffA);
            PG8_WAIT_V(8); PG8_WAIT_L(0); PG8_BAR; PG8_MMA(0, 0, At, B0); PG8_MMA(0, 1, At, B1); PG8_BAR; PG8_SCHED;
            PG8_LDA(At, 1, 1); PG8_STAGE(PG8_SB(1, 0), b3, voffB); PG8_STAGE(PG8_SB(1, 1), b3 + hstep, voffB); PG8_STAGE(PG8_SA(1, 0), a3, voffA);
            PG8_WAIT_V(8); PG8_WAIT_L(0); PG8_BAR; PG8_MMA(1, 0, At, B0); PG8_MMA(1, 1, At, B1); PG8_BAR; PG8_SCHED;
            } else {
            PG8_LDB(B0, 0, 0); PG8_SCHED; PG8_LDA(At, 0, 0); PG8_STAGE(PG8_SA(1, 1), a1 + hstep, voffA);
            PG8_WAIT_L(8); PG8_BAR; PG8_WAIT_L(0); PG8_MMA(0, 0, At, B0); PG8_BAR; PG8_SCHED;
            PG8_LDB(B1, 0, 1); PG8_STAGE(PG8_SB(0, 0), b2, voffB);
            PG8_BAR; PG8_WAIT_L(0); PG8_MMA(0, 1, At, B1); PG8_BAR;
            PG8_LDA(At, 0, 1); PG8_STAGE(PG8_SA(0, 0), a2, voffA);
            PG8_BAR; PG8_WAIT_L(0); PG8_MMA(1, 0, At, B0); PG8_BAR; PG8_SCHED;
            PG8_STAGE(PG8_SB(0, 1), b2 + hstep, voffB);
            PG8_WAIT_V(6); PG8_BAR; PG8_MMA(1, 1, At, B1); PG8_BAR;
            PG8_LDB(B0, 1, 0); PG8_SCHED; PG8_LDA(At, 1, 0); PG8_STAGE(PG8_SA(0, 1), a2 + hstep, voffA);
            PG8_WAIT_L(8); PG8_BAR; PG8_WAIT_L(0); PG8_MMA(0, 0, At, B0); PG8_BAR; PG8_SCHED;
            PG8_LDB(B1, 1, 1); PG8_STAGE(PG8_SB(1, 0), b3, voffB);
            PG8_BAR; PG8_WAIT_L(0); PG8_MMA(0, 1, At, B1); PG8_BAR;
            PG8_LDA(At, 1, 1); PG8_STAGE(PG8_SA(1, 0), a3, voffA);
            PG8_BAR; PG8_WAIT_L(0); PG8_MMA(1, 0, At, B0); PG8_BAR; PG8_SCHED;
            PG8_STAGE(PG8_SB(1, 1), b3 + hstep, voffB);
            PG8_WAIT_V(6); PG8_BAR; PG8_MMA(1, 1, At, B1); PG8_BAR;
            }
        }
        if constexpr (ALIGN_EPI) { if (wr == 0) PG8_BAR; }
        if constexpr (I8) {
#pragma unroll
            for (int a_ = 0; a_ < 2; ++a_)
#pragma unroll
                for (int b_ = 0; b_ < 2; ++b_)
#pragma unroll
                    for (int m_ = 0; m_ < 4; ++m_)
#pragma unroll
                        for (int n_ = 0; n_ < 2; ++n_)
#pragma unroll
                            for (int e_ = 0; e_ < 4; ++e_) acc[a_][b_][m_][n_][e_] = (float)__float_as_int(acc[a_][b_][m_][n_][e_]); }
        if constexpr (F8) asm volatile("s_nop 15\n\ts_nop 15" ::: "memory");
        if constexpr (!Epi::AFTER_DRAIN) { E(acc, cur, wr, wc, fr, fq); S.done(cur); }
        if (!has_next) break;
#pragma unroll
        for (int a = 0; a < 2; ++a)
#pragma unroll
            for (int b = 0; b < 2; ++b)
#pragma unroll
                for (int m = 0; m < 4; ++m)
#pragma unroll
                    for (int n = 0; n < 2; ++n) acc[a][b][m][n] = (f32x4){0.f, 0.f, 0.f, 0.f};
        cur = nxt; cA = nA; cB = nB; ++ui;
        if constexpr (ALIGN_EPI) { if (wr == 1) PG8_BAR; }
    }
    PG8_WAIT_V(0);
    if constexpr (!ALIGN_EPI) { if (wr == 0) PG8_BAR; }
    PG8_BAR;
    if constexpr (Epi::AFTER_DRAIN) { E.fused(acc, cur, wr, wc, fr, fq, lds, wid, lane); S.done(cur); }
#undef PG8_SA
#undef PG8_SB
#undef PG8_STAGE
#undef PG8_LDA
#undef PG8_LDB
#undef PG8_MMA
#undef PG8_WAIT_V
#undef PG8_WAIT_L
#undef PG8_BAR
#undef PG8_SCHED
}
}

namespace pg8 {
struct EpiStoreBf16 {
    static constexpr bool PERM = true, AFTER_DRAIN = false;
    bf16_t* O; int ldc, pad;
    __device__ __forceinline__ void operator()(const f32x4 (&acc)[2][2][4][2], const Unit& u, int wr, int wc, int fr, int fq) const {
        const int row0 = u.pm * BM + wr * 64 + fr, col0 = u.pn * BM + wc * 32 + 8 * fq;
#pragma unroll
        for (int ai = 0; ai < 2; ++ai)
#pragma unroll
            for (int m = 0; m < 4; ++m) { bf16_t* rowp = O + (size_t)(row0 + ai * HALF + m * 16) * ldc + col0;
#pragma unroll
                for (int bj = 0; bj < 2; ++bj) { const f32x4 v0 = acc[ai][bj][m][0], v1 = acc[ai][bj][m][1];
                    u32x4 w; w.x = cvt_pk_bf16(v0[0], v0[1]); w.y = cvt_pk_bf16(v0[2], v0[3]); w.z = cvt_pk_bf16(v1[0], v1[1]); w.w = cvt_pk_bf16(v1[2], v1[3]);
                    *(u32x4*)(rowp + bj * HALF) = w; } }
    }
};
struct EpiResF32 {
    static constexpr bool PERM = false, AFTER_DRAIN = false;
    const float* base; float* out; int ldc, pad;
    __device__ __forceinline__ void operator()(const f32x4 (&acc)[2][2][4][2], const Unit& u, int wr, int wc, int fr, int fq) const {
        const int row0 = u.pm * BM + wr * 64 + fr, col0 = u.pn * BM + wc * 32 + 4 * fq;
#pragma unroll
        for (int ai = 0; ai < 2; ++ai)
#pragma unroll
            for (int m = 0; m < 4; ++m) { const size_t off = (size_t)(row0 + ai * HALF + m * 16) * ldc + col0;
#pragma unroll
                for (int bj = 0; bj < 2; ++bj)
#pragma unroll
                    for (int n = 0; n < 2; ++n) { const f32x4 b = *(const f32x4*)(base + off + bj * HALF + n * 16); *(f32x4*)(out + off + bj * HALF + n * 16) = b + acc[ai][bj][m][n]; } }
    }
};
struct EpiSwiGLU {
    static constexpr bool PERM = true, AFTER_DRAIN = false;
    bf16_t* O; int ldc, pad;
    __device__ __forceinline__ void operator()(const f32x4 (&acc)[2][2][4][2], const Unit& u, int wr, int wc, int fr, int fq) const {
        const int row0 = u.pm * BM + wr * 64 + fr, col0 = u.pn * HALF + wc * 32 + 8 * fq;
#pragma unroll
        for (int ai = 0; ai < 2; ++ai)
#pragma unroll
            for (int m = 0; m < 4; ++m) { bf16_t* rowp = O + (size_t)(row0 + ai * HALF + m * 16) * ldc + col0;
                float r[8];
#pragma unroll
                for (int n = 0; n < 2; ++n)
#pragma unroll
                    for (int e = 0; e < 4; ++e) { const float g = acc[ai][0][m][n][e], up = acc[ai][1][m][n][e]; r[n * 4 + e] = g * up / (1.0f + __expf(-g)); }
                u32x4 w; w.x = cvt_pk_bf16(r[0], r[1]); w.y = cvt_pk_bf16(r[2], r[3]); w.z = cvt_pk_bf16(r[4], r[5]); w.w = cvt_pk_bf16(r[6], r[7]);
                *(u32x4*)rowp = w; }
    }
};
}

namespace pg8 {
struct EpiInProj {
    static constexpr bool PERM = true, AFTER_DRAIN = false;
    bf16_t* O; const float* cs; float* kmean;
    __device__ __forceinline__ void operator()(const f32x4 (&acc)[2][2][4][2], const Unit& u, int wr, int wc, int fr, int fq) const {
        const int row0 = u.pm * BM + wr * 64 + fr;
        if (u.pn >= 8) {
            const int col0 = u.pn * BM + wc * 32 + 8 * fq;
#pragma unroll
            for (int ai = 0; ai < 2; ++ai)
#pragma unroll
                for (int m = 0; m < 4; ++m) { bf16_t* rowp = O + (size_t)(row0 + ai * HALF + m * 16) * 6144 + col0;
#pragma unroll
                    for (int bj = 0; bj < 2; ++bj) { const f32x4 v0 = acc[ai][bj][m][0], v1 = acc[ai][bj][m][1];
                        u32x4 w; w.x = cvt_pk_bf16(v0[0], v0[1]); w.y = cvt_pk_bf16(v0[2], v0[3]); w.z = cvt_pk_bf16(v1[0], v1[1]); w.w = cvt_pk_bf16(v1[2], v1[3]);
                        *(u32x4*)(rowp + bj * HALF) = w; } }
        } else {
            const int sec = u.pn >> 2, head = 2 * (u.pn & 3) + (wc >> 1), d0 = (wc & 1) * 32 + 8 * fq;
            bf16_t* obase = O + sec * 1024 + head * 128 + d0;
            float csum[16];
#pragma unroll
            for (int i = 0; i < 16; ++i) csum[i] = 0.f;
#pragma unroll
            for (int ai = 0; ai < 2; ++ai)
#pragma unroll
                for (int m = 0; m < 4; ++m) { const int row = row0 + ai * HALF + m * 16;
                    const f32x4* cp = (const f32x4*)(cs + ((size_t)row * 64 + d0) * 2);
                    float ol[8], oh[8];
#pragma unroll
                    for (int n = 0; n < 2; ++n) { const f32x4 t0 = cp[2 * n], t1 = cp[2 * n + 1]; const f32x4 lo = acc[ai][0][m][n], hi = acc[ai][1][m][n];
                        ol[4 * n + 0] = lo[0] * t0[0] - hi[0] * t0[1]; oh[4 * n + 0] = hi[0] * t0[0] + lo[0] * t0[1];
                        ol[4 * n + 1] = lo[1] * t0[2] - hi[1] * t0[3]; oh[4 * n + 1] = hi[1] * t0[2] + lo[1] * t0[3];
                        ol[4 * n + 2] = lo[2] * t1[0] - hi[2] * t1[1]; oh[4 * n + 2] = hi[2] * t1[0] + lo[2] * t1[1];
                        ol[4 * n + 3] = lo[3] * t1[2] - hi[3] * t1[3]; oh[4 * n + 3] = hi[3] * t1[2] + lo[3] * t1[3]; }
                    u32x4 w; w.x = cvt_pk_bf16(ol[0], ol[1]); w.y = cvt_pk_bf16(ol[2], ol[3]); w.z = cvt_pk_bf16(ol[4], ol[5]); w.w = cvt_pk_bf16(ol[6], ol[7]);
                    *(u32x4*)(obase + (size_t)row * 6144) = w;
                    w.x = cvt_pk_bf16(oh[0], oh[1]); w.y = cvt_pk_bf16(oh[2], oh[3]); w.z = cvt_pk_bf16(oh[4], oh[5]); w.w = cvt_pk_bf16(oh[6], oh[7]);
                    *(u32x4*)(obase + (size_t)row * 6144 + 64) = w;
                    if (sec == 1) {
#pragma unroll
                        for (int i = 0; i < 8; ++i) { csum[i] += ol[i]; csum[8 + i] += oh[i]; } } }
            if (sec == 1) {
                float* km = kmean + (size_t)(((u.pm >> 4) * 8 + head) * 16 + (u.pm & 15)) * 128 + d0;
#pragma unroll
                for (int i = 0; i < 16; ++i) { float v = csum[i]; v += __shfl_xor(v, 1); v += __shfl_xor(v, 2); v += __shfl_xor(v, 4); v += __shfl_xor(v, 8);
                    if (fr == 0) atomicAdd(km + (i & 7) + (i >> 3) * 64, v * (1.f / 256.f)); }
            }
        }
    }
};
struct EpiScaledBf16 {
    static constexpr bool PERM = true, AFTER_DRAIN = false;
    bf16_t* O; const float* ra; const float* cw; int ldc, pad;
    __device__ __forceinline__ void operator()(const f32x4 (&acc)[2][2][4][2], const Unit& u, int wr, int wc, int fr, int fq) const {
        const int row0 = u.pm * BM + wr * 64 + fr, col0 = u.pn * BM + wc * 32 + 8 * fq;
        f32x4 cs_[2][2];
#pragma unroll
        for (int bj = 0; bj < 2; ++bj)
#pragma unroll
            for (int n = 0; n < 2; ++n) cs_[bj][n] = *(const f32x4*)(cw + col0 + bj * HALF + 4 * n) * (1.f / (127.f * 127.f));
#pragma unroll
        for (int ai = 0; ai < 2; ++ai)
#pragma unroll
            for (int m = 0; m < 4; ++m) { const int row = row0 + ai * HALF + m * 16; const float rs = ra[row]; bf16_t* rowp = O + (size_t)row * ldc + col0;
#pragma unroll
                for (int bj = 0; bj < 2; ++bj) { const f32x4 v0 = acc[ai][bj][m][0] * cs_[bj][0] * rs, v1 = acc[ai][bj][m][1] * cs_[bj][1] * rs;
                    u32x4 w; w.x = cvt_pk_bf16(v0[0], v0[1]); w.y = cvt_pk_bf16(v0[2], v0[3]); w.z = cvt_pk_bf16(v1[0], v1[1]); w.w = cvt_pk_bf16(v1[2], v1[3]);
                    *(u32x4*)(rowp + bj * HALF) = w; } }
    }
};
__device__ __forceinline__ float row_rinv(const float* ss, int row, int fq) {
    const f32x4* p = (const f32x4*)(ss + (size_t)row * 32 + fq * 8); const f32x4 a = p[0], b = p[1];
    float s = ((a[0] + a[1]) + (a[2] + a[3])) + ((b[0] + b[1]) + (b[2] + b[3]));
    s += __shfl_xor(s, 16); s += __shfl_xor(s, 32);
    return rsqrtf(s * (1.f / 2048.f) + 1e-6f);
}
template <bool BASE_F32, bool OUT_F8> struct EpiRes {
    static constexpr bool PERM = true, AFTER_DRAIN = false;
    const void* base; bf16_t* outb; unsigned char* out8; float* ss;
    __device__ __forceinline__ void operator()(const f32x4 (&acc)[2][2][4][2], const Unit& u, int wr, int wc, int fr, int fq) const {
        const int row0 = u.pm * BM + wr * 64 + fr, col0 = u.pn * BM + wc * 32 + 8 * fq;
#pragma unroll
        for (int ai = 0; ai < 2; ++ai)
#pragma unroll
            for (int m = 0; m < 4; ++m) { const int row = row0 + ai * HALF + m * 16; const size_t off = (size_t)row * 2048 + col0; float s = 0.f;
#pragma unroll
                for (int bj = 0; bj < 2; ++bj) { f32x4 v0, v1;
                    if (BASE_F32) { v0 = *(const f32x4*)((const float*)base + off + bj * HALF); v1 = *(const f32x4*)((const float*)base + off + bj * HALF + 4); }
                    else { const u32x4 bb = *(const u32x4*)((const bf16_t*)base + off + bj * HALF);
                        v0 = (f32x4){__uint_as_float(bb.x << 16), __uint_as_float(bb.x & 0xffff0000u), __uint_as_float(bb.y << 16), __uint_as_float(bb.y & 0xffff0000u)};
                        v1 = (f32x4){__uint_as_float(bb.z << 16), __uint_as_float(bb.z & 0xffff0000u), __uint_as_float(bb.w << 16), __uint_as_float(bb.w & 0xffff0000u)}; }
                    v0 = v0 + acc[ai][bj][m][0]; v1 = v1 + acc[ai][bj][m][1];
                    s += ((v0[0] * v0[0] + v0[1] * v0[1]) + (v0[2] * v0[2] + v0[3] * v0[3])) + ((v1[0] * v1[0] + v1[1] * v1[1]) + (v1[2] * v1[2] + v1[3] * v1[3]));
                    { u32x4 w; w.x = cvt_pk_bf16(v0[0], v0[1]); w.y = cvt_pk_bf16(v0[2], v0[3]); w.z = cvt_pk_bf16(v1[0], v1[1]); w.w = cvt_pk_bf16(v1[2], v1[3]);
                      *(u32x4*)(outb + off + bj * HALF) = w; }
                    if (OUT_F8) { typedef unsigned u32x2_ __attribute__((ext_vector_type(2))); u32x2_ w; w.x = pk4_fp8(v0[0], v0[1], v0[2], v0[3]); w.y = pk4_fp8(v1[0], v1[1], v1[2], v1[3]);
                        *(u32x2_*)(out8 + off + bj * HALF) = w; } }
                s += __shfl_xor(s, 16); s += __shfl_xor(s, 32);
                if (fq == 0) ss[(size_t)row * 32 + u.pn * 4 + wc] = s; }
    }
};
struct EpiRowScaleBf16 {
    static constexpr bool PERM = true, AFTER_DRAIN = false;
    bf16_t* O; const float* ss; int ldc, pad;
    __device__ __forceinline__ void operator()(const f32x4 (&acc)[2][2][4][2], const Unit& u, int wr, int wc, int fr, int fq) const {
        const int row0 = u.pm * BM + wr * 64 + fr, col0 = u.pn * BM + wc * 32 + 8 * fq;
#pragma unroll
        for (int ai = 0; ai < 2; ++ai)
#pragma unroll
            for (int m = 0; m < 4; ++m) { const int row = row0 + ai * HALF + m * 16; const float ri = row_rinv(ss, row, fq); bf16_t* rowp = O + (size_t)row * ldc + col0;
#pragma unroll
                for (int bj = 0; bj < 2; ++bj) { const f32x4 v0 = acc[ai][bj][m][0] * ri, v1 = acc[ai][bj][m][1] * ri;
                    u32x4 w; w.x = cvt_pk_bf16(v0[0], v0[1]); w.y = cvt_pk_bf16(v0[2], v0[3]); w.z = cvt_pk_bf16(v1[0], v1[1]); w.w = cvt_pk_bf16(v1[2], v1[3]);
                    *(u32x4*)(rowp + bj * HALF) = w; } }
    }
};
template <bool F8OUT> struct EpiSwiGLUNorm {
    static constexpr bool PERM = true, AFTER_DRAIN = false;
    bf16_t* O; const float* ss; int ldc, pad;
    __device__ __forceinline__ void operator()(const f32x4 (&acc)[2][2][4][2], const Unit& u, int wr, int wc, int fr, int fq) const {
        const int row0 = u.pm * BM + wr * 64 + fr, col0 = u.pn * HALF + wc * 32 + 8 * fq;
#pragma unroll
        for (int ai = 0; ai < 2; ++ai)
#pragma unroll
            for (int m = 0; m < 4; ++m) { const int row = row0 + ai * HALF + m * 16; const float ri = row_rinv(ss, row, fq); bf16_t* rowp = O + (size_t)row * ldc + col0;
                float r[8];
#pragma unroll
                for (int n = 0; n < 2; ++n)
#pragma unroll
                    for (int e = 0; e < 4; ++e) { const float g = acc[ai][0][m][n][e] * ri, up = acc[ai][1][m][n][e] * ri; r[n * 4 + e] = (g * up) * __builtin_amdgcn_rcpf(1.0f + __builtin_amdgcn_exp2f(g * -1.4426950408889634f)); }
                if (F8OUT) { typedef unsigned u32x2_ __attribute__((ext_vector_type(2))); u32x2_ w; w.x = pk4_fp8(r[0], r[1], r[2], r[3]); w.y = pk4_fp8(r[4], r[5], r[6], r[7]);
                    *(u32x2_*)((unsigned char*)O + (size_t)row * ldc + col0) = w; }
                else { u32x4 w; w.x = cvt_pk_bf16(r[0], r[1]); w.y = cvt_pk_bf16(r[2], r[3]); w.z = cvt_pk_bf16(r[4], r[5]); w.w = cvt_pk_bf16(r[6], r[7]);
                    *(u32x4*)rowp = w; } }
    }
};
}
typedef unsigned short bf16_t;
constexpr int DM = 2048, NB = 4, SEQ = 4096, MT = NB * SEQ;
constexpr int HD = 128, NH = 8, AW = 1024, CW = 1024, NPROJ = 6144;
constexpr int NBLK = 16, MBLK = 256;
constexpr int NMEM = 256, XH = 4, XW = 512, DFF = 5632;
constexpr float EPS = 1e-6f;
constexpr float SM_SCALE = 0.088388347648318440f;
constexpr size_t MiB = 1u << 20;
constexpr size_t WS_WIN = 0;
constexpr size_t WS_WOUT = 24 * MiB;
constexpr size_t WS_WXQ = 32 * MiB;
constexpr size_t WS_WXKV = 34 * MiB;
constexpr size_t WS_WXO = 38 * MiB;
constexpr size_t WS_WGU = 40 * MiB;
constexpr size_t WS_WDN = 84 * MiB;
constexpr size_t WS_H = 112 * MiB;
constexpr size_t WS_MRG = 176 * MiB;
constexpr size_t WS_PROJ = 240 * MiB;
constexpr size_t WS_ACT = 240 * MiB;
constexpr size_t WS_H8 = 208 * MiB;
constexpr size_t WS_X8 = 330 * MiB;
constexpr size_t WS_QX = 432 * MiB;
constexpr size_t WS_OX = 448 * MiB;
constexpr size_t WS_KVX = 464 * MiB;
constexpr size_t WS_MEMN = 466 * MiB;
constexpr size_t WS_CS = 470 * MiB;
constexpr size_t WS_KMEAN = 478 * MiB;
constexpr size_t WS_SS = 479 * MiB;
constexpr size_t WS_RMAX = 486 * MiB;
constexpr size_t WS_BAR = 485 * MiB;
constexpr size_t WS_CMAX = 485 * MiB + 16384;
constexpr size_t WS_END = 487 * MiB;

__device__ __forceinline__ float bf2f(unsigned v) { return __uint_as_float(v << 16); }
__device__ __forceinline__ unsigned f2bf(float f) { unsigned u = __float_as_uint(f); return (u + 0x7fffu + ((u >> 16) & 1u)) >> 16; }
__device__ __forceinline__ unsigned pk2(float lo, float hi) { return f2bf(lo) | (f2bf(hi) << 16); }
__device__ __forceinline__ float wave_sum(float v) {
#pragma unroll
    for (int o = 1; o < 64; o <<= 1) v += __shfl_xor(v, o);
    return v;
}
__device__ __forceinline__ float wave_max(float v) {
#pragma unroll
    for (int o = 1; o < 64; o <<= 1) v = fmaxf(v, __shfl_xor(v, o));
    return v;
}
typedef float f32x4 __attribute__((ext_vector_type(4)));
typedef unsigned u32x4 __attribute__((ext_vector_type(4)));
typedef unsigned u32x2 __attribute__((ext_vector_type(2)));

struct TJob { const float* src0; const float* src1; const float* gain; bf16_t* dst; int K, Nsrc, nrows, mode; float wscale; int f8; const float* colmax; };
struct TItem { const float* src; int c0, k0, n0; };
__device__ __forceinline__ TItem transpose_locate(const TJob& J, int item) {
    TItem t; const int nblk = J.nrows / 32, kb = item / nblk, nb = item % nblk; t.k0 = 64 * kb; t.n0 = 32 * nb; t.src = J.src0; t.c0 = t.n0;
    if (J.mode == 1 && t.n0 < 2048) { const int tile = t.n0 >> 8, c = t.n0 & 255, cc = c & 127; t.c0 = (tile >> 2) * 1024 + (2 * (tile & 3) + (cc >> 6)) * 128 + (cc & 63) + ((c >> 7) ? 64 : 0); }
    if (J.mode == 2) { const int tile = t.n0 >> 8, w = t.n0 & 255; if (w < 128) { t.c0 = tile * 128 + w; } else { t.src = J.src1; t.c0 = tile * 128 + w - 128; } }
    return t;
}
__device__ __forceinline__ void transpose_load(const TJob& J, const TItem& t, f32x4 (&ld)[8], int lane) {
#pragma unroll
    for (int i = 0; i < 8; ++i) ld[i] = *(const f32x4*)(t.src + (size_t)(t.k0 + 8 * i + (lane >> 3)) * J.Nsrc + t.c0 + 4 * (lane & 7));
}
__device__ __forceinline__ void transpose_store(const TJob& J, const TItem& t, const f32x4 (&ld)[8], float* scr, int lane) {
    const int k0 = t.k0, n0 = t.n0;
#pragma unroll
    for (int i = 0; i < 8; ++i) { const int kk = 8 * i + (lane >> 3); float gsc = J.wscale; if (J.gain) gsc *= J.gain[k0 + kk];
#pragma unroll
        for (int e = 0; e < 4; ++e) scr[kk * 33 + 4 * (lane & 7) + e] = ld[i][e] * gsc; }
    asm volatile("s_waitcnt lgkmcnt(0)" ::: "memory");
    const int c = lane & 7;
#pragma unroll
    for (int j = 0; j < 4; ++j) { const int n = (lane >> 3) + 8 * j; const float* s = scr + (8 * c) * 33 + n;
        if (J.f8 == 2) { const float cm = J.colmax[n0 + n], qs = cm > 0.f ? 127.f / cm : 0.f; unsigned q[8];
#pragma unroll
            for (int e = 0; e < 8; ++e) q[e] = (unsigned)((int)__builtin_rintf(__builtin_amdgcn_fmed3f(s[e * 33] * qs, -127.f, 127.f))) & 0xffu;
            u32x2 o; o.x = q[0] | (q[1] << 8) | (q[2] << 16) | (q[3] << 24); o.y = q[4] | (q[5] << 8) | (q[6] << 16) | (q[7] << 24);
            *(u32x2*)((unsigned char*)J.dst + (size_t)(n0 + n) * J.K + k0 + 8 * c) = o; }
        else if (J.f8) { u32x2 o; o.x = pg8::pk4_fp8(s[0 * 33], s[1 * 33], s[2 * 33], s[3 * 33]); o.y = pg8::pk4_fp8(s[4 * 33], s[5 * 33], s[6 * 33], s[7 * 33]);
            *(u32x2*)((unsigned char*)J.dst + (size_t)(n0 + n) * J.K + k0 + 8 * c) = o; }
        else { u32x4 o; o.x = pk2(s[0 * 33], s[1 * 33]); o.y = pk2(s[2 * 33], s[3 * 33]); o.z = pk2(s[4 * 33], s[5 * 33]); o.w = pk2(s[6 * 33], s[7 * 33]);
            *(u32x4*)(J.dst + (size_t)(n0 + n) * J.K + k0 + 8 * c) = o; } }
    asm volatile("s_waitcnt lgkmcnt(0)" ::: "memory");
}
__device__ __forceinline__ void ph_colmax(const float* W, int K, int Nsrc, int ncols, float* cmax, int gw, int NGW, int lane) {
    const int nstrip = ncols / 256, nitems = (K / 64) * nstrip;
    for (int it = gw; it < nitems; it += NGW) { const int kb = it / nstrip, sb = it % nstrip; const float* p = W + (size_t)(kb * 64) * Nsrc + sb * 256 + lane * 4;
        f32x4 mx = {0.f, 0.f, 0.f, 0.f};
#pragma unroll 8
        for (int r = 0; r < 64; ++r) { const f32x4 v = *(const f32x4*)(p + (size_t)r * Nsrc); mx[0] = fmaxf(mx[0], fabsf(v[0])); mx[1] = fmaxf(mx[1], fabsf(v[1])); mx[2] = fmaxf(mx[2], fabsf(v[2])); mx[3] = fmaxf(mx[3], fabsf(v[3])); }
#pragma unroll
        for (int e = 0; e < 4; ++e) atomicMax((unsigned*)cmax + sb * 256 + lane * 4 + e, __float_as_uint(mx[e])); }
}
__device__ __forceinline__ int ph_transpose_job(const TJob J, int base, float* scr, int gw, int NGW, int lane) {
    const int nitems = (J.K / 64) * (J.nrows / 32);
    const int first = (gw - base % NGW + NGW) % NGW;
    for (int it = first; it < nitems; it += 2 * NGW) {
        const TItem t0 = transpose_locate(J, it); f32x4 l0[8], l1[8]; transpose_load(J, t0, l0, lane);
        const bool two = it + NGW < nitems; const TItem t1 = transpose_locate(J, two ? it + NGW : it);
        if (two) transpose_load(J, t1, l1, lane);
        transpose_store(J, t0, l0, scr, lane);
        if (two) transpose_store(J, t1, l1, scr, lane);
    }
    return base + nitems;
}

__device__ __forceinline__ void rms_row_bf16(const float* xrow, const float* g, bf16_t* orow, int lane) {
    const f32x4* xr = (const f32x4*)xrow + lane; const f32x4* gr = (const f32x4*)g + lane;
    f32x4 v[8]; float s = 0.f;
#pragma unroll
    for (int j = 0; j < 8; ++j) { v[j] = xr[64 * j]; s += (v[j].x * v[j].x + v[j].y * v[j].y) + (v[j].z * v[j].z + v[j].w * v[j].w); }
    const float rinv = rsqrtf(wave_sum(s) * (1.f / DM) + EPS);
    u32x2* o8 = (u32x2*)orow + lane;
#pragma unroll
    for (int j = 0; j < 8; ++j) { const f32x4 gg = gr[64 * j]; u32x2 w; w.x = pk2(v[j].x * rinv * gg.x, v[j].y * rinv * gg.y); w.y = pk2(v[j].z * rinv * gg.z, v[j].w * rinv * gg.w); o8[64 * j] = w; }
}
__device__ __forceinline__ void ph_rms_bf16(const float* X, const float* g, bf16_t* O, unsigned char* O8, float* rmax, int rows, int gw, int NGW, int lane) {
    f32x4 v[8], nx[8];
    int r = gw;
    if (r < rows) {
#pragma unroll
        for (int j = 0; j < 8; ++j) v[j] = ((const f32x4*)(X + (size_t)r * DM) + lane)[64 * j]; }
    for (; r < rows; r += NGW) {
        const int rn = r + NGW;
        if (rn < rows) {
#pragma unroll
            for (int j = 0; j < 8; ++j) nx[j] = ((const f32x4*)(X + (size_t)rn * DM) + lane)[64 * j]; }
        float s = 0.f;
#pragma unroll
        for (int j = 0; j < 8; ++j) s += (v[j].x * v[j].x + v[j].y * v[j].y) + (v[j].z * v[j].z + v[j].w * v[j].w);
        const float rinv = rsqrtf(wave_sum(s) * (1.f / DM) + EPS);
        u32x2* o8 = (u32x2*)(O + (size_t)r * DM) + lane; const f32x4* gr = (const f32x4*)g + lane;
        float am = 0.f;
#pragma unroll
        for (int j = 0; j < 8; ++j) { const f32x4 gg = gr[64 * j]; v[j] = v[j] * rinv * gg; u32x2 w; w.x = pk2(v[j].x, v[j].y); w.y = pk2(v[j].z, v[j].w); o8[64 * j] = w;
            am = fmaxf(fmaxf(am, fmaxf(fabsf(v[j].x), fabsf(v[j].y))), fmaxf(fabsf(v[j].z), fabsf(v[j].w))); }
        if (O8) { am = wave_max(am); const float qs = am > 0.f ? 127.f / am : 0.f; if (lane == 0) rmax[r] = am;
#pragma unroll
            for (int j = 0; j < 8; ++j) { const unsigned q0 = (unsigned)((int)__builtin_rintf(v[j].x * qs)) & 0xffu, q1 = (unsigned)((int)__builtin_rintf(v[j].y * qs)) & 0xffu, q2 = (unsigned)((int)__builtin_rintf(v[j].z * qs)) & 0xffu, q3 = (unsigned)((int)__builtin_rintf(v[j].w * qs)) & 0xffu;
                ((unsigned*)(O8 + (size_t)r * DM))[64 * j + lane] = q0 | (q1 << 8) | (q2 << 16) | (q3 << 24); } }
#pragma unroll
        for (int j = 0; j < 8; ++j) v[j] = nx[j];
    }
}
__device__ __forceinline__ void ph_final_norm(const bf16_t* X, float* O, const float* g, const float* ss, int rows, int gw, int NGW, int lane) {
    for (int r = gw; r < rows; r += NGW) {
        const u32x4* xr = (const u32x4*)(X + (size_t)r * DM) + lane; f32x4* orow = (f32x4*)(O + (size_t)r * DM); const f32x4* gr = (const f32x4*)g;
        u32x4 v[4];
#pragma unroll
        for (int j = 0; j < 4; ++j) v[j] = xr[64 * j];
        const float part = (lane < 32) ? ss[(size_t)r * 32 + lane] : 0.f;
        const float rinv = rsqrtf(wave_sum(part) * (1.f / DM) + EPS);
#pragma unroll
        for (int j = 0; j < 4; ++j) { const int c4 = 2 * (64 * j + lane);
            const f32x4 lo = {__uint_as_float(v[j].x << 16), __uint_as_float(v[j].x & 0xffff0000u), __uint_as_float(v[j].y << 16), __uint_as_float(v[j].y & 0xffff0000u)};
            const f32x4 hi = {__uint_as_float(v[j].z << 16), __uint_as_float(v[j].z & 0xffff0000u), __uint_as_float(v[j].w << 16), __uint_as_float(v[j].w & 0xffff0000u)};
            orow[c4] = lo * rinv * gr[c4]; orow[c4 + 1] = hi * rinv * gr[c4 + 1]; }
    }
}

__device__ __forceinline__ void sincos_small(double r, double& s, double& c) {
    const double r2 = r * r;
    double a = -1.0 / 10888869450418352160768000000.0;
    a = a * r2 + 1.0 / 15511210043330985984000000.0;
    a = a * r2 - 1.0 / 25852016738884976640000.0;
    a = a * r2 + 1.0 / 51090942171709440000.0;
    a = a * r2 - 1.0 / 121645100408832000.0;
    a = a * r2 + 1.0 / 355687428096000.0;
    a = a * r2 - 1.0 / 1307674368000.0;
    a = a * r2 + 1.0 / 6227020800.0;
    a = a * r2 - 1.0 / 39916800.0;
    a = a * r2 + 1.0 / 362880.0;
    a = a * r2 - 1.0 / 5040.0;
    a = a * r2 + 1.0 / 120.0;
    a = a * r2 - 1.0 / 6.0;
    a = a * r2 + 1.0;
    s = a * r;
    double b = 1.0 / 403291461126605635584000000.0;
    b = b * r2 - 1.0 / 620448401733239439360000.0;
    b = b * r2 + 1.0 / 1124000727777607680000.0;
    b = b * r2 - 1.0 / 2432902008176640000.0;
    b = b * r2 + 1.0 / 6402373705728000.0;
    b = b * r2 - 1.0 / 20922789888000.0;
    b = b * r2 + 1.0 / 87178291200.0;
    b = b * r2 - 1.0 / 479001600.0;
    b = b * r2 + 1.0 / 3628800.0;
    b = b * r2 - 1.0 / 40320.0;
    b = b * r2 + 1.0 / 720.0;
    b = b * r2 - 1.0 / 24.0;
    b = b * r2 + 1.0 / 2.0;
    c = 1.0 - b * r2;
}
__device__ __forceinline__ void cs_entry(const int* pos, float* cs, int idx) {
    const int t = idx >> 6, f = idx & 63;
    double p = 1.0, bs = 0.8659643233600653;
#pragma unroll
    for (int bit = 0; bit < 6; ++bit) { if ((f >> bit) & 1) p *= bs; bs *= bs; }
    const double ang = (double)pos[t] * p;
    const double TWO_PI = 6.283185307179586;
    const double n = rint(ang / TWO_PI);
    const double r = fma(-n, TWO_PI, ang);
    double s, c; sincos_small(r, s, c);
    cs[2 * idx] = (float)c; cs[2 * idx + 1] = (float)s;
}
__device__ __forceinline__ void ph_cs(const int* pos, float* cs, int gtid, int NT) {
    for (int idx = gtid; idx < MT * 64; idx += NT) cs_entry(pos, cs, idx);
}
__device__ __forceinline__ void ph_rope_naive(bf16_t* proj, const float* cs, int gtid, int NT) {
    const long total = (long)MT * 2 * NH * 64;
    for (long i = gtid; i < total; i += NT) {
        const int d = (int)(i & 63), h = (int)((i >> 6) & 7), sec = (int)((i >> 9) & 1); const long t = i >> 10;
        bf16_t* p = proj + t * NPROJ + sec * 1024 + h * HD + d;
        const float a = bf2f(p[0]), b = bf2f(p[64]); const float c = cs[(t * 64 + d) * 2], s = cs[(t * 64 + d) * 2 + 1];
        p[0] = (bf16_t)f2bf(a * c - b * s); p[64] = (bf16_t)f2bf(b * c + a * s);
    }
}
__device__ __forceinline__ void ph_kmean_naive(const bf16_t* proj, float* kmean, int gtid, int NT) {
    for (int i = gtid; i < NB * NH * NBLK * HD; i += NT) {
        const int d = i & 127, blkid = i >> 7;
        const int blk = blkid & 15, h = (blkid >> 4) & 7, b = blkid >> 7;
        float s = 0.f;
        for (int j = 0; j < MBLK; ++j) s += bf2f(proj[(size_t)(b * SEQ + blk * MBLK + j) * NPROJ + 1024 + h * HD + d]);
        kmean[(size_t)blkid * HD + d] = s * (1.f / MBLK);
    }
}
__device__ __forceinline__ float dot_q_row(const float* sq, const bf16_t* krow) {
    float a = 0.f;
#pragma unroll
    for (int d = 0; d < 128; d += 8) { const u32x4 kk = *(const u32x4*)(krow + d);
        a += sq[d + 0] * bf2f(kk.x & 0xffffu) + sq[d + 1] * bf2f(kk.x >> 16) + sq[d + 2] * bf2f(kk.y & 0xffffu) + sq[d + 3] * bf2f(kk.y >> 16)
           + sq[d + 4] * bf2f(kk.z & 0xffffu) + sq[d + 5] * bf2f(kk.z >> 16) + sq[d + 6] * bf2f(kk.w & 0xffffu) + sq[d + 7] * bf2f(kk.w >> 16); }
    return a;
}
__device__ __forceinline__ void ph_moba_naive(const bf16_t* proj, const float* kmean, const float* g_attn, bf16_t* merged, float qscale_inv, float* scr, int gw, int NGW, int lane) {
    float* sq = scr; float* sp = scr + 128;
    for (int item = gw; item < MT * NH; item += NGW) {
        const int t = item >> 3, h = item & 7, b = t >> 12, ts = t & 4095, qb = ts >> 8, tq = ts & 255;
        const bf16_t* qrow = proj + (size_t)t * NPROJ + h * HD;
        const unsigned qq = *(const unsigned*)(qrow + 2 * lane);
        const float q0 = bf2f(qq & 0xffffu) * qscale_inv, q1 = bf2f(qq >> 16) * qscale_inv;
        asm volatile("s_waitcnt lgkmcnt(0)" ::: "memory");
        sq[2 * lane] = q0; sq[2 * lane + 1] = q1;
        float g[16];
#pragma unroll
        for (int i = 0; i < 16; ++i) { const float* km = kmean + (size_t)((b * 8 + h) * 16 + i) * HD; const float p = wave_sum(q0 * km[2 * lane] + q1 * km[2 * lane + 1]); g[i] = (i < qb) ? p : -INFINITY; }
        int sel[4];
#pragma unroll
        for (int r = 0; r < 3; ++r) { float best = -INFINITY; int bi = -1;
#pragma unroll
            for (int i = 0; i < 16; ++i) if (g[i] > best) { best = g[i]; bi = i; }
            sel[r] = bi;
#pragma unroll
            for (int i = 0; i < 16; ++i) if (i == bi) g[i] = -INFINITY; }
        sel[3] = qb;
        asm volatile("s_waitcnt lgkmcnt(0)" ::: "memory");
#pragma unroll
        for (int s = 0; s < 4; ++s) { const int blk = sel[s];
            for (int jj = 0; jj < 4; ++jj) { const int j = jj * 64 + lane; float sc = -INFINITY;
                if (blk >= 0 && (s < 3 || j <= tq)) sc = dot_q_row(sq, proj + (size_t)(b * SEQ + blk * MBLK + j) * NPROJ + 1024 + h * HD) * SM_SCALE;
                sp[s * 256 + j] = sc; } }
        asm volatile("s_waitcnt lgkmcnt(0)" ::: "memory");
        float m = -INFINITY; for (int i = lane; i < 1024; i += 64) m = fmaxf(m, sp[i]); m = wave_max(m);
        float l = 0.f; for (int i = lane; i < 1024; i += 64) { const float p = __expf(sp[i] - m); sp[i] = p; l += p; } l = wave_sum(l);
        asm volatile("s_waitcnt lgkmcnt(0)" ::: "memory");
        float o0 = 0.f, o1 = 0.f;
#pragma unroll
        for (int s = 0; s < 4; ++s) { const int blk = sel[s]; if (blk < 0) continue;
            const bf16_t* vb = proj + (size_t)(b * SEQ + blk * MBLK) * NPROJ + 2048 + h * HD + 2 * lane;
            for (int j = 0; j < 256; ++j) { const float p = sp[s * 256 + j]; const unsigned vv = *(const unsigned*)(vb + (size_t)j * NPROJ); o0 += p * bf2f(vv & 0xffffu); o1 += p * bf2f(vv >> 16); } }
        const float li = 1.f / l; o0 *= li; o1 *= li;
        const float rinv = rsqrtf(wave_sum(o0 * o0 + o1 * o1) * (1.f / HD) + EPS);
        *(unsigned*)(merged + (size_t)t * DM + h * HD + 2 * lane) = pk2(o0 * rinv * g_attn[h * HD + 2 * lane], o1 * rinv * g_attn[h * HD + 2 * lane + 1]);
    }
}
__device__ __forceinline__ void ph_conv_naive(const bf16_t* proj, const float* w_conv, const float* b_conv, const float* g_conv, bf16_t* merged, int gw, int NGW, int lane) {
    for (int item = gw; item < MT * 8; item += NGW) {
        const int t = item >> 3, grp = item & 7, ts = t & 4095; const int c = grp * 128 + 2 * lane;
        float y[2];
#pragma unroll
        for (int e = 0; e < 2; ++e) { float acc = b_conv[c + e];
#pragma unroll
            for (int k = 0; k < 3; ++k) { const int back = 2 - k; if (ts - back >= 0) { const bf16_t* r = proj + (size_t)(t - back) * NPROJ; acc += w_conv[k * CW + c + e] * (bf2f(r[3072 + c + e]) * bf2f(r[5120 + c + e])); } }
            y[e] = bf2f(proj[(size_t)t * NPROJ + 4096 + c + e]) * acc; }
        const float rinv = rsqrtf(wave_sum(y[0] * y[0] + y[1] * y[1]) * (1.f / HD) + EPS);
        *(unsigned*)(merged + (size_t)t * DM + AW + c) = pk2(y[0] * rinv * g_conv[c], y[1] * rinv * g_conv[c + 1]);
    }
}
__device__ __forceinline__ void ph_conv(const bf16_t* __restrict__ proj, const float* __restrict__ w_conv, const float* __restrict__ b_conv, const float* __restrict__ g_conv, bf16_t* __restrict__ merged, int gw, int NGW, int lane) {
    const int l16 = lane & 15, sub = lane >> 4, grp = gw & 7, c = grp * 128 + l16 * 8;
    float w0[8], w1[8], w2[8], bc[8], gc[8];
#pragma unroll
    for (int h = 0; h < 2; ++h) { const f32x4 a0 = *(const f32x4*)(w_conv + c + 4 * h), a1 = *(const f32x4*)(w_conv + CW + c + 4 * h), a2 = *(const f32x4*)(w_conv + 2 * CW + c + 4 * h), bb = *(const f32x4*)(b_conv + c + 4 * h), gg = *(const f32x4*)(g_conv + c + 4 * h);
#pragma unroll
        for (int e = 0; e < 4; ++e) { w0[4 * h + e] = a0[e]; w1[4 * h + e] = a1[e]; w2[4 * h + e] = a2[e]; bc[4 * h + e] = bb[e]; gc[4 * h + e] = gg[e]; } }
    const int step = (NGW >> 3) * 4;
    for (int t = (gw >> 3) * 4 + sub; t < MT; t += step) {
        const int ts = t & (SEQ - 1); const bf16_t* r0 = proj + (size_t)t * NPROJ + c;
        const u32x4 vb = *(const u32x4*)(r0 + 4096), c0 = *(const u32x4*)(r0 + 3072), x0 = *(const u32x4*)(r0 + 5120);
        u32x4 c1 = {0u, 0u, 0u, 0u}, x1 = c1, c2 = c1, x2 = c1;
        if (ts >= 1) { c1 = *(const u32x4*)(r0 - NPROJ + 3072); x1 = *(const u32x4*)(r0 - NPROJ + 5120); }
        if (ts >= 2) { c2 = *(const u32x4*)(r0 - 2 * NPROJ + 3072); x2 = *(const u32x4*)(r0 - 2 * NPROJ + 5120); }
        float y[8]; float ss = 0.f;
#pragma unroll
        for (int q = 0; q < 4; ++q)
#pragma unroll
            for (int hh = 0; hh < 2; ++hh) { const int e = 2 * q + hh;
                const float C0 = hh ? __uint_as_float(c0[q] & 0xffff0000u) : __uint_as_float(c0[q] << 16), X0 = hh ? __uint_as_float(x0[q] & 0xffff0000u) : __uint_as_float(x0[q] << 16);
                const float C1 = hh ? __uint_as_float(c1[q] & 0xffff0000u) : __uint_as_float(c1[q] << 16), X1 = hh ? __uint_as_float(x1[q] & 0xffff0000u) : __uint_as_float(x1[q] << 16);
                const float C2 = hh ? __uint_as_float(c2[q] & 0xffff0000u) : __uint_as_float(c2[q] << 16), X2 = hh ? __uint_as_float(x2[q] & 0xffff0000u) : __uint_as_float(x2[q] << 16);
                const float Bv = hh ? __uint_as_float(vb[q] & 0xffff0000u) : __uint_as_float(vb[q] << 16);
                const float acc = bc[e] + w2[e] * (C0 * X0) + w1[e] * (C1 * X1) + w0[e] * (C2 * X2);
                y[e] = Bv * acc; ss += y[e] * y[e]; }
        ss += __shfl_xor(ss, 1); ss += __shfl_xor(ss, 2); ss += __shfl_xor(ss, 4); ss += __shfl_xor(ss, 8);
        const float rinv = rsqrtf(ss * (1.f / HD) + EPS);
        u32x2 o; o.x = pg8::pk4_fp8(y[0] * rinv * gc[0], y[1] * rinv * gc[1], y[2] * rinv * gc[2], y[3] * rinv * gc[3]); o.y = pg8::pk4_fp8(y[4] * rinv * gc[4], y[5] * rinv * gc[5], y[6] * rinv * gc[6], y[7] * rinv * gc[7]);
        *(u32x2*)((unsigned char*)merged + (size_t)t * DM + AW + c) = o;
    }
}
__device__ __forceinline__ void ph_xattn_naive(const bf16_t* qx, const bf16_t* kvx, bf16_t* ox, float qscale_inv, float* scr, int gw, int NGW, int lane) {
    float* sq = scr; float* sp = scr + 128;
    for (int item = gw; item < MT * XH; item += NGW) {
        const int t = item >> 2, h = item & 3, b = t >> 12;
        const unsigned qq = *(const unsigned*)(qx + (size_t)t * XW + h * HD + 2 * lane);
        asm volatile("s_waitcnt lgkmcnt(0)" ::: "memory");
        sq[2 * lane] = bf2f(qq & 0xffffu) * qscale_inv; sq[2 * lane + 1] = bf2f(qq >> 16) * qscale_inv;
        asm volatile("s_waitcnt lgkmcnt(0)" ::: "memory");
        float m = -INFINITY;
        for (int jj = 0; jj < 4; ++jj) { const int j = jj * 64 + lane; const float sc = dot_q_row(sq, kvx + (size_t)(b * NMEM + j) * 1024 + h * HD) * SM_SCALE; sp[j] = sc; m = fmaxf(m, sc); }
        m = wave_max(m);
        asm volatile("s_waitcnt lgkmcnt(0)" ::: "memory");
        float l = 0.f; for (int i = lane; i < 256; i += 64) { const float p = __expf(sp[i] - m); sp[i] = p; l += p; } l = wave_sum(l);
        asm volatile("s_waitcnt lgkmcnt(0)" ::: "memory");
        float o0 = 0.f, o1 = 0.f; const bf16_t* vb = kvx + (size_t)(b * NMEM) * 1024 + 512 + h * HD + 2 * lane;
        for (int j = 0; j < 256; ++j) { const float p = sp[j]; const unsigned vv = *(const unsigned*)(vb + (size_t)j * 1024); o0 += p * bf2f(vv & 0xffffu); o1 += p * bf2f(vv >> 16); }
        const float li = 1.f / l;
        *(unsigned*)(ox + (size_t)t * XW + h * HD + 2 * lane) = pk2(o0 * li, o1 * li);
    }
}

namespace moba {
using bf16x8 = __attribute__((ext_vector_type(8))) short;
using s16x4  = __attribute__((ext_vector_type(4))) short;
using f32x16 = __attribute__((ext_vector_type(16))) float;
using u32x4v = __attribute__((ext_vector_type(4))) unsigned;
using f32x4v = __attribute__((ext_vector_type(4))) float;
constexpr int D = 128, NW = 8, QBLK = 32, KVBLK = 64;
constexpr float SCALE = 0.088388347648318440f, THR = 8.f;
constexpr int SHM_V = KVBLK * D * 2, SHM_K = KVBLK * D * 2;
constexpr int OFF_V = 0, OFF_K = 2 * SHM_V, OFF_WS = OFF_K + 2 * SHM_K, OFF_KM = OFF_WS + NW * 256, OFF_RS = OFF_KM + 16 * 128 * 4, RS_BYTES = (32 * 33 + 32) * 4, LDS_END = OFF_RS + NW * RS_BYTES;
static_assert(LDS_END <= 131072, "moba LDS");
#define KSWZ(row, colB) ((row) * 256 + ((colB) ^ (((row) & 7) << 4)))
#define SBAR() __builtin_amdgcn_sched_barrier(0)
__device__ __forceinline__ int crow(int r, int hi) { return (r & 3) + 8 * (r >> 2) + 4 * hi; }
__device__ __forceinline__ unsigned cvtpk(float lo, float hi) { unsigned r; asm volatile("v_cvt_pk_bf16_f32 %0, %1, %2" : "=v"(r) : "v"(lo), "v"(hi)); return r; }
__device__ __forceinline__ void partialSM(f32x16& p0, f32x16& p1, float& m_reg, float& mn, float& alpha) {
  constexpr float C = SCALE * 1.4426950408889634f;
  float pmax = p0[0];
#pragma unroll
  for (int r = 1; r < 16; ++r) pmax = fmaxf(pmax, p0[r]);
#pragma unroll
  for (int r = 0; r < 16; ++r) pmax = fmaxf(pmax, p1[r]);
  { auto rr = __builtin_amdgcn_permlane32_swap(__float_as_uint(pmax), __float_as_uint(pmax), false, false);
    pmax = fmaxf(__uint_as_float(rr[0]), __uint_as_float(rr[1])); }
  if (__builtin_expect(__all(pmax - m_reg <= THR / SCALE), 1)) { mn = m_reg; alpha = 1.f; }
  else { mn = fmaxf(m_reg, pmax); alpha = __builtin_amdgcn_exp2f((m_reg - mn) * C); m_reg = mn; }
  float mnC = -mn * C;
#pragma unroll
  for (int r = 0; r < 16; ++r) p0[r] = fmaf(p0[r], C, mnC);
#pragma unroll
  for (int r = 0; r < 16; ++r) p1[r] = fmaf(p1[r], C, mnC);
#pragma unroll
  for (int r = 0; r < 16; ++r) p0[r] = __builtin_amdgcn_exp2f(p0[r]);
}
__device__ __forceinline__ void finishSM(f32x16& p0, f32x16& p1, float alpha, float& l_reg, bf16x8& pa0, bf16x8& pa1, bf16x8& pa2, bf16x8& pa3) {
#pragma unroll
  for (int r = 0; r < 16; ++r) p1[r] = __builtin_amdgcn_exp2f(p1[r]);
  float ps = 0;
#pragma unroll
  for (int r = 0; r < 16; ++r) ps += p0[r];
#pragma unroll
  for (int r = 0; r < 16; ++r) ps += p1[r];
  { auto rr = __builtin_amdgcn_permlane32_swap(__float_as_uint(ps), __float_as_uint(ps), false, false);
    ps = __uint_as_float(rr[0]) + __uint_as_float(rr[1]); }
  l_reg = l_reg * alpha + ps;
#define PK4(P, BASE, OUT) do { unsigned a0 = cvtpk(P[BASE + 0], P[BASE + 1]), a1 = cvtpk(P[BASE + 2], P[BASE + 3]);   \
    unsigned b0 = cvtpk(P[BASE + 4], P[BASE + 5]), b1 = cvtpk(P[BASE + 6], P[BASE + 7]);                              \
    auto r0 = __builtin_amdgcn_permlane32_swap(a0, b0, false, false); auto r1 = __builtin_amdgcn_permlane32_swap(a1, b1, false, false); \
    u32x4v w = {r0[0], r1[0], r0[1], r1[1]}; OUT = *reinterpret_cast<bf16x8*>(&w); } while (0)
  PK4(p0, 0, pa0); PK4(p0, 8, pa1); PK4(p1, 0, pa2); PK4(p1, 8, pa3);
#undef PK4
}
__device__ __forceinline__ void qkt(f32x16& p0, f32x16& p1, const char* Ks, const bf16x8* qr, int r32, int hi, float binit = 0.f) {
#pragma unroll
  for (int r = 0; r < 16; ++r) { p0[r] = binit; p1[r] = binit; }
#pragma unroll
  for (int d0 = 0; d0 < 8; ++d0) { int cb = (d0 * 16 + hi * 8) * 2;
    bf16x8 b0 = *reinterpret_cast<const bf16x8*>(Ks + KSWZ(r32, cb));
    bf16x8 b1 = *reinterpret_cast<const bf16x8*>(Ks + KSWZ(32 + r32, cb));
    p0 = __builtin_amdgcn_mfma_f32_32x32x16_bf16(b0, qr[d0], p0, 0, 0, 0);
    p1 = __builtin_amdgcn_mfma_f32_32x32x16_bf16(b1, qr[d0], p1, 0, 0, 0); }
}
__device__ __forceinline__ int v_st(int k, int c) { const int kk = (k & ~0xC) | ((k & 4) << 1) | ((k & 8) >> 1); return ((kk >> 3) * 4 + (c >> 5)) * 512 + ((kk & 7) * 32 + (c & 31)) * 2; }
__device__ __forceinline__ int v_rd_base(int lane) { return ((lane & 3) << 3) | (((lane >> 2) & 3) << 6) | (((lane >> 4) & 1) << 5) | (((lane >> 5) & 1) << 8); }
constexpr int v_rd_off(int d0, int ks, int half) { return d0 * 512 + ks * 4096 + half * 2048; }
template <int OFF> __device__ __forceinline__ s16x4 tr_read(int vb) {
  s16x4 r; asm volatile("ds_read_b64_tr_b16 %0, %1 offset:%2" : "=&v"(r) : "v"(vb), "i"(OFF) : "memory"); return r;
}
template <int D0> __device__ __forceinline__ void pv_one(f32x16& od, int vb, bf16x8 pa0, bf16x8 pa1, bf16x8 pa2, bf16x8 pa3) {
  const s16x4 l0 = tr_read<v_rd_off(D0, 0, 0)>(vb), h0 = tr_read<v_rd_off(D0, 0, 1)>(vb), l1 = tr_read<v_rd_off(D0, 1, 0)>(vb), h1 = tr_read<v_rd_off(D0, 1, 1)>(vb);
  const s16x4 l2 = tr_read<v_rd_off(D0, 2, 0)>(vb), h2 = tr_read<v_rd_off(D0, 2, 1)>(vb), l3 = tr_read<v_rd_off(D0, 3, 0)>(vb), h3 = tr_read<v_rd_off(D0, 3, 1)>(vb);
  asm volatile("s_waitcnt lgkmcnt(0)" ::: "memory"); SBAR();
#define PK(L, H) (bf16x8){L[0], L[1], L[2], L[3], H[0], H[1], H[2], H[3]}
  od = __builtin_amdgcn_mfma_f32_32x32x16_bf16(pa0, PK(l0, h0), od, 0, 0, 0);
  od = __builtin_amdgcn_mfma_f32_32x32x16_bf16(pa1, PK(l1, h1), od, 0, 0, 0);
  od = __builtin_amdgcn_mfma_f32_32x32x16_bf16(pa2, PK(l2, h2), od, 0, 0, 0);
  od = __builtin_amdgcn_mfma_f32_32x32x16_bf16(pa3, PK(l3, h3), od, 0, 0, 0);
#undef PK
}
__device__ __forceinline__ void pv_d0(f32x16* o, int vb, bf16x8 pa0, bf16x8 pa1, bf16x8 pa2, bf16x8 pa3) {
  pv_one<0>(o[0], vb, pa0, pa1, pa2, pa3); pv_one<1>(o[1], vb, pa0, pa1, pa2, pa3); pv_one<2>(o[2], vb, pa0, pa1, pa2, pa3); pv_one<3>(o[3], vb, pa0, pa1, pa2, pa3);
}
template <int MODE> __device__ __forceinline__ float tile_bias(int j, int qb, unsigned selmask) {
  if constexpr (MODE != 0) return 0.f;
  const int kb = j >> 2;
  return (kb < qb && !((selmask >> kb) & 1u)) ? -INFINITY : 0.f;
}
template <int MODE> __device__ __forceinline__ void tile_causal(f32x16& p0, f32x16& p1, int j, int qb, int qrow, int hi) {
  if constexpr (MODE != 0) return;
  if ((j >> 2) < qb) return;
  const int kbase = (j & 3) * 64;
#pragma unroll
  for (int r = 0; r < 16; ++r) { const int key = kbase + crow(r, hi); if (key > qrow) p0[r] = -INFINITY; if (key + 32 > qrow) p1[r] = -INFINITY; }
}
template <int MODE> __device__ __forceinline__ void unit(int b, int h, int qb, const bf16_t* __restrict__ proj, const bf16_t* __restrict__ kvp, const float* __restrict__ kmean, const float* __restrict__ gain, bf16_t* __restrict__ merged, char* lds) {
  constexpr int LDQ = MODE == 0 ? NPROJ : XW, LDK = MODE == 0 ? NPROJ : 2 * XW, LDO = MODE == 0 ? DM : XW;
  const int tid = otid(), wid = tid >> 6, lane = tid & 63, r32 = lane & 31, hi = lane >> 5;
  char* V_lds = lds + OFF_V; char* K_lds = lds + OFF_K;
  float* ws = (float*)(lds + OFF_WS) + wid * 64; float* li_l = ws; float* al_l = ws + 32;
  char* KM = lds + OFF_KM; float* RS = (float*)(lds + OFF_RS + wid * RS_BYTES); float* RV = RS + 32 * 33;
  const long rowbase = (long)b * SEQ;
  const bf16_t* Qw = proj + (rowbase + qb * 256 + wid * QBLK + r32) * LDQ + h * D + hi * 8;
  const bf16_t* Kh = MODE == 0 ? proj + rowbase * LDK + 1024 + h * D : kvp + (long)b * NMEM * LDK + h * D;
  const bf16_t* Vh = MODE == 0 ? proj + rowbase * LDK + 2048 + h * D : kvp + (long)b * NMEM * LDK + XW + h * D;
  __syncthreads();
  if constexpr (MODE == 0)
  { const int blk = tid >> 5, c4 = (tid & 31) * 4;
    const f32x4v kv = *(const f32x4v*)(kmean + (size_t)((b * 8 + h) * 16 + blk) * D + c4);
    unsigned hb[4], lb[4];
#pragma unroll
    for (int e = 0; e < 4; ++e) { hb[e] = f2bf(kv[e]); lb[e] = f2bf(kv[e] - __uint_as_float(hb[e] << 16)); }
    typedef unsigned u32x2v __attribute__((ext_vector_type(2)));
    *(u32x2v*)(KM + KSWZ(blk, c4 * 2)) = (u32x2v){hb[0] | (hb[1] << 16), hb[2] | (hb[3] << 16)};
    *(u32x2v*)(KM + KSWZ(16 + blk, c4 * 2)) = (u32x2v){lb[0] | (lb[1] << 16), lb[2] | (lb[3] << 16)}; }
  float m_reg = -1e30f, l_reg = 0; f32x16 o[4] = {}; bf16x8 qr[8];
#pragma unroll
  for (int d0 = 0; d0 < 8; ++d0) qr[d0] = *reinterpret_cast<const bf16x8*>(Qw + d0 * 16);
  const int sr = tid >> 4, sc = (tid & 15) * 8, vst0 = v_st(sr, sc), vst1 = v_st(32 + sr, sc);
  const int vb0 = (int)(uintptr_t)V_lds + v_rd_base(lane);
  struct { bf16x8 vs0, vs1, ks0, ks1; } sr_[1];
#define SLOAD(i, k0) do { sr_[i].vs0 = *reinterpret_cast<const bf16x8*>(&Vh[(long)((k0) + sr) * LDK + sc]); sr_[i].vs1 = *reinterpret_cast<const bf16x8*>(&Vh[(long)((k0) + 32 + sr) * LDK + sc]); \
    sr_[i].ks0 = *reinterpret_cast<const bf16x8*>(&Kh[(long)((k0) + sr) * LDK + sc]); sr_[i].ks1 = *reinterpret_cast<const bf16x8*>(&Kh[(long)((k0) + 32 + sr) * LDK + sc]); } while (0)
#define SWRITE(bb, i) do { *(bf16x8*)(V_lds + (bb) * SHM_V + vst0) = sr_[i].vs0;          \
    *(bf16x8*)(V_lds + (bb) * SHM_V + vst1) = sr_[i].vs1; int kc = sc * 2;               \
    *(bf16x8*)(K_lds + (bb) * SHM_K + KSWZ(sr, kc)) = sr_[i].ks0;                       \
    *(bf16x8*)(K_lds + (bb) * SHM_K + KSWZ(32 + sr, kc)) = sr_[i].ks1; } while (0)
#define SWAIT() asm volatile("s_waitcnt vmcnt(0)" ::: "memory")
#define RESC(a) do { if (__any((a) < 1.f)) { if (hi == 0) al_l[r32] = (a); asm volatile("s_waitcnt lgkmcnt(0)" ::: "memory"); \
    _Pragma("unroll") for (int d = 0; d < 4; ++d) _Pragma("unroll") for (int r = 0; r < 16; ++r) o[d][r] *= al_l[crow(r, hi)]; } } while (0)
  const int NT = MODE == 0 ? 4 * (qb + 1) : 4;
  constexpr int SE = 0, SO = 0;
  SLOAD(SE, 0);
  __syncthreads();
  unsigned selmask = 0u;
  if constexpr (MODE == 0) {
    f32x16 gp = f32x16{};
#pragma unroll
    for (int d0 = 0; d0 < 8; ++d0) { const int cb = (d0 * 16 + hi * 8) * 2;
      const bf16x8 b0 = *reinterpret_cast<const bf16x8*>(KM + KSWZ(r32, cb));
      gp = __builtin_amdgcn_mfma_f32_32x32x16_bf16(b0, qr[d0], gp, 0, 0, 0); }
    float g[16];
#pragma unroll
    for (int r = 0; r < 8; ++r) { const float v = gp[r] + gp[r + 8];
      auto rr = __builtin_amdgcn_permlane32_swap(__float_as_uint(v), __float_as_uint(v), false, false);
      const int blo = (r < 4) ? r : 8 + (r - 4);
      g[blo] = __uint_as_float(rr[0]); g[blo + 4] = __uint_as_float(rr[1]); }
#pragma unroll
    for (int i = 0; i < 16; ++i) g[i] = (i < qb) ? g[i] : -INFINITY;
#pragma unroll
    for (int rnd = 0; rnd < 3; ++rnd) { float best = -INFINITY; int bi = -1;
#pragma unroll
      for (int i = 0; i < 16; ++i) if (g[i] > best) { best = g[i]; bi = i; }
      if (bi >= 0) selmask |= 1u << bi;
#pragma unroll
      for (int i = 0; i < 16; ++i) if (i == bi) g[i] = -INFINITY; }
  }
  const int qrow = wid * QBLK + r32;
  f32x16 pA0, pA1, pB0, pB1; float mnA, mnB, alA, alB; bf16x8 pa0, pa1, pa2, pa3;
  asm volatile("s_waitcnt vmcnt(0)" ::: "memory"); SWRITE(0, SE); __syncthreads();
  qkt(pA0, pA1, K_lds, qr, r32, hi, tile_bias<MODE>(0, qb, selmask)); tile_causal<MODE>(pA0, pA1, 0, qb, qrow, hi); partialSM(pA0, pA1, m_reg, mnA, alA);
  SLOAD(SO, KVBLK);
  SWAIT(); SWRITE(1, SO); __syncthreads();
  for (int j = 1; j + 1 < NT; j += 2) {
    SBAR(); qkt(pB0, pB1, K_lds + SHM_K, qr, r32, hi, tile_bias<MODE>(j, qb, selmask)); tile_causal<MODE>(pB0, pB1, j, qb, qrow, hi);
    finishSM(pA0, pA1, alA, l_reg, pa0, pa1, pa2, pa3); SBAR();
    SLOAD(SE, (j + 1) * KVBLK); SBAR();
    pv_d0(o, vb0, pa0, pa1, pa2, pa3); partialSM(pB0, pB1, m_reg, mnB, alB);
    __syncthreads(); SWAIT(); SWRITE(0, SE);
    RESC(alB); __syncthreads();
    SBAR(); qkt(pA0, pA1, K_lds, qr, r32, hi, tile_bias<MODE>(j + 1, qb, selmask)); tile_causal<MODE>(pA0, pA1, j + 1, qb, qrow, hi);
    finishSM(pB0, pB1, alB, l_reg, pa0, pa1, pa2, pa3); SBAR();
    SLOAD(SO, (j + 2) * KVBLK); SBAR();
    pv_d0(o, vb0 + SHM_V, pa0, pa1, pa2, pa3); partialSM(pA0, pA1, m_reg, mnA, alA);
    __syncthreads(); SWAIT(); SWRITE(1, SO);
    RESC(alA); __syncthreads();
  }
  SBAR(); qkt(pB0, pB1, K_lds + SHM_K, qr, r32, hi, tile_bias<MODE>(NT - 1, qb, selmask)); tile_causal<MODE>(pB0, pB1, NT - 1, qb, qrow, hi);
  finishSM(pA0, pA1, alA, l_reg, pa0, pa1, pa2, pa3); SBAR();
  pv_d0(o, vb0, pa0, pa1, pa2, pa3); partialSM(pB0, pB1, m_reg, mnB, alB);
  __syncthreads(); RESC(alB);
  finishSM(pB0, pB1, alB, l_reg, pa0, pa1, pa2, pa3); SBAR();
  pv_d0(o, vb0 + SHM_V, pa0, pa1, pa2, pa3);
  if (hi == 0) li_l[r32] = l_reg; asm volatile("s_waitcnt lgkmcnt(0)" ::: "memory");
  float rli[16];
#pragma unroll
  for (int r = 0; r < 16; ++r) rli[r] = __builtin_amdgcn_rcpf(li_l[crow(r, hi)]);
  if constexpr (MODE == 0) {
#pragma unroll
  for (int r = 0; r < 16; ++r) { float s = 0.f;
#pragma unroll
    for (int d0 = 0; d0 < 4; ++d0) { o[d0][r] *= rli[r]; s += o[d0][r] * o[d0][r]; }
    RS[crow(r, hi) * 33 + r32] = s; }
  asm volatile("s_waitcnt lgkmcnt(0)" ::: "memory");
  { float s = 0.f;
#pragma unroll
    for (int c = 0; c < 32; ++c) s += RS[r32 * 33 + c];
    if (hi == 0) RV[r32] = rsqrtf(s * (1.f / D) + EPS); }
  asm volatile("s_waitcnt lgkmcnt(0)" ::: "memory");
  float gn[4];
#pragma unroll
  for (int d0 = 0; d0 < 4; ++d0) gn[d0] = gain[h * D + d0 * 32 + r32];
  unsigned char* Ow8 = (unsigned char*)merged + (rowbase + qb * 256 + wid * QBLK) * LDO + h * D;
#pragma unroll
  for (int r = 0; r < 16; ++r) { const int orow = crow(r, hi); const float rv = RV[orow];
#pragma unroll
    for (int d0 = 0; d0 < 4; ++d0) { const float vv = __builtin_amdgcn_fmed3f(o[d0][r] * rv * gn[d0], -448.f, 448.f); Ow8[(long)orow * LDO + d0 * 32 + r32] = (unsigned char)(__builtin_amdgcn_cvt_pk_fp8_f32(vv, vv, 0, false) & 0xff); } }
  } else {
    unsigned char* Ow8 = (unsigned char*)merged + (rowbase + qb * 256 + wid * QBLK) * LDO + h * D;
#pragma unroll
    for (int r = 0; r < 16; ++r) { const int orow = crow(r, hi);
#pragma unroll
      for (int d0 = 0; d0 < 4; ++d0) { const float vv = __builtin_amdgcn_fmed3f(o[d0][r] * rli[r], -448.f, 448.f); Ow8[(long)orow * LDO + d0 * 32 + r32] = (unsigned char)(__builtin_amdgcn_cvt_pk_fp8_f32(vv, vv, 0, false) & 0xff); } }
  }
#undef SLOAD
#undef SWRITE
#undef SWAIT
#undef RESC
}
#undef KSWZ
#undef SBAR
}

#define LAS __attribute__((address_space(3)))
#define XB_TMO      128
#define XB_XCNT(j)  (256  + 64 * (j))
#define XB_XSUB(j)  (1280 + 64 * (j))
#define XB_XGEN(j)  (2304 + 64 * (j))
#define XB_TOP      3328
#define XB_TOPGEN   3392
#define XCD_BAR_WORDS 3456
#define XB_SPIN_CAP (1u << 18)

__device__ __forceinline__ unsigned xb_ld(unsigned* p)              { return __hip_atomic_load(p, __ATOMIC_RELAXED, __HIP_MEMORY_SCOPE_AGENT); }
__device__ __forceinline__ unsigned xb_add(unsigned* p, unsigned v) { return __hip_atomic_fetch_add(p, v, __ATOMIC_RELAXED, __HIP_MEMORY_SCOPE_AGENT); }
__device__ __forceinline__ unsigned xb_xcc_id() { return (unsigned)__builtin_amdgcn_s_getreg((3 << 11) | 20) & 0xFu; }
#define XB_SPIN(cond, bar) do { unsigned _sp = 0; while (cond) { __builtin_amdgcn_s_sleep(1); \
    if ((++_sp & 255u) == 0u) { if (xb_ld(&(bar)[XB_TMO])) break; if (_sp > XB_SPIN_CAP) { atomicAdd(&(bar)[XB_TMO], 1u); break; } } } } while (0)

struct XcdBarrier {
    unsigned* bar; unsigned x;
    volatile LAS unsigned* st;
};

__device__ __forceinline__ XcdBarrier xcd_barrier_post(unsigned* bar, volatile LAS unsigned* st) {
    XcdBarrier b; b.bar = bar; b.x = xb_xcc_id(); b.st = st;
    if (threadIdx.x == 0) (void)xb_add(&bar[XB_XCNT(b.x)], 1u);
    return b;
}
__device__ __forceinline__ void xcd_barrier_complete(unsigned* bar, unsigned x, unsigned& nloc, unsigned& nx) {
    const unsigned G = gridDim.x * gridDim.y * gridDim.z;
    unsigned sum, cnt, mine, sp = 0u;
    for (;;) {
        sum = 0u; cnt = 0u; mine = 0u;
#pragma unroll
        for (unsigned j = 0; j < 16; ++j) { const unsigned c = xb_ld(&bar[XB_XCNT(j)]); sum += c; cnt += (c > 0u) ? 1u : 0u; mine = (j == x) ? c : mine; }
        if (sum == G) break;
        __builtin_amdgcn_s_sleep(1);
        if ((++sp & 255u) == 0u) { if (xb_ld(&bar[XB_TMO])) break; if (sp > XB_SPIN_CAP) { atomicAdd(&bar[XB_TMO], 1u); break; } }
    }
    nloc = mine > 0u ? mine : 1u; nx = cnt > 0u ? cnt : 1u;
}

__device__ __forceinline__ void xcd_barrier(const XcdBarrier& b) {
    asm volatile("s_waitcnt vmcnt(0)" ::: "memory");
    __syncthreads();
    if (threadIdx.x == 0) {
        unsigned* bar = b.bar;
        __builtin_amdgcn_s_waitcnt(0);
        unsigned nloc = b.st[0], nx = b.st[1];
        if (nloc == 0u) { xcd_barrier_complete(bar, b.x, nloc, nx); b.st[0] = nloc; b.st[1] = nx; }
        const unsigned old = xb_add(&bar[XB_XSUB(b.x)], 1u);
        const unsigned gen = old / nloc;
        if (old + 1u == (gen + 1u) * nloc) {
            __builtin_amdgcn_fence(__ATOMIC_RELEASE, "agent");
            asm volatile("s_waitcnt vmcnt(0)" ::: "memory");
            const unsigned og = xb_add(&bar[XB_TOP], 1u);
            const unsigned tg = og / nx;
            if (og + 1u == (tg + 1u) * nx) xb_add(&bar[XB_TOPGEN], 1u);
            else XB_SPIN(xb_ld(&bar[XB_TOPGEN]) == tg, bar);
            __builtin_amdgcn_fence(__ATOMIC_ACQUIRE, "agent");
            xb_add(&bar[XB_XGEN(b.x)], 1u);
            asm volatile("s_waitcnt vmcnt(0)" ::: "memory");
        } else {
            XB_SPIN(xb_ld(&bar[XB_XGEN(b.x)]) == gen, bar);
            __builtin_amdgcn_fence(__ATOMIC_ACQUIRE, "agent");
            asm volatile("s_waitcnt vmcnt(0)" ::: "memory");
        }
    }
    __syncthreads();
}

namespace cg = cooperative_groups;
constexpr int LDS_BYTES = 147456;
struct Args { const void* in[20]; float* out; unsigned char* ws; int flags, pad; };
__global__ void __launch_bounds__(512, 2) mk_fwd(Args a) {
    extern __shared__ __attribute__((aligned(16))) unsigned char lds[];
    cg::grid_group grid = cg::this_grid();
    const int G = (int)gridDim.x, bx = (int)blockIdx.x;
    const int NGW = G * 8, NT = G * 512;
    volatile LAS unsigned* bar_st = (volatile LAS unsigned*)((LAS unsigned char*)lds + 131072 + 64);
    { const int t0 = otid(); if (t0 < 2) bar_st[t0] = 0u; }
    __syncthreads();
    const XcdBarrier bar = xcd_barrier_post((unsigned*)(a.ws + WS_BAR), bar_st);
    if (a.flags != 0) grid.sync();
#define IDS() const int tid = otid(), lane = tid & 63, wave = __builtin_amdgcn_readfirstlane(tid >> 6); const int gw = bx * 8 + wave, gtid = bx * 512 + tid; float* wscr = (float*)(lds + wave * 16384); (void)lane; (void)gw; (void)gtid; (void)wscr
#define IN_F(k) ((const float*)a.in[k])
#define WSP(T, off) ((T)(a.ws + (off)))
#define x IN_F(0)
#define mem IN_F(1)
#define pos ((const int*)a.in[2])
#define g_mix IN_F(3)
#define w_in IN_F(4)
#define w_conv IN_F(5)
#define b_conv IN_F(6)
#define g_attn IN_F(7)
#define g_conv IN_F(8)
#define w_out IN_F(9)
#define g_xattn IN_F(10)
#define g_mem IN_F(11)
#define w_xq IN_F(12)
#define w_xkv IN_F(13)
#define w_xo IN_F(14)
#define g_ffn IN_F(15)
#define w_gate IN_F(16)
#define w_up IN_F(17)
#define w_down IN_F(18)
#define g_final IN_F(19)
#define out (a.out)
#define Win WSP(bf16_t*, WS_WIN)
#define Wout WSP(bf16_t*, WS_WOUT)
#define Wxq WSP(bf16_t*, WS_WXQ)
#define Wxkv WSP(bf16_t*, WS_WXKV)
#define Wxo WSP(bf16_t*, WS_WXO)
#define Wgu WSP(bf16_t*, WS_WGU)
#define Wdn WSP(bf16_t*, WS_WDN)
#define H WSP(bf16_t*, WS_H)
#define MRG WSP(bf16_t*, WS_MRG)
#define PROJ WSP(bf16_t*, WS_PROJ)
#define ACT WSP(bf16_t*, WS_ACT)
#define QX WSP(bf16_t*, WS_QX)
#define OX WSP(bf16_t*, WS_OX)
#define KVX WSP(bf16_t*, WS_KVX)
#define MEMN WSP(bf16_t*, WS_MEMN)
#define CS WSP(float*, WS_CS)
#define KMEAN WSP(float*, WS_KMEAN)
#define X8 WSP(unsigned char*, WS_X8)
#define RMAX WSP(float*, WS_RMAX)
#define CMAX WSP(float*, WS_CMAX)
#define H8 WSP(unsigned char*, WS_H8)
#define Win8 WSP(bf16_t*, WS_WIN + 8 * MiB)
#define SS1 WSP(float*, WS_SS)
#define SS2 WSP(float*, WS_SS + 2 * MiB)
#define SS3 WSP(float*, WS_SS + 4 * MiB)
    PG8_LAS unsigned char* ldsg = (PG8_LAS unsigned char*)lds;

#define COMMA ,
#define GEMM(EpiT, Aop, Bop, Mr, Nc, Kd, ...) do { pg8::Gemm g_{Aop, Bop, Mr, Nc, Kd, 0}; pg8::StaticOrder S_; S_.init(Mr, Nc, G, bx); EpiT E_{__VA_ARGS__}; \
        pg8::gemm_phase<EpiT, pg8::StaticOrder, true, true>(ldsg, g_, S_, E_); } while (0)
#define GEMM8(EpiT, Aop, Bop, Mr, Nc, Kd, ...) do { pg8::Gemm g_{Aop, Bop, Mr, Nc, Kd, 0}; pg8::StaticOrder S_; S_.init(Mr, Nc, G, bx); EpiT E_{__VA_ARGS__}; \
        pg8::gemm_phase<EpiT, pg8::StaticOrder, true, true, 1, 0x77777777>(ldsg, g_, S_, E_); } while (0)
#define GEMMI8(EpiT, Aop, Bop, Mr, Nc, Kd, ...) do { pg8::Gemm g_{Aop, Bop, Mr, Nc, Kd, 0}; pg8::StaticOrder S_; S_.init(Mr, Nc, G, bx); EpiT E_{__VA_ARGS__}; \
        pg8::gemm_phase<EpiT, pg8::StaticOrder, true, true, 2>(ldsg, g_, S_, E_); } while (0)

    {
        IDS();
        int base = 0;
        base = ph_transpose_job(TJob{w_in, nullptr, nullptr, Win, DM, NPROJ, 2048, 1, 1.f, 0, nullptr}, base, wscr, gw, NGW, lane);
        base = ph_transpose_job(TJob{w_out, nullptr, nullptr, Wout, DM, DM, DM, 0, 256.f, 1, nullptr}, base, wscr, gw, NGW, lane);
        base = ph_transpose_job(TJob{w_xq, nullptr, g_xattn, Wxq, DM, XW, XW, 0, 256.f, 1, nullptr}, base, wscr, gw, NGW, lane);
        base = ph_transpose_job(TJob{w_xkv, nullptr, nullptr, Wxkv, DM, 2 * XW, 2 * XW, 0, 1.f, 0, nullptr}, base, wscr, gw, NGW, lane);
        base = ph_transpose_job(TJob{w_xo, nullptr, nullptr, Wxo, XW, DM, DM, 0, 256.f, 1, nullptr}, base, wscr, gw, NGW, lane);
    }
    { IDS(); ph_colmax(w_in + 2048, DM, NPROJ, 4096, CMAX, gw, NGW, lane); }
    { IDS(); ph_cs(pos, CS, gtid, NT); for (int i = gtid; i < NB * NH * NBLK * HD; i += NT) KMEAN[i] = 0.f; }
    xcd_barrier(bar);
    { IDS(); ph_rms_bf16(x, g_mix, H, H8, RMAX, MT, gw, NGW, lane); ph_rms_bf16(mem, g_mem, MEMN, nullptr, nullptr, NB * NMEM, gw, NGW, lane); }
    { IDS(); (void)ph_transpose_job(TJob{w_in + 2048, nullptr, nullptr, Win8, DM, NPROJ, 4096, 0, 1.f, 2, CMAX}, 0, wscr, gw, NGW, lane); }
    xcd_barrier(bar);
    GEMM(pg8::EpiInProj, H, Win, MT, 2048, DM, PROJ, CS, KMEAN);
    GEMMI8(pg8::EpiScaledBf16, (const bf16_t*)H8, Win8, MT, 4096, DM, PROJ + 2048, RMAX, CMAX, NPROJ, 0);
    xcd_barrier(bar);
    {
        const int vcu = (G % 8 == 0) ? (bx % 8) * (G / 8) + bx / 8 : bx;
        for (int p = vcu; p < NB * NH * 8; p += G) {
            const int bh = p >> 3, s = p & 7;
            moba::unit<0>(bh >> 3, bh & 7, s, PROJ, nullptr, KMEAN, g_attn, MRG, (char*)lds);
            moba::unit<0>(bh >> 3, bh & 7, 15 - s, PROJ, nullptr, KMEAN, g_attn, MRG, (char*)lds);
        }
        __syncthreads();
    }
    { IDS(); ph_conv(PROJ, w_conv, b_conv, g_conv, MRG, gw, NGW, lane); }
    xcd_barrier(bar);
    GEMM8(pg8::EpiRes<true COMMA true>, MRG, Wout, MT, DM, DM, x, H, X8, SS1);
    xcd_barrier(bar);
    GEMM8(pg8::EpiRowScaleBf16, (const bf16_t*)X8, Wxq, MT, XW, DM, QX, SS1, XW, 0);
    { pg8::Gemm g_{MEMN, Wxkv, NB * NMEM, 2 * XW, DM, 0}; pg8::StaticOrder S_; S_.init(NB * NMEM, 2 * XW, G, (bx + G - 128 % G) % G); pg8::EpiStoreBf16 E_{KVX, 2 * XW, 0};
      pg8::gemm_phase<pg8::EpiStoreBf16, pg8::StaticOrder, true, true>(ldsg, g_, S_, E_); }
    {
        IDS();
        const int nidle = (G > 144 + 16) ? G - 144 : G, first = (G > 144 + 16) ? 144 : 0;
        if (bx >= first) {
            const int gw2 = (bx - first) * 8 + wave, NGW2 = nidle * 8; int base = 0;
            base = ph_transpose_job(TJob{w_gate, w_up, g_ffn, Wgu, DM, DFF, 2 * DFF, 2, 256.f, 1, nullptr}, base, wscr, gw2, NGW2, lane);
            base = ph_transpose_job(TJob{w_down, nullptr, nullptr, Wdn, DFF, DM, DM, 0, 256.f, 1, nullptr}, base, wscr, gw2, NGW2, lane);
        }
    }
    xcd_barrier(bar);
    {
        const int vcu = (G % 8 == 0) ? (bx % 8) * (G / 8) + bx / 8 : bx;
        for (int p = vcu; p < NB * XH * (SEQ / 256); p += G) { const int bh = p >> 4, qt = p & 15; moba::unit<1>(bh >> 2, bh & 3, qt, QX, KVX, nullptr, nullptr, OX, (char*)lds); }
        __syncthreads();
    }
    xcd_barrier(bar);
    GEMM8(pg8::EpiRes<false COMMA true>, OX, Wxo, MT, DM, XW, H, H, X8, SS2);
    xcd_barrier(bar);
    GEMM8(pg8::EpiSwiGLUNorm<true>, (const bf16_t*)X8, Wgu, MT, 2 * DFF, DM, ACT, SS2, DFF, 0);
    xcd_barrier(bar);
    GEMM8(pg8::EpiRes<false COMMA false>, ACT, Wdn, MT, DM, DFF, H, H, nullptr, SS3);
    xcd_barrier(bar);
    { IDS(); ph_final_norm(H, out, g_final, SS3, MT, gw, NGW, lane); }
#undef GEMM
#undef COMMA
#undef GEMM8
#undef GEMMI8
#undef IDS
#undef x
#undef mem
#undef pos
#undef g_mix
#undef w_in
#undef w_conv
#undef b_conv
#undef g_attn
#undef g_conv
#undef w_out
#undef g_xattn
#undef g_mem
#undef w_xq
#undef w_xkv
#undef w_xo
#undef g_ffn
#undef w_gate
#undef w_up
#undef w_down
#undef g_final
#undef out
#undef Win
#undef Wout
#undef Wxq
#undef Wxkv
#undef Wxo
#undef Wgu
#undef Wdn
#undef H
#undef MRG
#undef PROJ
#undef ACT
#undef QX
#undef OX
#undef KVX
#undef MEMN
#undef CS
#undef KMEAN
#undef SS1
#undef X8
#undef RMAX
#undef CMAX
#undef H8
#undef Win8
#undef SS2
#undef SS3
#undef IN_F
#undef WSP
}

extern "C" void kernel_launch(void* const* d_in, const int* in_sizes, int n_in, void* d_out, int out_size, void* d_ws, size_t ws_size, hipStream_t stream) {
    static int grid_blocks = 0;
    if (grid_blocks == 0) {
        if (n_in != 20 || ws_size < WS_END) { fprintf(stderr, "kernel_launch: unexpected n_in %d / ws %zu\n", n_in, ws_size); grid_blocks = -1; return; }
        int dev = 0, cus = 0, per_cu = 0;
        (void)hipGetDevice(&dev); (void)hipDeviceGetAttribute(&cus, hipDeviceAttributeMultiprocessorCount, dev);
        (void)hipFuncSetAttribute((const void*)mk_fwd, hipFuncAttributeMaxDynamicSharedMemorySize, LDS_BYTES);
        (void)hipOccupancyMaxActiveBlocksPerMultiprocessor(&per_cu, (const void*)mk_fwd, 512, LDS_BYTES);
        if (per_cu < 1) { fprintf(stderr, "kernel_launch: occupancy query says %d blocks per CU\n", per_cu); per_cu = 1; }
        grid_blocks = cus;
        (void)hipGetLastError();
    }
    if (grid_blocks < 0) return;
    Args a{};
    for (int i = 0; i < 20; ++i) a.in[i] = d_in[i];
    a.out = (float*)d_out; a.ws = (unsigned char*)d_ws;
    (void)hipMemsetAsync((unsigned char*)d_ws + WS_BAR, 0, 32768, stream);
    void* args[] = {&a};
    hipError_t e = hipLaunchCooperativeKernel((const void*)mk_fwd, dim3(grid_blocks), dim3(512), args, LDS_BYTES, stream);
    if (e != hipSuccess) fprintf(stderr, "cooperative launch failed: %s (grid %d)\n", hipGetErrorString(e), grid_blocks);
}
```
